# Optimizing an MI355X kernel written in HIP

```python
import math
import jax
import jax.numpy as jnp
from jax import lax
import numpy as np

D_MODEL = 1024
BATCH = 8
SEQ = 8192
DEPTH = 1
DEC_BATCH = 32
DEC_SEQ = 64
PAST_LEN = 4096

CHUNK = 64
Q_BLOCK = 128
D_MIX = D_MODEL
D_ATTN = D_MIX // 2
D_SSM = D_MIX - D_ATTN
N_HEADS = 8
QK_NOPE = 64
QK_ROPE = 32
V_DIM = D_ATTN // N_HEADS
KV_LORA = 256
Q_LORA = 768
ROPE_THETA = 10000.0
SSM_GROUP = 16
N_SSM_GROUPS = D_SSM // SSM_GROUP
SSM_STATE = 64
D_FF = 4 * D_MODEL
D_IN = Q_LORA + KV_LORA + QK_ROPE + D_SSM
SPLITS = (Q_LORA, Q_LORA + KV_LORA, Q_LORA + KV_LORA + QK_ROPE)
SOFTMAX_SCALE = (QK_NOPE + QK_ROPE) ** -0.5
EPS = 1e-6
NEG_INF = -1e30

kernel_name = "hybrid_mla_s5_streaming_step"


def rmsnorm(x, g):
    xf = x.astype(jnp.float32)
    y = xf * lax.rsqrt(jnp.mean(xf * xf, axis=-1, keepdims=True) + EPS)
    return (y * g.astype(jnp.float32)).astype(x.dtype)


def apply_rope(x, pos):
    rdim = x.shape[-1]
    half = rdim // 2
    inv_freq = ROPE_THETA ** (-(jnp.arange(half, dtype=jnp.float32) * 2.0) / rdim)
    ang = pos.astype(jnp.float32)[:, None] * inv_freq[None, :]
    cos = jnp.cos(ang)[None, :, None, :]
    sin = jnp.sin(ang)[None, :, None, :]
    xf = x.astype(jnp.float32)
    x1, x2 = xf[..., :half], xf[..., half:]
    return jnp.concatenate([x1 * cos - x2 * sin, x1 * sin + x2 * cos], axis=-1).astype(x.dtype)


def chunk_attention(q, k, v, q_pos, k_pos):
    s = jnp.einsum("bqhd,bkhd->bhqk", q, k, preferred_element_type=jnp.float32) * SOFTMAX_SCALE
    visible = (k_pos[None, :] // CHUNK) <= (q_pos[:, None] // CHUNK)
    s = jnp.where(visible[None, None], s, NEG_INF)
    p = jax.nn.softmax(s, axis=-1)
    return jnp.einsum("bhqk,bkhd->bqhd", p.astype(v.dtype), v)


def mla_attention(q, k, v, q_pos, k_pos):
    bsz, t = q.shape[0], q.shape[1]
    if t <= Q_BLOCK:
        return chunk_attention(q, k, v, q_pos, k_pos)
    nb = t // Q_BLOCK
    qb = q.reshape(bsz, nb, Q_BLOCK, N_HEADS, q.shape[-1]).transpose(1, 0, 2, 3, 4)
    pb = q_pos.reshape(nb, Q_BLOCK)
    ob = lax.map(lambda args: chunk_attention(args[0], k, v, args[1], k_pos), (qb, pb))
    return ob.transpose(1, 0, 2, 3, 4).reshape(bsz, t, N_HEADS, V_DIM)


def s5_discretize(a_re, a_im, log_step):
    dt = jnp.exp(log_step.astype(jnp.float32))[:, None]
    lr, li = a_re.astype(jnp.float32), a_im.astype(jnp.float32)
    mag = jnp.exp(lr * dt)
    lb_re, lb_im = mag * jnp.cos(li * dt), mag * jnp.sin(li * dt)
    nr, ni = lb_re - 1.0, lb_im
    den = lr * lr + li * li
    coef_re = (nr * lr + ni * li) / den
    coef_im = (ni * lr - nr * li) / den
    return lb_re, lb_im, coef_re, coef_im


def _ssm_combine(e1, e2):
    a1r, a1i, b1r, b1i = e1
    a2r, a2i, b2r, b2i = e2
    return (a1r * a2r - a1i * a2i,
            a1r * a2i + a1i * a2r,
            a2r * b1r - a2i * b1i + b2r,
            a2r * b1i + a2i * b1r + b2i)


def s5_mixer(u, h0_re, h0_im, a_re, a_im, log_step, b_re, b_im, c_re, c_im, d_skip, w_glu):
    bsz, t, _ = u.shape
    f32 = jnp.float32
    lb_re, lb_im, coef_re, coef_im = s5_discretize(a_re, a_im, log_step)
    uf = u.astype(f32).reshape(bsz, t, N_SSM_GROUPS, SSM_GROUP)
    bu_re = jnp.einsum("btgp,gnp->btgn", uf, b_re.astype(f32))
    bu_im = jnp.einsum("btgp,gnp->btgn", uf, b_im.astype(f32))
    x_re = coef_re * bu_re - coef_im * bu_im
    x_im = coef_re * bu_im + coef_im * bu_re
    h0r, h0i = h0_re.astype(f32), h0_im.astype(f32)
    x_re = x_re.at[:, 0].add(lb_re * h0r - lb_im * h0i)
    x_im = x_im.at[:, 0].add(lb_re * h0i + lb_im * h0r)
    shape = (1, t, N_SSM_GROUPS, SSM_STATE)
    a_r = jnp.broadcast_to(lb_re, shape)
    a_i = jnp.broadcast_to(lb_im, shape)
    _, _, h_re, h_im = lax.associative_scan(_ssm_combine, (a_r, a_i, x_re, x_im), axis=1)
    y = (jnp.einsum("btgn,gpn->btgp", h_re, c_re.astype(f32))
         - jnp.einsum("btgn,gpn->btgp", h_im, c_im.astype(f32))
         + d_skip.astype(f32).reshape(N_SSM_GROUPS, SSM_GROUP) * uf)
    y = jax.nn.gelu(y.reshape(bsz, t, D_SSM))
    y = y * jax.nn.sigmoid(y @ w_glu.astype(f32))
    return y.astype(u.dtype), h_re[:, -1].astype(h0_re.dtype), h_im[:, -1].astype(h0_im.dtype)


def hybrid_layer(x, pos, past_latent, past_k_rope, past_pos, h0_re, h0_im,
                 g_mix, w_in, g_q_a, w_q_up, g_kv_a, w_kv_up, a_re, a_im, log_step,
                 b_re, b_im, c_re, c_im, d_skip, w_glu, g_attn_out, g_ssm_out, w_out,
                 g_mlp, w_up, w_down):
    bsz, t, _ = x.shape
    xn = rmsnorm(x, g_mix)
    c_q, c_kv, k_pe, u = jnp.split(xn @ w_in, SPLITS, axis=-1)
    q = (rmsnorm(c_q, g_q_a) @ w_q_up).reshape(bsz, t, N_HEADS, QK_NOPE + QK_ROPE)
    q = jnp.concatenate([q[..., :QK_NOPE], apply_rope(q[..., QK_NOPE:], pos)], axis=-1)
    latent = rmsnorm(c_kv, g_kv_a)
    k_rope = apply_rope(k_pe[:, :, None, :], pos)[:, :, 0, :]
    if past_latent is None:
        all_latent, all_k_rope, k_pos = latent, k_rope, pos
    else:
        all_latent = jnp.concatenate([past_latent, latent], axis=1)
        all_k_rope = jnp.concatenate([past_k_rope, k_rope], axis=1)
        k_pos = jnp.concatenate([past_pos, pos], axis=0)
    tk = all_latent.shape[1]
    kv = (all_latent @ w_kv_up).reshape(bsz, tk, N_HEADS, QK_NOPE + V_DIM)
    k = jnp.concatenate(
        [kv[..., :QK_NOPE], jnp.broadcast_to(all_k_rope[:, :, None, :], (bsz, tk, N_HEADS, QK_ROPE))],
        axis=-1)
    v = kv[..., QK_NOPE:]
    attn = mla_attention(q, k, v, pos, k_pos).reshape(bsz, t, D_ATTN)
    ssm, h_re, h_im = s5_mixer(u, h0_re, h0_im, a_re, a_im, log_step,
                               b_re, b_im, c_re, c_im, d_skip, w_glu)
    mixed = jnp.concatenate([rmsnorm(attn, g_attn_out), rmsnorm(ssm, g_ssm_out)], axis=-1) @ w_out
    h = x + mixed
    hn = rmsnorm(h, g_mlp)
    h = h + jnp.square(jax.nn.relu(hn @ w_up)) @ w_down
    return h, latent, k_rope, h_re, h_im


def setup_inputs(seed: int = 0) -> dict:
    key = jax.random.key(seed)
    ks = jax.random.split(key, 32)
    f32 = jnp.float32
    nrm = lambda k, shape, scale: jax.random.normal(k, shape, f32) * scale
    gain = lambda k, shape: 1.0 + 0.01 * jax.random.normal(k, shape, f32)
    L, G, N, P = DEPTH, N_SSM_GROUPS, SSM_STATE, SSM_GROUP
    n_idx = jnp.arange(N, dtype=f32)
    a_re = -0.5 + 0.01 * jax.random.normal(ks[6], (L, G, N), f32)
    a_im = math.pi * n_idx[None, None, :] + 0.01 * jax.random.normal(ks[7], (L, G, N), f32)
    log_step = jax.random.uniform(ks[8], (L, G), f32, math.log(1e-3), math.log(1e-1))
    return {
        "x_prompt": nrm(ks[0], (BATCH, SEQ, D_MODEL), 1.0),
        "x_sample": nrm(ks[1], (DEC_BATCH, DEC_SEQ, D_MODEL), 1.0),
        "cache_kv_latent": nrm(ks[2], (L, DEC_BATCH, PAST_LEN, KV_LORA), 1.0),
        "cache_k_rope": nrm(ks[3], (L, DEC_BATCH, PAST_LEN, QK_ROPE), 1.0),
        "state_ssm_re": nrm(ks[4], (L, DEC_BATCH, G, N), 0.5),
        "state_ssm_im": nrm(ks[5], (L, DEC_BATCH, G, N), 0.5),
        "g_mix": gain(ks[9], (L, D_MODEL)),
        "w_in": nrm(ks[10], (L, D_MODEL, D_IN), D_MODEL ** -0.5),
        "g_q_a": gain(ks[11], (L, Q_LORA)),
        "w_q_up": nrm(ks[12], (L, Q_LORA, N_HEADS * (QK_NOPE + QK_ROPE)), Q_LORA ** -0.5),
        "g_kv_a": gain(ks[13], (L, KV_LORA)),
        "w_kv_up": nrm(ks[14], (L, KV_LORA, N_HEADS * (QK_NOPE + V_DIM)), KV_LORA ** -0.5),
        "a_re": a_re,
        "a_im": a_im,
        "log_step": log_step,
        "b_re": nrm(ks[15], (L, G, N, P), (2 * P) ** -0.5),
        "b_im": nrm(ks[16], (L, G, N, P), (2 * P) ** -0.5),
        "c_re": nrm(ks[17], (L, G, P, N), N ** -0.5),
        "c_im": nrm(ks[18], (L, G, P, N), N ** -0.5),
        "d_skip": nrm(ks[19], (L, D_SSM), 1.0),
        "w_glu": nrm(ks[20], (L, D_SSM, D_SSM), D_SSM ** -0.5),
        "g_attn_out": gain(ks[21], (L, D_ATTN)),
        "g_ssm_out": gain(ks[22], (L, D_SSM)),
        "w_out": nrm(ks[23], (L, D_MIX, D_MODEL), D_MIX ** -0.5),
        "g_mlp": gain(ks[24], (L, D_MODEL)),
        "w_up": nrm(ks[25], (L, D_MODEL, D_FF), D_MODEL ** -0.5),
        "w_down": nrm(ks[26], (L, D_FF, D_MODEL), D_FF ** -0.5),
        "g_final": gain(ks[27], (D_MODEL,)),
    }


def reference(x_prompt, x_sample, cache_kv_latent, cache_k_rope, state_ssm_re, state_ssm_im,
              g_mix, w_in, g_q_a, w_q_up, g_kv_a, w_kv_up, a_re, a_im, log_step,
              b_re, b_im, c_re, c_im, d_skip, w_glu, g_attn_out, g_ssm_out, w_out,
              g_mlp, w_up, w_down, g_final):
    layer_weights = (g_mix, w_in, g_q_a, w_q_up, g_kv_a, w_kv_up, a_re, a_im, log_step,
                     b_re, b_im, c_re, c_im, d_skip, w_glu, g_attn_out, g_ssm_out, w_out,
                     g_mlp, w_up, w_down)

    def trunk(x, pos, past_latent, past_k_rope, past_pos, h0_re, h0_im):
        lat_out, kr_out, hr_out, hi_out = [], [], [], []
        for layer in range(DEPTH):
            w_l = [w[layer] for w in layer_weights]
            x, lat, kr, hr, hi = hybrid_layer(
                x, pos,
                None if past_latent is None else past_latent[layer],
                None if past_k_rope is None else past_k_rope[layer],
                past_pos, h0_re[layer], h0_im[layer], *w_l)
            lat_out.append(lat)
            kr_out.append(kr)
            hr_out.append(hr)
            hi_out.append(hi)
        return (rmsnorm(x, g_final), jnp.stack(lat_out), jnp.stack(kr_out),
                jnp.stack(hr_out), jnp.stack(hi_out))

    bp, tp = x_prompt.shape[0], x_prompt.shape[1]
    pos_p = jnp.arange(tp, dtype=jnp.int32)
    h0p = jnp.zeros((DEPTH, bp, N_SSM_GROUPS, SSM_STATE), state_ssm_re.dtype)
    y_prompt, lat_p, kr_p, hr_p, hi_p = trunk(x_prompt, pos_p, None, None, None, h0p, h0p)

    past = cache_kv_latent.shape[2]
    ts = x_sample.shape[1]
    past_pos = jnp.arange(past, dtype=jnp.int32)
    pos_s = past + jnp.arange(ts, dtype=jnp.int32)
    y_sample, lat_s, kr_s, hr_s, hi_s = trunk(x_sample, pos_s, cache_kv_latent, cache_k_rope,
                                              past_pos, state_ssm_re, state_ssm_im)
    return (y_prompt, y_sample, lat_p, kr_p, hr_p, hi_p, lat_s, kr_s, hr_s, hi_s)
```

```cpp
#include <hip/hip_runtime.h>
#include <hip/hip_cooperative_groups.h>
#include <stdint.h>
#include <cstdio>
namespace cg = cooperative_groups;
#define DI __device__ __forceinline__

typedef unsigned short bf16_t;
typedef short bf16x8 __attribute__((ext_vector_type(8)));
typedef float f32x16 __attribute__((ext_vector_type(16)));
typedef float f32x4 __attribute__((ext_vector_type(4)));
typedef unsigned u32x4 __attribute__((ext_vector_type(4)));
typedef unsigned u32x2 __attribute__((ext_vector_type(2)));

constexpr int NTP = 65536, NTS = 2048, NT = NTP + NTS, NK = NTP + 32 * 4160;
constexpr int SKS = 4160;
constexpr size_t OFF_Y = 0;
constexpr size_t OFF_LATP = (size_t)NT * 1024;
constexpr size_t OFF_KRP = OFF_LATP + (size_t)NTP * 256;
constexpr size_t OFF_HRP = OFF_KRP + (size_t)NTP * 32;
constexpr size_t OFF_HIP = OFF_HRP + 8 * 32 * 64;
constexpr size_t OFF_LATS = OFF_HIP + 8 * 32 * 64;
constexpr size_t OFF_KRS = OFF_LATS + (size_t)NTS * 256;
constexpr size_t OFF_HRS = OFF_KRS + (size_t)NTS * 32;
constexpr size_t OFF_HIS = OFF_HRS + 32 * 32 * 64;
constexpr size_t VT_S_OFF = (size_t)8 * 512 * 8192;
constexpr float EPS = 1e-6f;
constexpr int LDS_BYTES = 66560;
constexpr int NPHASE = 10;
constexpr int AQT = 1, NQQ = 128 / (4 / (64 / (32 * AQT)));

struct Params {
  const float* in[28];
  float* out;
  bf16_t *WinT, *WqT, *WkT, *WvT, *WgT, *WoT, *WuT, *WdT, *BbT, *CcT;
  float2 *lam, *lam64, *rope;
  float *rstd_x, *cq_part, *ckv_part, *attn_part, *ssm_part, *h_part, *out_part;
  int* counters;
  float2 *E, *S;
  bf16_t *Kn, *Vt, *Q, *latb, *krb, *ub, *ssm_y, *mix, *xb, *cq, *hb, *act;
  float* ckv_raw;
  int ph_lo, ph_hi;
};

DI int tid() { int t = __builtin_amdgcn_workitem_id_x(); asm volatile("" : "+v"(t)); return t; }
DI unsigned pk_bf16(float lo, float hi) { unsigned r; asm("v_cvt_pk_bf16_f32 %0, %1, %2" : "=v"(r) : "v"(lo), "v"(hi)); return r; }
DI bf16_t f2bf(float x) { return (bf16_t)(pk_bf16(x, 0.f) & 0xffffu); }
DI float bf2f(bf16_t v) { return __uint_as_float(((unsigned)v) << 16); }
DI int crow(int i, int hh) { return (i & 3) + 8 * (i >> 2) + 4 * hh; }
DI const float* xrow(const Params& p, int row) { return row < NTP ? p.in[0] + (size_t)row * 1024 : p.in[1] + (size_t)(row - NTP) * 1024; }
DI int pos_of(int row) { return row < NTP ? (row & 8191) : 4096 + ((row - NTP) & 63); }
DI int kr_of(int row) { return row < NTP ? row : NTP + ((row - NTP) >> 6) * SKS + 4096 + ((row - NTP) & 63); }
#define MFMA32(a, b, c) __builtin_amdgcn_mfma_f32_32x32x16_bf16((a), (b), (c), 0, 0, 0)
#define MFMA16(a, b, c) __builtin_amdgcn_mfma_f32_16x16x32_bf16((a), (b), (c), 0, 0, 0)

DI void sincos_d(double x, double& s4, double& c4) {
  double k = rint(x * 0.15915494309189535);
  double rr = fma(-k, 6.283185307179586, x);
  rr = fma(-k, 2.4492935982947064e-16, rr);
  double y = rr * 0.25, y2 = y * y;
  double s = y * (1 - y2 / 6 * (1 - y2 / 20 * (1 - y2 / 42 * (1 - y2 / 72 * (1 - y2 / 110 * (1 - y2 / 156 * (1 - y2 / 210)))))));
  double c = 1 - y2 / 2 * (1 - y2 / 12 * (1 - y2 / 30 * (1 - y2 / 56 * (1 - y2 / 90 * (1 - y2 / 132 * (1 - y2 / 182))))));
  double s2 = 2 * s * c, c2 = 1 - 2 * s * s;
  s4 = 2 * s2 * c2; c4 = 1 - 2 * s2 * s2;
}

DI void gemm_core(const bf16_t* __restrict__ A, int lda, const bf16_t* __restrict__ B, int ldb, int nk,
                  int m0, int n0, char* lds, f32x16 (&acc)[2][2], int midk, const float* ratio) {
  const int t = tid(), lane = t & 63, wid = t >> 6, wm = wid >> 1, wn = wid & 1;
  const int r = lane & 31, hh = lane >> 5;
  const int lc = t & 7, lr = t >> 3;
  const unsigned woff = lr * 128 + ((lc ^ ((lr >> 1) & 7)) << 4);
  const bf16_t* ga = A + (size_t)(m0 + lr) * lda + lc * 8;
  const bf16_t* gb = B + (size_t)(n0 + lr) * ldb + lc * 8;
  char* sA = lds; char* sB = lds + 32768;
  u32x4 ra[4], rb[4];
#pragma unroll
  for (int i = 0; i < 4; ++i) { ra[i] = *(const u32x4*)(ga + (size_t)(32 * i) * lda); rb[i] = *(const u32x4*)(gb + (size_t)(32 * i) * ldb); }
#pragma unroll
  for (int i = 0; i < 4; ++i) { *(u32x4*)(sA + woff + i * 4096) = ra[i]; *(u32x4*)(sB + woff + i * 4096) = rb[i]; }
#pragma unroll
  for (int a = 0; a < 2; ++a)
#pragma unroll
    for (int b = 0; b < 2; ++b)
#pragma unroll
      for (int i = 0; i < 16; ++i) acc[a][b][i] = 0.f;
  __syncthreads();
  const int rsw = (r >> 1) & 7;
  const unsigned aoff = (wm * 64 + r) * 128, boff = (wn * 64 + r) * 128;
  for (int kt = 0; kt < nk; ++kt) {
    const int cur = kt & 1;
    const bool more = (kt + 1 < nk);
    if (more) {
      const bf16_t* ga2 = ga + (kt + 1) * 64; const bf16_t* gb2 = gb + (kt + 1) * 64;
#pragma unroll
      for (int i = 0; i < 4; ++i) { ra[i] = *(const u32x4*)(ga2 + (size_t)(32 * i) * lda); rb[i] = *(const u32x4*)(gb2 + (size_t)(32 * i) * ldb); }
    }
    if (midk && kt == midk) {
#pragma unroll
      for (int mt = 0; mt < 2; ++mt)
#pragma unroll
        for (int i = 0; i < 16; ++i) { const float f = ratio[wm * 64 + mt * 32 + crow(i, hh)]; acc[mt][0][i] *= f; acc[mt][1][i] *= f; }
    }
    const char* cA = sA + cur * 16384; const char* cB = sB + cur * 16384;
#pragma unroll
    for (int ks = 0; ks < 4; ++ks) {
      const unsigned co = (((ks * 2 + hh) ^ rsw) << 4);
      const bf16x8 a0 = *(const bf16x8*)(cA + aoff + co), a1 = *(const bf16x8*)(cA + aoff + 4096 + co);
      const bf16x8 b0 = *(const bf16x8*)(cB + boff + co), b1 = *(const bf16x8*)(cB + boff + 4096 + co);
      acc[0][0] = MFMA32(a0, b0, acc[0][0]); acc[0][1] = MFMA32(a0, b1, acc[0][1]);
      acc[1][0] = MFMA32(a1, b0, acc[1][0]); acc[1][1] = MFMA32(a1, b1, acc[1][1]);
    }
    if (more) {
      char* nA = sA + (cur ^ 1) * 16384; char* nB = sB + (cur ^ 1) * 16384;
#pragma unroll
      for (int i = 0; i < 4; ++i) { *(u32x4*)(nA + woff + i * 4096) = ra[i]; *(u32x4*)(nB + woff + i * 4096) = rb[i]; }
    }
    __syncthreads();
  }
}

DI void rowscale_load(float* rs, const float* src, int np, float inv_dim, int m0) {
  const int t = tid();
  if (t < 128) {
    const int row = m0 + t;
    if (np == 0) rs[t] = src[row];
    else { float s = 0.f; for (int j = 0; j < np; ++j) s += src[(size_t)row * np + j]; rs[t] = rsqrtf(s * inv_dim + EPS); }
  }
}
DI float half_reduce(float s) {
  s += __shfl_xor(s, 1); s += __shfl_xor(s, 2); s += __shfl_xor(s, 4); s += __shfl_xor(s, 8); s += __shfl_xor(s, 16); return s;
}

#define EPI_IDS int t = tid(); asm volatile("" : "+v"(t)); const int lane = t & 63, wid = t >> 6, wm = wid >> 1, wn = wid & 1, r = lane & 31, hh = lane >> 5; (void)lane; (void)wid; (void)wm; (void)wn; (void)r; (void)hh;
#define GEMM_IDS const int t = tid(), lane = t & 63, wid = t >> 6, wm = wid >> 1, wn = wid & 1, r = lane & 31, hh = lane >> 5; (void)t; (void)wm; (void)wn; (void)r; (void)hh;

DI void transpose_tile(const float* __restrict__ src, int ld, int K, int kt, int nt, int job, const float* g0, const float* g1, bf16_t* __restrict__ dst, char* lds) {
  bf16_t* tile = (bf16_t*)lds;
  const int t = tid(), nl = t & 63, kq = t >> 6;
  const int n = nt * 64 + nl;
  int c = n;
  if (job == 0) { c = n < 1024 ? n : (n < 1536 ? 1056 + (n - 1024) : (n < 1568 ? 1024 + (n - 1536) : -1)); }
  else if (job == 2) c = (n >> 6) * 128 + (n & 63);
  else if (job == 3) c = (n >> 6) * 128 + 64 + (n & 63);
#pragma unroll 4
  for (int pass = 0; pass < 16; ++pass) {
    const int kl = pass * 4 + kq, k = kt * 64 + kl;
    float v = 0.f;
    if (c >= 0) {
      v = src[(size_t)k * ld + c];
      if (g0) { const float g = (g1 && k >= 512) ? g1[k - 512] : g0[k]; v *= g; }
    }
    tile[nl * 66 + kl] = f2bf(v);
  }
  __syncthreads();
  const int kl = t & 63;
#pragma unroll 4
  for (int pass = 0; pass < 16; ++pass) { const int nl2 = pass * 4 + kq; dst[(size_t)(nt * 64 + nl2) * K + kt * 64 + kl] = tile[nl2 * 66 + kl]; }
  __syncthreads();
}

DI void phase0(const Params& p, char* lds) {
  const int t = tid(), nb = gridDim.x, bid = blockIdx.x, lane = t & 63, wid = t >> 6;
  if (bid == 0 && t < 64) p.counters[t] = 0;
  for (int ti = bid; ti < 2992; ti += nb) {
    int job, base, nNt, ld, K; const float* src; const float* g0 = nullptr; const float* g1 = nullptr; bf16_t* dst;
    if (ti < 416) { job = 0; base = 0; nNt = 26; ld = 1568; K = 1024; src = p.in[7]; g0 = p.in[6]; dst = p.WinT; }
    else if (ti < 560) { job = 1; base = 416; nNt = 12; ld = 768; K = 768; src = p.in[9]; g0 = p.in[8]; dst = p.WqT; }
    else if (ti < 592) { job = 2; base = 560; nNt = 8; ld = 1024; K = 256; src = p.in[11]; dst = p.WkT; }
    else if (ti < 624) { job = 3; base = 592; nNt = 8; ld = 1024; K = 256; src = p.in[11]; dst = p.WvT; }
    else if (ti < 688) { job = 4; base = 624; nNt = 8; ld = 512; K = 512; src = p.in[20]; dst = p.WgT; }
    else if (ti < 944) { job = 5; base = 688; nNt = 16; ld = 1024; K = 1024; src = p.in[23]; g0 = p.in[21]; g1 = p.in[22]; dst = p.WoT; }
    else if (ti < 1968) { job = 6; base = 944; nNt = 64; ld = 4096; K = 1024; src = p.in[25]; g0 = p.in[24]; dst = p.WuT; }
    else { job = 7; base = 1968; nNt = 16; ld = 1024; K = 4096; src = p.in[26]; dst = p.WdT; }
    const int tile = ti - base;
    transpose_tile(src, ld, K, tile / nNt, tile % nNt, job, g0, g1, dst, lds);
  }
  for (int row = bid * 4 + wid; row < NT; row += nb * 4) {
    const float* x = xrow(p, row);
    f32x4 v[4]; float ss = 0.f;
#pragma unroll
    for (int j = 0; j < 4; ++j) { v[j] = *(const f32x4*)(x + lane * 4 + 256 * j); ss += v[j][0] * v[j][0] + v[j][1] * v[j][1] + v[j][2] * v[j][2] + v[j][3] * v[j][3]; }
    ss += __shfl_xor(ss, 32); ss = half_reduce(ss);
#pragma unroll
    for (int j = 0; j < 4; ++j) { u32x2 w; w.x = pk_bf16(v[j][0], v[j][1]); w.y = pk_bf16(v[j][2], v[j][3]); *(u32x2*)(p.xb + (size_t)row * 1024 + lane * 4 + 256 * j) = w; }
    if (lane == 0) p.rstd_x[row] = rsqrtf(ss * (1.f / 1024.f) + EPS);
  }
  const int gt = bid * 256 + t, ngt = nb * 256;
  for (int v = gt; v < 32 * 4096 * 32; v += ngt) {
    const size_t e0 = (size_t)v * 8; const int b = (int)(e0 >> 20), rem = (int)(e0 & 1048575), tt = rem >> 8, c = rem & 255;
    const f32x4 a = *(const f32x4*)(p.in[2] + e0), bq = *(const f32x4*)(p.in[2] + e0 + 4);
    u32x4 w; w.x = pk_bf16(a[0], a[1]); w.y = pk_bf16(a[2], a[3]); w.z = pk_bf16(bq[0], bq[1]); w.w = pk_bf16(bq[2], bq[3]);
    *(u32x4*)(p.latb + (size_t)(NTP + b * SKS + tt) * 256 + c) = w;
  }
  for (int v = gt; v < 32 * 4096 * 4; v += ngt) {
    const size_t e0 = (size_t)v * 8; const int b = (int)(e0 >> 17), rem = (int)(e0 & 131071), tt = rem >> 5, c = rem & 31;
    const f32x4 a = *(const f32x4*)(p.in[3] + e0), bq = *(const f32x4*)(p.in[3] + e0 + 4);
    u32x4 w; w.x = pk_bf16(a[0], a[1]); w.y = pk_bf16(a[2], a[3]); w.z = pk_bf16(bq[0], bq[1]); w.w = pk_bf16(bq[2], bq[3]);
    *(u32x4*)(p.krb + (size_t)(NTP + b * SKS + tt) * 32 + c) = w;
  }
  if (gt < 2048) {
    const int g = gt >> 6, n = gt & 63;
    const double dt = exp((double)p.in[14][g]);
    const double lr = p.in[12][gt], li = p.in[13][gt];
    const double mag = exp(lr * dt); double s, c; sincos_d(li * dt, s, c);
    const double lbr = mag * c, lbi = mag * s;
    const double nr = lbr - 1.0, ni = lbi, den = lr * lr + li * li;
    const double cr = (nr * lr + ni * li) / den, ci = (ni * lr - nr * li) / den;
    p.lam[gt] = make_float2((float)lbr, (float)lbi);
    const double mag64 = exp(64.0 * lr * dt); sincos_d(64.0 * li * dt, s, c);
    p.lam64[gt] = make_float2((float)(mag64 * c), (float)(mag64 * s));
    for (int q = 0; q < 16; ++q) {
      const double br = p.in[15][(size_t)gt * 16 + q], bi = p.in[16][(size_t)gt * 16 + q];
      p.BbT[(size_t)(g * 128 + n) * 16 + q] = f2bf((float)(cr * br - ci * bi));
      p.BbT[(size_t)(g * 128 + 64 + n) * 16 + q] = f2bf((float)(cr * bi + ci * br));
      p.CcT[(size_t)(g * 16 + q) * 128 + n] = f2bf(p.in[17][(size_t)(g * 16 + q) * 64 + n]);
      p.CcT[(size_t)(g * 16 + q) * 128 + 64 + n] = f2bf(-p.in[18][(size_t)(g * 16 + q) * 64 + n]);
    }
  }
  for (int e = gt; e < 8192 * 16; e += ngt) {
    const int pos = e >> 4, i = e & 15;
    const float inv = (float)exp(-(double)i * (9.210340371976184 / 16.0));
    const float ang = (float)pos * inv;
    double s, c; sincos_d((double)ang, s, c);
    p.rope[e] = make_float2((float)c, (float)s);
  }
}

DI void phase1(const Params& p, char* lds) {
  float* rs = (float*)(lds + 65536);
  const int ntiles = 528 * 13;
  for (int ti = blockIdx.x; ti < ntiles; ti += gridDim.x) {
    const int tm = ti / 13, tn = ti % 13, m0 = tm * 128, n0 = tn * 128;
    __syncthreads();
    rowscale_load(rs, p.rstd_x, 0, 0.f, m0);
    f32x16 acc[2][2];
    gemm_core(p.xb, 1024, p.WinT, 1024, 16, m0, n0, lds, acc, 0, nullptr);
    { EPI_IDS
    if (tn < 8) {
#pragma unroll
      for (int mt = 0; mt < 2; ++mt)
#pragma unroll
        for (int i = 0; i < 16; ++i) {
          const int rl = wm * 64 + mt * 32 + crow(i, hh), row = m0 + rl;
          const float sc = rs[rl];
          const float v0 = acc[mt][0][i] * sc, v1 = acc[mt][1][i] * sc;
          const int c0 = n0 + wn * 64 + r;
          if (tn < 6) { bf16_t* d = p.cq + (size_t)row * 768 + c0; d[0] = f2bf(v0); d[32] = f2bf(v1); }
          else { float* d = p.ckv_raw + (size_t)row * 256 + (c0 - 768); d[0] = v0; d[32] = v1; }
          const float s = half_reduce(v0 * v0 + v1 * v1);
          if (r == 0) { if (tn < 6) p.cq_part[(size_t)row * 12 + tn * 2 + wn] = s; else p.ckv_part[(size_t)row * 4 + (tn - 6) * 2 + wn] = s; }
        }
    } else if (tn < 12) {
#pragma unroll
      for (int mt = 0; mt < 2; ++mt)
#pragma unroll
        for (int i = 0; i < 16; ++i) {
          const int rl = wm * 64 + mt * 32 + crow(i, hh), row = m0 + rl;
          const float sc = rs[rl];
          bf16_t* d = p.ub + (size_t)row * 512 + (n0 - 1024) + wn * 64 + r;
          d[0] = f2bf(acc[mt][0][i] * sc); d[32] = f2bf(acc[mt][1][i] * sc);
        }
    } else if (wn == 0) {
#pragma unroll
      for (int mt = 0; mt < 2; ++mt)
#pragma unroll
        for (int i = 0; i < 16; ++i) {
          const int rl = wm * 64 + mt * 32 + crow(i, hh), row = m0 + rl;
          const float v0 = acc[mt][0][i] * rs[rl];
          const float other = __shfl_xor(v0, 16);
          const float2 cs = p.rope[pos_of(row) * 16 + (r & 15)];
          const float o = (r < 16) ? (v0 * cs.x - other * cs.y) : (other * cs.y + v0 * cs.x);
          float* dst = row < NTP ? p.out + OFF_KRP + (size_t)row * 32 : p.out + OFF_KRS + (size_t)(row - NTP) * 32;
          dst[r] = o;
          p.krb[(size_t)kr_of(row) * 32 + r] = f2bf(o);
        }
    }
    }
  }
}

DI void ssm_chunk(const Params& p, int row0, int g, float& hr, float& hi, bool write_y, char* lds_w) {
  const int lane = tid() & 63, r = lane & 31, hh = lane >> 5;
  const float2 lm = p.lam[g * 64 + lane];
  bf16x8 bfr[4];
#pragma unroll
  for (int nt = 0; nt < 4; ++nt) bfr[nt] = *(const bf16x8*)(p.BbT + (size_t)(g * 128 + nt * 32 + r) * 16 + hh * 8);
  const int fr = lane & 15, fq = lane >> 4;
  bf16x8 cfr[4];
#pragma unroll
  for (int ks = 0; ks < 4; ++ks) cfr[ks] = *(const bf16x8*)(p.CcT + (size_t)(g * 16 + fr) * 128 + ks * 32 + fq * 8);
  const float dsk = p.in[19][g * 16 + fr];
#pragma unroll 1
  for (int sub = 0; sub < 2; ++sub) {
    const int rb = row0 + sub * 32;
    const bf16x8 uf = *(const bf16x8*)(p.ub + (size_t)(rb + r) * 512 + g * 16 + hh * 8);
    f32x16 z; for (int i = 0; i < 16; ++i) z[i] = 0.f;
    const f32x16 x0 = MFMA32(uf, bfr[0], z), x1 = MFMA32(uf, bfr[1], z), x2 = MFMA32(uf, bfr[2], z), x3 = MFMA32(uf, bfr[3], z);
    float xr0[16], xr1[16], xi0[16], xi1[16];
#pragma unroll
    for (int i = 0; i < 16; ++i) {
      const float sre = hh ? x0[i] : x1[i];
      const float rre = __shfl_xor(sre, 32);
      const float sim = hh ? x2[i] : x3[i];
      const float rim = __shfl_xor(sim, 32);
      xr0[i] = hh ? rre : x0[i]; xr1[i] = hh ? x1[i] : rre;
      xi0[i] = hh ? rim : x2[i]; xi1[i] = hh ? x3[i] : rim;
    }
    bf16_t* Hs = (bf16_t*)lds_w;
#pragma unroll
    for (int m = 0; m < 4; ++m) {
#pragma unroll
      for (int half = 0; half < 2; ++half) {
#pragma unroll
        for (int jj = 0; jj < 4; ++jj) {
          const int i = 4 * m + jj, tt = 8 * m + 4 * half + jj;
          const float xr = half ? xr1[i] : xr0[i], xi = half ? xi1[i] : xi0[i];
          const float nr = lm.x * hr - lm.y * hi + xr;
          const float ni = lm.x * hi + lm.y * hr + xi;
          hr = nr; hi = ni;
          if (write_y) { Hs[tt * 136 + lane] = f2bf(hr); Hs[tt * 136 + 64 + lane] = f2bf(hi); }
        }
      }
    }
    if (write_y) {
      asm volatile("s_waitcnt lgkmcnt(0)" ::: "memory");
      __builtin_amdgcn_wave_barrier();
#pragma unroll
      for (int mt = 0; mt < 2; ++mt) {
        f32x4 y = {0.f, 0.f, 0.f, 0.f};
#pragma unroll
        for (int ks = 0; ks < 4; ++ks) {
          const bf16x8 hf = *(const bf16x8*)(Hs + (mt * 16 + fr) * 136 + ks * 32 + fq * 8);
          y = MFMA16(hf, cfr[ks], y);
        }
#pragma unroll
        for (int j = 0; j < 4; ++j) {
          const int row = rb + mt * 16 + fq * 4 + j;
          const float u = bf2f(p.ub[(size_t)row * 512 + g * 16 + fr]);
          const float v = y[j] + dsk * u;
          const float zz = 0.7978845608028654f * (v + 0.044715f * v * v * v);
          const float th = 1.f - 2.f / (__expf(2.f * zz) + 1.f);
          p.ssm_y[(size_t)row * 512 + g * 16 + fr] = f2bf(0.5f * v * (1.f + th));
        }
      }
      asm volatile("s_waitcnt lgkmcnt(0)" ::: "memory");
      __builtin_amdgcn_wave_barrier();
    }
  }
}

DI void phase2(const Params& p, char* lds) {
  const int lane = tid() & 63, wid = tid() >> 6;
  const int nb = gridDim.x, bid = blockIdx.x;
  for (int row = bid * 4 + wid; row < NT; row += nb * 4) {
    const f32x4 v = *(const f32x4*)(p.ckv_raw + (size_t)row * 256 + lane * 4);
    const f32x4 pp = *(const f32x4*)(p.ckv_part + (size_t)row * 4);
    const float rstd = rsqrtf((pp[0] + pp[1] + pp[2] + pp[3]) * (1.f / 256.f) + EPS);
    const f32x4 g = *(const f32x4*)(p.in[10] + lane * 4);
    f32x4 o; o[0] = v[0] * rstd * g[0]; o[1] = v[1] * rstd * g[1]; o[2] = v[2] * rstd * g[2]; o[3] = v[3] * rstd * g[3];
    float* dst = row < NTP ? p.out + OFF_LATP + (size_t)row * 256 : p.out + OFF_LATS + (size_t)(row - NTP) * 256;
    *(f32x4*)(dst + lane * 4) = o;
    u32x2 w; w.x = pk_bf16(o[0], o[1]); w.y = pk_bf16(o[2], o[3]);
    *(u32x2*)(p.latb + (size_t)kr_of(row) * 256 + lane * 4) = w;
  }
  for (int it = bid * 4 + wid; it < 8 * 128 * 32; it += nb * 4) {
    const int g = it & 31, c = (it >> 5) & 127, b = it >> 12;
    float hr = 0.f, hi = 0.f;
    ssm_chunk(p, b * 8192 + c * 64, g, hr, hi, false, lds + wid * 8704);
    p.E[(size_t)it * 64 + lane] = make_float2(hr, hi);
  }
  float* rs = (float*)(lds + 65536);
  for (int ti = bid; ti < 528 * 6; ti += nb) {
    const int tm = ti / 6, tn = ti % 6, m0 = tm * 128, n0 = tn * 128;
    __syncthreads();
    rowscale_load(rs, p.cq_part, 12, 1.f / 768.f, m0);
    f32x16 acc[2][2];
    gemm_core(p.cq, 768, p.WqT, 768, 12, m0, n0, lds, acc, 0, nullptr);
    int t2 = tid(); asm volatile("" : "+v"(t2)); const int lane2 = t2 & 63, wid2 = t2 >> 6, wm = wid2 >> 1, wn = wid2 & 1, r = lane2 & 31, hh = lane2 >> 5;
    const float qs = 0.10206207261596577f * 1.4426950408889634f;
#pragma unroll
    for (int mt = 0; mt < 2; ++mt)
#pragma unroll
      for (int nt = 0; nt < 2; ++nt) {
        const int cb = n0 + wn * 64 + nt * 32;
        const bool isrope = (cb % 96) == 64;
#pragma unroll
        for (int i = 0; i < 16; ++i) {
          const int rl = wm * 64 + mt * 32 + crow(i, hh), row = m0 + rl;
          float v = acc[mt][nt][i] * rs[rl];
          if (isrope) {
            const float other = __shfl_xor(v, 16);
            const float2 cs = p.rope[pos_of(row) * 16 + (r & 15)];
            v = (r < 16) ? (v * cs.x - other * cs.y) : (other * cs.y + v * cs.x);
          }
          p.Q[(size_t)row * 768 + cb + r] = f2bf(v * qs);
        }
      }
  }
}

DI void phase3(const Params& p, char* lds) {
  const int lane = tid() & 63, wid = tid() >> 6;
  const int nb = gridDim.x, bid = blockIdx.x;
  for (int it = bid * 4 + wid; it < 256; it += nb * 4) {
    const int b = it >> 5, g = it & 31;
    const float2 l64 = p.lam64[g * 64 + lane];
    float sr = 0.f, si = 0.f;
    for (int c = 0; c < 128; ++c) {
      const size_t idx = ((size_t)((b * 128 + c) * 32 + g)) * 64 + lane;
      p.S[idx] = make_float2(sr, si);
      const float2 e = p.E[idx];
      const float nr = l64.x * sr - l64.y * si + e.x, ni = l64.x * si + l64.y * sr + e.y;
      sr = nr; si = ni;
    }
  }
  for (int ti = bid; ti < 1552 * 4; ti += nb) {
    const int tm = ti >> 2, tn = ti & 3, m0 = tm * 128, n0 = tn * 128;
    f32x16 acc[2][2];
    gemm_core(p.latb, 256, p.WkT, 256, 4, m0, n0, lds, acc, 0, nullptr);
    int t2 = tid(); asm volatile("" : "+v"(t2)); const int lane2 = t2 & 63, wid2 = t2 >> 6, wm = wid2 >> 1, wn = wid2 & 1, r = lane2 & 31, hh = lane2 >> 5;
#pragma unroll
    for (int mt = 0; mt < 2; ++mt)
#pragma unroll
      for (int nt = 0; nt < 2; ++nt)
#pragma unroll
        for (int i = 0; i < 16; ++i) {
          const int row = m0 + wm * 64 + mt * 32 + crow(i, hh);
          p.Kn[(size_t)row * 512 + n0 + wn * 64 + nt * 32 + r] = f2bf(acc[mt][nt][i]);
        }
  }
  for (int ti = bid; ti < 1552 * 4; ti += nb) {
    const int tn = ti >> 2, tm = ti & 3, m0 = tm * 128, n0 = tn * 128;
    f32x16 acc[2][2];
    gemm_core(p.WvT, 256, p.latb, 256, 4, m0, n0, lds, acc, 0, nullptr);
    int t2 = tid(); asm volatile("" : "+v"(t2)); const int lane2 = t2 & 63, wid2 = t2 >> 6, wm = wid2 >> 1, wn = wid2 & 1, r = lane2 & 31, hh = lane2 >> 5;
#pragma unroll
    for (int nt = 0; nt < 2; ++nt) {
      const int kr = n0 + wn * 64 + nt * 32 + r;
      size_t cbase; int S;
      if (kr < NTP) { cbase = (size_t)(kr >> 13) * 512 * 8192 + (kr & 8191); S = 8192; }
      else { const int k2 = kr - NTP, b = k2 / SKS, tt = k2 - b * SKS; cbase = VT_S_OFF + (size_t)b * 512 * SKS + tt; S = SKS; }
#pragma unroll
      for (int mt = 0; mt < 2; ++mt)
#pragma unroll
        for (int i = 0; i < 16; ++i) {
          const int hd = m0 + wm * 64 + mt * 32 + crow(i, hh);
          p.Vt[cbase + (size_t)hd * S] = f2bf(acc[mt][nt][i]);
        }
    }
  }
}

template <int QT>
DI void attn_item(const Params& p, int kind, int b, int h, int qq, char* lds) {
  const int t = tid(), lane = t & 63, wid = t >> 6, r = lane & 31, hh = lane >> 5;
  int qrow0, nkb_w, nkb_max, S; size_t kr0; const bf16_t* vt_base;
  constexpr int RW = 32 * QT, WPC = 64 / RW, CPB = 4 / WPC;
  if (kind == 0) {
    const int c = qq * CPB + wid / WPC; qrow0 = b * 8192 + c * 64 + (wid % WPC) * RW; nkb_w = c + 1; nkb_max = qq * CPB + CPB; kr0 = (size_t)b * 8192; S = 8192;
    vt_base = p.Vt + (size_t)(b * 8 + h) * 64 * 8192;
  } else {
    qrow0 = NTP + b * 64 + (wid % WPC) * RW; nkb_w = (wid < WPC) ? 65 : 0; nkb_max = 65; kr0 = (size_t)NTP + (size_t)b * SKS; S = SKS;
    vt_base = p.Vt + VT_S_OFF + (size_t)(b * 8 + h) * 64 * SKS;
  }
  bf16x8 qf[QT][6];
#pragma unroll
  for (int qt = 0; qt < QT; ++qt)
#pragma unroll
    for (int ks = 0; ks < 6; ++ks) qf[qt][ks] = *(const bf16x8*)(p.Q + (size_t)(qrow0 + qt * 32 + r) * 768 + h * 96 + ks * 16 + hh * 8);
  f32x16 o[2][QT];
  float mrun[QT], lrun[QT];
#pragma unroll
  for (int qt = 0; qt < QT; ++qt) { mrun[qt] = -1e30f; lrun[qt] = 0.f;
#pragma unroll
    for (int dt = 0; dt < 2; ++dt)
#pragma unroll
      for (int i = 0; i < 16; ++i) o[dt][qt][i] = 0.f; }
  const int kkey = t >> 3, kc = t & 7;
  const int rkey = t >> 2, rc = t & 3;
  const int vd = t >> 3, vc = t & 7;
  const bf16_t* gk = p.Kn + (kr0 + kkey) * 512 + h * 64 + kc * 8;
  const bf16_t* gr = p.krb + (kr0 + rkey) * 32 + rc * 8;
  const bf16_t* gv = vt_base + (size_t)vd * S + vc * 8;
  const unsigned kw0 = kkey * 208 + kc * 16, kw1 = kw0 + 32 * 208, rw = rkey * 208 + 128 + rc * 16;
  const unsigned vlo = vd * 144 + (vc >> 1) * 32 + (vc & 1) * 8, vhi = vlo + 16;
  constexpr int KB = 13312, VB = 9216, BUF = KB + VB;
  u32x4 k0r, k1r, rr, v0r, v1r;
  k0r = *(const u32x4*)gk; k1r = *(const u32x4*)(gk + 32 * 512); rr = *(const u32x4*)gr;
  v0r = *(const u32x4*)gv; v1r = *(const u32x4*)(gv + (size_t)32 * S);
  __syncthreads();
  {
    char* kb_ = lds; char* vb_ = lds + KB;
    *(u32x4*)(kb_ + kw0) = k0r; *(u32x4*)(kb_ + kw1) = k1r; *(u32x4*)(kb_ + rw) = rr;
    *(u32x2*)(vb_ + vlo) = (u32x2){v0r.x, v0r.y}; *(u32x2*)(vb_ + vhi) = (u32x2){v0r.z, v0r.w};
    *(u32x2*)(vb_ + vlo + 32 * 144) = (u32x2){v1r.x, v1r.y}; *(u32x2*)(vb_ + vhi + 32 * 144) = (u32x2){v1r.z, v1r.w};
  }
  __syncthreads();
  for (int kb = 0; kb < nkb_max; ++kb) {
    const int cur = kb & 1;
    const bool more = kb + 1 < nkb_max;
    if (more) {
      const size_t ko = (size_t)(kb + 1) * 64;
      k0r = *(const u32x4*)(gk + ko * 512); k1r = *(const u32x4*)(gk + (ko + 32) * 512); rr = *(const u32x4*)(gr + ko * 32);
      v0r = *(const u32x4*)(gv + ko); v1r = *(const u32x4*)(gv + (size_t)32 * S + ko);
    }
    if (kb < nkb_w) {
      const char* kt_ = lds + cur * BUF; const char* vt_ = kt_ + KB;
      f32x16 st[2][QT];
#pragma unroll
      for (int kt = 0; kt < 2; ++kt)
#pragma unroll
        for (int qt = 0; qt < QT; ++qt)
#pragma unroll
          for (int i = 0; i < 16; ++i) st[kt][qt][i] = 0.f;
#pragma unroll
      for (int ks = 0; ks < 6; ++ks)
#pragma unroll
        for (int kt = 0; kt < 2; ++kt) {
          const bf16x8 kf = *(const bf16x8*)(kt_ + (kt * 32 + r) * 208 + ks * 32 + hh * 16);
#pragma unroll
          for (int qt = 0; qt < QT; ++qt) st[kt][qt] = MFMA32(kf, qf[qt][ks], st[kt][qt]);
        }
      bf16x8 pb[2][QT][2];
#pragma unroll
      for (int qt = 0; qt < QT; ++qt) {
        float mx = mrun[qt];
#pragma unroll
        for (int kt = 0; kt < 2; ++kt)
#pragma unroll
          for (int i = 0; i < 16; ++i) mx = fmaxf(mx, st[kt][qt][i]);
        mx = fmaxf(mx, __shfl_xor(mx, 32));
        const float alpha = __builtin_amdgcn_exp2f(mrun[qt] - mx);
        mrun[qt] = mx;
        float ls = 0.f;
#pragma unroll
        for (int kt = 0; kt < 2; ++kt) {
#pragma unroll
          for (int i = 0; i < 16; ++i) { const float pv = __builtin_amdgcn_exp2f(st[kt][qt][i] - mx); ls += pv; st[kt][qt][i] = pv; }
#pragma unroll
          for (int s2 = 0; s2 < 2; ++s2) {
            u32x4 w;
            w.x = pk_bf16(st[kt][qt][8 * s2 + 0], st[kt][qt][8 * s2 + 1]); w.y = pk_bf16(st[kt][qt][8 * s2 + 2], st[kt][qt][8 * s2 + 3]);
            w.z = pk_bf16(st[kt][qt][8 * s2 + 4], st[kt][qt][8 * s2 + 5]); w.w = pk_bf16(st[kt][qt][8 * s2 + 6], st[kt][qt][8 * s2 + 7]);
            pb[kt][qt][s2] = __builtin_bit_cast(bf16x8, w);
          }
        }
        lrun[qt] = lrun[qt] * alpha + ls;
#pragma unroll
        for (int dt = 0; dt < 2; ++dt)
#pragma unroll
          for (int i = 0; i < 16; ++i) o[dt][qt][i] *= alpha;
      }
#pragma unroll
      for (int dt = 0; dt < 2; ++dt)
#pragma unroll
        for (int kt = 0; kt < 2; ++kt)
#pragma unroll
          for (int s2 = 0; s2 < 2; ++s2) {
            const bf16x8 vf = *(const bf16x8*)(vt_ + (dt * 32 + r) * 144 + (kt * 2 + s2) * 32 + hh * 16);
#pragma unroll
            for (int qt = 0; qt < QT; ++qt) o[dt][qt] = MFMA32(vf, pb[kt][qt][s2], o[dt][qt]);
          }
    }
    if (more) {
      char* kb_ = lds + (cur ^ 1) * BUF; char* vb_ = kb_ + KB;
      *(u32x4*)(kb_ + kw0) = k0r; *(u32x4*)(kb_ + kw1) = k1r; *(u32x4*)(kb_ + rw) = rr;
      *(u32x2*)(vb_ + vlo) = (u32x2){v0r.x, v0r.y}; *(u32x2*)(vb_ + vhi) = (u32x2){v0r.z, v0r.w};
      *(u32x2*)(vb_ + vlo + 32 * 144) = (u32x2){v1r.x, v1r.y}; *(u32x2*)(vb_ + vhi + 32 * 144) = (u32x2){v1r.z, v1r.w};
    }
    __syncthreads();
  }
  if (nkb_w > 0) {
#pragma unroll
    for (int qt = 0; qt < QT; ++qt) {
      const float lt = lrun[qt] + __shfl_xor(lrun[qt], 32);
      const float inv = 1.f / lt;
      const int row = qrow0 + qt * 32 + r;
      float ss = 0.f;
#pragma unroll
      for (int dt = 0; dt < 2; ++dt)
#pragma unroll
        for (int i4 = 0; i4 < 4; ++i4) {
          const float a0 = o[dt][qt][4 * i4] * inv, a1 = o[dt][qt][4 * i4 + 1] * inv, a2 = o[dt][qt][4 * i4 + 2] * inv, a3 = o[dt][qt][4 * i4 + 3] * inv;
          ss += a0 * a0 + a1 * a1 + a2 * a2 + a3 * a3;
          u32x2 w; w.x = pk_bf16(a0, a1); w.y = pk_bf16(a2, a3);
          *(u32x2*)(p.mix + (size_t)row * 1024 + h * 64 + dt * 32 + 8 * i4 + 4 * hh) = w;
        }
      ss += __shfl_xor(ss, 32);
      if (hh == 0) p.attn_part[(size_t)row * 8 + h] = ss;
    }
  }
}

DI void phase4(const Params& p, char* lds) {
  const int t = tid(), lane = t & 63, wid = t >> 6;
  const int nb = gridDim.x, bid = blockIdx.x;
  int* nxt = (int*)(lds + 65536);
  for (;;) {
    __syncthreads();
    if (t == 0) *nxt = atomicAdd(p.counters, 1);
    __syncthreads();
    const int it = *nxt;
    if (it >= 256 + 64 * NQQ) break;
    if (it < 256) attn_item<AQT>(p, 1, it >> 3, it & 7, 0, lds);
    else { const int j = it - 256; const int qq = NQQ - 1 - (j >> 6), bh = j & 63; attn_item<AQT>(p, 0, bh >> 3, bh & 7, qq, lds); }
  }
  __syncthreads();
  for (int it = bid * 4 + wid; it < 8 * 128 * 32 + 1024; it += nb * 4) {
    if (it < 8 * 128 * 32) {
      const int g = it & 31, c = (it >> 5) & 127, b = it >> 12;
      const float2 s0 = p.S[(size_t)it * 64 + lane];
      float hr = s0.x, hi = s0.y;
      ssm_chunk(p, b * 8192 + c * 64, g, hr, hi, true, lds + wid * 8704);
      if (c == 127) { p.out[OFF_HRP + (size_t)(b * 32 + g) * 64 + lane] = hr; p.out[OFF_HIP + (size_t)(b * 32 + g) * 64 + lane] = hi; }
    } else {
      const int j = it - 8 * 128 * 32, g = j & 31, b = j >> 5;
      float hr = p.in[4][(size_t)(b * 32 + g) * 64 + lane], hi = p.in[5][(size_t)(b * 32 + g) * 64 + lane];
      ssm_chunk(p, NTP + b * 64, g, hr, hi, true, lds + wid * 8704);
      p.out[OFF_HRS + (size_t)(b * 32 + g) * 64 + lane] = hr; p.out[OFF_HIS + (size_t)(b * 32 + g) * 64 + lane] = hi;
    }
  }
}

DI void phase5(const Params& p, char* lds) {
  for (int ti = blockIdx.x; ti < 528 * 4; ti += gridDim.x) {
    const int tm = ti >> 2, tn = ti & 3, m0 = tm * 128, n0 = tn * 128;
    f32x16 acc[2][2];
    gemm_core(p.ssm_y, 512, p.WgT, 512, 8, m0, n0, lds, acc, 0, nullptr);
    { EPI_IDS
#pragma unroll
    for (int mt = 0; mt < 2; ++mt)
#pragma unroll
      for (int i = 0; i < 16; ++i) {
        const int row = m0 + wm * 64 + mt * 32 + crow(i, hh);
        float ss = 0.f;
#pragma unroll
        for (int nt = 0; nt < 2; ++nt) {
          const int col = n0 + wn * 64 + nt * 32 + r;
          const float y = bf2f(p.ssm_y[(size_t)row * 512 + col]);
          const float o = y / (1.f + __expf(-acc[mt][nt][i]));
          ss += o * o;
          p.mix[(size_t)row * 1024 + 512 + col] = f2bf(o);
        }
        ss = half_reduce(ss);
        if (r == 0) p.ssm_part[(size_t)row * 8 + tn * 2 + wn] = ss;
      }
    }
  }
}

DI void phase6(const Params& p, char* lds) {
  float* rsS = (float*)(lds + 65536); float* ratio = rsS + 128;
  for (int ti = blockIdx.x; ti < 528 * 8; ti += gridDim.x) {
    const int tm = ti >> 3, tn = ti & 7, m0 = tm * 128, n0 = tn * 128;
    __syncthreads();
    if (tid() < 128) {
      const int t = tid(); const int row = m0 + t; float sa = 0.f, sb = 0.f;
      for (int j = 0; j < 8; ++j) { sa += p.attn_part[(size_t)row * 8 + j]; sb += p.ssm_part[(size_t)row * 8 + j]; }
      const float ra = rsqrtf(sa * (1.f / 512.f) + EPS), rb = rsqrtf(sb * (1.f / 512.f) + EPS);
      rsS[t] = rb; ratio[t] = ra / rb;
    }
    f32x16 acc[2][2];
    gemm_core(p.mix, 1024, p.WoT, 1024, 16, m0, n0, lds, acc, 8, ratio);
    { EPI_IDS
#pragma unroll
    for (int mt = 0; mt < 2; ++mt)
#pragma unroll
      for (int i = 0; i < 16; ++i) {
        const int rl = wm * 64 + mt * 32 + crow(i, hh), row = m0 + rl;
        const float sc = rsS[rl];
        const float* xr = xrow(p, row);
        float ss = 0.f;
#pragma unroll
        for (int nt = 0; nt < 2; ++nt) {
          const int col = n0 + wn * 64 + nt * 32 + r;
          const float hv = xr[col] + acc[mt][nt][i] * sc;
          ss += hv * hv;
          p.out[OFF_Y + (size_t)row * 1024 + col] = hv;
          p.hb[(size_t)row * 1024 + col] = f2bf(hv);
        }
        ss = half_reduce(ss);
        if (r == 0) p.h_part[(size_t)row * 16 + tn * 2 + wn] = ss;
      }
    }
  }
}

DI void phase7(const Params& p, char* lds) {
  float* rs = (float*)(lds + 65536);
  for (int ti = blockIdx.x; ti < 528 * 32; ti += gridDim.x) {
    const int tm = ti >> 5, tn = ti & 31, m0 = tm * 128, n0 = tn * 128;
    __syncthreads();
    rowscale_load(rs, p.h_part, 16, 1.f / 1024.f, m0);
    f32x16 acc[2][2];
    gemm_core(p.hb, 1024, p.WuT, 1024, 16, m0, n0, lds, acc, 0, nullptr);
    { EPI_IDS
#pragma unroll
    for (int mt = 0; mt < 2; ++mt)
#pragma unroll
      for (int i = 0; i < 16; ++i) {
        const int rl = wm * 64 + mt * 32 + crow(i, hh), row = m0 + rl;
        const float sc = rs[rl];
#pragma unroll
        for (int nt = 0; nt < 2; ++nt) {
          const float v = fmaxf(acc[mt][nt][i] * sc, 0.f);
          p.act[(size_t)row * 4096 + n0 + wn * 64 + nt * 32 + r] = f2bf(v * v);
        }
      }
    }
  }
}

DI void phase8(const Params& p, char* lds) {
  for (int ti = blockIdx.x; ti < 528 * 8; ti += gridDim.x) {
    const int tm = ti >> 3, tn = ti & 7, m0 = tm * 128, n0 = tn * 128;
    f32x16 acc[2][2];
    gemm_core(p.act, 4096, p.WdT, 4096, 64, m0, n0, lds, acc, 0, nullptr);
    { EPI_IDS
#pragma unroll
    for (int mt = 0; mt < 2; ++mt)
#pragma unroll
      for (int i = 0; i < 16; ++i) {
        const int row = m0 + wm * 64 + mt * 32 + crow(i, hh);
        float ss = 0.f;
#pragma unroll
        for (int nt = 0; nt < 2; ++nt) {
          const size_t idx = OFF_Y + (size_t)row * 1024 + n0 + wn * 64 + nt * 32 + r;
          const float ov = p.out[idx] + acc[mt][nt][i];
          ss += ov * ov;
          p.out[idx] = ov;
        }
        ss = half_reduce(ss);
        if (r == 0) p.out_part[(size_t)row * 16 + tn * 2 + wn] = ss;
      }
    }
  }
}

DI void phase9(const Params& p) {
  const int t = tid(), lane = t & 63, wid = t >> 6;
  for (int row = blockIdx.x * 4 + wid; row < NT; row += gridDim.x * 4) {
    float s = 0.f;
    for (int j = 0; j < 16; ++j) s += p.out_part[(size_t)row * 16 + j];
    const float rstd = rsqrtf(s * (1.f / 1024.f) + EPS);
    float* y = p.out + OFF_Y + (size_t)row * 1024;
#pragma unroll
    for (int j = 0; j < 4; ++j) {
      f32x4 v = *(const f32x4*)(y + lane * 4 + 256 * j);
      const f32x4 g = *(const f32x4*)(p.in[27] + lane * 4 + 256 * j);
      v[0] *= rstd * g[0]; v[1] *= rstd * g[1]; v[2] *= rstd * g[2]; v[3] *= rstd * g[3];
      *(f32x4*)(y + lane * 4 + 256 * j) = v;
    }
  }
}

template <bool COOP>
__global__ void __launch_bounds__(256, 2) mega(Params p) {
  __shared__ __attribute__((aligned(16))) char lds[LDS_BYTES];
  for (int ph = p.ph_lo; ph < p.ph_hi; ++ph) {
#ifdef ONLY_PHASE
    if (ph != ONLY_PHASE) continue;
#endif
    switch (ph) {
      case 0: phase0(p, lds); break;
      case 1: phase1(p, lds); break;
      case 2: phase2(p, lds); break;
      case 3: phase3(p, lds); break;
      case 4: phase4(p, lds); break;
      case 5: phase5(p, lds); break;
      case 6: phase6(p, lds); break;
      case 7: phase7(p, lds); break;
      case 8: phase8(p, lds); break;
      default: phase9(p); break;
    }
    if (COOP) { if (ph + 1 < p.ph_hi) cg::this_grid().sync(); }
  }
}

static size_t al256(size_t x) { return (x + 255) & ~(size_t)255; }

extern "C" void kernel_launch(void* const* d_in, const int* in_sizes, int n_in, void* d_out, int out_size, void* d_ws, size_t ws_size, hipStream_t stream) {
  Params p{};
  for (int i = 0; i < 28; ++i) p.in[i] = (const float*)d_in[i];
  p.out = (float*)d_out;
  char* base = (char*)d_ws; size_t off = 0;
  auto take = [&](size_t bytes) { char* q = base + off; off = al256(off + bytes); return q; };
  p.WinT = (bf16_t*)take((size_t)1664 * 1024 * 2);
  p.WqT = (bf16_t*)take((size_t)768 * 768 * 2);
  p.WkT = (bf16_t*)take((size_t)512 * 256 * 2);
  p.WvT = (bf16_t*)take((size_t)512 * 256 * 2);
  p.WgT = (bf16_t*)take((size_t)512 * 512 * 2);
  p.WoT = (bf16_t*)take((size_t)1024 * 1024 * 2);
  p.WuT = (bf16_t*)take((size_t)4096 * 1024 * 2);
  p.WdT = (bf16_t*)take((size_t)1024 * 4096 * 2);
  p.BbT = (bf16_t*)take((size_t)32 * 128 * 16 * 2);
  p.CcT = (bf16_t*)take((size_t)32 * 16 * 128 * 2);
  p.lam = (float2*)take(2048 * 8);
  p.lam64 = (float2*)take(2048 * 8);
  p.rope = (float2*)take((size_t)8192 * 16 * 8);
  p.rstd_x = (float*)take((size_t)NT * 4);
  p.cq_part = (float*)take((size_t)NT * 12 * 4);
  p.ckv_part = (float*)take((size_t)NT * 4 * 4);
  p.attn_part = (float*)take((size_t)NT * 8 * 4);
  p.ssm_part = (float*)take((size_t)NT * 8 * 4);
  p.h_part = (float*)take((size_t)NT * 16 * 4);
  p.out_part = (float*)take((size_t)NT * 16 * 4);
  p.counters = (int*)take(256);
  p.E = (float2*)take((size_t)8 * 128 * 32 * 64 * 8);
  p.S = (float2*)take((size_t)8 * 128 * 32 * 64 * 8);
  const size_t a0 = off;
  p.Kn = (bf16_t*)take((size_t)NK * 512 * 2);
  const size_t aVt = off;
  p.Vt = (bf16_t*)take((size_t)NK * 512 * 2);
  p.Q = (bf16_t*)take((size_t)NT * 768 * 2);
  p.latb = (bf16_t*)take((size_t)NK * 256 * 2);
  p.krb = (bf16_t*)take((size_t)NK * 32 * 2);
  p.ub = (bf16_t*)take((size_t)NT * 512 * 2);
  const size_t aSsmY = off;
  p.ssm_y = (bf16_t*)take((size_t)NT * 512 * 2);
  p.mix = (bf16_t*)take((size_t)NT * 1024 * 2);
  const size_t total = off;
  p.xb = (bf16_t*)(base + a0);
  p.cq = (bf16_t*)(base + aVt);
  p.ckv_raw = (float*)(base + aVt + al256((size_t)NT * 768 * 2));
  p.act = (bf16_t*)(base + a0);
  const size_t aHb = a0 + al256((size_t)NT * 4096 * 2);
  p.hb = (bf16_t*)(base + aHb);
  if (aHb + (size_t)NT * 1024 * 2 > aSsmY || total > ws_size) { fprintf(stderr, "workspace layout error: total %zu ws %zu\n", total, ws_size); return; }

  const int MULTI = 1;
  if (MULTI) {
    for (int ph = 0; ph < NPHASE; ++ph) {
      p.ph_lo = ph; p.ph_hi = ph + 1;
      hipLaunchKernelGGL(mega<false>, dim3(512), dim3(256), 0, stream, p);
    }
  } else {
    static int grid_blocks = 0;
    if (!grid_blocks) {
      int dev = 0, cus = 0, per_cu = 0;
      hipGetDevice(&dev);
      hipDeviceGetAttribute(&cus, hipDeviceAttributeMultiprocessorCount, dev);
      hipOccupancyMaxActiveBlocksPerMultiprocessor(&per_cu, mega<true>, 256, 0);
      grid_blocks = cus * per_cu;
    }
    p.ph_lo = 0; p.ph_hi = NPHASE;
    void* args[] = {&p};
    hipError_t e = hipLaunchCooperativeKernel((void*)mega<true>, dim3(grid_blocks), dim3(256), args, 0, stream);
    if (e != hipSuccess) fprintf(stderr, "cooperative launch failed: %s (grid %d)\n", hipGetErrorString(e), grid_blocks);
  }
}
```

```cpp
#include <hip/hip_runtime.h>
#include <hip/hip_cooperative_groups.h>
#include <stdint.h>
#include <cstdio>
namespace cg = cooperative_groups;
#define DI __device__ __forceinline__

typedef unsigned short bf16_t;
typedef short bf16x8 __attribute__((ext_vector_type(8)));
typedef float f32x16 __attribute__((ext_vector_type(16)));
typedef float f32x4 __attribute__((ext_vector_type(4)));
typedef unsigned u32x4 __attribute__((ext_vector_type(4)));
typedef unsigned u32x2 __attribute__((ext_vector_type(2)));

constexpr int NTP = 65536, NTS = 2048, NT = NTP + NTS, NK = NTP + 32 * 4160;
constexpr int SKS = 4160;
constexpr size_t OFF_Y = 0;
constexpr size_t OFF_LATP = (size_t)NT * 1024;
constexpr size_t OFF_KRP = OFF_LATP + (size_t)NTP * 256;
constexpr size_t OFF_HRP = OFF_KRP + (size_t)NTP * 32;
constexpr size_t OFF_HIP = OFF_HRP + 8 * 32 * 64;
constexpr size_t OFF_LATS = OFF_HIP + 8 * 32 * 64;
constexpr size_t OFF_KRS = OFF_LATS + (size_t)NTS * 256;
constexpr size_t OFF_HRS = OFF_KRS + (size_t)NTS * 32;
constexpr size_t OFF_HIS = OFF_HRS + 32 * 32 * 64;
constexpr size_t VT_S_OFF = (size_t)8 * 512 * 8192;
constexpr float EPS = 1e-6f;
constexpr int LDS_BYTES = 67584;
constexpr int NPHASE = 10;
constexpr int AQT = 1, NQQ = 128 / (4 / (64 / (32 * AQT)));

struct Params {
  const float* in[28];
  float* out;
  bf16_t *WinT, *WqT, *WkT, *WvT, *WgT, *WoT, *WuT, *WdT, *BbT, *CcT;
  float2 *lam, *lam64, *rope;
  float *rstd_x, *cq_part, *ckv_part, *attn_part, *ssm_part, *h_part, *out_part;
  int* counters;
  float2 *E, *S;
  bf16_t *Kn, *Vt, *Q, *latb, *krb, *ub, *ssm_y, *mix, *xb, *cq, *hb, *act;
  float* ckv_raw;
  int ph_lo, ph_hi;
};

DI int tid() { int t = __builtin_amdgcn_workitem_id_x(); asm volatile("" : "+v"(t)); return t; }
typedef __bf16 nbf16x2 __attribute__((ext_vector_type(2)));
typedef float f32x2 __attribute__((ext_vector_type(2)));
DI unsigned pk_bf16(float lo, float hi) { f32x2 v = {lo, hi}; return __builtin_bit_cast(unsigned, __builtin_convertvector(v, nbf16x2)); }
DI bf16_t f2bf(float x) { return (bf16_t)(pk_bf16(x, 0.f) & 0xffffu); }
DI float bf2f(bf16_t v) { return __uint_as_float(((unsigned)v) << 16); }
DI int crow(int i, int hh) { return (i & 3) + 8 * (i >> 2) + 4 * hh; }
DI const float* xrow(const Params& p, int row) { return row < NTP ? p.in[0] + (size_t)row * 1024 : p.in[1] + (size_t)(row - NTP) * 1024; }
DI int pos_of(int row) { return row < NTP ? (row & 8191) : 4096 + ((row - NTP) & 63); }
DI int kr_of(int row) { return row < NTP ? row : NTP + ((row - NTP) >> 6) * SKS + 4096 + ((row - NTP) & 63); }
#define MFMA32(a, b, c) __builtin_amdgcn_mfma_f32_32x32x16_bf16((a), (b), (c), 0, 0, 0)
#define MFMA16(a, b, c) __builtin_amdgcn_mfma_f32_16x16x32_bf16((a), (b), (c), 0, 0, 0)

DI void sincos_d(double x, double& s4, double& c4) {
  double k = rint(x * 0.15915494309189535);
  double rr = fma(-k, 6.283185307179586, x);
  rr = fma(-k, 2.4492935982947064e-16, rr);
  double y = rr * 0.25, y2 = y * y;
  double s = y * (1 - y2 / 6 * (1 - y2 / 20 * (1 - y2 / 42 * (1 - y2 / 72 * (1 - y2 / 110 * (1 - y2 / 156 * (1 - y2 / 210)))))));
  double c = 1 - y2 / 2 * (1 - y2 / 12 * (1 - y2 / 30 * (1 - y2 / 56 * (1 - y2 / 90 * (1 - y2 / 132 * (1 - y2 / 182))))));
  double s2 = 2 * s * c, c2 = 1 - 2 * s * s;
  s4 = 2 * s2 * c2; c4 = 1 - 2 * s2 * s2;
}

DI void gemm_core(const bf16_t* __restrict__ A, int lda, const bf16_t* __restrict__ B, int ldb, int nk,
                  int m0, int n0, char* lds, f32x16 (&acc)[2][2], int midk, const float* ratio) {
  const int t = tid(), lane = t & 63, wid = t >> 6, wm = wid >> 1, wn = wid & 1;
  const int r = lane & 31, hh = lane >> 5;
  const int lc = t & 7, lr = t >> 3;
  const unsigned woff = lr * 128 + ((lc ^ ((lr >> 1) & 7)) << 4);
  const bf16_t* ga = A + (size_t)(m0 + lr) * lda + lc * 8;
  const bf16_t* gb = B + (size_t)(n0 + lr) * ldb + lc * 8;
  char* sA = lds; char* sB = lds + 32768;
  u32x4 ra[4], rb[4];
#pragma unroll
  for (int i = 0; i < 4; ++i) { ra[i] = *(const u32x4*)(ga + (size_t)(32 * i) * lda); rb[i] = *(const u32x4*)(gb + (size_t)(32 * i) * ldb); }
#pragma unroll
  for (int i = 0; i < 4; ++i) { *(u32x4*)(sA + woff + i * 4096) = ra[i]; *(u32x4*)(sB + woff + i * 4096) = rb[i]; }
#pragma unroll
  for (int a = 0; a < 2; ++a)
#pragma unroll
    for (int b = 0; b < 2; ++b)
#pragma unroll
      for (int i = 0; i < 16; ++i) acc[a][b][i] = 0.f;
  __syncthreads();
  const int rsw = (r >> 1) & 7;
  const unsigned aoff = (wm * 64 + r) * 128, boff = (wn * 64 + r) * 128;
  for (int kt = 0; kt < nk; ++kt) {
    const int cur = kt & 1;
    const bool more = (kt + 1 < nk);
    if (more) {
      const bf16_t* ga2 = ga + (kt + 1) * 64; const bf16_t* gb2 = gb + (kt + 1) * 64;
#pragma unroll
      for (int i = 0; i < 4; ++i) { ra[i] = *(const u32x4*)(ga2 + (size_t)(32 * i) * lda); rb[i] = *(const u32x4*)(gb2 + (size_t)(32 * i) * ldb); }
    }
    if (midk && kt == midk) {
#pragma unroll
      for (int mt = 0; mt < 2; ++mt)
      { const float f = ratio[wm * 64 + mt * 32 + r];
#pragma unroll
        for (int i = 0; i < 16; ++i) { acc[mt][0][i] *= f; acc[mt][1][i] *= f; } }
    }
    const char* cA = sA + cur * 16384; const char* cB = sB + cur * 16384;
#pragma unroll
    for (int ks = 0; ks < 4; ++ks) {
      const unsigned co = (((ks * 2 + hh) ^ rsw) << 4);
      const bf16x8 a0 = *(const bf16x8*)(cA + aoff + co), a1 = *(const bf16x8*)(cA + aoff + 4096 + co);
      const bf16x8 b0 = *(const bf16x8*)(cB + boff + co), b1 = *(const bf16x8*)(cB + boff + 4096 + co);
      acc[0][0] = MFMA32(b0, a0, acc[0][0]); acc[0][1] = MFMA32(b1, a0, acc[0][1]);
      acc[1][0] = MFMA32(b0, a1, acc[1][0]); acc[1][1] = MFMA32(b1, a1, acc[1][1]);
    }
    if (more) {
      char* nA = sA + (cur ^ 1) * 16384; char* nB = sB + (cur ^ 1) * 16384;
#pragma unroll
      for (int i = 0; i < 4; ++i) { *(u32x4*)(nA + woff + i * 4096) = ra[i]; *(u32x4*)(nB + woff + i * 4096) = rb[i]; }
    }
    __syncthreads();
  }
}

DI void rowscale_load(float* rs, const float* src, int np, float inv_dim, int m0) {
  const int t = tid();
  if (t < 128) {
    const int row = m0 + t;
    if (np == 0) rs[t] = src[row];
    else { float s = 0.f; for (int j = 0; j < np; ++j) s += src[(size_t)row * np + j]; rs[t] = rsqrtf(s * inv_dim + EPS); }
  }
}

template <bool BLKA = false, class TileFn, class RsFn, class EpiFn>
DI void gemm_stream(const bf16_t* __restrict__ A, int lda, const bf16_t* __restrict__ B, int ldb, int nk, char* lds, int midk,
                    TileFn tile_fn, RsFn rs_fn, EpiFn epi) {
  int m0, n0;
  if (!tile_fn(0, m0, n0)) return;
  const int t = tid(), lane = t & 63, wid = t >> 6, wm = wid >> 1, wn = wid & 1;
  const int r = lane & 31, hh = lane >> 5;
  const int lc = t & 7, lr = t >> 3;
  const unsigned woff = lr * 128 + ((lc ^ ((lr >> 1) & 7)) << 4);
  char* sA = lds; char* sB = lds + 32768;
  float* rsbuf = (float*)(lds + 65536);
  const int rsw = (r >> 1) & 7;
  const unsigned aoff = (wm * 64 + r) * 128, boff = (wn * 64 + r) * 128;
  int lj = 0, lkt = 0, lm0 = m0, ln0 = n0; bool lvalid = true;
  u32x4 ra0[4], rb0[4], ra1[4], rb1[4];
#define GS_LOAD(RA, RB) do {   \
        \
      const bf16_t* ga_ = BLKA ? A + ((size_t)(lm0 >> 7) * nk + lkt) * 8192 + lr * 64 + lc * 8 : A + (size_t)(lm0 + lr) * lda + lc * 8 + lkt * 64; const bf16_t* gb_ = B + (size_t)(ln0 + lr) * ldb + lc * 8 + lkt * 64; \
      _Pragma("unroll") for (int i = 0; i < 4; ++i) { RA[i] = *(const u32x4*)(ga_ + (size_t)(32 * i) * (BLKA ? 64 : lda)); RB[i] = *(const u32x4*)(gb_ + (size_t)(32 * i) * ldb); } \
      if (++lkt == nk) { lkt = 0; if (lvalid) { ++lj; lvalid = tile_fn(lj, lm0, ln0); } } } while (0)
  GS_LOAD(ra0, rb0);
  GS_LOAD(ra1, rb1);
  {
    float2 rv = make_float2(0.f, 0.f);
    if (t < 128) rv = rs_fn(m0, t);
    __syncthreads();
#pragma unroll
    for (int i = 0; i < 4; ++i) { *(u32x4*)(sA + woff + i * 4096) = ra0[i]; *(u32x4*)(sB + woff + i * 4096) = rb0[i]; }
    if (t < 128) { rsbuf[t] = rv.x; rsbuf[128 + t] = rv.y; }
    __syncthreads();
  }
  int cur = 0;
  for (int j = 0;; ++j) {
    int m1 = 0, n1 = 0;
    const bool has_next = tile_fn(j + 1, m1, n1);
    const float* rs = rsbuf + (j & 1) * 256;
    f32x16 acc[2][2];
#pragma unroll
    for (int a = 0; a < 2; ++a)
#pragma unroll
      for (int b = 0; b < 2; ++b)
#pragma unroll
        for (int i = 0; i < 16; ++i) acc[a][b][i] = 0.f;
#define GS_STEP(RL_A, RL_B, RW_A, RW_B, KT) do { \
      const bool last_ = ((KT) + 1 == nk); const bool wr_ = !last_ || has_next; \
      float2 rv_ = make_float2(0.f, 0.f); \
      if (last_ && has_next) { if (t < 128) rv_ = rs_fn(m1, t); asm volatile("" : "+v"(rv_.x), "+v"(rv_.y)); }   \
      GS_LOAD(RL_A, RL_B); \
      if (midk && (KT) == midk) { _Pragma("unroll") for (int mt = 0; mt < 2; ++mt) { const float f = rs[128 + wm * 64 + mt * 32 + r]; \
          _Pragma("unroll") for (int i = 0; i < 16; ++i) { acc[mt][0][i] *= f; acc[mt][1][i] *= f; } } } \
      const char* cA = sA + cur * 16384; const char* cB = sB + cur * 16384; \
      _Pragma("unroll") for (int ks = 0; ks < 4; ++ks) { \
        const unsigned co = (((ks * 2 + hh) ^ rsw) << 4); \
        const bf16x8 a0 = *(const bf16x8*)(cA + aoff + co), a1 = *(const bf16x8*)(cA + aoff + 4096 + co); \
        const bf16x8 b0 = *(const bf16x8*)(cB + boff + co), b1 = *(const bf16x8*)(cB + boff + 4096 + co); \
        acc[0][0] = MFMA32(b0, a0, acc[0][0]); acc[0][1] = MFMA32(b1, a0, acc[0][1]); \
        acc[1][0] = MFMA32(b0, a1, acc[1][0]); acc[1][1] = MFMA32(b1, a1, acc[1][1]); } \
      if (wr_) { char* nA = sA + (cur ^ 1) * 16384; char* nB = sB + (cur ^ 1) * 16384; \
        _Pragma("unroll") for (int i = 0; i < 4; ++i) { *(u32x4*)(nA + woff + i * 4096) = RW_A[i]; *(u32x4*)(nB + woff + i * 4096) = RW_B[i]; } \
        if (last_ && t < 128) { float* rn = rsbuf + ((j + 1) & 1) * 256; rn[t] = rv_.x; rn[128 + t] = rv_.y; } } \
      __syncthreads(); cur ^= 1; } while (0)
    for (int kt = 0; kt < nk; kt += 2) {
      GS_STEP(ra0, rb0, ra1, rb1, kt);
      GS_STEP(ra1, rb1, ra0, rb0, kt + 1);
    }
    epi(acc, m0, n0, rs);
    if (!has_next) break;
    m0 = m1; n0 = n1;
  }
#undef GS_STEP
#undef GS_LOAD
  __syncthreads();
}

DI float half_reduce(float s) {
  s += __shfl_xor(s, 1); s += __shfl_xor(s, 2); s += __shfl_xor(s, 4); s += __shfl_xor(s, 8); s += __shfl_xor(s, 16); return s;
}

#define EPI_IDS int t = tid(); asm volatile("" : "+v"(t)); const int lane = t & 63, wid = t >> 6, wm = wid >> 1, wn = wid & 1, r = lane & 31, hh = lane >> 5; (void)lane; (void)wid; (void)wm; (void)wn; (void)r; (void)hh;
#define GEMM_IDS const int t = tid(), lane = t & 63, wid = t >> 6, wm = wid >> 1, wn = wid & 1, r = lane & 31, hh = lane >> 5; (void)t; (void)wm; (void)wn; (void)r; (void)hh;

DI void transpose_tile(const float* __restrict__ src, int ld, int K, int kt, int nt, int job, const float* g0, const float* g1, bf16_t* __restrict__ dst, char* lds) {
  bf16_t* tile = (bf16_t*)lds;
  const int t = tid(), nl = t & 63, kq = t >> 6;
  const int n = nt * 64 + nl;
  int c = n;
  if (job == 0) { c = n < 1024 ? n : (n < 1536 ? 1056 + (n - 1024) : (n < 1568 ? 1024 + (n - 1536) : -1)); }
  else if (job == 2) c = (n >> 6) * 128 + (n & 63);
  else if (job == 3) c = (n >> 6) * 128 + 64 + (n & 63);
#pragma unroll 4
  for (int pass = 0; pass < 16; ++pass) {
    const int kl = pass * 4 + kq, k = kt * 64 + kl;
    float v = 0.f;
    if (c >= 0) {
      v = src[(size_t)k * ld + c];
      if (g0) { const float g = (g1 && k >= 512) ? g1[k - 512] : g0[k]; v *= g; }
    }
    tile[nl * 66 + kl] = f2bf(v);
  }
  __syncthreads();
  const int kl = t & 63;
#pragma unroll 4
  for (int pass = 0; pass < 16; ++pass) { const int nl2 = pass * 4 + kq; dst[(size_t)(nt * 64 + nl2) * K + kt * 64 + kl] = tile[nl2 * 66 + kl]; }
  __syncthreads();
}

DI void phase0(const Params& p, char* lds) {
  const int t = tid(), nb = gridDim.x, bid = blockIdx.x, lane = t & 63, wid = t >> 6;
  for (int ti = bid; ti < 2992; ti += nb) {
    int job, base, nNt, ld, K; const float* src; const float* g0 = nullptr; const float* g1 = nullptr; bf16_t* dst;
    if (ti < 416) { job = 0; base = 0; nNt = 26; ld = 1568; K = 1024; src = p.in[7]; g0 = p.in[6]; dst = p.WinT; }
    else if (ti < 560) { job = 1; base = 416; nNt = 12; ld = 768; K = 768; src = p.in[9]; g0 = p.in[8]; dst = p.WqT; }
    else if (ti < 592) { job = 2; base = 560; nNt = 8; ld = 1024; K = 256; src = p.in[11]; dst = p.WkT; }
    else if (ti < 624) { job = 3; base = 592; nNt = 8; ld = 1024; K = 256; src = p.in[11]; dst = p.WvT; }
    else if (ti < 688) { job = 4; base = 624; nNt = 8; ld = 512; K = 512; src = p.in[20]; dst = p.WgT; }
    else if (ti < 944) { job = 5; base = 688; nNt = 16; ld = 1024; K = 1024; src = p.in[23]; g0 = p.in[21]; g1 = p.in[22]; dst = p.WoT; }
    else if (ti < 1968) { job = 6; base = 944; nNt = 64; ld = 4096; K = 1024; src = p.in[25]; g0 = p.in[24]; dst = p.WuT; }
    else { job = 7; base = 1968; nNt = 16; ld = 1024; K = 4096; src = p.in[26]; dst = p.WdT; }
    const int tile = ti - base;
    transpose_tile(src, ld, K, tile / nNt, tile % nNt, job, g0, g1, dst, lds);
  }
  for (int row = bid * 4 + wid; row < NT; row += nb * 4) {
    const float* x = xrow(p, row);
    f32x4 v[4]; float ss = 0.f;
#pragma unroll
    for (int j = 0; j < 4; ++j) { v[j] = *(const f32x4*)(x + lane * 4 + 256 * j); ss += v[j][0] * v[j][0] + v[j][1] * v[j][1] + v[j][2] * v[j][2] + v[j][3] * v[j][3]; }
    ss += __shfl_xor(ss, 32); ss = half_reduce(ss);
#pragma unroll
    for (int j = 0; j < 4; ++j) { u32x2 w; w.x = pk_bf16(v[j][0], v[j][1]); w.y = pk_bf16(v[j][2], v[j][3]); *(u32x2*)(p.xb + (size_t)row * 1024 + lane * 4 + 256 * j) = w; }
    if (lane == 0) p.rstd_x[row] = rsqrtf(ss * (1.f / 1024.f) + EPS);
  }
  const int gt = bid * 256 + t, ngt = nb * 256;
  for (int v = gt; v < 32 * 4096 * 32; v += ngt) {
    const size_t e0 = (size_t)v * 8; const int b = (int)(e0 >> 20), rem = (int)(e0 & 1048575), tt = rem >> 8, c = rem & 255;
    const f32x4 a = *(const f32x4*)(p.in[2] + e0), bq = *(const f32x4*)(p.in[2] + e0 + 4);
    u32x4 w; w.x = pk_bf16(a[0], a[1]); w.y = pk_bf16(a[2], a[3]); w.z = pk_bf16(bq[0], bq[1]); w.w = pk_bf16(bq[2], bq[3]);
    *(u32x4*)(p.latb + (size_t)(NTP + b * SKS + tt) * 256 + c) = w;
  }
  for (int v = gt; v < 32 * 4096 * 4; v += ngt) {
    const size_t e0 = (size_t)v * 8; const int b = (int)(e0 >> 17), rem = (int)(e0 & 131071), tt = rem >> 5, c = rem & 31;
    const f32x4 a = *(const f32x4*)(p.in[3] + e0), bq = *(const f32x4*)(p.in[3] + e0 + 4);
    u32x4 w; w.x = pk_bf16(a[0], a[1]); w.y = pk_bf16(a[2], a[3]); w.z = pk_bf16(bq[0], bq[1]); w.w = pk_bf16(bq[2], bq[3]);
    *(u32x4*)(p.krb + (size_t)(NTP + b * SKS + tt) * 32 + c) = w;
  }
  if (gt < 2048) {
    const int g = gt >> 6, n = gt & 63;
    const double dt = (double)expf(p.in[14][g]);
    const double lr = p.in[12][gt], li = p.in[13][gt];
    const double mag = (double)expf((float)(lr * dt)); double s, c; sincos_d(li * dt, s, c);
    const double lbr = mag * c, lbi = mag * s;
    const double nr = lbr - 1.0, ni = lbi, den = lr * lr + li * li;
    const double cr = (nr * lr + ni * li) / den, ci = (ni * lr - nr * li) / den;
    p.lam[gt] = make_float2((float)lbr, (float)lbi);
    const double mag64 = (double)expf((float)(64.0 * lr * dt)); sincos_d(64.0 * li * dt, s, c);
    p.lam64[gt] = make_float2((float)(mag64 * c), (float)(mag64 * s));
    for (int q = 0; q < 16; ++q) {
      const double br = p.in[15][(size_t)gt * 16 + q], bi = p.in[16][(size_t)gt * 16 + q];
      p.BbT[(size_t)(g * 128 + n) * 16 + q] = f2bf((float)(cr * br - ci * bi));
      p.BbT[(size_t)(g * 128 + 64 + n) * 16 + q] = f2bf((float)(cr * bi + ci * br));
      p.CcT[(size_t)(g * 16 + q) * 128 + n] = f2bf(p.in[17][(size_t)(g * 16 + q) * 64 + n]);
      p.CcT[(size_t)(g * 16 + q) * 128 + 64 + n] = f2bf(-p.in[18][(size_t)(g * 16 + q) * 64 + n]);
    }
  }
  for (int e = gt; e < 8192 * 16; e += ngt) {
    const int pos = e >> 4, i = e & 15;
    const float inv = expf(-(float)i * (9.210340371976184f / 16.0f));
    const float ang = (float)pos * inv;
    double s, c; sincos_d((double)ang, s, c);
    p.rope[e] = make_float2((float)c, (float)s);
  }
}

DI void phase1(const Params& p, char* lds) {
  float* rs = (float*)(lds + 65536);
  const int ntiles = 528 * 13;
  {
    auto tile_fn = [&](int j, int& m0, int& n0) -> bool { const int li = (int)(blockIdx.x >> 3) + j * (int)(gridDim.x >> 3); const int ti_ = li / 13, tj_ = li - ti_ * 13; const int tbig = ti_ * 8 + (int)(blockIdx.x & 7); if (tbig >= 528) return false; m0 = tbig * 128; n0 = tj_ * 128; return true; };
    auto rs_fn = [&](int m0, int t) -> float2 { return make_float2(p.rstd_x[m0 + t], 0.f); };
    auto epi = [&](f32x16 (&acc)[2][2], int m0, int n0, const float* rs) {
    const int tn = n0 >> 7; (void)tn;
    { EPI_IDS
    if (tn < 8) {
#pragma unroll
      for (int mt = 0; mt < 2; ++mt) {
        const int rl = wm * 64 + mt * 32 + r, row = m0 + rl;
        const float sc = rs[rl];
        float ss = 0.f;
#pragma unroll
        for (int nt = 0; nt < 2; ++nt)
#pragma unroll
          for (int i4 = 0; i4 < 4; ++i4) {
            const float v0 = acc[mt][nt][4 * i4] * sc, v1 = acc[mt][nt][4 * i4 + 1] * sc, v2 = acc[mt][nt][4 * i4 + 2] * sc, v3 = acc[mt][nt][4 * i4 + 3] * sc;
            ss += v0 * v0 + v1 * v1 + v2 * v2 + v3 * v3;
            const int col = n0 + wn * 64 + nt * 32 + 8 * i4 + 4 * hh;
            if (tn < 6) { u32x2 w; w.x = pk_bf16(v0, v1); w.y = pk_bf16(v2, v3); *(u32x2*)(p.cq + (size_t)row * 768 + col) = w; }
            else { f32x4 w = {v0, v1, v2, v3}; *(f32x4*)(p.ckv_raw + (size_t)row * 256 + (col - 768)) = w; }
          }
        ss += __shfl_xor(ss, 32);
        if (hh == 0) { if (tn < 6) p.cq_part[(size_t)row * 12 + tn * 2 + wn] = ss; else p.ckv_part[(size_t)row * 4 + (tn - 6) * 2 + wn] = ss; }
      }
    } else if (tn < 12) {
#pragma unroll
      for (int mt = 0; mt < 2; ++mt) {
        const int rl = wm * 64 + mt * 32 + r, row = m0 + rl;
        const float sc = rs[rl];
#pragma unroll
        for (int nt = 0; nt < 2; ++nt)
#pragma unroll
          for (int i4 = 0; i4 < 4; ++i4) {
            u32x2 w; w.x = pk_bf16(acc[mt][nt][4 * i4] * sc, acc[mt][nt][4 * i4 + 1] * sc); w.y = pk_bf16(acc[mt][nt][4 * i4 + 2] * sc, acc[mt][nt][4 * i4 + 3] * sc);
            *(u32x2*)(p.ub + (size_t)row * 512 + (n0 - 1024) + wn * 64 + nt * 32 + 8 * i4 + 4 * hh) = w;
          }
      }
    } else if (wn == 0) {
#pragma unroll
      for (int mt = 0; mt < 2; ++mt) {
        const int rl = wm * 64 + mt * 32 + r, row = m0 + rl;
        const float sc = rs[rl];
        float* dst = row < NTP ? p.out + OFF_KRP + (size_t)row * 32 : p.out + OFF_KRS + (size_t)(row - NTP) * 32;
        bf16_t* dkb = p.krb + (size_t)kr_of(row) * 32;
        const float* rp = (const float*)(p.rope + pos_of(row) * 16);
#pragma unroll
        for (int ih = 0; ih < 2; ++ih) {
          const int j0 = 8 * ih + 4 * hh;
          const f32x4 c01 = *(const f32x4*)(rp + 2 * j0), c23 = *(const f32x4*)(rp + 2 * j0 + 4);
          const float cc[4] = {c01[0], c01[2], c23[0], c23[2]}, sn[4] = {c01[1], c01[3], c23[1], c23[3]};
          f32x4 o1, o2;
#pragma unroll
          for (int jj = 0; jj < 4; ++jj) {
            const float x1 = acc[mt][0][4 * ih + jj] * sc, x2 = acc[mt][0][8 + 4 * ih + jj] * sc;
            o1[jj] = x1 * cc[jj] - x2 * sn[jj]; o2[jj] = x1 * sn[jj] + x2 * cc[jj];
          }
          *(f32x4*)(dst + j0) = o1; *(f32x4*)(dst + 16 + j0) = o2;
          u32x2 w1, w2; w1.x = pk_bf16(o1[0], o1[1]); w1.y = pk_bf16(o1[2], o1[3]); w2.x = pk_bf16(o2[0], o2[1]); w2.y = pk_bf16(o2[2], o2[3]);
          *(u32x2*)(dkb + j0) = w1; *(u32x2*)(dkb + 16 + j0) = w2;
        }
      }
    }
    }

    };
    gemm_stream(p.xb, 1024, p.WinT, 1024, 16, lds, 0, tile_fn, rs_fn, epi);
  }
}

DI void ssm_chunk(const Params& p, int row0, int g, float& hr, float& hi, bool write_y, char* lds_w) {
  const int lane = tid() & 63, r = lane & 31, hh = lane >> 5;
  const float2 lm = p.lam[g * 64 + lane];
  bf16x8 bfr[4];
#pragma unroll
  for (int nt = 0; nt < 4; ++nt) bfr[nt] = *(const bf16x8*)(p.BbT + (size_t)(g * 128 + nt * 32 + r) * 16 + hh * 8);
  const int fr = lane & 15, fq = lane >> 4;
  bf16x8 cfr[4];
#pragma unroll
  for (int ks = 0; ks < 4; ++ks) cfr[ks] = *(const bf16x8*)(p.CcT + (size_t)(g * 16 + fr) * 128 + ks * 32 + fq * 8);
  const float dsk = p.in[19][g * 16 + fr];
#pragma unroll 1
  for (int sub = 0; sub < 2; ++sub) {
    const int rb = row0 + sub * 32;
    const bf16x8 uf = *(const bf16x8*)(p.ub + (size_t)(rb + r) * 512 + g * 16 + hh * 8);
    f32x16 z; for (int i = 0; i < 16; ++i) z[i] = 0.f;
    const f32x16 x0 = MFMA32(uf, bfr[0], z), x1 = MFMA32(uf, bfr[1], z), x2 = MFMA32(uf, bfr[2], z), x3 = MFMA32(uf, bfr[3], z);
    float xr0[16], xr1[16], xi0[16], xi1[16];
#pragma unroll
    for (int i = 0; i < 16; ++i) {
      const float sre = hh ? x0[i] : x1[i];
      const float rre = __shfl_xor(sre, 32);
      const float sim = hh ? x2[i] : x3[i];
      const float rim = __shfl_xor(sim, 32);
      xr0[i] = hh ? rre : x0[i]; xr1[i] = hh ? x1[i] : rre;
      xi0[i] = hh ? rim : x2[i]; xi1[i] = hh ? x3[i] : rim;
    }
    bf16_t* Hs = (bf16_t*)lds_w;
#pragma unroll
    for (int m = 0; m < 4; ++m) {
#pragma unroll
      for (int half = 0; half < 2; ++half) {
#pragma unroll
        for (int jj = 0; jj < 4; ++jj) {
          const int i = 4 * m + jj, tt = 8 * m + 4 * half + jj;
          const float xr = half ? xr1[i] : xr0[i], xi = half ? xi1[i] : xi0[i];
          const float nr = lm.x * hr - lm.y * hi + xr;
          const float ni = lm.x * hi + lm.y * hr + xi;
          hr = nr; hi = ni;
          if (write_y) { Hs[tt * 136 + lane] = f2bf(hr); Hs[tt * 136 + 64 + lane] = f2bf(hi); }
        }
      }
    }
    if (write_y) {
      asm volatile("s_waitcnt lgkmcnt(0)" ::: "memory");
      __builtin_amdgcn_wave_barrier();
#pragma unroll
      for (int mt = 0; mt < 2; ++mt) {
        f32x4 y = {0.f, 0.f, 0.f, 0.f};
#pragma unroll
        for (int ks = 0; ks < 4; ++ks) {
          const bf16x8 hf = *(const bf16x8*)(Hs + (mt * 16 + fr) * 136 + ks * 32 + fq * 8);
          y = MFMA16(hf, cfr[ks], y);
        }
#pragma unroll
        for (int j = 0; j < 4; ++j) {
          const int row = rb + mt * 16 + fq * 4 + j;
          const float u = bf2f(p.ub[(size_t)row * 512 + g * 16 + fr]);
          const float v = y[j] + dsk * u;
          const float zz = 0.7978845608028654f * (v + 0.044715f * v * v * v);
          const float th = 1.f - 2.f / (__expf(2.f * zz) + 1.f);
          p.ssm_y[(size_t)row * 512 + g * 16 + fr] = f2bf(0.5f * v * (1.f + th));
        }
      }
      asm volatile("s_waitcnt lgkmcnt(0)" ::: "memory");
      __builtin_amdgcn_wave_barrier();
    }
  }
}

DI void phase2(const Params& p, char* lds) {
  const int lane = tid() & 63, wid = tid() >> 6;
  const int nb = gridDim.x, bid = blockIdx.x;
  for (int row = bid * 4 + wid; row < NT; row += nb * 4) {
    const f32x4 v = *(const f32x4*)(p.ckv_raw + (size_t)row * 256 + lane * 4);
    const f32x4 pp = *(const f32x4*)(p.ckv_part + (size_t)row * 4);
    const float rstd = rsqrtf((pp[0] + pp[1] + pp[2] + pp[3]) * (1.f / 256.f) + EPS);
    const f32x4 g = *(const f32x4*)(p.in[10] + lane * 4);
    f32x4 o; o[0] = v[0] * rstd * g[0]; o[1] = v[1] * rstd * g[1]; o[2] = v[2] * rstd * g[2]; o[3] = v[3] * rstd * g[3];
    float* dst = row < NTP ? p.out + OFF_LATP + (size_t)row * 256 : p.out + OFF_LATS + (size_t)(row - NTP) * 256;
    *(f32x4*)(dst + lane * 4) = o;
    u32x2 w; w.x = pk_bf16(o[0], o[1]); w.y = pk_bf16(o[2], o[3]);
    *(u32x2*)(p.latb + (size_t)kr_of(row) * 256 + lane * 4) = w;
  }
  for (int it = bid * 4 + wid; it < 8 * 128 * 32; it += nb * 4) {
    const int g = it & 31, c = (it >> 5) & 127, b = it >> 12;
    float hr = 0.f, hi = 0.f;
    ssm_chunk(p, b * 8192 + c * 64, g, hr, hi, false, lds + wid * 8704);
    p.E[(size_t)it * 64 + lane] = make_float2(hr, hi);
  }
  float* rs = (float*)(lds + 65536);
  {
    auto tile_fn = [&](int j, int& m0, int& n0) -> bool { const int li = (int)(blockIdx.x >> 3) + j * (int)(gridDim.x >> 3); const int ti_ = li / 6, tj_ = li - ti_ * 6; const int tbig = ti_ * 8 + (int)(blockIdx.x & 7); if (tbig >= 528) return false; m0 = tbig * 128; n0 = tj_ * 128; return true; };
    auto rs_fn = [&](int m0, int t) -> float2 { float sm = 0.f; for (int q = 0; q < 3; ++q) { const f32x4 v = *(const f32x4*)(p.cq_part + (size_t)(m0 + t) * 12 + 4 * q); sm += (v[0] + v[1]) + (v[2] + v[3]); } return make_float2(rsqrtf(sm * (1.f / 768.f) + EPS), 0.f); };
    auto epi = [&](f32x16 (&acc)[2][2], int m0, int n0, const float* rs) {
    const int tn = n0 >> 7; (void)tn;
    EPI_IDS
    const float qs = 0.10206207261596577f * 1.4426950408889634f;
#pragma unroll
    for (int mt = 0; mt < 2; ++mt) {
      const int rl = wm * 64 + mt * 32 + r, row = m0 + rl;
      const float sc = rs[rl] * qs;
      const float* rp = (const float*)(p.rope + pos_of(row) * 16);
#pragma unroll
      for (int nt = 0; nt < 2; ++nt) {
        const int cb = n0 + wn * 64 + nt * 32;
        bf16_t* qd = p.Q + (size_t)row * 768 + cb;
        if ((cb % 96) == 64) {
#pragma unroll
          for (int ih = 0; ih < 2; ++ih) {
            const int j0 = 8 * ih + 4 * hh;
            const f32x4 c01 = *(const f32x4*)(rp + 2 * j0), c23 = *(const f32x4*)(rp + 2 * j0 + 4);
            const float cc[4] = {c01[0], c01[2], c23[0], c23[2]}, sn[4] = {c01[1], c01[3], c23[1], c23[3]};
            float o1[4], o2[4];
#pragma unroll
            for (int jj = 0; jj < 4; ++jj) {
              const float x1 = acc[mt][nt][4 * ih + jj] * sc, x2 = acc[mt][nt][8 + 4 * ih + jj] * sc;
              o1[jj] = x1 * cc[jj] - x2 * sn[jj]; o2[jj] = x1 * sn[jj] + x2 * cc[jj];
            }
            u32x2 w1, w2; w1.x = pk_bf16(o1[0], o1[1]); w1.y = pk_bf16(o1[2], o1[3]); w2.x = pk_bf16(o2[0], o2[1]); w2.y = pk_bf16(o2[2], o2[3]);
            *(u32x2*)(qd + j0) = w1; *(u32x2*)(qd + 16 + j0) = w2;
          }
        } else {
#pragma unroll
          for (int i4 = 0; i4 < 4; ++i4) {
            u32x2 w; w.x = pk_bf16(acc[mt][nt][4 * i4] * sc, acc[mt][nt][4 * i4 + 1] * sc); w.y = pk_bf16(acc[mt][nt][4 * i4 + 2] * sc, acc[mt][nt][4 * i4 + 3] * sc);
            *(u32x2*)(qd + 8 * i4 + 4 * hh) = w;
          }
        }
      }
    }

    };
    gemm_stream(p.cq, 768, p.WqT, 768, 12, lds, 0, tile_fn, rs_fn, epi);
  }
}

DI void phase3(const Params& p, char* lds) {
  const int lane = tid() & 63, wid = tid() >> 6;
  const int nb = gridDim.x, bid = blockIdx.x;
  for (int it = bid * 4 + wid; it < 256; it += nb * 4) {
    const int b = it >> 5, g = it & 31;
    const float2 l64 = p.lam64[g * 64 + lane];
    float sr = 0.f, si = 0.f;
    const size_t base = ((size_t)(b * 128) * 32 + g) * 64 + lane;
    for (int c0 = 0; c0 < 128; c0 += 16) {
      float2 e[16];
#pragma unroll
      for (int j = 0; j < 16; ++j) e[j] = p.E[base + (size_t)(c0 + j) * 2048];
#pragma unroll
      for (int j = 0; j < 16; ++j) {
        p.S[base + (size_t)(c0 + j) * 2048] = make_float2(sr, si);
        const float nr = l64.x * sr - l64.y * si + e[j].x, ni = l64.x * si + l64.y * sr + e[j].y;
        sr = nr; si = ni;
      }
    }
  }
  {
    auto tile_fn = [&](int j, int& m0, int& n0) -> bool { const int li = (int)(blockIdx.x >> 3) + j * (int)(gridDim.x >> 3); const int ti_ = li / 4, tj_ = li - ti_ * 4; const int tbig = ti_ * 8 + (int)(blockIdx.x & 7); if (tbig >= 1552) return false; m0 = tbig * 128; n0 = tj_ * 128; return true; };
    auto rs_fn = [&](int m0, int t) -> float2 { return make_float2(0.f, 0.f); };
    auto epi = [&](f32x16 (&acc)[2][2], int m0, int n0, const float* rs) {
    const int tn = n0 >> 7; (void)tn;
    EPI_IDS
#pragma unroll
    for (int mt = 0; mt < 2; ++mt) {
      const int row = m0 + wm * 64 + mt * 32 + r;
#pragma unroll
      for (int nt = 0; nt < 2; ++nt)
#pragma unroll
        for (int i4 = 0; i4 < 4; ++i4) {
          u32x2 w; w.x = pk_bf16(acc[mt][nt][4 * i4], acc[mt][nt][4 * i4 + 1]); w.y = pk_bf16(acc[mt][nt][4 * i4 + 2], acc[mt][nt][4 * i4 + 3]);
          *(u32x2*)(p.Kn + (size_t)row * 512 + n0 + wn * 64 + nt * 32 + 8 * i4 + 4 * hh) = w;
        }
    }

    };
    gemm_stream(p.latb, 256, p.WkT, 256, 4, lds, 0, tile_fn, rs_fn, epi);
  }
  {
    auto tile_fn = [&](int j, int& m0, int& n0) -> bool { const int li = (int)(blockIdx.x >> 3) + j * (int)(gridDim.x >> 3); const int ti_ = li / 4, tj_ = li - ti_ * 4; const int tbig = ti_ * 8 + (int)(blockIdx.x & 7); if (tbig >= 1552) return false; n0 = tbig * 128; m0 = tj_ * 128; return true; };
    auto rs_fn = [&](int m0, int t) -> float2 { return make_float2(0.f, 0.f); };
    auto epi = [&](f32x16 (&acc)[2][2], int m0, int n0, const float* rs) {
    const int tn = n0 >> 7; (void)tn;
    EPI_IDS
#pragma unroll
    for (int nt = 0; nt < 2; ++nt)
#pragma unroll
      for (int i4 = 0; i4 < 4; ++i4) {
        const int kr = n0 + wn * 64 + nt * 32 + 8 * i4 + 4 * hh;
        size_t cbase; int S;
        if (kr < NTP) { cbase = (size_t)(kr >> 13) * 512 * 8192 + (kr & 8191); S = 8192; }
        else { const int k2 = kr - NTP, b = k2 / SKS, tt = k2 - b * SKS; cbase = VT_S_OFF + (size_t)b * 512 * SKS + tt; S = SKS; }
#pragma unroll
        for (int mt = 0; mt < 2; ++mt) {
          const int hd = m0 + wm * 64 + mt * 32 + r;
          u32x2 w; w.x = pk_bf16(acc[mt][nt][4 * i4], acc[mt][nt][4 * i4 + 1]); w.y = pk_bf16(acc[mt][nt][4 * i4 + 2], acc[mt][nt][4 * i4 + 3]);
          *(u32x2*)(p.Vt + cbase + (size_t)hd * S) = w;
        }
      }

    };
    gemm_stream(p.WvT, 256, p.latb, 256, 4, lds, 0, tile_fn, rs_fn, epi);
  }
}

template <int QT>
DI void attn_item(const Params& p, int kind, int b, int h, int qq, char* lds) {
  const int t = tid(), lane = t & 63, wid = t >> 6, r = lane & 31, hh = lane >> 5;
  int qrow0, nkb_w, nkb_max, S; size_t kr0; const bf16_t* vt_base;
  constexpr int RW = 32 * QT, WPC = 64 / RW, CPB = 4 / WPC;
  if (kind == 0) {
    const int c = qq * CPB + wid / WPC; qrow0 = b * 8192 + c * 64 + (wid % WPC) * RW; nkb_w = c + 1; nkb_max = qq * CPB + CPB; kr0 = (size_t)b * 8192; S = 8192;
    vt_base = p.Vt + (size_t)(b * 8 + h) * 64 * 8192;
  } else {
    qrow0 = NTP + b * 64 + (wid % WPC) * RW; nkb_w = (wid < WPC) ? 65 : 0; nkb_max = 65; kr0 = (size_t)NTP + (size_t)b * SKS; S = SKS;
    vt_base = p.Vt + VT_S_OFF + (size_t)(b * 8 + h) * 64 * SKS;
  }
  bf16x8 qf[QT][6];
#pragma unroll
  for (int qt = 0; qt < QT; ++qt)
#pragma unroll
    for (int ks = 0; ks < 6; ++ks) qf[qt][ks] = *(const bf16x8*)(p.Q + (size_t)(qrow0 + qt * 32 + r) * 768 + h * 96 + ks * 16 + hh * 8);
  f32x16 o[2][QT];
  float mrun[QT], lrun[QT];
#pragma unroll
  for (int qt = 0; qt < QT; ++qt) { mrun[qt] = -1e30f; lrun[qt] = 0.f;
#pragma unroll
    for (int dt = 0; dt < 2; ++dt)
#pragma unroll
      for (int i = 0; i < 16; ++i) o[dt][qt][i] = 0.f; }
  const int kkey = t >> 3, kc = t & 7;
  const int rkey = t >> 2, rc = t & 3;
  const int vd = t >> 3, vc = t & 7;
  const bf16_t* gk = p.Kn + (kr0 + kkey) * 512 + h * 64 + kc * 8;
  const bf16_t* gr = p.krb + (kr0 + rkey) * 32 + rc * 8;
  const bf16_t* gv = vt_base + (size_t)vd * S + vc * 8;
  const unsigned kw0 = kkey * 208 + kc * 16, kw1 = kw0 + 32 * 208, rw = rkey * 208 + 128 + rc * 16;
  const unsigned vlo = vd * 144 + (vc >> 1) * 32 + (vc & 1) * 8, vhi = vlo + 16;
  constexpr int KB = 13312, VB = 9216, BUF = KB + VB;
  u32x4 k0r, k1r, rr, v0r, v1r;
  k0r = *(const u32x4*)gk; k1r = *(const u32x4*)(gk + 32 * 512); rr = *(const u32x4*)gr;
  v0r = *(const u32x4*)gv; v1r = *(const u32x4*)(gv + (size_t)32 * S);
  __syncthreads();
  {
    char* kb_ = lds; char* vb_ = lds + KB;
    *(u32x4*)(kb_ + kw0) = k0r; *(u32x4*)(kb_ + kw1) = k1r; *(u32x4*)(kb_ + rw) = rr;
    *(u32x2*)(vb_ + vlo) = (u32x2){v0r.x, v0r.y}; *(u32x2*)(vb_ + vhi) = (u32x2){v0r.z, v0r.w};
    *(u32x2*)(vb_ + vlo + 32 * 144) = (u32x2){v1r.x, v1r.y}; *(u32x2*)(vb_ + vhi + 32 * 144) = (u32x2){v1r.z, v1r.w};
  }
  __syncthreads();
  for (int kb = 0; kb < nkb_max; ++kb) {
    const int cur = kb & 1;
    const bool more = kb + 1 < nkb_max;
    if (more) {
      const size_t ko = (size_t)(kb + 1) * 64;
      k0r = *(const u32x4*)(gk + ko * 512); k1r = *(const u32x4*)(gk + (ko + 32) * 512); rr = *(const u32x4*)(gr + ko * 32);
      v0r = *(const u32x4*)(gv + ko); v1r = *(const u32x4*)(gv + (size_t)32 * S + ko);
    }
    if (kb < nkb_w) {
      const char* kt_ = lds + cur * BUF; const char* vt_ = kt_ + KB;
      f32x16 st[2][QT];
#pragma unroll
      for (int kt = 0; kt < 2; ++kt)
#pragma unroll
        for (int qt = 0; qt < QT; ++qt)
#pragma unroll
          for (int i = 0; i < 16; ++i) st[kt][qt][i] = 0.f;
#pragma unroll
      for (int ks = 0; ks < 6; ++ks)
#pragma unroll
        for (int kt = 0; kt < 2; ++kt) {
          const bf16x8 kf = *(const bf16x8*)(kt_ + (kt * 32 + r) * 208 + ks * 32 + hh * 16);
#pragma unroll
          for (int qt = 0; qt < QT; ++qt) st[kt][qt] = MFMA32(kf, qf[qt][ks], st[kt][qt]);
        }
      bf16x8 pb[2][QT][2];
#pragma unroll
      for (int qt = 0; qt < QT; ++qt) {
        float mx = mrun[qt];
#pragma unroll
        for (int kt = 0; kt < 2; ++kt)
#pragma unroll
          for (int i = 0; i < 16; ++i) mx = fmaxf(mx, st[kt][qt][i]);
        mx = fmaxf(mx, __shfl_xor(mx, 32));
        const float alpha = __builtin_amdgcn_exp2f(mrun[qt] - mx);
        mrun[qt] = mx;
        float ls = 0.f;
#pragma unroll
        for (int kt = 0; kt < 2; ++kt) {
#pragma unroll
          for (int i = 0; i < 16; ++i) { const float pv = __builtin_amdgcn_exp2f(st[kt][qt][i] - mx); ls += pv; st[kt][qt][i] = pv; }
#pragma unroll
          for (int s2 = 0; s2 < 2; ++s2) {
            u32x4 w;
            w.x = pk_bf16(st[kt][qt][8 * s2 + 0], st[kt][qt][8 * s2 + 1]); w.y = pk_bf16(st[kt][qt][8 * s2 + 2], st[kt][qt][8 * s2 + 3]);
            w.z = pk_bf16(st[kt][qt][8 * s2 + 4], st[kt][qt][8 * s2 + 5]); w.w = pk_bf16(st[kt][qt][8 * s2 + 6], st[kt][qt][8 * s2 + 7]);
            pb[kt][qt][s2] = __builtin_bit_cast(bf16x8, w);
          }
        }
        lrun[qt] = lrun[qt] * alpha + ls;
#pragma unroll
        for (int dt = 0; dt < 2; ++dt)
#pragma unroll
          for (int i = 0; i < 16; ++i) o[dt][qt][i] *= alpha;
      }
#pragma unroll
      for (int dt = 0; dt < 2; ++dt)
#pragma unroll
        for (int kt = 0; kt < 2; ++kt)
#pragma unroll
          for (int s2 = 0; s2 < 2; ++s2) {
            const bf16x8 vf = *(const bf16x8*)(vt_ + (dt * 32 + r) * 144 + (kt * 2 + s2) * 32 + hh * 16);
#pragma unroll
            for (int qt = 0; qt < QT; ++qt) o[dt][qt] = MFMA32(vf, pb[kt][qt][s2], o[dt][qt]);
          }
    }
    if (more) {
      char* kb_ = lds + (cur ^ 1) * BUF; char* vb_ = kb_ + KB;
      *(u32x4*)(kb_ + kw0) = k0r; *(u32x4*)(kb_ + kw1) = k1r; *(u32x4*)(kb_ + rw) = rr;
      *(u32x2*)(vb_ + vlo) = (u32x2){v0r.x, v0r.y}; *(u32x2*)(vb_ + vhi) = (u32x2){v0r.z, v0r.w};
      *(u32x2*)(vb_ + vlo + 32 * 144) = (u32x2){v1r.x, v1r.y}; *(u32x2*)(vb_ + vhi + 32 * 144) = (u32x2){v1r.z, v1r.w};
    }
    __syncthreads();
  }
  if (nkb_w > 0) {
#pragma unroll
    for (int qt = 0; qt < QT; ++qt) {
      const float lt = lrun[qt] + __shfl_xor(lrun[qt], 32);
      const float inv = 1.f / lt;
      const int row = qrow0 + qt * 32 + r;
      float ss = 0.f;
#pragma unroll
      for (int dt = 0; dt < 2; ++dt)
#pragma unroll
        for (int i4 = 0; i4 < 4; ++i4) {
          const float a0 = o[dt][qt][4 * i4] * inv, a1 = o[dt][qt][4 * i4 + 1] * inv, a2 = o[dt][qt][4 * i4 + 2] * inv, a3 = o[dt][qt][4 * i4 + 3] * inv;
          ss += a0 * a0 + a1 * a1 + a2 * a2 + a3 * a3;
          u32x2 w; w.x = pk_bf16(a0, a1); w.y = pk_bf16(a2, a3);
          *(u32x2*)(p.mix + (size_t)row * 1024 + h * 64 + dt * 32 + 8 * i4 + 4 * hh) = w;
        }
      ss += __shfl_xor(ss, 32);
      if (hh == 0) p.attn_part[(size_t)row * 8 + h] = ss;
    }
  }
}

DI void phase4(const Params& p, char* lds, int qidx) {
  const int t = tid(), lane = t & 63, wid = t >> 6;
  const int nb = gridDim.x, bid = blockIdx.x;
  int* nxt = (int*)(lds + 65536);
  for (;;) {
    __syncthreads();
    if (t == 0) *nxt = atomicAdd(p.counters + qidx, 1);
    __syncthreads();
    const int it = *nxt;
    if (it >= 256 + 64 * NQQ) break;
    if (it < 256) attn_item<AQT>(p, 1, it >> 3, it & 7, 0, lds);
    else { const int j = it - 256; const int qq = NQQ - 1 - (j >> 6), bh = j & 63; attn_item<AQT>(p, 0, bh >> 3, bh & 7, qq, lds); }
  }
  __syncthreads();
  for (int it = bid * 4 + wid; it < 8 * 128 * 32 + 1024; it += nb * 4) {
    if (it < 8 * 128 * 32) {
      const int g = it & 31, c = (it >> 5) & 127, b = it >> 12;
      const float2 s0 = p.S[(size_t)it * 64 + lane];
      float hr = s0.x, hi = s0.y;
      ssm_chunk(p, b * 8192 + c * 64, g, hr, hi, true, lds + wid * 8704);
      if (c == 127) { p.out[OFF_HRP + (size_t)(b * 32 + g) * 64 + lane] = hr; p.out[OFF_HIP + (size_t)(b * 32 + g) * 64 + lane] = hi; }
    } else {
      const int j = it - 8 * 128 * 32, g = j & 31, b = j >> 5;
      float hr = p.in[4][(size_t)(b * 32 + g) * 64 + lane], hi = p.in[5][(size_t)(b * 32 + g) * 64 + lane];
      ssm_chunk(p, NTP + b * 64, g, hr, hi, true, lds + wid * 8704);
      p.out[OFF_HRS + (size_t)(b * 32 + g) * 64 + lane] = hr; p.out[OFF_HIS + (size_t)(b * 32 + g) * 64 + lane] = hi;
    }
  }
}

DI void phase5(const Params& p, char* lds) {
  {
    auto tile_fn = [&](int j, int& m0, int& n0) -> bool { const int li = (int)(blockIdx.x >> 3) + j * (int)(gridDim.x >> 3); const int ti_ = li / 4, tj_ = li - ti_ * 4; const int tbig = ti_ * 8 + (int)(blockIdx.x & 7); if (tbig >= 528) return false; m0 = tbig * 128; n0 = tj_ * 128; return true; };
    auto rs_fn = [&](int m0, int t) -> float2 { return make_float2(0.f, 0.f); };
    auto epi = [&](f32x16 (&acc)[2][2], int m0, int n0, const float* rs) {
    const int tn = n0 >> 7; (void)tn;
    { EPI_IDS
#pragma unroll
    for (int mt = 0; mt < 2; ++mt) {
      const int row = m0 + wm * 64 + mt * 32 + r;
      float ss = 0.f;
#pragma unroll
      for (int nt = 0; nt < 2; ++nt)
#pragma unroll
        for (int i4 = 0; i4 < 4; ++i4) {
          const int col = n0 + wn * 64 + nt * 32 + 8 * i4 + 4 * hh;
          const u32x2 yv = *(const u32x2*)(p.ssm_y + (size_t)row * 512 + col);
          const float y0 = __uint_as_float(yv.x << 16), y1 = __uint_as_float(yv.x & 0xffff0000u), y2 = __uint_as_float(yv.y << 16), y3 = __uint_as_float(yv.y & 0xffff0000u);
          const float o0 = y0 / (1.f + __expf(-acc[mt][nt][4 * i4])), o1 = y1 / (1.f + __expf(-acc[mt][nt][4 * i4 + 1]));
          const float o2 = y2 / (1.f + __expf(-acc[mt][nt][4 * i4 + 2])), o3 = y3 / (1.f + __expf(-acc[mt][nt][4 * i4 + 3]));
          ss += o0 * o0 + o1 * o1 + o2 * o2 + o3 * o3;
          u32x2 w; w.x = pk_bf16(o0, o1); w.y = pk_bf16(o2, o3);
          *(u32x2*)(p.mix + (size_t)row * 1024 + 512 + col) = w;
        }
      ss += __shfl_xor(ss, 32);
      if (hh == 0) p.ssm_part[(size_t)row * 8 + tn * 2 + wn] = ss;
    }
    }

    };
    gemm_stream(p.ssm_y, 512, p.WgT, 512, 8, lds, 0, tile_fn, rs_fn, epi);
  }
}

DI void phase6(const Params& p, char* lds) {
  float* rsS = (float*)(lds + 65536); float* ratio = rsS + 128;
  const int xb_ = blockIdx.x & 7, xl_ = blockIdx.x >> 3, nbx_ = gridDim.x >> 3;
  for (int j = 0;; ++j) {
    const int li6 = xl_ + j * nbx_, tm = (li6 >> 3) * 8 + xb_, tn = li6 & 7, m0 = tm * 128, n0 = tn * 128;
    if (tm >= 528) break;
    __syncthreads();
    if (tid() < 128) {
      const int t = tid(); const int row = m0 + t; float sa = 0.f, sb = 0.f;
      for (int j = 0; j < 8; ++j) { sa += p.attn_part[(size_t)row * 8 + j]; sb += p.ssm_part[(size_t)row * 8 + j]; }
      const float ra = rsqrtf(sa * (1.f / 512.f) + EPS), rb = rsqrtf(sb * (1.f / 512.f) + EPS);
      rsS[t] = rb; ratio[t] = ra / rb;
    }
    f32x16 acc[2][2];
    gemm_core(p.mix, 1024, p.WoT, 1024, 16, m0, n0, lds, acc, 8, ratio);
    { EPI_IDS
#pragma unroll
    for (int mt = 0; mt < 2; ++mt) {
      const int rl = wm * 64 + mt * 32 + r, row = m0 + rl;
      const float sc = rsS[rl];
      const float* xr = xrow(p, row);
      float ss = 0.f;
#pragma unroll
      for (int nt = 0; nt < 2; ++nt)
#pragma unroll
        for (int i4 = 0; i4 < 4; ++i4) {
          const int col = n0 + wn * 64 + nt * 32 + 8 * i4 + 4 * hh;
          const f32x4 xv = *(const f32x4*)(xr + col);
          f32x4 hv;
#pragma unroll
          for (int jj = 0; jj < 4; ++jj) { hv[jj] = xv[jj] + acc[mt][nt][4 * i4 + jj] * sc; ss += hv[jj] * hv[jj]; }
          *(f32x4*)(p.out + OFF_Y + (size_t)row * 1024 + col) = hv;
          u32x2 w; w.x = pk_bf16(hv[0], hv[1]); w.y = pk_bf16(hv[2], hv[3]);
          *(u32x2*)(p.hb + (size_t)row * 1024 + col) = w;
        }
      ss += __shfl_xor(ss, 32);
      if (hh == 0) p.h_part[(size_t)row * 16 + tn * 2 + wn] = ss;
    }
    }
  }
}

DI void phase7(const Params& p, char* lds) {
  float* rs = (float*)(lds + 65536);
  const int xb_ = blockIdx.x & 7, xl_ = blockIdx.x >> 3, nbx_ = gridDim.x >> 3;
  {
    auto tile_fn = [&](int j, int& m0, int& n0) -> bool { const int tm = j * (nbx_ >> 2) + (xl_ >> 2); if (tm >= 528) return false; m0 = tm * 128; n0 = (xb_ * 4 + (xl_ & 3)) * 128; return true; };
    auto rs_fn = [&](int m0, int t) -> float2 { float sm = 0.f; for (int q = 0; q < 4; ++q) { const f32x4 v = *(const f32x4*)(p.h_part + (size_t)(m0 + t) * 16 + 4 * q); sm += (v[0] + v[1]) + (v[2] + v[3]); } return make_float2(rsqrtf(sm * (1.f / 1024.f) + EPS), 0.f); };
    auto epi = [&](f32x16 (&acc)[2][2], int m0, int n0, const float* rs) {
    const int tn = n0 >> 7; (void)tn;
    { EPI_IDS
#pragma unroll
    for (int mt = 0; mt < 2; ++mt) {
      const int rl = wm * 64 + mt * 32 + r, row = m0 + rl;
      const float sc = rs[rl];
#pragma unroll
      for (int nt = 0; nt < 2; ++nt)
#pragma unroll
        for (int i4 = 0; i4 < 4; ++i4) {
          float v[4];
#pragma unroll
          for (int jj = 0; jj < 4; ++jj) { const float a = fmaxf(acc[mt][nt][4 * i4 + jj] * sc, 0.f); v[jj] = a * a; }
          u32x2 w; w.x = pk_bf16(v[0], v[1]); w.y = pk_bf16(v[2], v[3]);
          { const int col = n0 + wn * 64 + nt * 32 + 8 * i4 + 4 * hh;
            *(u32x2*)(p.act + (((size_t)(row >> 7) * 64 + (col >> 6)) * 128 + (row & 127)) * 64 + (col & 63)) = w; }
        }
    }
    }

    };
    gemm_stream(p.hb, 1024, p.WuT, 1024, 16, lds, 0, tile_fn, rs_fn, epi);
  }
}

DI void phase8(const Params& p, char* lds) {
  const int xb_ = blockIdx.x & 7, xl_ = blockIdx.x >> 3, nbx_ = gridDim.x >> 3;
  {
    auto tile_fn = [&](int j, int& m0, int& n0) -> bool { const int li = (int)(blockIdx.x >> 3) + j * (int)(gridDim.x >> 3); const int ti_ = li / 8, tj_ = li - ti_ * 8; const int tbig = ti_ * 8 + (int)(blockIdx.x & 7); if (tbig >= 528) return false; m0 = tbig * 128; n0 = tj_ * 128; return true; };
    auto rs_fn = [&](int m0, int t) -> float2 { return make_float2(0.f, 0.f); };
    auto epi = [&](f32x16 (&acc)[2][2], int m0, int n0, const float* rs) {
    const int tn = n0 >> 7; (void)tn;
    { EPI_IDS
#pragma unroll
    for (int mt = 0; mt < 2; ++mt) {
      const int row = m0 + wm * 64 + mt * 32 + r;
      float ss = 0.f;
#pragma unroll
      for (int nt = 0; nt < 2; ++nt)
#pragma unroll
        for (int i4 = 0; i4 < 4; ++i4) {
          float* yp = p.out + OFF_Y + (size_t)row * 1024 + n0 + wn * 64 + nt * 32 + 8 * i4 + 4 * hh;
          f32x4 ov = *(const f32x4*)yp;
#pragma unroll
          for (int jj = 0; jj < 4; ++jj) { ov[jj] += acc[mt][nt][4 * i4 + jj]; ss += ov[jj] * ov[jj]; }
          *(f32x4*)yp = ov;
          if (i4 == 1 || i4 == 3) __builtin_amdgcn_sched_barrier(0);
        }
      ss += __shfl_xor(ss, 32);
      if (hh == 0) p.out_part[(size_t)row * 16 + tn * 2 + wn] = ss;
    }
    }

    };
    gemm_stream<true>(p.act, 4096, p.WdT, 4096, 64, lds, 0, tile_fn, rs_fn, epi);
  }
}

DI void phase9(const Params& p) {
  const int t = tid(), lane = t & 63, wid = t >> 6;
  for (int row = blockIdx.x * 4 + wid; row < NT; row += gridDim.x * 4) {
    float s = 0.f;
    for (int j = 0; j < 16; ++j) s += p.out_part[(size_t)row * 16 + j];
    const float rstd = rsqrtf(s * (1.f / 1024.f) + EPS);
    float* y = p.out + OFF_Y + (size_t)row * 1024;
#pragma unroll
    for (int j = 0; j < 4; ++j) {
      f32x4 v = *(const f32x4*)(y + lane * 4 + 256 * j);
      const f32x4 g = *(const f32x4*)(p.in[27] + lane * 4 + 256 * j);
      v[0] *= rstd * g[0]; v[1] *= rstd * g[1]; v[2] *= rstd * g[2]; v[3] *= rstd * g[3];
      *(f32x4*)(y + lane * 4 + 256 * j) = v;
    }
  }
}

DI void grid_barrier(unsigned* cnt, unsigned target) {
  asm volatile("s_waitcnt vmcnt(0)" ::: "memory");
  __syncthreads();
  if (tid() == 0) {
    __builtin_amdgcn_fence(__ATOMIC_RELEASE, "agent");
    asm volatile("s_waitcnt vmcnt(0)" ::: "memory");
    __hip_atomic_fetch_add(cnt, 1u, __ATOMIC_RELAXED, __HIP_MEMORY_SCOPE_AGENT);
    while (__hip_atomic_load(cnt, __ATOMIC_RELAXED, __HIP_MEMORY_SCOPE_AGENT) < target) __builtin_amdgcn_s_sleep(2);
  }
  __syncthreads();
  __builtin_amdgcn_fence(__ATOMIC_ACQUIRE, "agent");
  asm volatile("s_waitcnt vmcnt(0)" ::: "memory");
}

template <bool COOP>
__global__ void __launch_bounds__(256, 2) mega(Params p) {
  __shared__ __attribute__((aligned(16))) char lds[LDS_BYTES];
  for (int ph = p.ph_lo; ph < p.ph_hi; ++ph) {
#ifdef ONLY_PHASE
    if (ph != ONLY_PHASE) continue;
#endif
    switch (ph) {
      case 0: phase0(p, lds); break;
      case 1: phase1(p, lds); break;
      case 2: phase2(p, lds); break;
      case 3: phase3(p, lds); break;
      case 4: phase4(p, lds, 0); break;
      case 5: phase5(p, lds); break;
      case 6: phase6(p, lds); break;
      case 7: phase7(p, lds); break;
      case 8: phase8(p, lds); break;
      default: phase9(p); break;
    }
#ifdef DOUBLE_PHASE
    if (ph == DOUBLE_PHASE) {
      __syncthreads();
      switch (ph) { case 0: phase0(p, lds); break; case 1: phase1(p, lds); break; case 2: phase2(p, lds); break; case 3: phase3(p, lds); break; case 4: phase4(p, lds, 1); break;
                    case 5: phase5(p, lds); break; case 6: phase6(p, lds); break; case 7: phase7(p, lds); break; default: break; }
    }
#endif
    if (COOP) { if (ph + 1 < p.ph_hi) { if (ph == 0) cg::this_grid().sync(); else grid_barrier((unsigned*)p.counters + 32, (unsigned)ph * gridDim.x); } }
  }
}

static size_t al256(size_t x) { return (x + 255) & ~(size_t)255; }

extern "C" void kernel_launch(void* const* d_in, const int* in_sizes, int n_in, void* d_out, int out_size, void* d_ws, size_t ws_size, hipStream_t stream) {
  Params p{};
  for (int i = 0; i < 28; ++i) p.in[i] = (const float*)d_in[i];
  p.out = (float*)d_out;
  char* base = (char*)d_ws; size_t off = 0;
  auto take = [&](size_t bytes) { char* q = base + off; off = al256(off + bytes); return q; };
  p.WinT = (bf16_t*)take((size_t)1664 * 1024 * 2);
  p.WqT = (bf16_t*)take((size_t)768 * 768 * 2);
  p.WkT = (bf16_t*)take((size_t)512 * 256 * 2);
  p.WvT = (bf16_t*)take((size_t)512 * 256 * 2);
  p.WgT = (bf16_t*)take((size_t)512 * 512 * 2);
  p.WoT = (bf16_t*)take((size_t)1024 * 1024 * 2);
  p.WuT = (bf16_t*)take((size_t)4096 * 1024 * 2);
  p.WdT = (bf16_t*)take((size_t)1024 * 4096 * 2);
  p.BbT = (bf16_t*)take((size_t)32 * 128 * 16 * 2);
  p.CcT = (bf16_t*)take((size_t)32 * 16 * 128 * 2);
  p.lam = (float2*)take(2048 * 8);
  p.lam64 = (float2*)take(2048 * 8);
  p.rope = (float2*)take((size_t)8192 * 16 * 8);
  p.rstd_x = (float*)take((size_t)NT * 4);
  p.cq_part = (float*)take((size_t)NT * 12 * 4);
  p.ckv_part = (float*)take((size_t)NT * 4 * 4);
  p.attn_part = (float*)take((size_t)NT * 8 * 4);
  p.ssm_part = (float*)take((size_t)NT * 8 * 4);
  p.h_part = (float*)take((size_t)NT * 16 * 4);
  p.out_part = (float*)take((size_t)NT * 16 * 4);
  p.counters = (int*)take(256);
  p.E = (float2*)take((size_t)8 * 128 * 32 * 64 * 8);
  p.S = (float2*)take((size_t)8 * 128 * 32 * 64 * 8);
  const size_t a0 = off;
  p.Kn = (bf16_t*)take((size_t)NK * 512 * 2);
  const size_t aVt = off;
  p.Vt = (bf16_t*)take((size_t)NK * 512 * 2);
  p.Q = (bf16_t*)take((size_t)NT * 768 * 2);
  p.latb = (bf16_t*)take((size_t)NK * 256 * 2);
  p.krb = (bf16_t*)take((size_t)NK * 32 * 2);
  p.ub = (bf16_t*)take((size_t)NT * 512 * 2);
  const size_t aSsmY = off;
  p.ssm_y = (bf16_t*)take((size_t)NT * 512 * 2);
  p.mix = (bf16_t*)take((size_t)NT * 1024 * 2);
  const size_t total = off;
  p.xb = (bf16_t*)(base + a0);
  p.cq = (bf16_t*)(base + aVt);
  p.ckv_raw = (float*)(base + aVt + al256((size_t)NT * 768 * 2));
  p.act = (bf16_t*)(base + a0);
  const size_t aHb = a0 + al256((size_t)NT * 4096 * 2);
  p.hb = (bf16_t*)(base + aHb);
  if (aHb + (size_t)NT * 1024 * 2 > aSsmY || total > ws_size) { fprintf(stderr, "workspace layout error: total %zu ws %zu\n", total, ws_size); return; }

  const int MULTI = 0;
  hipMemsetAsync(p.counters, 0, 256, stream);
  if (MULTI) {
    for (int ph = 0; ph < NPHASE; ++ph) {
      p.ph_lo = ph; p.ph_hi = ph + 1;
      hipLaunchKernelGGL(mega<false>, dim3(512), dim3(256), 0, stream, p);
    }
  } else {
    static int grid_blocks = 0;
    if (!grid_blocks) {
      int dev = 0, cus = 0, per_cu = 0;
      hipGetDevice(&dev);
      hipDeviceGetAttribute(&cus, hipDeviceAttributeMultiprocessorCount, dev);
      hipOccupancyMaxActiveBlocksPerMultiprocessor(&per_cu, mega<true>, 256, 0);
      grid_blocks = cus * per_cu;
    }
    p.ph_lo = 0; p.ph_hi = NPHASE;
    void* args[] = {&p};
    hipError_t e = hipLaunchCooperativeKernel((void*)mega<true>, dim3(grid_blocks), dim3(256), args, 0, stream);
    if (e != hipSuccess) fprintf(stderr, "cooperative launch failed: %s (grid %d)\n", hipGetErrorString(e), grid_blocks);
  }
}
```

```cpp
#include <hip/hip_runtime.h>
#include <hip/hip_cooperative_groups.h>
#include <stdint.h>
#include <cstdio>
namespace cg = cooperative_groups;
#define DI __device__ __forceinline__

typedef unsigned short bf16_t;
typedef short bf16x8 __attribute__((ext_vector_type(8)));
typedef float f32x16 __attribute__((ext_vector_type(16)));
typedef float f32x4 __attribute__((ext_vector_type(4)));
typedef unsigned u32x4 __attribute__((ext_vector_type(4)));
typedef unsigned u32x2 __attribute__((ext_vector_type(2)));

constexpr int NTP = 65536, NTS = 2048, NT = NTP + NTS, NK = NTP + 32 * 4160;
constexpr int SKS = 4160;
constexpr size_t OFF_Y = 0;
constexpr size_t OFF_LATP = (size_t)NT * 1024;
constexpr size_t OFF_KRP = OFF_LATP + (size_t)NTP * 256;
constexpr size_t OFF_HRP = OFF_KRP + (size_t)NTP * 32;
constexpr size_t OFF_HIP = OFF_HRP + 8 * 32 * 64;
constexpr size_t OFF_LATS = OFF_HIP + 8 * 32 * 64;
constexpr size_t OFF_KRS = OFF_LATS + (size_t)NTS * 256;
constexpr size_t OFF_HRS = OFF_KRS + (size_t)NTS * 32;
constexpr size_t OFF_HIS = OFF_HRS + 32 * 32 * 64;
constexpr size_t VT_S_OFF = (size_t)8 * 512 * 8192;
constexpr float EPS = 1e-6f;
constexpr int LDS_BYTES = 67584;
constexpr int NPHASE = 10;
constexpr int AQT = 1, NQQ = 128 / (4 / (64 / (32 * AQT)));

struct Params {
  const float* in[28];
  float* out;
  bf16_t *WinT, *WqT, *WkT, *WvT, *WgT, *WoT, *WuT, *WdT, *BbT, *CcT;
  float2 *lam, *lam64, *rope;
  float *rstd_x, *cq_part, *ckv_part, *attn_part, *ssm_part, *h_part, *out_part;
  int* counters;
  float2 *E, *S;
  bf16_t *Kn, *Vt, *Q, *latb, *krb, *ub, *ssm_y, *mix, *xb, *cq, *hb, *act;
  float* ckv_raw;
  int ph_lo, ph_hi;
};

DI int tid() { int t = __builtin_amdgcn_workitem_id_x(); asm volatile("" : "+v"(t)); return t; }
typedef __bf16 nbf16x2 __attribute__((ext_vector_type(2)));
typedef float f32x2 __attribute__((ext_vector_type(2)));
DI unsigned pk_bf16(float lo, float hi) { f32x2 v = {lo, hi}; return __builtin_bit_cast(unsigned, __builtin_convertvector(v, nbf16x2)); }
DI bf16_t f2bf(float x) { return (bf16_t)(pk_bf16(x, 0.f) & 0xffffu); }
DI float bf2f(bf16_t v) { return __uint_as_float(((unsigned)v) << 16); }
DI int crow(int i, int hh) { return (i & 3) + 8 * (i >> 2) + 4 * hh; }
DI const float* xrow(const Params& p, int row) { return row < NTP ? p.in[0] + (size_t)row * 1024 : p.in[1] + (size_t)(row - NTP) * 1024; }
DI int pos_of(int row) { return row < NTP ? (row & 8191) : 4096 + ((row - NTP) & 63); }
DI int kr_of(int row) { return row < NTP ? row : NTP + ((row - NTP) >> 6) * SKS + 4096 + ((row - NTP) & 63); }
#define MFMA32(a, b, c) __builtin_amdgcn_mfma_f32_32x32x16_bf16((a), (b), (c), 0, 0, 0)
#define MFMA16(a, b, c) __builtin_amdgcn_mfma_f32_16x16x32_bf16((a), (b), (c), 0, 0, 0)

DI void sincos_d(double x, double& s4, double& c4) {
  double k = rint(x * 0.15915494309189535);
  double rr = fma(-k, 6.283185307179586, x);
  rr = fma(-k, 2.4492935982947064e-16, rr);
  double y = rr * 0.25, y2 = y * y;
  double s = y * (1 - y2 / 6 * (1 - y2 / 20 * (1 - y2 / 42 * (1 - y2 / 72 * (1 - y2 / 110 * (1 - y2 / 156 * (1 - y2 / 210)))))));
  double c = 1 - y2 / 2 * (1 - y2 / 12 * (1 - y2 / 30 * (1 - y2 / 56 * (1 - y2 / 90 * (1 - y2 / 132 * (1 - y2 / 182))))));
  double s2 = 2 * s * c, c2 = 1 - 2 * s * s;
  s4 = 2 * s2 * c2; c4 = 1 - 2 * s2 * s2;
}

DI void gemm_core(const bf16_t* __restrict__ A, int lda, const bf16_t* __restrict__ B, int ldb, int nk,
                  int m0, int n0, char* lds, f32x16 (&acc)[2][2], int midk, const float* ratio) {
  const int t = tid(), lane = t & 63, wid = t >> 6, wm = wid >> 1, wn = wid & 1;
  const int r = lane & 31, hh = lane >> 5;
  const int lc = t & 7, lr = t >> 3;
  const unsigned woff = lr * 128 + ((lc ^ ((lr >> 1) & 7)) << 4);
  const bf16_t* ga = A + (size_t)(m0 + lr) * lda + lc * 8;
  const bf16_t* gb = B + (size_t)(n0 + lr) * ldb + lc * 8;
  char* sA = lds; char* sB = lds + 32768;
  u32x4 ra[4], rb[4];
#pragma unroll
  for (int i = 0; i < 4; ++i) { ra[i] = *(const u32x4*)(ga + (size_t)(32 * i) * lda); rb[i] = *(const u32x4*)(gb + (size_t)(32 * i) * ldb); }
#pragma unroll
  for (int i = 0; i < 4; ++i) { *(u32x4*)(sA + woff + i * 4096) = ra[i]; *(u32x4*)(sB + woff + i * 4096) = rb[i]; }
#pragma unroll
  for (int a = 0; a < 2; ++a)
#pragma unroll
    for (int b = 0; b < 2; ++b)
#pragma unroll
      for (int i = 0; i < 16; ++i) acc[a][b][i] = 0.f;
  __syncthreads();
  const int rsw = (r >> 1) & 7;
  const unsigned aoff = (wm * 64 + r) * 128, boff = (wn * 64 + r) * 128;
  for (int kt = 0; kt < nk; ++kt) {
    const int cur = kt & 1;
    const bool more = (kt + 1 < nk);
    if (more) {
      const bf16_t* ga2 = ga + (kt + 1) * 64; const bf16_t* gb2 = gb + (kt + 1) * 64;
#pragma unroll
      for (int i = 0; i < 4; ++i) { ra[i] = *(const u32x4*)(ga2 + (size_t)(32 * i) * lda); rb[i] = *(const u32x4*)(gb2 + (size_t)(32 * i) * ldb); }
    }
    if (midk && kt == midk) {
#pragma unroll
      for (int mt = 0; mt < 2; ++mt)
      { const float f = ratio[wm * 64 + mt * 32 + r];
#pragma unroll
        for (int i = 0; i < 16; ++i) { acc[mt][0][i] *= f; acc[mt][1][i] *= f; } }
    }
    const char* cA = sA + cur * 16384; const char* cB = sB + cur * 16384;
#pragma unroll
    for (int ks = 0; ks < 4; ++ks) {
      const unsigned co = (((ks * 2 + hh) ^ rsw) << 4);
      const bf16x8 a0 = *(const bf16x8*)(cA + aoff + co), a1 = *(const bf16x8*)(cA + aoff + 4096 + co);
      const bf16x8 b0 = *(const bf16x8*)(cB + boff + co), b1 = *(const bf16x8*)(cB + boff + 4096 + co);
      acc[0][0] = MFMA32(b0, a0, acc[0][0]); acc[0][1] = MFMA32(b1, a0, acc[0][1]);
      acc[1][0] = MFMA32(b0, a1, acc[1][0]); acc[1][1] = MFMA32(b1, a1, acc[1][1]);
    }
    if (more) {
      char* nA = sA + (cur ^ 1) * 16384; char* nB = sB + (cur ^ 1) * 16384;
#pragma unroll
      for (int i = 0; i < 4; ++i) { *(u32x4*)(nA + woff + i * 4096) = ra[i]; *(u32x4*)(nB + woff + i * 4096) = rb[i]; }
    }
    __syncthreads();
  }
}

DI void rowscale_load(float* rs, const float* src, int np, float inv_dim, int m0) {
  const int t = tid();
  if (t < 128) {
    const int row = m0 + t;
    if (np == 0) rs[t] = src[row];
    else { float s = 0.f; for (int j = 0; j < np; ++j) s += src[(size_t)row * np + j]; rs[t] = rsqrtf(s * inv_dim + EPS); }
  }
}

template <bool BLKA = false, class TileFn, class RsFn, class EpiFn>
DI void gemm_stream(const bf16_t* __restrict__ A, int lda, const bf16_t* __restrict__ B, int ldb, int nk, char* lds, int midk,
                    TileFn tile_fn, RsFn rs_fn, EpiFn epi) {
  int m0, n0;
  if (!tile_fn(0, m0, n0)) return;
  const int t = tid(), lane = t & 63, wid = t >> 6, wm = wid >> 1, wn = wid & 1;
  const int r = lane & 31, hh = lane >> 5;
  const int lc = t & 7, lr = t >> 3;
  const unsigned woff = lr * 128 + ((lc ^ ((lr >> 1) & 7)) << 4);
  char* sA = lds; char* sB = lds + 32768;
  float* rsbuf = (float*)(lds + 65536);
  const int rsw = (r >> 1) & 7;
  const unsigned aoff = (wm * 64 + r) * 128, boff = (wn * 64 + r) * 128;
  int lj = 0, lkt = 0, lm0 = m0, ln0 = n0; bool lvalid = true;
  u32x4 ra0[4], rb0[4], ra1[4], rb1[4];
#define GS_LOAD(RA, RB) do {   \
        \
      const bf16_t* ga_ = BLKA ? A + ((size_t)(lm0 >> 7) * nk + lkt) * 8192 + lr * 64 + lc * 8 : A + (size_t)(lm0 + lr) * lda + lc * 8 + lkt * 64; const bf16_t* gb_ = B + (size_t)(ln0 + lr) * ldb + lc * 8 + lkt * 64; \
      _Pragma("unroll") for (int i = 0; i < 4; ++i) { RA[i] = *(const u32x4*)(ga_ + (size_t)(32 * i) * (BLKA ? 64 : lda)); RB[i] = *(const u32x4*)(gb_ + (size_t)(32 * i) * ldb); } \
      if (++lkt == nk) { lkt = 0; if (lvalid) { ++lj; lvalid = tile_fn(lj, lm0, ln0); } } } while (0)
  GS_LOAD(ra0, rb0);
  GS_LOAD(ra1, rb1);
  {
    float2 rv = make_float2(0.f, 0.f);
    if (t < 128) rv = rs_fn(m0, t);
    __syncthreads();
#pragma unroll
    for (int i = 0; i < 4; ++i) { *(u32x4*)(sA + woff + i * 4096) = ra0[i]; *(u32x4*)(sB + woff + i * 4096) = rb0[i]; }
    if (t < 128) { rsbuf[t] = rv.x; rsbuf[128 + t] = rv.y; }
    __syncthreads();
  }
  int cur = 0;
  for (int j = 0;; ++j) {
    int m1 = 0, n1 = 0;
    const bool has_next = tile_fn(j + 1, m1, n1);
    const float* rs = rsbuf + (j & 1) * 256;
    f32x16 acc[2][2];
#pragma unroll
    for (int a = 0; a < 2; ++a)
#pragma unroll
      for (int b = 0; b < 2; ++b)
#pragma unroll
        for (int i = 0; i < 16; ++i) acc[a][b][i] = 0.f;
#define GS_STEP(RL_A, RL_B, RW_A, RW_B, KT) do { \
      const bool last_ = ((KT) + 1 == nk); const bool wr_ = !last_ || has_next; \
      float2 rv_ = make_float2(0.f, 0.f); \
      if (last_ && has_next) { if (t < 128) rv_ = rs_fn(m1, t); asm volatile("" : "+v"(rv_.x), "+v"(rv_.y)); }   \
      GS_LOAD(RL_A, RL_B); \
      if (midk && (KT) == midk) { _Pragma("unroll") for (int mt = 0; mt < 2; ++mt) { const float f = rs[128 + wm * 64 + mt * 32 + r]; \
          _Pragma("unroll") for (int i = 0; i < 16; ++i) { acc[mt][0][i] *= f; acc[mt][1][i] *= f; } } } \
      const char* cA = sA + cur * 16384; const char* cB = sB + cur * 16384; \
      _Pragma("unroll") for (int ks = 0; ks < 4; ++ks) { \
        const unsigned co = (((ks * 2 + hh) ^ rsw) << 4); \
        const bf16x8 a0 = *(const bf16x8*)(cA + aoff + co), a1 = *(const bf16x8*)(cA + aoff + 4096 + co); \
        const bf16x8 b0 = *(const bf16x8*)(cB + boff + co), b1 = *(const bf16x8*)(cB + boff + 4096 + co); \
        acc[0][0] = MFMA32(b0, a0, acc[0][0]); acc[0][1] = MFMA32(b1, a0, acc[0][1]); \
        acc[1][0] = MFMA32(b0, a1, acc[1][0]); acc[1][1] = MFMA32(b1, a1, acc[1][1]); } \
      if (wr_) { char* nA = sA + (cur ^ 1) * 16384; char* nB = sB + (cur ^ 1) * 16384; \
        _Pragma("unroll") for (int i = 0; i < 4; ++i) { *(u32x4*)(nA + woff + i * 4096) = RW_A[i]; *(u32x4*)(nB + woff + i * 4096) = RW_B[i]; } \
        if (last_ && t < 128) { float* rn = rsbuf + ((j + 1) & 1) * 256; rn[t] = rv_.x; rn[128 + t] = rv_.y; } } \
      __syncthreads(); cur ^= 1; } while (0)
    for (int kt = 0; kt < nk; kt += 2) {
      GS_STEP(ra0, rb0, ra1, rb1, kt);
      GS_STEP(ra1, rb1, ra0, rb0, kt + 1);
    }
    epi(acc, m0, n0, rs);
    if (!has_next) break;
    m0 = m1; n0 = n1;
  }
#undef GS_STEP
#undef GS_LOAD
  __syncthreads();
}

DI float half_reduce(float s) {
  s += __shfl_xor(s, 1); s += __shfl_xor(s, 2); s += __shfl_xor(s, 4); s += __shfl_xor(s, 8); s += __shfl_xor(s, 16); return s;
}

#define EPI_IDS int t = tid(); asm volatile("" : "+v"(t)); const int lane = t & 63, wid = t >> 6, wm = wid >> 1, wn = wid & 1, r = lane & 31, hh = lane >> 5; (void)lane; (void)wid; (void)wm; (void)wn; (void)r; (void)hh;
#define GEMM_IDS const int t = tid(), lane = t & 63, wid = t >> 6, wm = wid >> 1, wn = wid & 1, r = lane & 31, hh = lane >> 5; (void)t; (void)wm; (void)wn; (void)r; (void)hh;

DI void transpose_tile(const float* __restrict__ src, int ld, int K, int kt, int nt, int job, const float* g0, const float* g1, bf16_t* __restrict__ dst, char* lds) {
  bf16_t* tile = (bf16_t*)lds;
  const int t = tid(), nl = t & 63, kq = t >> 6;
  const int n = nt * 64 + nl;
  int c = n;
  if (job == 0) { c = n < 1024 ? n : (n < 1536 ? 1056 + (n - 1024) : (n < 1568 ? 1024 + (n - 1536) : -1)); }
  else if (job == 2) c = (n >> 6) * 128 + (n & 63);
  else if (job == 3) c = (n >> 6) * 128 + 64 + (n & 63);
#pragma unroll 4
  for (int pass = 0; pass < 16; ++pass) {
    const int kl = pass * 4 + kq, k = kt * 64 + kl;
    float v = 0.f;
    if (c >= 0) {
      v = src[(size_t)k * ld + c];
      if (g0) { const float g = (g1 && k >= 512) ? g1[k - 512] : g0[k]; v *= g; }
    }
    tile[nl * 66 + kl] = f2bf(v);
  }
  __syncthreads();
  const int kl = t & 63;
#pragma unroll 4
  for (int pass = 0; pass < 16; ++pass) { const int nl2 = pass * 4 + kq; dst[(size_t)(nt * 64 + nl2) * K + kt * 64 + kl] = tile[nl2 * 66 + kl]; }
  __syncthreads();
}

DI void phase0(const Params& p, char* lds) {
  const int t = tid(), nb = gridDim.x, bid = blockIdx.x, lane = t & 63, wid = t >> 6;
  for (int ti = bid; ti < 2992; ti += nb) {
    int job, base, nNt, ld, K; const float* src; const float* g0 = nullptr; const float* g1 = nullptr; bf16_t* dst;
    if (ti < 416) { job = 0; base = 0; nNt = 26; ld = 1568; K = 1024; src = p.in[7]; g0 = p.in[6]; dst = p.WinT; }
    else if (ti < 560) { job = 1; base = 416; nNt = 12; ld = 768; K = 768; src = p.in[9]; g0 = p.in[8]; dst = p.WqT; }
    else if (ti < 592) { job = 2; base = 560; nNt = 8; ld = 1024; K = 256; src = p.in[11]; dst = p.WkT; }
    else if (ti < 624) { job = 3; base = 592; nNt = 8; ld = 1024; K = 256; src = p.in[11]; dst = p.WvT; }
    else if (ti < 688) { job = 4; base = 624; nNt = 8; ld = 512; K = 512; src = p.in[20]; dst = p.WgT; }
    else if (ti < 944) { job = 5; base = 688; nNt = 16; ld = 1024; K = 1024; src = p.in[23]; g0 = p.in[21]; g1 = p.in[22]; dst = p.WoT; }
    else if (ti < 1968) { job = 6; base = 944; nNt = 64; ld = 4096; K = 1024; src = p.in[25]; g0 = p.in[24]; dst = p.WuT; }
    else { job = 7; base = 1968; nNt = 16; ld = 1024; K = 4096; src = p.in[26]; dst = p.WdT; }
    const int tile = ti - base;
    transpose_tile(src, ld, K, tile / nNt, tile % nNt, job, g0, g1, dst, lds);
  }
  for (int row = bid * 4 + wid; row < NT; row += nb * 4) {
    const float* x = xrow(p, row);
    f32x4 v[4]; float ss = 0.f;
#pragma unroll
    for (int j = 0; j < 4; ++j) { v[j] = *(const f32x4*)(x + lane * 4 + 256 * j); ss += v[j][0] * v[j][0] + v[j][1] * v[j][1] + v[j][2] * v[j][2] + v[j][3] * v[j][3]; }
    ss += __shfl_xor(ss, 32); ss = half_reduce(ss);
#pragma unroll
    for (int j = 0; j < 4; ++j) { u32x2 w; w.x = pk_bf16(v[j][0], v[j][1]); w.y = pk_bf16(v[j][2], v[j][3]); *(u32x2*)(p.xb + (size_t)row * 1024 + lane * 4 + 256 * j) = w; }
    if (lane == 0) p.rstd_x[row] = rsqrtf(ss * (1.f / 1024.f) + EPS);
  }
  const int gt = bid * 256 + t, ngt = nb * 256;
  for (int v = gt; v < 32 * 4096 * 32; v += ngt) {
    const size_t e0 = (size_t)v * 8; const int b = (int)(e0 >> 20), rem = (int)(e0 & 1048575), tt = rem >> 8, c = rem & 255;
    const f32x4 a = *(const f32x4*)(p.in[2] + e0), bq = *(const f32x4*)(p.in[2] + e0 + 4);
    u32x4 w; w.x = pk_bf16(a[0], a[1]); w.y = pk_bf16(a[2], a[3]); w.z = pk_bf16(bq[0], bq[1]); w.w = pk_bf16(bq[2], bq[3]);
    *(u32x4*)(p.latb + (size_t)(NTP + b * SKS + tt) * 256 + c) = w;
  }
  for (int v = gt; v < 32 * 4096 * 4; v += ngt) {
    const size_t e0 = (size_t)v * 8; const int b = (int)(e0 >> 17), rem = (int)(e0 & 131071), tt = rem >> 5, c = rem & 31;
    const f32x4 a = *(const f32x4*)(p.in[3] + e0), bq = *(const f32x4*)(p.in[3] + e0 + 4);
    u32x4 w; w.x = pk_bf16(a[0], a[1]); w.y = pk_bf16(a[2], a[3]); w.z = pk_bf16(bq[0], bq[1]); w.w = pk_bf16(bq[2], bq[3]);
    *(u32x4*)(p.krb + (size_t)(NTP + b * SKS + tt) * 32 + c) = w;
  }
  if (gt < 2048) {
    const int g = gt >> 6, n = gt & 63;
    const double dt = (double)expf(p.in[14][g]);
    const double lr = p.in[12][gt], li = p.in[13][gt];
    const double mag = (double)expf((float)(lr * dt)); double s, c; sincos_d(li * dt, s, c);
    const double lbr = mag * c, lbi = mag * s;
    const double nr = lbr - 1.0, ni = lbi, den = lr * lr + li * li;
    const double cr = (nr * lr + ni * li) / den, ci = (ni * lr - nr * li) / den;
    p.lam[gt] = make_float2((float)lbr, (float)lbi);
    const double mag64 = (double)expf((float)(64.0 * lr * dt)); sincos_d(64.0 * li * dt, s, c);
    p.lam64[gt] = make_float2((float)(mag64 * c), (float)(mag64 * s));
    for (int q = 0; q < 16; ++q) {
      const double br = p.in[15][(size_t)gt * 16 + q], bi = p.in[16][(size_t)gt * 16 + q];
      p.BbT[(size_t)(g * 128 + n) * 16 + q] = f2bf((float)(cr * br - ci * bi));
      p.BbT[(size_t)(g * 128 + 64 + n) * 16 + q] = f2bf((float)(cr * bi + ci * br));
      p.CcT[(size_t)(g * 16 + q) * 128 + n] = f2bf(p.in[17][(size_t)(g * 16 + q) * 64 + n]);
      p.CcT[(size_t)(g * 16 + q) * 128 + 64 + n] = f2bf(-p.in[18][(size_t)(g * 16 + q) * 64 + n]);
    }
  }
  for (int e = gt; e < 8192 * 16; e += ngt) {
    const int pos = e >> 4, i = e & 15;
    const float inv = expf(-(float)i * (9.210340371976184f / 16.0f));
    const float ang = (float)pos * inv;
    double s, c; sincos_d((double)ang, s, c);
    p.rope[e] = make_float2((float)c, (float)s);
  }
}

DI void phase1(const Params& p, char* lds) {
  float* rs = (float*)(lds + 65536);
  const int ntiles = 528 * 13;
  {
    auto tile_fn = [&](int j, int& m0, int& n0) -> bool { const int li = (int)(blockIdx.x >> 3) + j * (int)(gridDim.x >> 3); const int ti_ = li / 13, tj_ = li - ti_ * 13; const int tbig = ti_ * 8 + (int)(blockIdx.x & 7); if (tbig >= 528) return false; m0 = tbig * 128; n0 = tj_ * 128; return true; };
    auto rs_fn = [&](int m0, int t) -> float2 { return make_float2(p.rstd_x[m0 + t], 0.f); };
    auto epi = [&](f32x16 (&acc)[2][2], int m0, int n0, const float* rs) {
    const int tn = n0 >> 7; (void)tn;
    { EPI_IDS
    if (tn < 8) {
#pragma unroll
      for (int mt = 0; mt < 2; ++mt) {
        const int rl = wm * 64 + mt * 32 + r, row = m0 + rl;
        const float sc = rs[rl];
        float ss = 0.f;
#pragma unroll
        for (int nt = 0; nt < 2; ++nt)
#pragma unroll
          for (int i4 = 0; i4 < 4; ++i4) {
            const float v0 = acc[mt][nt][4 * i4] * sc, v1 = acc[mt][nt][4 * i4 + 1] * sc, v2 = acc[mt][nt][4 * i4 + 2] * sc, v3 = acc[mt][nt][4 * i4 + 3] * sc;
            ss += v0 * v0 + v1 * v1 + v2 * v2 + v3 * v3;
            const int col = n0 + wn * 64 + nt * 32 + 8 * i4 + 4 * hh;
            if (tn < 6) { u32x2 w; w.x = pk_bf16(v0, v1); w.y = pk_bf16(v2, v3); *(u32x2*)(p.cq + (size_t)row * 768 + col) = w; }
            else { f32x4 w = {v0, v1, v2, v3}; *(f32x4*)(p.ckv_raw + (size_t)row * 256 + (col - 768)) = w; }
          }
        ss += __shfl_xor(ss, 32);
        if (hh == 0) { if (tn < 6) p.cq_part[(size_t)row * 12 + tn * 2 + wn] = ss; else p.ckv_part[(size_t)row * 4 + (tn - 6) * 2 + wn] = ss; }
      }
    } else if (tn < 12) {
#pragma unroll
      for (int mt = 0; mt < 2; ++mt) {
        const int rl = wm * 64 + mt * 32 + r, row = m0 + rl;
        const float sc = rs[rl];
#pragma unroll
        for (int nt = 0; nt < 2; ++nt)
#pragma unroll
          for (int i4 = 0; i4 < 4; ++i4) {
            u32x2 w; w.x = pk_bf16(acc[mt][nt][4 * i4] * sc, acc[mt][nt][4 * i4 + 1] * sc); w.y = pk_bf16(acc[mt][nt][4 * i4 + 2] * sc, acc[mt][nt][4 * i4 + 3] * sc);
            *(u32x2*)(p.ub + (size_t)row * 512 + (n0 - 1024) + wn * 64 + nt * 32 + 8 * i4 + 4 * hh) = w;
          }
      }
    } else if (wn == 0) {
#pragma unroll
      for (int mt = 0; mt < 2; ++mt) {
        const int rl = wm * 64 + mt * 32 + r, row = m0 + rl;
        const float sc = rs[rl];
        float* dst = row < NTP ? p.out + OFF_KRP + (size_t)row * 32 : p.out + OFF_KRS + (size_t)(row - NTP) * 32;
        bf16_t* dkb = p.krb + (size_t)kr_of(row) * 32;
        const float* rp = (const float*)(p.rope + pos_of(row) * 16);
#pragma unroll
        for (int ih = 0; ih < 2; ++ih) {
          const int j0 = 8 * ih + 4 * hh;
          const f32x4 c01 = *(const f32x4*)(rp + 2 * j0), c23 = *(const f32x4*)(rp + 2 * j0 + 4);
          const float cc[4] = {c01[0], c01[2], c23[0], c23[2]}, sn[4] = {c01[1], c01[3], c23[1], c23[3]};
          f32x4 o1, o2;
#pragma unroll
          for (int jj = 0; jj < 4; ++jj) {
            const float x1 = acc[mt][0][4 * ih + jj] * sc, x2 = acc[mt][0][8 + 4 * ih + jj] * sc;
            o1[jj] = x1 * cc[jj] - x2 * sn[jj]; o2[jj] = x1 * sn[jj] + x2 * cc[jj];
          }
          *(f32x4*)(dst + j0) = o1; *(f32x4*)(dst + 16 + j0) = o2;
          u32x2 w1, w2; w1.x = pk_bf16(o1[0], o1[1]); w1.y = pk_bf16(o1[2], o1[3]); w2.x = pk_bf16(o2[0], o2[1]); w2.y = pk_bf16(o2[2], o2[3]);
          *(u32x2*)(dkb + j0) = w1; *(u32x2*)(dkb + 16 + j0) = w2;
        }
      }
    }
    }

    };
    gemm_stream(p.xb, 1024, p.WinT, 1024, 16, lds, 0, tile_fn, rs_fn, epi);
  }
}

DI void ssm_chunk(const Params& p, int row0, int g, float& hr, float& hi, bool write_y, char* lds_w) {
  const int lane = tid() & 63, r = lane & 31, hh = lane >> 5;
  const float2 lm = p.lam[g * 64 + lane];
  bf16x8 bfr[4];
#pragma unroll
  for (int nt = 0; nt < 4; ++nt) bfr[nt] = *(const bf16x8*)(p.BbT + (size_t)(g * 128 + nt * 32 + r) * 16 + hh * 8);
  const int fr = lane & 15, fq = lane >> 4;
  bf16x8 cfr[4];
#pragma unroll
  for (int ks = 0; ks < 4; ++ks) cfr[ks] = *(const bf16x8*)(p.CcT + (size_t)(g * 16 + fr) * 128 + ks * 32 + fq * 8);
  const float dsk = p.in[19][g * 16 + fr];
#pragma unroll 1
  for (int sub = 0; sub < 2; ++sub) {
    const int rb = row0 + sub * 32;
    const bf16x8 uf = *(const bf16x8*)(p.ub + (size_t)(rb + r) * 512 + g * 16 + hh * 8);
    f32x16 z; for (int i = 0; i < 16; ++i) z[i] = 0.f;
    const f32x16 x0 = MFMA32(uf, bfr[0], z), x1 = MFMA32(uf, bfr[1], z), x2 = MFMA32(uf, bfr[2], z), x3 = MFMA32(uf, bfr[3], z);
    float xr0[16], xr1[16], xi0[16], xi1[16];
#pragma unroll
    for (int i = 0; i < 16; ++i) {
      const float sre = hh ? x0[i] : x1[i];
      const float rre = __shfl_xor(sre, 32);
      const float sim = hh ? x2[i] : x3[i];
      const float rim = __shfl_xor(sim, 32);
      xr0[i] = hh ? rre : x0[i]; xr1[i] = hh ? x1[i] : rre;
      xi0[i] = hh ? rim : x2[i]; xi1[i] = hh ? x3[i] : rim;
    }
    bf16_t* Hs = (bf16_t*)lds_w;
#pragma unroll
    for (int m = 0; m < 4; ++m) {
#pragma unroll
      for (int half = 0; half < 2; ++half) {
#pragma unroll
        for (int jj = 0; jj < 4; ++jj) {
          const int i = 4 * m + jj, tt = 8 * m + 4 * half + jj;
          const float xr = half ? xr1[i] : xr0[i], xi = half ? xi1[i] : xi0[i];
          const float nr = lm.x * hr - lm.y * hi + xr;
          const float ni = lm.x * hi + lm.y * hr + xi;
          hr = nr; hi = ni;
          if (write_y) { Hs[tt * 136 + lane] = f2bf(hr); Hs[tt * 136 + 64 + lane] = f2bf(hi); }
        }
      }
    }
    if (write_y) {
      asm volatile("s_waitcnt lgkmcnt(0)" ::: "memory");
      __builtin_amdgcn_wave_barrier();
#pragma unroll
      for (int mt = 0; mt < 2; ++mt) {
        f32x4 y = {0.f, 0.f, 0.f, 0.f};
#pragma unroll
        for (int ks = 0; ks < 4; ++ks) {
          const bf16x8 hf = *(const bf16x8*)(Hs + (mt * 16 + fr) * 136 + ks * 32 + fq * 8);
          y = MFMA16(hf, cfr[ks], y);
        }
#pragma unroll
        for (int j = 0; j < 4; ++j) {
          const int row = rb + mt * 16 + fq * 4 + j;
          const float u = bf2f(p.ub[(size_t)row * 512 + g * 16 + fr]);
          const float v = y[j] + dsk * u;
          const float zz = 0.7978845608028654f * (v + 0.044715f * v * v * v);
          const float th = 1.f - 2.f / (__expf(2.f * zz) + 1.f);
          p.ssm_y[(size_t)row * 512 + g * 16 + fr] = f2bf(0.5f * v * (1.f + th));
        }
      }
      asm volatile("s_waitcnt lgkmcnt(0)" ::: "memory");
      __builtin_amdgcn_wave_barrier();
    }
  }
}

DI void phase2(const Params& p, char* lds) {
  const int lane = tid() & 63, wid = tid() >> 6;
  const int nb = gridDim.x, bid = blockIdx.x;
  for (int row = bid * 4 + wid; row < NT; row += nb * 4) {
    const f32x4 v = *(const f32x4*)(p.ckv_raw + (size_t)row * 256 + lane * 4);
    const f32x4 pp = *(const f32x4*)(p.ckv_part + (size_t)row * 4);
    const float rstd = rsqrtf((pp[0] + pp[1] + pp[2] + pp[3]) * (1.f / 256.f) + EPS);
    const f32x4 g = *(const f32x4*)(p.in[10] + lane * 4);
    f32x4 o; o[0] = v[0] * rstd * g[0]; o[1] = v[1] * rstd * g[1]; o[2] = v[2] * rstd * g[2]; o[3] = v[3] * rstd * g[3];
    float* dst = row < NTP ? p.out + OFF_LATP + (size_t)row * 256 : p.out + OFF_LATS + (size_t)(row - NTP) * 256;
    *(f32x4*)(dst + lane * 4) = o;
    u32x2 w; w.x = pk_bf16(o[0], o[1]); w.y = pk_bf16(o[2], o[3]);
    *(u32x2*)(p.latb + (size_t)kr_of(row) * 256 + lane * 4) = w;
  }
  for (int it = bid * 4 + wid; it < 8 * 128 * 32; it += nb * 4) {
    const int g = it & 31, c = (it >> 5) & 127, b = it >> 12;
    float hr = 0.f, hi = 0.f;
    ssm_chunk(p, b * 8192 + c * 64, g, hr, hi, false, lds + wid * 8704);
    p.E[(size_t)it * 64 + lane] = make_float2(hr, hi);
  }
  float* rs = (float*)(lds + 65536);
  {
    auto tile_fn = [&](int j, int& m0, int& n0) -> bool { const int li = (int)(blockIdx.x >> 3) + j * (int)(gridDim.x >> 3); const int ti_ = li / 6, tj_ = li - ti_ * 6; const int tbig = ti_ * 8 + (int)(blockIdx.x & 7); if (tbig >= 528) return false; m0 = tbig * 128; n0 = tj_ * 128; return true; };
    auto rs_fn = [&](int m0, int t) -> float2 { float sm = 0.f; for (int q = 0; q < 3; ++q) { const f32x4 v = *(const f32x4*)(p.cq_part + (size_t)(m0 + t) * 12 + 4 * q); sm += (v[0] + v[1]) + (v[2] + v[3]); } return make_float2(rsqrtf(sm * (1.f / 768.f) + EPS), 0.f); };
    auto epi = [&](f32x16 (&acc)[2][2], int m0, int n0, const float* rs) {
    const int tn = n0 >> 7; (void)tn;
    EPI_IDS
    const float qs = 0.10206207261596577f * 1.4426950408889634f;
#pragma unroll
    for (int mt = 0; mt < 2; ++mt) {
      const int rl = wm * 64 + mt * 32 + r, row = m0 + rl;
      const float sc = rs[rl] * qs;
      const float* rp = (const float*)(p.rope + pos_of(row) * 16);
#pragma unroll
      for (int nt = 0; nt < 2; ++nt) {
        const int cb = n0 + wn * 64 + nt * 32;
        bf16_t* qd = p.Q + (size_t)row * 768 + cb;
        if ((cb % 96) == 64) {
#pragma unroll
          for (int ih = 0; ih < 2; ++ih) {
            const int j0 = 8 * ih + 4 * hh;
            const f32x4 c01 = *(const f32x4*)(rp + 2 * j0), c23 = *(const f32x4*)(rp + 2 * j0 + 4);
            const float cc[4] = {c01[0], c01[2], c23[0], c23[2]}, sn[4] = {c01[1], c01[3], c23[1], c23[3]};
            float o1[4], o2[4];
#pragma unroll
            for (int jj = 0; jj < 4; ++jj) {
              const float x1 = acc[mt][nt][4 * ih + jj] * sc, x2 = acc[mt][nt][8 + 4 * ih + jj] * sc;
              o1[jj] = x1 * cc[jj] - x2 * sn[jj]; o2[jj] = x1 * sn[jj] + x2 * cc[jj];
            }
            u32x2 w1, w2; w1.x = pk_bf16(o1[0], o1[1]); w1.y = pk_bf16(o1[2], o1[3]); w2.x = pk_bf16(o2[0], o2[1]); w2.y = pk_bf16(o2[2], o2[3]);
            *(u32x2*)(qd + j0) = w1; *(u32x2*)(qd + 16 + j0) = w2;
          }
        } else {
#pragma unroll
          for (int i4 = 0; i4 < 4; ++i4) {
            u32x2 w; w.x = pk_bf16(acc[mt][nt][4 * i4] * sc, acc[mt][nt][4 * i4 + 1] * sc); w.y = pk_bf16(acc[mt][nt][4 * i4 + 2] * sc, acc[mt][nt][4 * i4 + 3] * sc);
            *(u32x2*)(qd + 8 * i4 + 4 * hh) = w;
          }
        }
      }
    }

    };
    gemm_stream(p.cq, 768, p.WqT, 768, 12, lds, 0, tile_fn, rs_fn, epi);
  }
}

DI void phase3(const Params& p, char* lds) {
  const int lane = tid() & 63, wid = tid() >> 6;
  const int nb = gridDim.x, bid = blockIdx.x;
  for (int it = bid * 4 + wid; it < 256; it += nb * 4) {
    const int b = it >> 5, g = it & 31;
    const float2 l64 = p.lam64[g * 64 + lane];
    float sr = 0.f, si = 0.f;
    const size_t base = ((size_t)(b * 128) * 32 + g) * 64 + lane;
    for (int c0 = 0; c0 < 128; c0 += 16) {
      float2 e[16];
#pragma unroll
      for (int j = 0; j < 16; ++j) e[j] = p.E[base + (size_t)(c0 + j) * 2048];
#pragma unroll
      for (int j = 0; j < 16; ++j) {
        p.S[base + (size_t)(c0 + j) * 2048] = make_float2(sr, si);
        const float nr = l64.x * sr - l64.y * si + e[j].x, ni = l64.x * si + l64.y * sr + e[j].y;
        sr = nr; si = ni;
      }
    }
  }
  {
    auto tile_fn = [&](int j, int& m0, int& n0) -> bool { const int li = (int)(blockIdx.x >> 3) + j * (int)(gridDim.x >> 3); const int ti_ = li / 4, tj_ = li - ti_ * 4; const int tbig = ti_ * 8 + (int)(blockIdx.x & 7); if (tbig >= 1552) return false; m0 = tbig * 128; n0 = tj_ * 128; return true; };
    auto rs_fn = [&](int m0, int t) -> float2 { return make_float2(0.f, 0.f); };
    auto epi = [&](f32x16 (&acc)[2][2], int m0, int n0, const float* rs) {
    const int tn = n0 >> 7; (void)tn;
    EPI_IDS
#pragma unroll
    for (int mt = 0; mt < 2; ++mt) {
      const int row = m0 + wm * 64 + mt * 32 + r;
#pragma unroll
      for (int nt = 0; nt < 2; ++nt)
#pragma unroll
        for (int i4 = 0; i4 < 4; ++i4) {
          u32x2 w; w.x = pk_bf16(acc[mt][nt][4 * i4], acc[mt][nt][4 * i4 + 1]); w.y = pk_bf16(acc[mt][nt][4 * i4 + 2], acc[mt][nt][4 * i4 + 3]);
          *(u32x2*)(p.Kn + (size_t)row * 512 + n0 + wn * 64 + nt * 32 + 8 * i4 + 4 * hh) = w;
        }
    }

    };
    gemm_stream(p.latb, 256, p.WkT, 256, 4, lds, 0, tile_fn, rs_fn, epi);
  }
  {
    auto tile_fn = [&](int j, int& m0, int& n0) -> bool { const int li = (int)(blockIdx.x >> 3) + j * (int)(gridDim.x >> 3); const int ti_ = li / 4, tj_ = li - ti_ * 4; const int tbig = ti_ * 8 + (int)(blockIdx.x & 7); if (tbig >= 1552) return false; n0 = tbig * 128; m0 = tj_ * 128; return true; };
    auto rs_fn = [&](int m0, int t) -> float2 { return make_float2(0.f, 0.f); };
    auto epi = [&](f32x16 (&acc)[2][2], int m0, int n0, const float* rs) {
    const int tn = n0 >> 7; (void)tn;
    EPI_IDS
#pragma unroll
    for (int nt = 0; nt < 2; ++nt)
#pragma unroll
      for (int i4 = 0; i4 < 4; ++i4) {
        const int kr = n0 + wn * 64 + nt * 32 + 8 * i4 + 4 * hh;
        size_t cbase; int S;
        if (kr < NTP) { cbase = (size_t)(kr >> 13) * 512 * 8192 + (kr & 8191); S = 8192; }
        else { const int k2 = kr - NTP, b = k2 / SKS, tt = k2 - b * SKS; cbase = VT_S_OFF + (size_t)b * 512 * SKS + tt; S = SKS; }
#pragma unroll
        for (int mt = 0; mt < 2; ++mt) {
          const int hd = m0 + wm * 64 + mt * 32 + r;
          u32x2 w; w.x = pk_bf16(acc[mt][nt][4 * i4], acc[mt][nt][4 * i4 + 1]); w.y = pk_bf16(acc[mt][nt][4 * i4 + 2], acc[mt][nt][4 * i4 + 3]);
          *(u32x2*)(p.Vt + cbase + (size_t)hd * S) = w;
        }
      }

    };
    gemm_stream(p.WvT, 256, p.latb, 256, 4, lds, 0, tile_fn, rs_fn, epi);
  }
}

template <int QT, bool HALF>
DI void attn_item(const Params& p, int kind, int b, int h, int qq, char* lds) {
  const int t = tid(), lane = t & 63, wid = t >> 6, r = lane & 31, hh = lane >> 5;
  int qrow0, nkb_w, nkb_max, S; size_t kr0; const bf16_t* vt_base;
  constexpr int RW = 32 * QT, WPC = 64 / RW, CPB = 4 / WPC;
  if (kind == 0) {
    const int c = qq * CPB + wid / WPC; qrow0 = b * 8192 + c * 64 + (wid % WPC) * RW; nkb_w = c + 1; nkb_max = qq * CPB + CPB; kr0 = (size_t)b * 8192; S = 8192;
    vt_base = p.Vt + (size_t)(b * 8 + h) * 64 * 8192;
  } else {
    qrow0 = NTP + b * 64 + (wid % WPC) * RW; nkb_w = (wid < WPC) ? 65 : 0; nkb_max = 65; kr0 = (size_t)NTP + (size_t)b * SKS; S = SKS;
    vt_base = p.Vt + VT_S_OFF + (size_t)(b * 8 + h) * 64 * SKS;
  }
  bf16x8 qf[QT][6];
#pragma unroll
  for (int qt = 0; qt < QT; ++qt)
#pragma unroll
    for (int ks = 0; ks < 6; ++ks) qf[qt][ks] = *(const bf16x8*)(p.Q + (size_t)(qrow0 + qt * 32 + r) * 768 + h * 96 + ks * 16 + hh * 8);
  f32x16 o[2][QT];
  float mrun[QT], lrun[QT];
#pragma unroll
  for (int qt = 0; qt < QT; ++qt) { mrun[qt] = -1e30f; lrun[qt] = 0.f;
#pragma unroll
    for (int dt = 0; dt < 2; ++dt)
#pragma unroll
      for (int i = 0; i < 16; ++i) o[dt][qt][i] = 0.f; }
  const int kkey = t >> 3, kc = t & 7;
  const int rkey = t >> 2, rc = t & 3;
  const int vd = t >> 3, vc = t & 7;
  const bf16_t* gk = p.Kn + (kr0 + kkey) * 512 + h * 64 + kc * 8;
  const bf16_t* gr = p.krb + (kr0 + rkey) * 32 + rc * 8;
  const bf16_t* gv = vt_base + (size_t)vd * S + vc * 8;
  const unsigned kw0 = kkey * 208 + kc * 16, kw1 = kw0 + 32 * 208, rw = rkey * 208 + 128 + rc * 16;
  const unsigned vlo = vd * 144 + (vc >> 1) * 32 + (vc & 1) * 8, vhi = vlo + 16;
  constexpr int KB = 13312, VB = 9216, BUF = KB + VB;
  u32x4 k0r, k1r, rr, v0r, v1r;
  k0r = *(const u32x4*)gk; k1r = *(const u32x4*)(gk + 32 * 512); rr = *(const u32x4*)gr;
  v0r = *(const u32x4*)gv; v1r = *(const u32x4*)(gv + (size_t)32 * S);
  __syncthreads();
  {
    char* kb_ = lds; char* vb_ = lds + KB;
    *(u32x4*)(kb_ + kw0) = k0r; *(u32x4*)(kb_ + kw1) = k1r; *(u32x4*)(kb_ + rw) = rr;
    *(u32x2*)(vb_ + vlo) = (u32x2){v0r.x, v0r.y}; *(u32x2*)(vb_ + vhi) = (u32x2){v0r.z, v0r.w};
    *(u32x2*)(vb_ + vlo + 32 * 144) = (u32x2){v1r.x, v1r.y}; *(u32x2*)(vb_ + vhi + 32 * 144) = (u32x2){v1r.z, v1r.w};
  }
  __syncthreads();
  for (int kb = 0; kb < nkb_max; ++kb) {
    const int cur = kb & 1;
    const bool more = kb + 1 < nkb_max;
    if (more) {
      const size_t ko = (size_t)(kb + 1) * 64;
      k0r = *(const u32x4*)(gk + ko * 512); k1r = *(const u32x4*)(gk + (ko + 32) * 512); rr = *(const u32x4*)(gr + ko * 32);
      v0r = *(const u32x4*)(gv + ko); v1r = *(const u32x4*)(gv + (size_t)32 * S + ko);
    }
    if (HALF && kb < nkb_w) {
      const char* kt_ = lds + cur * BUF; const char* vt_ = kt_ + KB;
#pragma unroll
      for (int kt = 0; kt < 2; ++kt) {
        f32x16 sh[QT];
#pragma unroll
        for (int qt = 0; qt < QT; ++qt)
#pragma unroll
          for (int i = 0; i < 16; ++i) sh[qt][i] = 0.f;
#pragma unroll
        for (int ks = 0; ks < 6; ++ks) {
          const bf16x8 kf = *(const bf16x8*)(kt_ + (kt * 32 + r) * 208 + ks * 32 + hh * 16);
#pragma unroll
          for (int qt = 0; qt < QT; ++qt) sh[qt] = MFMA32(kf, qf[qt][ks], sh[qt]);
        }
        bf16x8 ph[QT][2];
#pragma unroll
        for (int qt = 0; qt < QT; ++qt) {
          float mx = sh[qt][0];
#pragma unroll
          for (int i = 1; i < 16; ++i) mx = fmaxf(mx, sh[qt][i]);
          mx = fmaxf(mx, __shfl_xor(mx, 32));
          const bool need = mx > mrun[qt] + 8.f;
          if (__any(need)) {
            const float mnew = need ? mx : mrun[qt];
            const float alpha = __builtin_amdgcn_exp2f(mrun[qt] - mnew);
            mrun[qt] = mnew; lrun[qt] *= alpha;
#pragma unroll
            for (int dt = 0; dt < 2; ++dt)
#pragma unroll
              for (int i = 0; i < 16; ++i) o[dt][qt][i] *= alpha;
          }
          float ls = 0.f;
#pragma unroll
          for (int i = 0; i < 16; ++i) { const float pv = __builtin_amdgcn_exp2f(sh[qt][i] - mrun[qt]); ls += pv; sh[qt][i] = pv; }
          lrun[qt] += ls;
#pragma unroll
          for (int s2 = 0; s2 < 2; ++s2) {
            u32x4 w;
            w.x = pk_bf16(sh[qt][8 * s2 + 0], sh[qt][8 * s2 + 1]); w.y = pk_bf16(sh[qt][8 * s2 + 2], sh[qt][8 * s2 + 3]);
            w.z = pk_bf16(sh[qt][8 * s2 + 4], sh[qt][8 * s2 + 5]); w.w = pk_bf16(sh[qt][8 * s2 + 6], sh[qt][8 * s2 + 7]);
            ph[qt][s2] = __builtin_bit_cast(bf16x8, w);
          }
        }
#pragma unroll
        for (int dt = 0; dt < 2; ++dt)
#pragma unroll
          for (int s2 = 0; s2 < 2; ++s2) {
            const bf16x8 vf = *(const bf16x8*)(vt_ + (dt * 32 + r) * 144 + (kt * 2 + s2) * 32 + hh * 16);
#pragma unroll
            for (int qt = 0; qt < QT; ++qt) o[dt][qt] = MFMA32(vf, ph[qt][s2], o[dt][qt]);
          }
      }
    }
    if (!HALF && kb < nkb_w) {
      const char* kt_ = lds + cur * BUF; const char* vt_ = kt_ + KB;
      f32x16 st[2][QT];
#pragma unroll
      for (int kt = 0; kt < 2; ++kt)
#pragma unroll
        for (int qt = 0; qt < QT; ++qt)
#pragma unroll
          for (int i = 0; i < 16; ++i) st[kt][qt][i] = 0.f;
#pragma unroll
      for (int ks = 0; ks < 6; ++ks)
#pragma unroll
        for (int kt = 0; kt < 2; ++kt) {
          const bf16x8 kf = *(const bf16x8*)(kt_ + (kt * 32 + r) * 208 + ks * 32 + hh * 16);
#pragma unroll
          for (int qt = 0; qt < QT; ++qt) st[kt][qt] = MFMA32(kf, qf[qt][ks], st[kt][qt]);
        }
      bf16x8 pb[2][QT][2];
#pragma unroll
      for (int qt = 0; qt < QT; ++qt) {
        float mx = mrun[qt];
#pragma unroll
        for (int kt = 0; kt < 2; ++kt)
#pragma unroll
          for (int i = 0; i < 16; ++i) mx = fmaxf(mx, st[kt][qt][i]);
        mx = fmaxf(mx, __shfl_xor(mx, 32));
        const float alpha = __builtin_amdgcn_exp2f(mrun[qt] - mx);
        mrun[qt] = mx;
        float ls = 0.f;
#pragma unroll
        for (int kt = 0; kt < 2; ++kt) {
#pragma unroll
          for (int i = 0; i < 16; ++i) { const float pv = __builtin_amdgcn_exp2f(st[kt][qt][i] - mx); ls += pv; st[kt][qt][i] = pv; }
#pragma unroll
          for (int s2 = 0; s2 < 2; ++s2) {
            u32x4 w;
            w.x = pk_bf16(st[kt][qt][8 * s2 + 0], st[kt][qt][8 * s2 + 1]); w.y = pk_bf16(st[kt][qt][8 * s2 + 2], st[kt][qt][8 * s2 + 3]);
            w.z = pk_bf16(st[kt][qt][8 * s2 + 4], st[kt][qt][8 * s2 + 5]); w.w = pk_bf16(st[kt][qt][8 * s2 + 6], st[kt][qt][8 * s2 + 7]);
            pb[kt][qt][s2] = __builtin_bit_cast(bf16x8, w);
          }
        }
        lrun[qt] = lrun[qt] * alpha + ls;
#pragma unroll
        for (int dt = 0; dt < 2; ++dt)
#pragma unroll
          for (int i = 0; i < 16; ++i) o[dt][qt][i] *= alpha;
      }
#pragma unroll
      for (int dt = 0; dt < 2; ++dt)
#pragma unroll
        for (int kt = 0; kt < 2; ++kt)
#pragma unroll
          for (int s2 = 0; s2 < 2; ++s2) {
            const bf16x8 vf = *(const bf16x8*)(vt_ + (dt * 32 + r) * 144 + (kt * 2 + s2) * 32 + hh * 16);
#pragma unroll
            for (int qt = 0; qt < QT; ++qt) o[dt][qt] = MFMA32(vf, pb[kt][qt][s2], o[dt][qt]);
          }
    }
    if (more) {
      char* kb_ = lds + (cur ^ 1) * BUF; char* vb_ = kb_ + KB;
      *(u32x4*)(kb_ + kw0) = k0r; *(u32x4*)(kb_ + kw1) = k1r; *(u32x4*)(kb_ + rw) = rr;
      *(u32x2*)(vb_ + vlo) = (u32x2){v0r.x, v0r.y}; *(u32x2*)(vb_ + vhi) = (u32x2){v0r.z, v0r.w};
      *(u32x2*)(vb_ + vlo + 32 * 144) = (u32x2){v1r.x, v1r.y}; *(u32x2*)(vb_ + vhi + 32 * 144) = (u32x2){v1r.z, v1r.w};
    }
    __syncthreads();
  }
  if (nkb_w > 0) {
#pragma unroll
    for (int qt = 0; qt < QT; ++qt) {
      const float lt = lrun[qt] + __shfl_xor(lrun[qt], 32);
      const float inv = 1.f / lt;
      const int row = qrow0 + qt * 32 + r;
      float ss = 0.f;
#pragma unroll
      for (int dt = 0; dt < 2; ++dt)
#pragma unroll
        for (int i4 = 0; i4 < 4; ++i4) {
          const float a0 = o[dt][qt][4 * i4] * inv, a1 = o[dt][qt][4 * i4 + 1] * inv, a2 = o[dt][qt][4 * i4 + 2] * inv, a3 = o[dt][qt][4 * i4 + 3] * inv;
          ss += a0 * a0 + a1 * a1 + a2 * a2 + a3 * a3;
          u32x2 w; w.x = pk_bf16(a0, a1); w.y = pk_bf16(a2, a3);
          *(u32x2*)(p.mix + (size_t)row * 1024 + h * 64 + dt * 32 + 8 * i4 + 4 * hh) = w;
        }
      ss += __shfl_xor(ss, 32);
      if (hh == 0) p.attn_part[(size_t)row * 8 + h] = ss;
    }
  }
}

DI void phase4(const Params& p, char* lds, int qidx) {
  const int t = tid(), lane = t & 63, wid = t >> 6;
  const int nb = gridDim.x, bid = blockIdx.x;
  int* nxt = (int*)(lds + 65536);
  for (;;) {
    __syncthreads();
    if (t == 0) *nxt = atomicAdd(p.counters + qidx, 1);
    __syncthreads();
    const int it = *nxt;
    if (it >= 256 + 64 * 32) break;
    if (it < 256) attn_item<1, false>(p, 1, it >> 3, it & 7, 0, lds);
    else { const int j = it - 256; const int qq = 31 - (j >> 6), bh = j & 63; attn_item<2, true>(p, 0, bh >> 3, bh & 7, qq, lds); }
  }
  __syncthreads();
  for (int it = bid * 4 + wid; it < 8 * 128 * 32 + 1024; it += nb * 4) {
    if (it < 8 * 128 * 32) {
      const int g = it & 31, c = (it >> 5) & 127, b = it >> 12;
      const float2 s0 = p.S[(size_t)it * 64 + lane];
      float hr = s0.x, hi = s0.y;
      ssm_chunk(p, b * 8192 + c * 64, g, hr, hi, true, lds + wid * 8704);
      if (c == 127) { p.out[OFF_HRP + (size_t)(b * 32 + g) * 64 + lane] = hr; p.out[OFF_HIP + (size_t)(b * 32 + g) * 64 + lane] = hi; }
    } else {
      const int j = it - 8 * 128 * 32, g = j & 31, b = j >> 5;
      float hr = p.in[4][(size_t)(b * 32 + g) * 64 + lane], hi = p.in[5][(size_t)(b * 32 + g) * 64 + lane];
      ssm_chunk(p, NTP + b * 64, g, hr, hi, true, lds + wid * 8704);
      p.out[OFF_HRS + (size_t)(b * 32 + g) * 64 + lane] = hr; p.out[OFF_HIS + (size_t)(b * 32 + g) * 64 + lane] = hi;
    }
  }
}

DI void phase5(const Params& p, char* lds) {
  {
    auto tile_fn = [&](int j, int& m0, int& n0) -> bool { const int li = (int)(blockIdx.x >> 3) + j * (int)(gridDim.x >> 3); const int ti_ = li / 4, tj_ = li - ti_ * 4; const int tbig = ti_ * 8 + (int)(blockIdx.x & 7); if (tbig >= 528) return false; m0 = tbig * 128; n0 = tj_ * 128; return true; };
    auto rs_fn = [&](int m0, int t) -> float2 { return make_float2(0.f, 0.f); };
    auto epi = [&](f32x16 (&acc)[2][2], int m0, int n0, const float* rs) {
    const int tn = n0 >> 7; (void)tn;
    { EPI_IDS
#pragma unroll
    for (int mt = 0; mt < 2; ++mt) {
      const int row = m0 + wm * 64 + mt * 32 + r;
      float ss = 0.f;
#pragma unroll
      for (int nt = 0; nt < 2; ++nt)
#pragma unroll
        for (int i4 = 0; i4 < 4; ++i4) {
          const int col = n0 + wn * 64 + nt * 32 + 8 * i4 + 4 * hh;
          const u32x2 yv = *(const u32x2*)(p.ssm_y + (size_t)row * 512 + col);
          const float y0 = __uint_as_float(yv.x << 16), y1 = __uint_as_float(yv.x & 0xffff0000u), y2 = __uint_as_float(yv.y << 16), y3 = __uint_as_float(yv.y & 0xffff0000u);
          const float o0 = y0 / (1.f + __expf(-acc[mt][nt][4 * i4])), o1 = y1 / (1.f + __expf(-acc[mt][nt][4 * i4 + 1]));
          const float o2 = y2 / (1.f + __expf(-acc[mt][nt][4 * i4 + 2])), o3 = y3 / (1.f + __expf(-acc[mt][nt][4 * i4 + 3]));
          ss += o0 * o0 + o1 * o1 + o2 * o2 + o3 * o3;
          u32x2 w; w.x = pk_bf16(o0, o1); w.y = pk_bf16(o2, o3);
          *(u32x2*)(p.mix + (size_t)row * 1024 + 512 + col) = w;
        }
      ss += __shfl_xor(ss, 32);
      if (hh == 0) p.ssm_part[(size_t)row * 8 + tn * 2 + wn] = ss;
    }
    }

    };
    gemm_stream(p.ssm_y, 512, p.WgT, 512, 8, lds, 0, tile_fn, rs_fn, epi);
  }
}

DI void phase6(const Params& p, char* lds) {
  float* rsS = (float*)(lds + 65536); float* ratio = rsS + 128;
  const int xb_ = blockIdx.x & 7, xl_ = blockIdx.x >> 3, nbx_ = gridDim.x >> 3;
  for (int j = 0;; ++j) {
    const int li6 = xl_ + j * nbx_, tm = (li6 >> 3) * 8 + xb_, tn = li6 & 7, m0 = tm * 128, n0 = tn * 128;
    if (tm >= 528) break;
    __syncthreads();
    if (tid() < 128) {
      const int t = tid(); const int row = m0 + t; float sa = 0.f, sb = 0.f;
      for (int j = 0; j < 8; ++j) { sa += p.attn_part[(size_t)row * 8 + j]; sb += p.ssm_part[(size_t)row * 8 + j]; }
      const float ra = rsqrtf(sa * (1.f / 512.f) + EPS), rb = rsqrtf(sb * (1.f / 512.f) + EPS);
      rsS[t] = rb; ratio[t] = ra / rb;
    }
    f32x16 acc[2][2];
    gemm_core(p.mix, 1024, p.WoT, 1024, 16, m0, n0, lds, acc, 8, ratio);
    { EPI_IDS
#pragma unroll
    for (int mt = 0; mt < 2; ++mt) {
      const int rl = wm * 64 + mt * 32 + r, row = m0 + rl;
      const float sc = rsS[rl];
      const float* xr = xrow(p, row);
      float ss = 0.f;
#pragma unroll
      for (int nt = 0; nt < 2; ++nt)
#pragma unroll
        for (int i4 = 0; i4 < 4; ++i4) {
          const int col = n0 + wn * 64 + nt * 32 + 8 * i4 + 4 * hh;
          const f32x4 xv = *(const f32x4*)(xr + col);
          f32x4 hv;
#pragma unroll
          for (int jj = 0; jj < 4; ++jj) { hv[jj] = xv[jj] + acc[mt][nt][4 * i4 + jj] * sc; ss += hv[jj] * hv[jj]; }
          *(f32x4*)(p.out + OFF_Y + (size_t)row * 1024 + col) = hv;
          u32x2 w; w.x = pk_bf16(hv[0], hv[1]); w.y = pk_bf16(hv[2], hv[3]);
          *(u32x2*)(p.hb + (size_t)row * 1024 + col) = w;
        }
      ss += __shfl_xor(ss, 32);
      if (hh == 0) p.h_part[(size_t)row * 16 + tn * 2 + wn] = ss;
    }
    }
  }
}

DI void phase7(const Params& p, char* lds) {
  float* rs = (float*)(lds + 65536);
  const int xb_ = blockIdx.x & 7, xl_ = blockIdx.x >> 3, nbx_ = gridDim.x >> 3;
  {
    auto tile_fn = [&](int j, int& m0, int& n0) -> bool { const int tm = j * (nbx_ >> 2) + (xl_ >> 2); if (tm >= 528) return false; m0 = tm * 128; n0 = (xb_ * 4 + (xl_ & 3)) * 128; return true; };
    auto rs_fn = [&](int m0, int t) -> float2 { float sm = 0.f; for (int q = 0; q < 4; ++q) { const f32x4 v = *(const f32x4*)(p.h_part + (size_t)(m0 + t) * 16 + 4 * q); sm += (v[0] + v[1]) + (v[2] + v[3]); } return make_float2(rsqrtf(sm * (1.f / 1024.f) + EPS), 0.f); };
    auto epi = [&](f32x16 (&acc)[2][2], int m0, int n0, const float* rs) {
    const int tn = n0 >> 7; (void)tn;
    { EPI_IDS
#pragma unroll
    for (int mt = 0; mt < 2; ++mt) {
      const int rl = wm * 64 + mt * 32 + r, row = m0 + rl;
      const float sc = rs[rl];
#pragma unroll
      for (int nt = 0; nt < 2; ++nt)
#pragma unroll
        for (int i4 = 0; i4 < 4; ++i4) {
          float v[4];
#pragma unroll
          for (int jj = 0; jj < 4; ++jj) { const float a = fmaxf(acc[mt][nt][4 * i4 + jj] * sc, 0.f); v[jj] = a * a; }
          u32x2 w; w.x = pk_bf16(v[0], v[1]); w.y = pk_bf16(v[2], v[3]);
          { const int col = n0 + wn * 64 + nt * 32 + 8 * i4 + 4 * hh;
            *(u32x2*)(p.act + (((size_t)(row >> 7) * 64 + (col >> 6)) * 128 + (row & 127)) * 64 + (col & 63)) = w; }
        }
    }
    }

    };
    gemm_stream(p.hb, 1024, p.WuT, 1024, 16, lds, 0, tile_fn, rs_fn, epi);
  }
}

DI void phase8(const Params& p, char* lds) {
  const int xb_ = blockIdx.x & 7, xl_ = blockIdx.x >> 3, nbx_ = gridDim.x >> 3;
  {
    auto tile_fn = [&](int j, int& m0, int& n0) -> bool { const int li = (int)(blockIdx.x >> 3) + j * (int)(gridDim.x >> 3); const int ti_ = li / 8, tj_ = li - ti_ * 8; const int tbig = ti_ * 8 + (int)(blockIdx.x & 7); if (tbig >= 528) return false; m0 = tbig * 128; n0 = tj_ * 128; return true; };
    auto rs_fn = [&](int m0, int t) -> float2 { return make_float2(0.f, 0.f); };
    auto epi = [&](f32x16 (&acc)[2][2], int m0, int n0, const float* rs) {
    const int tn = n0 >> 7; (void)tn;
    { EPI_IDS
#pragma unroll
    for (int mt = 0; mt < 2; ++mt) {
      const int row = m0 + wm * 64 + mt * 32 + r;
      float ss = 0.f;
#pragma unroll
      for (int nt = 0; nt < 2; ++nt)
#pragma unroll
        for (int i4 = 0; i4 < 4; ++i4) {
          float* yp = p.out + OFF_Y + (size_t)row * 1024 + n0 + wn * 64 + nt * 32 + 8 * i4 + 4 * hh;
          f32x4 ov = *(const f32x4*)yp;
#pragma unroll
          for (int jj = 0; jj < 4; ++jj) { ov[jj] += acc[mt][nt][4 * i4 + jj]; ss += ov[jj] * ov[jj]; }
          *(f32x4*)yp = ov;
          if (i4 == 1 || i4 == 3) __builtin_amdgcn_sched_barrier(0);
        }
      ss += __shfl_xor(ss, 32);
      if (hh == 0) p.out_part[(size_t)row * 16 + tn * 2 + wn] = ss;
    }
    }

    };
    gemm_stream<true>(p.act, 4096, p.WdT, 4096, 64, lds, 0, tile_fn, rs_fn, epi);
  }
}

DI void phase9(const Params& p) {
  const int t = tid(), lane = t & 63, wid = t >> 6;
  for (int row = blockIdx.x * 4 + wid; row < NT; row += gridDim.x * 4) {
    float s = 0.f;
    for (int j = 0; j < 16; ++j) s += p.out_part[(size_t)row * 16 + j];
    const float rstd = rsqrtf(s * (1.f / 1024.f) + EPS);
    float* y = p.out + OFF_Y + (size_t)row * 1024;
#pragma unroll
    for (int j = 0; j < 4; ++j) {
      f32x4 v = *(const f32x4*)(y + lane * 4 + 256 * j);
      const f32x4 g = *(const f32x4*)(p.in[27] + lane * 4 + 256 * j);
      v[0] *= rstd * g[0]; v[1] *= rstd * g[1]; v[2] *= rstd * g[2]; v[3] *= rstd * g[3];
      *(f32x4*)(y + lane * 4 + 256 * j) = v;
    }
  }
}

DI void grid_barrier(unsigned* cnt, unsigned target) {
  asm volatile("s_waitcnt vmcnt(0)" ::: "memory");
  __syncthreads();
  if (tid() == 0) {
    __builtin_amdgcn_fence(__ATOMIC_RELEASE, "agent");
    asm volatile("s_waitcnt vmcnt(0)" ::: "memory");
    __hip_atomic_fetch_add(cnt, 1u, __ATOMIC_RELAXED, __HIP_MEMORY_SCOPE_AGENT);
    while (__hip_atomic_load(cnt, __ATOMIC_RELAXED, __HIP_MEMORY_SCOPE_AGENT) < target) __builtin_amdgcn_s_sleep(2);
  }
  __syncthreads();
  __builtin_amdgcn_fence(__ATOMIC_ACQUIRE, "agent");
  asm volatile("s_waitcnt vmcnt(0)" ::: "memory");
}

template <bool COOP>
__global__ void __launch_bounds__(256, 2) mega(Params p) {
  __shared__ __attribute__((aligned(16))) char lds[LDS_BYTES];
  for (int ph = p.ph_lo; ph < p.ph_hi; ++ph) {
#ifdef ONLY_PHASE
    if (ph != ONLY_PHASE) continue;
#endif
    switch (ph) {
      case 0: phase0(p, lds); break;
      case 1: phase1(p, lds); break;
      case 2: phase2(p, lds); break;
      case 3: phase3(p, lds); break;
      case 4: phase4(p, lds, 0); break;
      case 5: phase5(p, lds); break;
      case 6: phase6(p, lds); break;
      case 7: phase7(p, lds); break;
      case 8: phase8(p, lds); break;
      default: phase9(p); break;
    }
#ifdef DOUBLE_PHASE
    if (ph == DOUBLE_PHASE) {
      __syncthreads();
      switch (ph) { case 0: phase0(p, lds); break; case 1: phase1(p, lds); break; case 2: phase2(p, lds); break; case 3: phase3(p, lds); break; case 4: phase4(p, lds, 1); break;
                    case 5: phase5(p, lds); break; case 6: phase6(p, lds); break; case 7: phase7(p, lds); break; default: break; }
    }
#endif
    if (COOP) { if (ph + 1 < p.ph_hi) { if (ph == 0) cg::this_grid().sync(); else grid_barrier((unsigned*)p.counters + 32, (unsigned)ph * gridDim.x); } }
  }
}

static size_t al256(size_t x) { return (x + 255) & ~(size_t)255; }

extern "C" void kernel_launch(void* const* d_in, const int* in_sizes, int n_in, void* d_out, int out_size, void* d_ws, size_t ws_size, hipStream_t stream) {
  Params p{};
  for (int i = 0; i < 28; ++i) p.in[i] = (const float*)d_in[i];
  p.out = (float*)d_out;
  char* base = (char*)d_ws; size_t off = 0;
  auto take = [&](size_t bytes) { char* q = base + off; off = al256(off + bytes); return q; };
  p.WinT = (bf16_t*)take((size_t)1664 * 1024 * 2);
  p.WqT = (bf16_t*)take((size_t)768 * 768 * 2);
  p.WkT = (bf16_t*)take((size_t)512 * 256 * 2);
  p.WvT = (bf16_t*)take((size_t)512 * 256 * 2);
  p.WgT = (bf16_t*)take((size_t)512 * 512 * 2);
  p.WoT = (bf16_t*)take((size_t)1024 * 1024 * 2);
  p.WuT = (bf16_t*)take((size_t)4096 * 1024 * 2);
  p.WdT = (bf16_t*)take((size_t)1024 * 4096 * 2);
  p.BbT = (bf16_t*)take((size_t)32 * 128 * 16 * 2);
  p.CcT = (bf16_t*)take((size_t)32 * 16 * 128 * 2);
  p.lam = (float2*)take(2048 * 8);
  p.lam64 = (float2*)take(2048 * 8);
  p.rope = (float2*)take((size_t)8192 * 16 * 8);
  p.rstd_x = (float*)take((size_t)NT * 4);
  p.cq_part = (float*)take((size_t)NT * 12 * 4);
  p.ckv_part = (float*)take((size_t)NT * 4 * 4);
  p.attn_part = (float*)take((size_t)NT * 8 * 4);
  p.ssm_part = (float*)take((size_t)NT * 8 * 4);
  p.h_part = (float*)take((size_t)NT * 16 * 4);
  p.out_part = (float*)take((size_t)NT * 16 * 4);
  p.counters = (int*)take(256);
  p.E = (float2*)take((size_t)8 * 128 * 32 * 64 * 8);
  p.S = (float2*)take((size_t)8 * 128 * 32 * 64 * 8);
  const size_t a0 = off;
  p.Kn = (bf16_t*)take((size_t)NK * 512 * 2);
  const size_t aVt = off;
  p.Vt = (bf16_t*)take((size_t)NK * 512 * 2);
  p.Q = (bf16_t*)take((size_t)NT * 768 * 2);
  p.latb = (bf16_t*)take((size_t)NK * 256 * 2);
  p.krb = (bf16_t*)take((size_t)NK * 32 * 2);
  p.ub = (bf16_t*)take((size_t)NT * 512 * 2);
  const size_t aSsmY = off;
  p.ssm_y = (bf16_t*)take((size_t)NT * 512 * 2);
  p.mix = (bf16_t*)take((size_t)NT * 1024 * 2);
  const size_t total = off;
  p.xb = (bf16_t*)(base + a0);
  p.cq = (bf16_t*)(base + aVt);
  p.ckv_raw = (float*)(base + aVt + al256((size_t)NT * 768 * 2));
  p.act = (bf16_t*)(base + a0);
  const size_t aHb = a0 + al256((size_t)NT * 4096 * 2);
  p.hb = (bf16_t*)(base + aHb);
  if (aHb + (size_t)NT * 1024 * 2 > aSsmY || total > ws_size) { fprintf(stderr, "workspace layout error: total %zu ws %zu\n", total, ws_size); return; }

  const int MULTI = 0;
  hipMemsetAsync(p.counters, 0, 256, stream);
  if (MULTI) {
    for (int ph = 0; ph < NPHASE; ++ph) {
      p.ph_lo = ph; p.ph_hi = ph + 1;
      hipLaunchKernelGGL(mega<false>, dim3(512), dim3(256), 0, stream, p);
    }
  } else {
    static int grid_blocks = 0;
    if (!grid_blocks) {
      int dev = 0, cus = 0, per_cu = 0;
      hipGetDevice(&dev);
      hipDeviceGetAttribute(&cus, hipDeviceAttributeMultiprocessorCount, dev);
      hipOccupancyMaxActiveBlocksPerMultiprocessor(&per_cu, mega<true>, 256, 0);
      grid_blocks = cus * per_cu;
    }
    p.ph_lo = 0; p.ph_hi = NPHASE;
    void* args[] = {&p};
    hipError_t e = hipLaunchCooperativeKernel((void*)mega<true>, dim3(grid_blocks), dim3(256), args, 0, stream);
    if (e != hipSuccess) fprintf(stderr, "cooperative launch failed: %s (grid %d)\n", hipGetErrorString(e), grid_blocks);
  }
}
```

```cpp
#include <hip/hip_runtime.h>
#include <hip/hip_cooperative_groups.h>
#include <stdint.h>
#include <cstdio>
namespace cg = cooperative_groups;
#define DI __device__ __forceinline__

typedef unsigned short bf16_t;
typedef short bf16x8 __attribute__((ext_vector_type(8)));
typedef float f32x16 __attribute__((ext_vector_type(16)));
typedef float f32x4 __attribute__((ext_vector_type(4)));
typedef unsigned u32x4 __attribute__((ext_vector_type(4)));
typedef unsigned u32x2 __attribute__((ext_vector_type(2)));

constexpr int NTP = 65536, NTS = 2048, NT = NTP + NTS, NK = NTP + 32 * 4160;
constexpr int SKS = 4160;
constexpr size_t OFF_Y = 0;
constexpr size_t OFF_LATP = (size_t)NT * 1024;
constexpr size_t OFF_KRP = OFF_LATP + (size_t)NTP * 256;
constexpr size_t OFF_HRP = OFF_KRP + (size_t)NTP * 32;
constexpr size_t OFF_HIP = OFF_HRP + 8 * 32 * 64;
constexpr size_t OFF_LATS = OFF_HIP + 8 * 32 * 64;
constexpr size_t OFF_KRS = OFF_LATS + (size_t)NTS * 256;
constexpr size_t OFF_HRS = OFF_KRS + (size_t)NTS * 32;
constexpr size_t OFF_HIS = OFF_HRS + 32 * 32 * 64;
constexpr size_t VT_S_OFF = (size_t)8 * 512 * 8192;
constexpr float EPS = 1e-6f;
constexpr int LDS_BYTES = 67600;
constexpr int NPHASE = 10;
constexpr int AQT = 1, NQQ = 128 / (4 / (64 / (32 * AQT)));

struct Params {
  const float* in[28];
  float* out;
  bf16_t *WinT, *WqT, *WkT, *WvT, *WgT, *WoT, *WuT, *WdT, *BbT, *CcT;
  float2 *lam, *lam64, *rope;
  float *rstd_x, *cq_part, *ckv_part, *attn_part, *ssm_part, *h_part, *out_part;
  int* counters;
  float2 *E, *S;
  bf16_t *Kn, *Vt, *Q, *latb, *krb, *ub, *ssm_y, *mix, *xb, *cq, *hb, *act;
  float* ckv_raw;
  int ph_lo, ph_hi;
};

DI int tid() { int t = __builtin_amdgcn_workitem_id_x(); asm volatile("" : "+v"(t)); return t; }
typedef __bf16 nbf16x2 __attribute__((ext_vector_type(2)));
typedef float f32x2 __attribute__((ext_vector_type(2)));
DI unsigned pk_bf16(float lo, float hi) { f32x2 v = {lo, hi}; return __builtin_bit_cast(unsigned, __builtin_convertvector(v, nbf16x2)); }
DI bf16_t f2bf(float x) { return (bf16_t)(pk_bf16(x, 0.f) & 0xffffu); }
DI float bf2f(bf16_t v) { return __uint_as_float(((unsigned)v) << 16); }
DI int crow(int i, int hh) { return (i & 3) + 8 * (i >> 2) + 4 * hh; }
DI const float* xrow(const Params& p, int row) { return row < NTP ? p.in[0] + (size_t)row * 1024 : p.in[1] + (size_t)(row - NTP) * 1024; }
DI int pos_of(int row) { return row < NTP ? (row & 8191) : 4096 + ((row - NTP) & 63); }
DI int kr_of(int row) { return row < NTP ? row : NTP + ((row - NTP) >> 6) * SKS + 4096 + ((row - NTP) & 63); }
#define MFMA32(a, b, c) __builtin_amdgcn_mfma_f32_32x32x16_bf16((a), (b), (c), 0, 0, 0)
#define MFMA16(a, b, c) __builtin_amdgcn_mfma_f32_16x16x32_bf16((a), (b), (c), 0, 0, 0)

DI void sincos_d(double x, double& s4, double& c4) {
  double k = rint(x * 0.15915494309189535);
  double rr = fma(-k, 6.283185307179586, x);
  rr = fma(-k, 2.4492935982947064e-16, rr);
  double y = rr * 0.25, y2 = y * y;
  double s = y * (1 - y2 / 6 * (1 - y2 / 20 * (1 - y2 / 42 * (1 - y2 / 72 * (1 - y2 / 110 * (1 - y2 / 156 * (1 - y2 / 210)))))));
  double c = 1 - y2 / 2 * (1 - y2 / 12 * (1 - y2 / 30 * (1 - y2 / 56 * (1 - y2 / 90 * (1 - y2 / 132 * (1 - y2 / 182))))));
  double s2 = 2 * s * c, c2 = 1 - 2 * s * s;
  s4 = 2 * s2 * c2; c4 = 1 - 2 * s2 * s2;
}

DI void gemm_core(const bf16_t* __restrict__ A, int lda, const bf16_t* __restrict__ B, int ldb, int nk,
                  int m0, int n0, char* lds, f32x16 (&acc)[2][2], int midk, const float* ratio) {
  const int t = tid(), lane = t & 63, wid = t >> 6, wm = wid >> 1, wn = wid & 1;
  const int r = lane & 31, hh = lane >> 5;
  const int lc = t & 7, lr = t >> 3;
  const unsigned woff = lr * 128 + ((lc ^ ((lr >> 1) & 7)) << 4);
  const bf16_t* ga = A + (size_t)(m0 + lr) * lda + lc * 8;
  const bf16_t* gb = B + (size_t)(n0 + lr) * ldb + lc * 8;
  char* sA = lds; char* sB = lds + 32768;
  u32x4 ra[4], rb[4];
#pragma unroll
  for (int i = 0; i < 4; ++i) { ra[i] = *(const u32x4*)(ga + (size_t)(32 * i) * lda); rb[i] = *(const u32x4*)(gb + (size_t)(32 * i) * ldb); }
#pragma unroll
  for (int i = 0; i < 4; ++i) { *(u32x4*)(sA + woff + i * 4096) = ra[i]; *(u32x4*)(sB + woff + i * 4096) = rb[i]; }
#pragma unroll
  for (int a = 0; a < 2; ++a)
#pragma unroll
    for (int b = 0; b < 2; ++b)
#pragma unroll
      for (int i = 0; i < 16; ++i) acc[a][b][i] = 0.f;
  __syncthreads();
  const int rsw = (r >> 1) & 7;
  const unsigned aoff = (wm * 64 + r) * 128, boff = (wn * 64 + r) * 128;
  for (int kt = 0; kt < nk; ++kt) {
    const int cur = kt & 1;
    const bool more = (kt + 1 < nk);
    if (more) {
      const bf16_t* ga2 = ga + (kt + 1) * 64; const bf16_t* gb2 = gb + (kt + 1) * 64;
#pragma unroll
      for (int i = 0; i < 4; ++i) { ra[i] = *(const u32x4*)(ga2 + (size_t)(32 * i) * lda); rb[i] = *(const u32x4*)(gb2 + (size_t)(32 * i) * ldb); }
    }
    if (midk && kt == midk) {
#pragma unroll
      for (int mt = 0; mt < 2; ++mt)
      { const float f = ratio[wm * 64 + mt * 32 + r];
#pragma unroll
        for (int i = 0; i < 16; ++i) { acc[mt][0][i] *= f; acc[mt][1][i] *= f; } }
    }
    const char* cA = sA + cur * 16384; const char* cB = sB + cur * 16384;
#pragma unroll
    for (int ks = 0; ks < 4; ++ks) {
      const unsigned co = (((ks * 2 + hh) ^ rsw) << 4);
      const bf16x8 a0 = *(const bf16x8*)(cA + aoff + co), a1 = *(const bf16x8*)(cA + aoff + 4096 + co);
      const bf16x8 b0 = *(const bf16x8*)(cB + boff + co), b1 = *(const bf16x8*)(cB + boff + 4096 + co);
      acc[0][0] = MFMA32(b0, a0, acc[0][0]); acc[0][1] = MFMA32(b1, a0, acc[0][1]);
      acc[1][0] = MFMA32(b0, a1, acc[1][0]); acc[1][1] = MFMA32(b1, a1, acc[1][1]);
    }
    if (more) {
      char* nA = sA + (cur ^ 1) * 16384; char* nB = sB + (cur ^ 1) * 16384;
#pragma unroll
      for (int i = 0; i < 4; ++i) { *(u32x4*)(nA + woff + i * 4096) = ra[i]; *(u32x4*)(nB + woff + i * 4096) = rb[i]; }
    }
    __syncthreads();
  }
}

DI void rowscale_load(float* rs, const float* src, int np, float inv_dim, int m0) {
  const int t = tid();
  if (t < 128) {
    const int row = m0 + t;
    if (np == 0) rs[t] = src[row];
    else { float s = 0.f; for (int j = 0; j < np; ++j) s += src[(size_t)row * np + j]; rs[t] = rsqrtf(s * inv_dim + EPS); }
  }
}

template <bool BLKA = false, class TileFn, class RsFn, class EpiFn>
DI void gemm_stream(const bf16_t* __restrict__ A, int lda, const bf16_t* __restrict__ B, int ldb, int nk, char* lds, int midk,
                    TileFn tile_fn, RsFn rs_fn, EpiFn epi) {
  int m0, n0;
  if (!tile_fn(0, m0, n0)) return;
  const int t = tid(), lane = t & 63, wid = t >> 6, wm = wid >> 1, wn = wid & 1;
  const int r = lane & 31, hh = lane >> 5;
  const int lc = t & 7, lr = t >> 3;
  const unsigned woff = lr * 128 + ((lc ^ ((lr >> 1) & 7)) << 4);
  char* sA = lds; char* sB = lds + 32768;
  float* rsbuf = (float*)(lds + 65536);
  const int rsw = (r >> 1) & 7;
  const unsigned aoff = (wm * 64 + r) * 128, boff = (wn * 64 + r) * 128;
  int lj = 0, lkt = 0, lm0 = m0, ln0 = n0; bool lvalid = true;
  u32x4 ra0[4], rb0[4], ra1[4], rb1[4];
#define GS_LOAD(RA, RB) do {   \
        \
      const bf16_t* ga_ = BLKA ? A + ((size_t)(lm0 >> 7) * nk + lkt) * 8192 + lr * 64 + lc * 8 : A + (size_t)(lm0 + lr) * lda + lc * 8 + lkt * 64; const bf16_t* gb_ = B + (size_t)(ln0 + lr) * ldb + lc * 8 + lkt * 64; \
      _Pragma("unroll") for (int i = 0; i < 4; ++i) { RA[i] = *(const u32x4*)(ga_ + (size_t)(32 * i) * (BLKA ? 64 : lda)); RB[i] = *(const u32x4*)(gb_ + (size_t)(32 * i) * ldb); } \
      if (++lkt == nk) { lkt = 0; if (lvalid) { ++lj; lvalid = tile_fn(lj, lm0, ln0); } } } while (0)
  GS_LOAD(ra0, rb0);
  GS_LOAD(ra1, rb1);
  {
    float2 rv = make_float2(0.f, 0.f);
    if (t < 128) rv = rs_fn(m0, t);
    __syncthreads();
#pragma unroll
    for (int i = 0; i < 4; ++i) { *(u32x4*)(sA + woff + i * 4096) = ra0[i]; *(u32x4*)(sB + woff + i * 4096) = rb0[i]; }
    if (t < 128) { rsbuf[t] = rv.x; rsbuf[128 + t] = rv.y; }
    __syncthreads();
  }
  int cur = 0;
  for (int j = 0;; ++j) {
    int m1 = 0, n1 = 0;
    const bool has_next = tile_fn(j + 1, m1, n1);
    const float* rs = rsbuf + (j & 1) * 256;
    f32x16 acc[2][2];
#pragma unroll
    for (int a = 0; a < 2; ++a)
#pragma unroll
      for (int b = 0; b < 2; ++b)
#pragma unroll
        for (int i = 0; i < 16; ++i) acc[a][b][i] = 0.f;
#define GS_STEP(RL_A, RL_B, RW_A, RW_B, KT) do { \
      const bool last_ = ((KT) + 1 == nk); const bool wr_ = !last_ || has_next; \
      float2 rv_ = make_float2(0.f, 0.f); \
      if (last_ && has_next) { if (t < 128) rv_ = rs_fn(m1, t); asm volatile("" : "+v"(rv_.x), "+v"(rv_.y)); }   \
      GS_LOAD(RL_A, RL_B); \
      if (midk && (KT) == midk) { _Pragma("unroll") for (int mt = 0; mt < 2; ++mt) { const float f = rs[128 + wm * 64 + mt * 32 + r]; \
          _Pragma("unroll") for (int i = 0; i < 16; ++i) { acc[mt][0][i] *= f; acc[mt][1][i] *= f; } } } \
      const char* cA = sA + cur * 16384; const char* cB = sB + cur * 16384; \
      _Pragma("unroll") for (int ks = 0; ks < 4; ++ks) { \
        const unsigned co = (((ks * 2 + hh) ^ rsw) << 4); \
        const bf16x8 a0 = *(const bf16x8*)(cA + aoff + co), a1 = *(const bf16x8*)(cA + aoff + 4096 + co); \
        const bf16x8 b0 = *(const bf16x8*)(cB + boff + co), b1 = *(const bf16x8*)(cB + boff + 4096 + co); \
        acc[0][0] = MFMA32(b0, a0, acc[0][0]); acc[0][1] = MFMA32(b1, a0, acc[0][1]); \
        acc[1][0] = MFMA32(b0, a1, acc[1][0]); acc[1][1] = MFMA32(b1, a1, acc[1][1]); } \
      if (wr_) { char* nA = sA + (cur ^ 1) * 16384; char* nB = sB + (cur ^ 1) * 16384; \
        _Pragma("unroll") for (int i = 0; i < 4; ++i) { *(u32x4*)(nA + woff + i * 4096) = RW_A[i]; *(u32x4*)(nB + woff + i * 4096) = RW_B[i]; } \
        if (last_ && t < 128) { float* rn = rsbuf + ((j + 1) & 1) * 256; rn[t] = rv_.x; rn[128 + t] = rv_.y; } } \
      __syncthreads(); cur ^= 1; } while (0)
    for (int kt = 0; kt < nk; kt += 2) {
      GS_STEP(ra0, rb0, ra1, rb1, kt);
      GS_STEP(ra1, rb1, ra0, rb0, kt + 1);
    }
    epi(acc, m0, n0, rs);
    if (!has_next) break;
    m0 = m1; n0 = n1;
  }
#undef GS_STEP
#undef GS_LOAD
  __syncthreads();
}

DI float half_reduce(float s) {
  s += __shfl_xor(s, 1); s += __shfl_xor(s, 2); s += __shfl_xor(s, 4); s += __shfl_xor(s, 8); s += __shfl_xor(s, 16); return s;
}

#define EPI_IDS int t = tid(); asm volatile("" : "+v"(t)); const int lane = t & 63, wid = t >> 6, wm = wid >> 1, wn = wid & 1, r = lane & 31, hh = lane >> 5; (void)lane; (void)wid; (void)wm; (void)wn; (void)r; (void)hh;
#define GEMM_IDS const int t = tid(), lane = t & 63, wid = t >> 6, wm = wid >> 1, wn = wid & 1, r = lane & 31, hh = lane >> 5; (void)t; (void)wm; (void)wn; (void)r; (void)hh;

DI void transpose_tile(const float* __restrict__ src, int ld, int K, int kt, int nt, int job, const float* g0, const float* g1, bf16_t* __restrict__ dst, char* lds) {
  bf16_t* tile = (bf16_t*)lds;
  const int t = tid(), nl = t & 63, kq = t >> 6;
  const int n = nt * 64 + nl;
  int c = n;
  if (job == 0) { c = n < 1024 ? n : (n < 1536 ? 1056 + (n - 1024) : (n < 1568 ? 1024 + (n - 1536) : -1)); }
  else if (job == 2) c = (n >> 6) * 128 + (n & 63);
  else if (job == 3) c = (n >> 6) * 128 + 64 + (n & 63);
#pragma unroll 4
  for (int pass = 0; pass < 16; ++pass) {
    const int kl = pass * 4 + kq, k = kt * 64 + kl;
    float v = 0.f;
    if (c >= 0) {
      v = src[(size_t)k * ld + c];
      if (g0) { const float g = (g1 && k >= 512) ? g1[k - 512] : g0[k]; v *= g; }
    }
    tile[nl * 66 + kl] = f2bf(v);
  }
  __syncthreads();
  const int kl = t & 63;
#pragma unroll 4
  for (int pass = 0; pass < 16; ++pass) { const int nl2 = pass * 4 + kq; dst[(size_t)(nt * 64 + nl2) * K + kt * 64 + kl] = tile[nl2 * 66 + kl]; }
  __syncthreads();
}

DI void phase0(const Params& p, char* lds) {
  const int t = tid(), nb = gridDim.x, bid = blockIdx.x, lane = t & 63, wid = t >> 6;
  for (int ti = bid; ti < 2992; ti += nb) {
    int job, base, nNt, ld, K; const float* src; const float* g0 = nullptr; const float* g1 = nullptr; bf16_t* dst;
    if (ti < 416) { job = 0; base = 0; nNt = 26; ld = 1568; K = 1024; src = p.in[7]; g0 = p.in[6]; dst = p.WinT; }
    else if (ti < 560) { job = 1; base = 416; nNt = 12; ld = 768; K = 768; src = p.in[9]; g0 = p.in[8]; dst = p.WqT; }
    else if (ti < 592) { job = 2; base = 560; nNt = 8; ld = 1024; K = 256; src = p.in[11]; dst = p.WkT; }
    else if (ti < 624) { job = 3; base = 592; nNt = 8; ld = 1024; K = 256; src = p.in[11]; dst = p.WvT; }
    else if (ti < 688) { job = 4; base = 624; nNt = 8; ld = 512; K = 512; src = p.in[20]; dst = p.WgT; }
    else if (ti < 944) { job = 5; base = 688; nNt = 16; ld = 1024; K = 1024; src = p.in[23]; g0 = p.in[21]; g1 = p.in[22]; dst = p.WoT; }
    else if (ti < 1968) { job = 6; base = 944; nNt = 64; ld = 4096; K = 1024; src = p.in[25]; g0 = p.in[24]; dst = p.WuT; }
    else { job = 7; base = 1968; nNt = 16; ld = 1024; K = 4096; src = p.in[26]; dst = p.WdT; }
    const int tile = ti - base;
    transpose_tile(src, ld, K, tile / nNt, tile % nNt, job, g0, g1, dst, lds);
  }
  for (int row = bid * 4 + wid; row < NT; row += nb * 4) {
    const float* x = xrow(p, row);
    f32x4 v[4]; float ss = 0.f;
#pragma unroll
    for (int j = 0; j < 4; ++j) { v[j] = *(const f32x4*)(x + lane * 4 + 256 * j); ss += v[j][0] * v[j][0] + v[j][1] * v[j][1] + v[j][2] * v[j][2] + v[j][3] * v[j][3]; }
    ss += __shfl_xor(ss, 32); ss = half_reduce(ss);
#pragma unroll
    for (int j = 0; j < 4; ++j) { u32x2 w; w.x = pk_bf16(v[j][0], v[j][1]); w.y = pk_bf16(v[j][2], v[j][3]); *(u32x2*)(p.xb + (size_t)row * 1024 + lane * 4 + 256 * j) = w; }
    if (lane == 0) p.rstd_x[row] = rsqrtf(ss * (1.f / 1024.f) + EPS);
  }
  const int gt = bid * 256 + t, ngt = nb * 256;
  for (int v = gt; v < 32 * 4096 * 32; v += ngt) {
    const size_t e0 = (size_t)v * 8; const int b = (int)(e0 >> 20), rem = (int)(e0 & 1048575), tt = rem >> 8, c = rem & 255;
    const f32x4 a = *(const f32x4*)(p.in[2] + e0), bq = *(const f32x4*)(p.in[2] + e0 + 4);
    u32x4 w; w.x = pk_bf16(a[0], a[1]); w.y = pk_bf16(a[2], a[3]); w.z = pk_bf16(bq[0], bq[1]); w.w = pk_bf16(bq[2], bq[3]);
    *(u32x4*)(p.latb + (size_t)(NTP + b * SKS + tt) * 256 + c) = w;
  }
  for (int v = gt; v < 32 * 4096 * 4; v += ngt) {
    const size_t e0 = (size_t)v * 8; const int b = (int)(e0 >> 17), rem = (int)(e0 & 131071), tt = rem >> 5, c = rem & 31;
    const f32x4 a = *(const f32x4*)(p.in[3] + e0), bq = *(const f32x4*)(p.in[3] + e0 + 4);
    u32x4 w; w.x = pk_bf16(a[0], a[1]); w.y = pk_bf16(a[2], a[3]); w.z = pk_bf16(bq[0], bq[1]); w.w = pk_bf16(bq[2], bq[3]);
    *(u32x4*)(p.krb + (size_t)(NTP + b * SKS + tt) * 32 + c) = w;
  }
  if (gt < 2048) {
    const int g = gt >> 6, n = gt & 63;
    const double dt = (double)expf(p.in[14][g]);
    const double lr = p.in[12][gt], li = p.in[13][gt];
    const double mag = (double)expf((float)(lr * dt)); double s, c; sincos_d(li * dt, s, c);
    const double lbr = mag * c, lbi = mag * s;
    const double nr = lbr - 1.0, ni = lbi, den = lr * lr + li * li;
    const double cr = (nr * lr + ni * li) / den, ci = (ni * lr - nr * li) / den;
    p.lam[gt] = make_float2((float)lbr, (float)lbi);
    const double mag64 = (double)expf((float)(64.0 * lr * dt)); sincos_d(64.0 * li * dt, s, c);
    p.lam64[gt] = make_float2((float)(mag64 * c), (float)(mag64 * s));
    for (int q = 0; q < 16; ++q) {
      const double br = p.in[15][(size_t)gt * 16 + q], bi = p.in[16][(size_t)gt * 16 + q];
      p.BbT[(size_t)(g * 128 + n) * 16 + q] = f2bf((float)(cr * br - ci * bi));
      p.BbT[(size_t)(g * 128 + 64 + n) * 16 + q] = f2bf((float)(cr * bi + ci * br));
      p.CcT[(size_t)(g * 16 + q) * 128 + n] = f2bf(p.in[17][(size_t)(g * 16 + q) * 64 + n]);
      p.CcT[(size_t)(g * 16 + q) * 128 + 64 + n] = f2bf(-p.in[18][(size_t)(g * 16 + q) * 64 + n]);
    }
  }
  for (int e = gt; e < 8192 * 16; e += ngt) {
    const int pos = e >> 4, i = e & 15;
    const float inv = expf(-(float)i * (9.210340371976184f / 16.0f));
    const float ang = (float)pos * inv;
    double s, c; sincos_d((double)ang, s, c);
    p.rope[e] = make_float2((float)c, (float)s);
  }
}

DI void phase1(const Params& p, char* lds) {
  float* rs = (float*)(lds + 65536);
  const int ntiles = 528 * 13;
  {
    auto tile_fn = [&](int j, int& m0, int& n0) -> bool { const int li = (int)(blockIdx.x >> 3) + j * (int)(gridDim.x >> 3); const int ti_ = li / 13, tj_ = li - ti_ * 13; const int tbig = ti_ * 8 + (int)(blockIdx.x & 7); if (tbig >= 528) return false; m0 = tbig * 128; n0 = tj_ * 128; return true; };
    auto rs_fn = [&](int m0, int t) -> float2 { return make_float2(p.rstd_x[m0 + t], 0.f); };
    auto epi = [&](f32x16 (&acc)[2][2], int m0, int n0, const float* rs) {
    const int tn = n0 >> 7; (void)tn;
    { EPI_IDS
    if (tn < 8) {
#pragma unroll
      for (int mt = 0; mt < 2; ++mt) {
        const int rl = wm * 64 + mt * 32 + r, row = m0 + rl;
        const float sc = rs[rl];
        float ss = 0.f;
#pragma unroll
        for (int nt = 0; nt < 2; ++nt)
#pragma unroll
          for (int i4 = 0; i4 < 4; ++i4) {
            const float v0 = acc[mt][nt][4 * i4] * sc, v1 = acc[mt][nt][4 * i4 + 1] * sc, v2 = acc[mt][nt][4 * i4 + 2] * sc, v3 = acc[mt][nt][4 * i4 + 3] * sc;
            ss += v0 * v0 + v1 * v1 + v2 * v2 + v3 * v3;
            const int col = n0 + wn * 64 + nt * 32 + 8 * i4 + 4 * hh;
            if (tn < 6) { u32x2 w; w.x = pk_bf16(v0, v1); w.y = pk_bf16(v2, v3); *(u32x2*)(p.cq + (size_t)row * 768 + col) = w; }
            else { f32x4 w = {v0, v1, v2, v3}; *(f32x4*)(p.ckv_raw + (size_t)row * 256 + (col - 768)) = w; }
          }
        ss += __shfl_xor(ss, 32);
        if (hh == 0) { if (tn < 6) p.cq_part[(size_t)row * 12 + tn * 2 + wn] = ss; else p.ckv_part[(size_t)row * 4 + (tn - 6) * 2 + wn] = ss; }
      }
    } else if (tn < 12) {
#pragma unroll
      for (int mt = 0; mt < 2; ++mt) {
        const int rl = wm * 64 + mt * 32 + r, row = m0 + rl;
        const float sc = rs[rl];
#pragma unroll
        for (int nt = 0; nt < 2; ++nt)
#pragma unroll
          for (int i4 = 0; i4 < 4; ++i4) {
            u32x2 w; w.x = pk_bf16(acc[mt][nt][4 * i4] * sc, acc[mt][nt][4 * i4 + 1] * sc); w.y = pk_bf16(acc[mt][nt][4 * i4 + 2] * sc, acc[mt][nt][4 * i4 + 3] * sc);
            *(u32x2*)(p.ub + (size_t)row * 512 + (n0 - 1024) + wn * 64 + nt * 32 + 8 * i4 + 4 * hh) = w;
          }
      }
    } else if (wn == 0) {
#pragma unroll
      for (int mt = 0; mt < 2; ++mt) {
        const int rl = wm * 64 + mt * 32 + r, row = m0 + rl;
        const float sc = rs[rl];
        float* dst = row < NTP ? p.out + OFF_KRP + (size_t)row * 32 : p.out + OFF_KRS + (size_t)(row - NTP) * 32;
        bf16_t* dkb = p.krb + (size_t)kr_of(row) * 32;
        const float* rp = (const float*)(p.rope + pos_of(row) * 16);
#pragma unroll
        for (int ih = 0; ih < 2; ++ih) {
          const int j0 = 8 * ih + 4 * hh;
          const f32x4 c01 = *(const f32x4*)(rp + 2 * j0), c23 = *(const f32x4*)(rp + 2 * j0 + 4);
          const float cc[4] = {c01[0], c01[2], c23[0], c23[2]}, sn[4] = {c01[1], c01[3], c23[1], c23[3]};
          f32x4 o1, o2;
#pragma unroll
          for (int jj = 0; jj < 4; ++jj) {
            const float x1 = acc[mt][0][4 * ih + jj] * sc, x2 = acc[mt][0][8 + 4 * ih + jj] * sc;
            o1[jj] = x1 * cc[jj] - x2 * sn[jj]; o2[jj] = x1 * sn[jj] + x2 * cc[jj];
          }
          *(f32x4*)(dst + j0) = o1; *(f32x4*)(dst + 16 + j0) = o2;
          u32x2 w1, w2; w1.x = pk_bf16(o1[0], o1[1]); w1.y = pk_bf16(o1[2], o1[3]); w2.x = pk_bf16(o2[0], o2[1]); w2.y = pk_bf16(o2[2], o2[3]);
          *(u32x2*)(dkb + j0) = w1; *(u32x2*)(dkb + 16 + j0) = w2;
        }
      }
    }
    }

    };
    gemm_stream(p.xb, 1024, p.WinT, 1024, 16, lds, 0, tile_fn, rs_fn, epi);
  }
}

DI void ssm_chunk(const Params& p, int row0, int g, float& hr, float& hi, bool write_y, char* lds_w) {
  const int lane = tid() & 63, r = lane & 31, hh = lane >> 5;
  const float2 lm = p.lam[g * 64 + lane];
  bf16x8 bfr[4];
#pragma unroll
  for (int nt = 0; nt < 4; ++nt) bfr[nt] = *(const bf16x8*)(p.BbT + (size_t)(g * 128 + nt * 32 + r) * 16 + hh * 8);
  const int fr = lane & 15, fq = lane >> 4;
  bf16x8 cfr[4];
#pragma unroll
  for (int ks = 0; ks < 4; ++ks) cfr[ks] = *(const bf16x8*)(p.CcT + (size_t)(g * 16 + fr) * 128 + ks * 32 + fq * 8);
  const float dsk = p.in[19][g * 16 + fr];
#pragma unroll 1
  for (int sub = 0; sub < 2; ++sub) {
    const int rb = row0 + sub * 32;
    const bf16x8 uf = *(const bf16x8*)(p.ub + (size_t)(rb + r) * 512 + g * 16 + hh * 8);
    f32x16 z; for (int i = 0; i < 16; ++i) z[i] = 0.f;
    const f32x16 x0 = MFMA32(uf, bfr[0], z), x1 = MFMA32(uf, bfr[1], z), x2 = MFMA32(uf, bfr[2], z), x3 = MFMA32(uf, bfr[3], z);
    float xr0[16], xr1[16], xi0[16], xi1[16];
#pragma unroll
    for (int i = 0; i < 16; ++i) {
      const auto re = __builtin_amdgcn_permlane32_swap(__float_as_uint(x0[i]), __float_as_uint(x1[i]), false, false);
      const auto im = __builtin_amdgcn_permlane32_swap(__float_as_uint(x2[i]), __float_as_uint(x3[i]), false, false);
      xr0[i] = __uint_as_float(re[0]); xr1[i] = __uint_as_float(re[1]);
      xi0[i] = __uint_as_float(im[0]); xi1[i] = __uint_as_float(im[1]);
    }
    bf16_t* Hs = (bf16_t*)lds_w;
#pragma unroll
    for (int m = 0; m < 4; ++m) {
#pragma unroll
      for (int half = 0; half < 2; ++half) {
#pragma unroll
        for (int jj = 0; jj < 4; ++jj) {
          const int i = 4 * m + jj, tt = 8 * m + 4 * half + jj;
          const float xr = half ? xr1[i] : xr0[i], xi = half ? xi1[i] : xi0[i];
          const float nr = lm.x * hr - lm.y * hi + xr;
          const float ni = lm.x * hi + lm.y * hr + xi;
          hr = nr; hi = ni;
          if (write_y) { Hs[tt * 136 + lane] = f2bf(hr); Hs[tt * 136 + 64 + lane] = f2bf(hi); }
        }
      }
    }
    if (write_y) {
      asm volatile("s_waitcnt lgkmcnt(0)" ::: "memory");
      __builtin_amdgcn_wave_barrier();
#pragma unroll
      for (int mt = 0; mt < 2; ++mt) {
        f32x4 y = {0.f, 0.f, 0.f, 0.f};
#pragma unroll
        for (int ks = 0; ks < 4; ++ks) {
          const bf16x8 hf = *(const bf16x8*)(Hs + (mt * 16 + fr) * 136 + ks * 32 + fq * 8);
          y = MFMA16(hf, cfr[ks], y);
        }
#pragma unroll
        for (int j = 0; j < 4; ++j) {
          const int row = rb + mt * 16 + fq * 4 + j;
          const float u = bf2f(p.ub[(size_t)row * 512 + g * 16 + fr]);
          const float v = y[j] + dsk * u;
          const float zz = 0.7978845608028654f * (v + 0.044715f * v * v * v);
          const float th = 1.f - 2.f / (__expf(2.f * zz) + 1.f);
          p.ssm_y[(size_t)row * 512 + g * 16 + fr] = f2bf(0.5f * v * (1.f + th));
        }
      }
      asm volatile("s_waitcnt lgkmcnt(0)" ::: "memory");
      __builtin_amdgcn_wave_barrier();
    }
  }
}

DI void phase2(const Params& p, char* lds) {
  const int lane = tid() & 63, wid = tid() >> 6;
  const int nb = gridDim.x, bid = blockIdx.x;
  for (int row = bid * 4 + wid; row < NT; row += nb * 4) {
    const f32x4 v = *(const f32x4*)(p.ckv_raw + (size_t)row * 256 + lane * 4);
    const f32x4 pp = *(const f32x4*)(p.ckv_part + (size_t)row * 4);
    const float rstd = rsqrtf((pp[0] + pp[1] + pp[2] + pp[3]) * (1.f / 256.f) + EPS);
    const f32x4 g = *(const f32x4*)(p.in[10] + lane * 4);
    f32x4 o; o[0] = v[0] * rstd * g[0]; o[1] = v[1] * rstd * g[1]; o[2] = v[2] * rstd * g[2]; o[3] = v[3] * rstd * g[3];
    float* dst = row < NTP ? p.out + OFF_LATP + (size_t)row * 256 : p.out + OFF_LATS + (size_t)(row - NTP) * 256;
    *(f32x4*)(dst + lane * 4) = o;
    u32x2 w; w.x = pk_bf16(o[0], o[1]); w.y = pk_bf16(o[2], o[3]);
    *(u32x2*)(p.latb + (size_t)kr_of(row) * 256 + lane * 4) = w;
  }
  for (int it = bid * 4 + wid; it < 8 * 128 * 32; it += nb * 4) {
    const int g = it & 31, c = (it >> 5) & 127, b = it >> 12;
    float hr = 0.f, hi = 0.f;
    ssm_chunk(p, b * 8192 + c * 64, g, hr, hi, false, lds + wid * 8704);
    p.E[(size_t)it * 64 + lane] = make_float2(hr, hi);
  }
  float* rs = (float*)(lds + 65536);
  {
    auto tile_fn = [&](int j, int& m0, int& n0) -> bool { const int li = (int)(blockIdx.x >> 3) + j * (int)(gridDim.x >> 3); const int ti_ = li / 6, tj_ = li - ti_ * 6; const int tbig = ti_ * 8 + (int)(blockIdx.x & 7); if (tbig >= 528) return false; m0 = tbig * 128; n0 = tj_ * 128; return true; };
    auto rs_fn = [&](int m0, int t) -> float2 { float sm = 0.f; for (int q = 0; q < 3; ++q) { const f32x4 v = *(const f32x4*)(p.cq_part + (size_t)(m0 + t) * 12 + 4 * q); sm += (v[0] + v[1]) + (v[2] + v[3]); } return make_float2(rsqrtf(sm * (1.f / 768.f) + EPS), 0.f); };
    auto epi = [&](f32x16 (&acc)[2][2], int m0, int n0, const float* rs) {
    const int tn = n0 >> 7; (void)tn;
    EPI_IDS
    const float qs = 0.10206207261596577f * 1.4426950408889634f;
#pragma unroll
    for (int mt = 0; mt < 2; ++mt) {
      const int rl = wm * 64 + mt * 32 + r, row = m0 + rl;
      const float sc = rs[rl] * qs;
      const float* rp = (const float*)(p.rope + pos_of(row) * 16);
#pragma unroll
      for (int nt = 0; nt < 2; ++nt) {
        const int cb = n0 + wn * 64 + nt * 32;
        bf16_t* qd = p.Q + (size_t)row * 768 + cb;
        if ((cb % 96) == 64) {
#pragma unroll
          for (int ih = 0; ih < 2; ++ih) {
            const int j0 = 8 * ih + 4 * hh;
            const f32x4 c01 = *(const f32x4*)(rp + 2 * j0), c23 = *(const f32x4*)(rp + 2 * j0 + 4);
            const float cc[4] = {c01[0], c01[2], c23[0], c23[2]}, sn[4] = {c01[1], c01[3], c23[1], c23[3]};
            float o1[4], o2[4];
#pragma unroll
            for (int jj = 0; jj < 4; ++jj) {
              const float x1 = acc[mt][nt][4 * ih + jj] * sc, x2 = acc[mt][nt][8 + 4 * ih + jj] * sc;
              o1[jj] = x1 * cc[jj] - x2 * sn[jj]; o2[jj] = x1 * sn[jj] + x2 * cc[jj];
            }
            u32x2 w1, w2; w1.x = pk_bf16(o1[0], o1[1]); w1.y = pk_bf16(o1[2], o1[3]); w2.x = pk_bf16(o2[0], o2[1]); w2.y = pk_bf16(o2[2], o2[3]);
            *(u32x2*)(qd + j0) = w1; *(u32x2*)(qd + 16 + j0) = w2;
          }
        } else {
#pragma unroll
          for (int i4 = 0; i4 < 4; ++i4) {
            u32x2 w; w.x = pk_bf16(acc[mt][nt][4 * i4] * sc, acc[mt][nt][4 * i4 + 1] * sc); w.y = pk_bf16(acc[mt][nt][4 * i4 + 2] * sc, acc[mt][nt][4 * i4 + 3] * sc);
            *(u32x2*)(qd + 8 * i4 + 4 * hh) = w;
          }
        }
      }
    }

    };
    gemm_stream(p.cq, 768, p.WqT, 768, 12, lds, 0, tile_fn, rs_fn, epi);
  }
}

DI void phase3(const Params& p, char* lds) {
  const int lane = tid() & 63, wid = tid() >> 6;
  const int nb = gridDim.x, bid = blockIdx.x;
  for (int it = bid * 4 + wid; it < 256; it += nb * 4) {
    const int b = it >> 5, g = it & 31;
    const float2 l64 = p.lam64[g * 64 + lane];
    float sr = 0.f, si = 0.f;
    const size_t base = ((size_t)(b * 128) * 32 + g) * 64 + lane;
    for (int c0 = 0; c0 < 128; c0 += 16) {
      float2 e[16];
#pragma unroll
      for (int j = 0; j < 16; ++j) e[j] = p.E[base + (size_t)(c0 + j) * 2048];
#pragma unroll
      for (int j = 0; j < 16; ++j) {
        p.S[base + (size_t)(c0 + j) * 2048] = make_float2(sr, si);
        const float nr = l64.x * sr - l64.y * si + e[j].x, ni = l64.x * si + l64.y * sr + e[j].y;
        sr = nr; si = ni;
      }
    }
  }
  {
    auto tile_fn = [&](int j, int& m0, int& n0) -> bool { const int li = (int)(blockIdx.x >> 3) + j * (int)(gridDim.x >> 3); const int ti_ = li / 4, tj_ = li - ti_ * 4; const int tbig = ti_ * 8 + (int)(blockIdx.x & 7); if (tbig >= 1552) return false; m0 = tbig * 128; n0 = tj_ * 128; return true; };
    auto rs_fn = [&](int m0, int t) -> float2 { return make_float2(0.f, 0.f); };
    auto epi = [&](f32x16 (&acc)[2][2], int m0, int n0, const float* rs) {
    const int tn = n0 >> 7; (void)tn;
    EPI_IDS
#pragma unroll
    for (int mt = 0; mt < 2; ++mt) {
      const int row = m0 + wm * 64 + mt * 32 + r;
#pragma unroll
      for (int nt = 0; nt < 2; ++nt)
#pragma unroll
        for (int i4 = 0; i4 < 4; ++i4) {
          u32x2 w; w.x = pk_bf16(acc[mt][nt][4 * i4], acc[mt][nt][4 * i4 + 1]); w.y = pk_bf16(acc[mt][nt][4 * i4 + 2], acc[mt][nt][4 * i4 + 3]);
          *(u32x2*)(p.Kn + (size_t)row * 512 + n0 + wn * 64 + nt * 32 + 8 * i4 + 4 * hh) = w;
        }
    }

    };
    gemm_stream(p.latb, 256, p.WkT, 256, 4, lds, 0, tile_fn, rs_fn, epi);
  }
  {
    auto tile_fn = [&](int j, int& m0, int& n0) -> bool { const int li = (int)(blockIdx.x >> 3) + j * (int)(gridDim.x >> 3); const int ti_ = li / 4, tj_ = li - ti_ * 4; const int tbig = ti_ * 8 + (int)(blockIdx.x & 7); if (tbig >= 1552) return false; n0 = tbig * 128; m0 = tj_ * 128; return true; };
    auto rs_fn = [&](int m0, int t) -> float2 { return make_float2(0.f, 0.f); };
    auto epi = [&](f32x16 (&acc)[2][2], int m0, int n0, const float* rs) {
    const int tn = n0 >> 7; (void)tn;
    EPI_IDS
#pragma unroll
    for (int nt = 0; nt < 2; ++nt)
#pragma unroll
      for (int i4 = 0; i4 < 4; ++i4) {
        const int kr = n0 + wn * 64 + nt * 32 + 8 * i4 + 4 * hh;
        size_t cbase; int S;
        if (kr < NTP) { cbase = (size_t)(kr >> 13) * 512 * 8192 + (kr & 8191); S = 8192; }
        else { const int k2 = kr - NTP, b = k2 / SKS, tt = k2 - b * SKS; cbase = VT_S_OFF + (size_t)b * 512 * SKS + tt; S = SKS; }
#pragma unroll
        for (int mt = 0; mt < 2; ++mt) {
          const int hd = m0 + wm * 64 + mt * 32 + r;
          u32x2 w; w.x = pk_bf16(acc[mt][nt][4 * i4], acc[mt][nt][4 * i4 + 1]); w.y = pk_bf16(acc[mt][nt][4 * i4 + 2], acc[mt][nt][4 * i4 + 3]);
          *(u32x2*)(p.Vt + cbase + (size_t)hd * S) = w;
        }
      }

    };
    gemm_stream(p.WvT, 256, p.latb, 256, 4, lds, 0, tile_fn, rs_fn, epi);
  }
}

template <int QT, bool HALF>
DI void attn_item(const Params& p, int kind, int b, int h, int qq, char* lds) {
  const int t = tid(), lane = t & 63, wid = t >> 6, r = lane & 31, hh = lane >> 5;
  int qrow0, nkb_w, nkb_max, S; size_t kr0; const bf16_t* vt_base;
  constexpr int RW = 32 * QT, WPC = 64 / RW, CPB = 4 / WPC;
  if (kind == 0) {
    const int c = qq * CPB + wid / WPC; qrow0 = b * 8192 + c * 64 + (wid % WPC) * RW; nkb_w = c + 1; nkb_max = qq * CPB + CPB; kr0 = (size_t)b * 8192; S = 8192;
    vt_base = p.Vt + (size_t)(b * 8 + h) * 64 * 8192;
  } else {
    qrow0 = NTP + b * 64 + (wid % WPC) * RW; nkb_w = (wid < WPC) ? 65 : 0; nkb_max = 65; kr0 = (size_t)NTP + (size_t)b * SKS; S = SKS;
    vt_base = p.Vt + VT_S_OFF + (size_t)(b * 8 + h) * 64 * SKS;
  }
  bf16x8 qf[QT][6];
#pragma unroll
  for (int qt = 0; qt < QT; ++qt)
#pragma unroll
    for (int ks = 0; ks < 6; ++ks) qf[qt][ks] = *(const bf16x8*)(p.Q + (size_t)(qrow0 + qt * 32 + r) * 768 + h * 96 + ks * 16 + hh * 8);
  f32x16 o[2][QT];
  float mrun[QT], lrun[QT];
#pragma unroll
  for (int qt = 0; qt < QT; ++qt) { mrun[qt] = -1e30f; lrun[qt] = 0.f;
#pragma unroll
    for (int dt = 0; dt < 2; ++dt)
#pragma unroll
      for (int i = 0; i < 16; ++i) o[dt][qt][i] = 0.f; }
  const int kkey = t >> 3, kc = t & 7;
  const int rkey = t >> 2, rc = t & 3;
  const int vd = t >> 3, vc = t & 7;
  const bf16_t* gk = p.Kn + (kr0 + kkey) * 512 + h * 64 + kc * 8;
  const bf16_t* gr = p.krb + (kr0 + rkey) * 32 + rc * 8;
  const bf16_t* gv = vt_base + (size_t)vd * S + vc * 8;
  const unsigned kw0 = kkey * 208 + kc * 16, kw1 = kw0 + 32 * 208, rw = rkey * 208 + 128 + rc * 16;
  const unsigned vlo = vd * 144 + (vc >> 1) * 32 + (vc & 1) * 8, vhi = vlo + 16;
  constexpr int KB = 13312, VB = 9216, BUF = KB + VB;
  u32x4 k0r, k1r, rr, v0r, v1r;
  k0r = *(const u32x4*)gk; k1r = *(const u32x4*)(gk + 32 * 512); rr = *(const u32x4*)gr;
  v0r = *(const u32x4*)gv; v1r = *(const u32x4*)(gv + (size_t)32 * S);
  __syncthreads();
  {
    char* kb_ = lds; char* vb_ = lds + KB;
    *(u32x4*)(kb_ + kw0) = k0r; *(u32x4*)(kb_ + kw1) = k1r; *(u32x4*)(kb_ + rw) = rr;
    *(u32x2*)(vb_ + vlo) = (u32x2){v0r.x, v0r.y}; *(u32x2*)(vb_ + vhi) = (u32x2){v0r.z, v0r.w};
    *(u32x2*)(vb_ + vlo + 32 * 144) = (u32x2){v1r.x, v1r.y}; *(u32x2*)(vb_ + vhi + 32 * 144) = (u32x2){v1r.z, v1r.w};
  }
  __syncthreads();
  for (int kb = 0; kb < nkb_max; ++kb) {
    const int cur = kb & 1;
    const bool more = kb + 1 < nkb_max;
    if (more) {
      const size_t ko = (size_t)(kb + 1) * 64;
      k0r = *(const u32x4*)(gk + ko * 512); k1r = *(const u32x4*)(gk + (ko + 32) * 512); rr = *(const u32x4*)(gr + ko * 32);
      v0r = *(const u32x4*)(gv + ko); v1r = *(const u32x4*)(gv + (size_t)32 * S + ko);
    }
    if (HALF && kb < nkb_w) {
      const char* kt_ = lds + cur * BUF; const char* vt_ = kt_ + KB;
#pragma unroll
      for (int kt = 0; kt < 2; ++kt) {
        f32x16 sh[QT];
#pragma unroll
        for (int qt = 0; qt < QT; ++qt)
#pragma unroll
          for (int i = 0; i < 16; ++i) sh[qt][i] = 0.f;
#pragma unroll
        for (int ks = 0; ks < 6; ++ks) {
          const bf16x8 kf = *(const bf16x8*)(kt_ + (kt * 32 + r) * 208 + ks * 32 + hh * 16);
#pragma unroll
          for (int qt = 0; qt < QT; ++qt) sh[qt] = MFMA32(kf, qf[qt][ks], sh[qt]);
        }
        bf16x8 ph[QT][2];
#pragma unroll
        for (int qt = 0; qt < QT; ++qt) {
          float mx = sh[qt][0];
#pragma unroll
          for (int i = 1; i < 16; ++i) mx = fmaxf(mx, sh[qt][i]);
          mx = fmaxf(mx, __shfl_xor(mx, 32));
          const bool need = mx > mrun[qt] + 8.f;
          if (__any(need)) {
            const float mnew = need ? mx : mrun[qt];
            const float alpha = __builtin_amdgcn_exp2f(mrun[qt] - mnew);
            mrun[qt] = mnew; lrun[qt] *= alpha;
#pragma unroll
            for (int dt = 0; dt < 2; ++dt)
#pragma unroll
              for (int i = 0; i < 16; ++i) o[dt][qt][i] *= alpha;
          }
          float ls = 0.f;
#pragma unroll
          for (int i = 0; i < 16; ++i) { const float pv = __builtin_amdgcn_exp2f(sh[qt][i] - mrun[qt]); ls += pv; sh[qt][i] = pv; }
          lrun[qt] += ls;
#pragma unroll
          for (int s2 = 0; s2 < 2; ++s2) {
            u32x4 w;
            w.x = pk_bf16(sh[qt][8 * s2 + 0], sh[qt][8 * s2 + 1]); w.y = pk_bf16(sh[qt][8 * s2 + 2], sh[qt][8 * s2 + 3]);
            w.z = pk_bf16(sh[qt][8 * s2 + 4], sh[qt][8 * s2 + 5]); w.w = pk_bf16(sh[qt][8 * s2 + 6], sh[qt][8 * s2 + 7]);
            ph[qt][s2] = __builtin_bit_cast(bf16x8, w);
          }
        }
#pragma unroll
        for (int dt = 0; dt < 2; ++dt)
#pragma unroll
          for (int s2 = 0; s2 < 2; ++s2) {
            const bf16x8 vf = *(const bf16x8*)(vt_ + (dt * 32 + r) * 144 + (kt * 2 + s2) * 32 + hh * 16);
#pragma unroll
            for (int qt = 0; qt < QT; ++qt) o[dt][qt] = MFMA32(vf, ph[qt][s2], o[dt][qt]);
          }
      }
    }
    if (!HALF && kb < nkb_w) {
      const char* kt_ = lds + cur * BUF; const char* vt_ = kt_ + KB;
      f32x16 st[2][QT];
#pragma unroll
      for (int kt = 0; kt < 2; ++kt)
#pragma unroll
        for (int qt = 0; qt < QT; ++qt)
#pragma unroll
          for (int i = 0; i < 16; ++i) st[kt][qt][i] = 0.f;
#pragma unroll
      for (int ks = 0; ks < 6; ++ks)
#pragma unroll
        for (int kt = 0; kt < 2; ++kt) {
          const bf16x8 kf = *(const bf16x8*)(kt_ + (kt * 32 + r) * 208 + ks * 32 + hh * 16);
#pragma unroll
          for (int qt = 0; qt < QT; ++qt) st[kt][qt] = MFMA32(kf, qf[qt][ks], st[kt][qt]);
        }
      bf16x8 pb[2][QT][2];
#pragma unroll
      for (int qt = 0; qt < QT; ++qt) {
        float mx = mrun[qt];
#pragma unroll
        for (int kt = 0; kt < 2; ++kt)
#pragma unroll
          for (int i = 0; i < 16; ++i) mx = fmaxf(mx, st[kt][qt][i]);
        mx = fmaxf(mx, __shfl_xor(mx, 32));
        const float alpha = __builtin_amdgcn_exp2f(mrun[qt] - mx);
        mrun[qt] = mx;
        float ls = 0.f;
#pragma unroll
        for (int kt = 0; kt < 2; ++kt) {
#pragma unroll
          for (int i = 0; i < 16; ++i) { const float pv = __builtin_amdgcn_exp2f(st[kt][qt][i] - mx); ls += pv; st[kt][qt][i] = pv; }
#pragma unroll
          for (int s2 = 0; s2 < 2; ++s2) {
            u32x4 w;
            w.x = pk_bf16(st[kt][qt][8 * s2 + 0], st[kt][qt][8 * s2 + 1]); w.y = pk_bf16(st[kt][qt][8 * s2 + 2], st[kt][qt][8 * s2 + 3]);
            w.z = pk_bf16(st[kt][qt][8 * s2 + 4], st[kt][qt][8 * s2 + 5]); w.w = pk_bf16(st[kt][qt][8 * s2 + 6], st[kt][qt][8 * s2 + 7]);
            pb[kt][qt][s2] = __builtin_bit_cast(bf16x8, w);
          }
        }
        lrun[qt] = lrun[qt] * alpha + ls;
#pragma unroll
        for (int dt = 0; dt < 2; ++dt)
#pragma unroll
          for (int i = 0; i < 16; ++i) o[dt][qt][i] *= alpha;
      }
#pragma unroll
      for (int dt = 0; dt < 2; ++dt)
#pragma unroll
        for (int kt = 0; kt < 2; ++kt)
#pragma unroll
          for (int s2 = 0; s2 < 2; ++s2) {
            const bf16x8 vf = *(const bf16x8*)(vt_ + (dt * 32 + r) * 144 + (kt * 2 + s2) * 32 + hh * 16);
#pragma unroll
            for (int qt = 0; qt < QT; ++qt) o[dt][qt] = MFMA32(vf, pb[kt][qt][s2], o[dt][qt]);
          }
    }
    if (more) {
      char* kb_ = lds + (cur ^ 1) * BUF; char* vb_ = kb_ + KB;
      *(u32x4*)(kb_ + kw0) = k0r; *(u32x4*)(kb_ + kw1) = k1r; *(u32x4*)(kb_ + rw) = rr;
      *(u32x2*)(vb_ + vlo) = (u32x2){v0r.x, v0r.y}; *(u32x2*)(vb_ + vhi) = (u32x2){v0r.z, v0r.w};
      *(u32x2*)(vb_ + vlo + 32 * 144) = (u32x2){v1r.x, v1r.y}; *(u32x2*)(vb_ + vhi + 32 * 144) = (u32x2){v1r.z, v1r.w};
    }
    __syncthreads();
  }
  if (nkb_w > 0) {
#pragma unroll
    for (int qt = 0; qt < QT; ++qt) {
      const float lt = lrun[qt] + __shfl_xor(lrun[qt], 32);
      const float inv = 1.f / lt;
      const int row = qrow0 + qt * 32 + r;
      float ss = 0.f;
#pragma unroll
      for (int dt = 0; dt < 2; ++dt)
#pragma unroll
        for (int i4 = 0; i4 < 4; ++i4) {
          const float a0 = o[dt][qt][4 * i4] * inv, a1 = o[dt][qt][4 * i4 + 1] * inv, a2 = o[dt][qt][4 * i4 + 2] * inv, a3 = o[dt][qt][4 * i4 + 3] * inv;
          ss += a0 * a0 + a1 * a1 + a2 * a2 + a3 * a3;
          u32x2 w; w.x = pk_bf16(a0, a1); w.y = pk_bf16(a2, a3);
          *(u32x2*)(p.mix + (size_t)row * 1024 + h * 64 + dt * 32 + 8 * i4 + 4 * hh) = w;
        }
      ss += __shfl_xor(ss, 32);
      if (hh == 0) p.attn_part[(size_t)row * 8 + h] = ss;
    }
  }
}

DI void phase4(const Params& p, char* lds, int qidx) {
  const int t = tid(), lane = t & 63, wid = t >> 6;
  const int nb = gridDim.x, bid = blockIdx.x;
  int* nxt = (int*)(lds + 65536);
  for (;;) {
    __syncthreads();
    if (t == 0) *nxt = atomicAdd(p.counters + qidx, 1);
    __syncthreads();
    const int it = *nxt;
    if (it >= 256 + 64 * 32) break;
    if (it < 256) attn_item<1, false>(p, 1, it >> 3, it & 7, 0, lds);
    else { const int j = it - 256; const int qq = 31 - (j >> 6), bh = j & 63; attn_item<2, true>(p, 0, bh >> 3, bh & 7, qq, lds); }
  }
  __syncthreads();
  for (int it = bid * 4 + wid; it < 8 * 128 * 32 + 1024; it += nb * 4) {
    if (it < 8 * 128 * 32) {
      const int g = it & 31, c = (it >> 5) & 127, b = it >> 12;
      const float2 s0 = p.S[(size_t)it * 64 + lane];
      float hr = s0.x, hi = s0.y;
      ssm_chunk(p, b * 8192 + c * 64, g, hr, hi, true, lds + wid * 8704);
      if (c == 127) { p.out[OFF_HRP + (size_t)(b * 32 + g) * 64 + lane] = hr; p.out[OFF_HIP + (size_t)(b * 32 + g) * 64 + lane] = hi; }
    } else {
      const int j = it - 8 * 128 * 32, g = j & 31, b = j >> 5;
      float hr = p.in[4][(size_t)(b * 32 + g) * 64 + lane], hi = p.in[5][(size_t)(b * 32 + g) * 64 + lane];
      ssm_chunk(p, NTP + b * 64, g, hr, hi, true, lds + wid * 8704);
      p.out[OFF_HRS + (size_t)(b * 32 + g) * 64 + lane] = hr; p.out[OFF_HIS + (size_t)(b * 32 + g) * 64 + lane] = hi;
    }
  }
}

DI void phase5(const Params& p, char* lds) {
  {
    auto tile_fn = [&](int j, int& m0, int& n0) -> bool { const int li = (int)(blockIdx.x >> 3) + j * (int)(gridDim.x >> 3); const int ti_ = li / 4, tj_ = li - ti_ * 4; const int tbig = ti_ * 8 + (int)(blockIdx.x & 7); if (tbig >= 528) return false; m0 = tbig * 128; n0 = tj_ * 128; return true; };
    auto rs_fn = [&](int m0, int t) -> float2 { return make_float2(0.f, 0.f); };
    auto epi = [&](f32x16 (&acc)[2][2], int m0, int n0, const float* rs) {
    const int tn = n0 >> 7; (void)tn;
    { EPI_IDS
#pragma unroll
    for (int mt = 0; mt < 2; ++mt) {
      const int row = m0 + wm * 64 + mt * 32 + r;
      float ss = 0.f;
#pragma unroll
      for (int nt = 0; nt < 2; ++nt)
#pragma unroll
        for (int i4 = 0; i4 < 4; ++i4) {
          const int col = n0 + wn * 64 + nt * 32 + 8 * i4 + 4 * hh;
          const u32x2 yv = *(const u32x2*)(p.ssm_y + (size_t)row * 512 + col);
          const float y0 = __uint_as_float(yv.x << 16), y1 = __uint_as_float(yv.x & 0xffff0000u), y2 = __uint_as_float(yv.y << 16), y3 = __uint_as_float(yv.y & 0xffff0000u);
          const float o0 = y0 / (1.f + __expf(-acc[mt][nt][4 * i4])), o1 = y1 / (1.f + __expf(-acc[mt][nt][4 * i4 + 1]));
          const float o2 = y2 / (1.f + __expf(-acc[mt][nt][4 * i4 + 2])), o3 = y3 / (1.f + __expf(-acc[mt][nt][4 * i4 + 3]));
          ss += o0 * o0 + o1 * o1 + o2 * o2 + o3 * o3;
          u32x2 w; w.x = pk_bf16(o0, o1); w.y = pk_bf16(o2, o3);
          *(u32x2*)(p.mix + (size_t)row * 1024 + 512 + col) = w;
        }
      ss += __shfl_xor(ss, 32);
      if (hh == 0) p.ssm_part[(size_t)row * 8 + tn * 2 + wn] = ss;
    }
    }

    };
    gemm_stream(p.ssm_y, 512, p.WgT, 512, 8, lds, 0, tile_fn, rs_fn, epi);
  }
}

DI void phase6(const Params& p, char* lds) {
  float* rsS = (float*)(lds + 65536); float* ratio = rsS + 128;
  const int xb_ = blockIdx.x & 7, xl_ = blockIdx.x >> 3, nbx_ = gridDim.x >> 3;
  for (int j = 0;; ++j) {
    const int li6 = xl_ + j * nbx_, tm = (li6 >> 3) * 8 + xb_, tn = li6 & 7, m0 = tm * 128, n0 = tn * 128;
    if (tm >= 528) break;
    __syncthreads();
    if (tid() < 128) {
      const int t = tid(); const int row = m0 + t; float sa = 0.f, sb = 0.f;
      for (int j = 0; j < 8; ++j) { sa += p.attn_part[(size_t)row * 8 + j]; sb += p.ssm_part[(size_t)row * 8 + j]; }
      const float ra = rsqrtf(sa * (1.f / 512.f) + EPS), rb = rsqrtf(sb * (1.f / 512.f) + EPS);
      rsS[t] = rb; ratio[t] = ra / rb;
    }
    f32x16 acc[2][2];
    gemm_core(p.mix, 1024, p.WoT, 1024, 16, m0, n0, lds, acc, 8, ratio);
    { EPI_IDS
#pragma unroll
    for (int mt = 0; mt < 2; ++mt) {
      const int rl = wm * 64 + mt * 32 + r, row = m0 + rl;
      const float sc = rsS[rl];
      const float* xr = xrow(p, row);
      float ss = 0.f;
#pragma unroll
      for (int nt = 0; nt < 2; ++nt)
#pragma unroll
        for (int i4 = 0; i4 < 4; ++i4) {
          const int col = n0 + wn * 64 + nt * 32 + 8 * i4 + 4 * hh;
          const f32x4 xv = *(const f32x4*)(xr + col);
          f32x4 hv;
#pragma unroll
          for (int jj = 0; jj < 4; ++jj) { hv[jj] = xv[jj] + acc[mt][nt][4 * i4 + jj] * sc; ss += hv[jj] * hv[jj]; }
          u32x2 w; w.x = pk_bf16(hv[0], hv[1]); w.y = pk_bf16(hv[2], hv[3]);
          *(u32x2*)(p.hb + (size_t)row * 1024 + col) = w;
        }
      ss += __shfl_xor(ss, 32);
      if (hh == 0) p.h_part[(size_t)row * 16 + tn * 2 + wn] = ss;
    }
    }
  }
}

DI void phase7(const Params& p, char* lds) {
  float* rs = (float*)(lds + 65536);
  const int xb_ = blockIdx.x & 7, xl_ = blockIdx.x >> 3, nbx_ = gridDim.x >> 3;
  {
    auto tile_fn = [&](int j, int& m0, int& n0) -> bool { const int tm = j * (nbx_ >> 2) + (xl_ >> 2); if (tm >= 528) return false; m0 = tm * 128; n0 = (xb_ * 4 + (xl_ & 3)) * 128; return true; };
    auto rs_fn = [&](int m0, int t) -> float2 { float sm = 0.f; for (int q = 0; q < 4; ++q) { const f32x4 v = *(const f32x4*)(p.h_part + (size_t)(m0 + t) * 16 + 4 * q); sm += (v[0] + v[1]) + (v[2] + v[3]); } return make_float2(rsqrtf(sm * (1.f / 1024.f) + EPS), 0.f); };
    auto epi = [&](f32x16 (&acc)[2][2], int m0, int n0, const float* rs) {
    const int tn = n0 >> 7; (void)tn;
    { EPI_IDS
#pragma unroll
    for (int mt = 0; mt < 2; ++mt) {
      const int rl = wm * 64 + mt * 32 + r, row = m0 + rl;
      const float sc = rs[rl];
#pragma unroll
      for (int nt = 0; nt < 2; ++nt)
#pragma unroll
        for (int i4 = 0; i4 < 4; ++i4) {
          float v[4];
#pragma unroll
          for (int jj = 0; jj < 4; ++jj) { const float a = fmaxf(acc[mt][nt][4 * i4 + jj] * sc, 0.f); v[jj] = a * a; }
          u32x2 w; w.x = pk_bf16(v[0], v[1]); w.y = pk_bf16(v[2], v[3]);
          { const int col = n0 + wn * 64 + nt * 32 + 8 * i4 + 4 * hh;
            *(u32x2*)(p.act + (((size_t)(row >> 7) * 64 + (col >> 6)) * 128 + (row & 127)) * 64 + (col & 63)) = w; }
        }
    }
    }

    };
    gemm_stream(p.hb, 1024, p.WuT, 1024, 16, lds, 0, tile_fn, rs_fn, epi);
  }
}

DI void phase8(const Params& p, char* lds) {
  const int xb_ = blockIdx.x & 7, xl_ = blockIdx.x >> 3, nbx_ = gridDim.x >> 3;
  {
    auto tile_fn = [&](int j, int& m0, int& n0) -> bool { const int li = (int)(blockIdx.x >> 3) + j * (int)(gridDim.x >> 3); const int ti_ = li / 8, tj_ = li - ti_ * 8; const int tbig = ti_ * 8 + (int)(blockIdx.x & 7); if (tbig >= 528) return false; m0 = tbig * 128; n0 = tj_ * 128; return true; };
    auto rs_fn = [&](int m0, int t) -> float2 { return make_float2(0.f, 0.f); };
    auto epi = [&](f32x16 (&acc)[2][2], int m0, int n0, const float* rs) {
    const int tn = n0 >> 7; (void)tn;
    { EPI_IDS
#pragma unroll
    for (int mt = 0; mt < 2; ++mt) {
      const int row = m0 + wm * 64 + mt * 32 + r;
      float ss = 0.f;
#pragma unroll
      for (int nt = 0; nt < 2; ++nt)
#pragma unroll
        for (int i4 = 0; i4 < 4; ++i4) {
          float* yp = p.out + OFF_Y + (size_t)row * 1024 + n0 + wn * 64 + nt * 32 + 8 * i4 + 4 * hh;
          const u32x2 hq = *(const u32x2*)(p.hb + (size_t)row * 1024 + n0 + wn * 64 + nt * 32 + 8 * i4 + 4 * hh);
          f32x4 ov = {__uint_as_float(hq.x << 16), __uint_as_float(hq.x & 0xffff0000u), __uint_as_float(hq.y << 16), __uint_as_float(hq.y & 0xffff0000u)};
#pragma unroll
          for (int jj = 0; jj < 4; ++jj) { ov[jj] += acc[mt][nt][4 * i4 + jj]; ss += ov[jj] * ov[jj]; }
          *(f32x4*)yp = ov;
          if (i4 == 1 || i4 == 3) __builtin_amdgcn_sched_barrier(0);
        }
      ss += __shfl_xor(ss, 32);
      if (hh == 0) p.out_part[(size_t)row * 16 + tn * 2 + wn] = ss;
    }
    }

    };
    gemm_stream<true>(p.act, 4096, p.WdT, 4096, 64, lds, 0, tile_fn, rs_fn, epi);
  }
}

DI void phase9(const Params& p) {
  const int t = tid(), lane = t & 63, wid = t >> 6;
  for (int row = blockIdx.x * 4 + wid; row < NT; row += gridDim.x * 4) {
    float s = 0.f;
    for (int j = 0; j < 16; ++j) s += p.out_part[(size_t)row * 16 + j];
    const float rstd = rsqrtf(s * (1.f / 1024.f) + EPS);
    float* y = p.out + OFF_Y + (size_t)row * 1024;
#pragma unroll
    for (int j = 0; j < 4; ++j) {
      f32x4 v = *(const f32x4*)(y + lane * 4 + 256 * j);
      const f32x4 g = *(const f32x4*)(p.in[27] + lane * 4 + 256 * j);
      v[0] *= rstd * g[0]; v[1] *= rstd * g[1]; v[2] *= rstd * g[2]; v[3] *= rstd * g[3];
      *(f32x4*)(y + lane * 4 + 256 * j) = v;
    }
  }
}

DI void grid_barrier(unsigned* cnt, unsigned target) {
  asm volatile("s_waitcnt vmcnt(0)" ::: "memory");
  __syncthreads();
  if (tid() == 0) {
    __builtin_amdgcn_fence(__ATOMIC_RELEASE, "agent");
    asm volatile("s_waitcnt vmcnt(0)" ::: "memory");
    __hip_atomic_fetch_add(cnt, 1u, __ATOMIC_RELAXED, __HIP_MEMORY_SCOPE_AGENT);
    while (__hip_atomic_load(cnt, __ATOMIC_RELAXED, __HIP_MEMORY_SCOPE_AGENT) < target) __builtin_amdgcn_s_sleep(2);
  }
  __syncthreads();
  __builtin_amdgcn_fence(__ATOMIC_ACQUIRE, "agent");
  asm volatile("s_waitcnt vmcnt(0)" ::: "memory");
}

#define XB_TMO      128
#define XB_XCNT(j)  (256  + 64 * (j))
#define XB_XSUB(j)  (1280 + 64 * (j))
#define XB_XGEN(j)  (2304 + 64 * (j))
#define XB_TOP      3328
#define XB_TOPGEN   3392
#define XCD_BAR_WORDS 3456
#define XB_SPIN_CAP (1u << 22)
#define LAS __attribute__((address_space(3)))
DI unsigned xb_ld(unsigned* p)              { return __hip_atomic_load(p, __ATOMIC_RELAXED, __HIP_MEMORY_SCOPE_AGENT); }
DI unsigned xb_add(unsigned* p, unsigned v) { return __hip_atomic_fetch_add(p, v, __ATOMIC_RELAXED, __HIP_MEMORY_SCOPE_AGENT); }
DI unsigned xb_xcc_id() { return (unsigned)__builtin_amdgcn_s_getreg((3 << 11) | 20) & 0xFu; }
#define XB_SPIN(cond, bar) do { unsigned _sp = 0; while (cond) { __builtin_amdgcn_s_sleep(1); \
    if ((++_sp & 255u) == 0u) { if (xb_ld(&(bar)[XB_TMO])) break; if (_sp > XB_SPIN_CAP) { atomicAdd(&(bar)[XB_TMO], 1u); break; } } } } while (0)
struct XcdBarrier { unsigned* bar; unsigned x; volatile LAS unsigned* st; };
DI XcdBarrier xcd_barrier_post(unsigned* bar, volatile LAS unsigned* st) {
  XcdBarrier b; b.bar = bar; b.x = xb_xcc_id(); b.st = st;
  if (tid() == 0) (void)xb_add(&bar[XB_XCNT(b.x)], 1u);
  return b;
}
DI void xcd_barrier_complete(unsigned* bar, unsigned x, unsigned& nloc, unsigned& nx) {
  const unsigned G = gridDim.x * gridDim.y * gridDim.z;
  unsigned sum, cnt, mine, sp = 0u;
  for (;;) {
    sum = 0u; cnt = 0u; mine = 0u;
#pragma unroll
    for (unsigned j = 0; j < 16; ++j) { const unsigned c = xb_ld(&bar[XB_XCNT(j)]); sum += c; cnt += (c > 0u) ? 1u : 0u; mine = (j == x) ? c : mine; }
    if (sum == G) break;
    __builtin_amdgcn_s_sleep(1);
    if ((++sp & 255u) == 0u) { if (xb_ld(&bar[XB_TMO])) break; if (sp > XB_SPIN_CAP) { atomicAdd(&bar[XB_TMO], 1u); break; } }
  }
  nloc = mine > 0u ? mine : 1u; nx = cnt > 0u ? cnt : 1u;
}
DI void xcd_barrier(const XcdBarrier& b) {
  asm volatile("s_waitcnt vmcnt(0)" ::: "memory");
  __syncthreads();
  if (tid() == 0) {
    unsigned* bar = b.bar;
    __builtin_amdgcn_s_waitcnt(0);
    unsigned nloc = b.st[0], nx = b.st[1];
    if (nloc == 0u) { xcd_barrier_complete(bar, b.x, nloc, nx); b.st[0] = nloc; b.st[1] = nx; }
    const unsigned old = xb_add(&bar[XB_XSUB(b.x)], 1u);
    const unsigned gen = old / nloc;
    if (old + 1u == (gen + 1u) * nloc) {
      __builtin_amdgcn_fence(__ATOMIC_RELEASE, "agent");
      asm volatile("s_waitcnt vmcnt(0)" ::: "memory");
      const unsigned og = xb_add(&bar[XB_TOP], 1u);
      const unsigned tg = og / nx;
      if (og + 1u == (tg + 1u) * nx) xb_add(&bar[XB_TOPGEN], 1u);
      else XB_SPIN(xb_ld(&bar[XB_TOPGEN]) == tg, bar);
      __builtin_amdgcn_fence(__ATOMIC_ACQUIRE, "agent");
      xb_add(&bar[XB_XGEN(b.x)], 1u);
      asm volatile("s_waitcnt vmcnt(0)" ::: "memory");
    } else {
      XB_SPIN(xb_ld(&bar[XB_XGEN(b.x)]) == gen, bar);
      __builtin_amdgcn_fence(__ATOMIC_ACQUIRE, "agent");
      asm volatile("s_waitcnt vmcnt(0)" ::: "memory");
    }
  }
  __syncthreads();
}

template <bool COOP>
__global__ void __launch_bounds__(256, 2) mega(Params p) {
  __shared__ __attribute__((aligned(16))) char lds[LDS_BYTES];
  XcdBarrier xb{};
  if (COOP) {
    volatile LAS unsigned* st = (volatile LAS unsigned*)(lds + 67584);
    if (tid() == 0) { st[0] = 0u; st[1] = 0u; }
    __syncthreads();
    xb = xcd_barrier_post((unsigned*)p.counters + 64, st);
  }
  for (int ph = p.ph_lo; ph < p.ph_hi; ++ph) {
#ifdef ONLY_PHASE
    if (ph != ONLY_PHASE) continue;
#endif
    switch (ph) {
      case 0: phase0(p, lds); break;
      case 1: phase1(p, lds); break;
      case 2: phase2(p, lds); break;
      case 3: phase3(p, lds); break;
      case 4: phase4(p, lds, 0); break;
      case 5: phase5(p, lds); break;
      case 6: phase6(p, lds); break;
      case 7: phase7(p, lds); break;
      case 8: phase8(p, lds); break;
      default: phase9(p); break;
    }
#ifdef DOUBLE_PHASE
    if (ph == DOUBLE_PHASE) {
      __syncthreads();
      switch (ph) { case 0: phase0(p, lds); break; case 1: phase1(p, lds); break; case 2: phase2(p, lds); break; case 3: phase3(p, lds); break; case 4: phase4(p, lds, 1); break;
                    case 5: phase5(p, lds); break; case 6: phase6(p, lds); break; case 7: phase7(p, lds); break; default: break; }
    }
#endif
    if (COOP) { if (ph + 1 < p.ph_hi) { if (ph == 0) cg::this_grid().sync(); else xcd_barrier(xb); } }
  }
}

static size_t al256(size_t x) { return (x + 255) & ~(size_t)255; }

extern "C" void kernel_launch(void* const* d_in, const int* in_sizes, int n_in, void* d_out, int out_size, void* d_ws, size_t ws_size, hipStream_t stream) {
  Params p{};
  for (int i = 0; i < 28; ++i) p.in[i] = (const float*)d_in[i];
  p.out = (float*)d_out;
  char* base = (char*)d_ws; size_t off = 0;
  auto take = [&](size_t bytes) { char* q = base + off; off = al256(off + bytes); return q; };
  p.WinT = (bf16_t*)take((size_t)1664 * 1024 * 2);
  p.WqT = (bf16_t*)take((size_t)768 * 768 * 2);
  p.WkT = (bf16_t*)take((size_t)512 * 256 * 2);
  p.WvT = (bf16_t*)take((size_t)512 * 256 * 2);
  p.WgT = (bf16_t*)take((size_t)512 * 512 * 2);
  p.WoT = (bf16_t*)take((size_t)1024 * 1024 * 2);
  p.WuT = (bf16_t*)take((size_t)4096 * 1024 * 2);
  p.WdT = (bf16_t*)take((size_t)1024 * 4096 * 2);
  p.BbT = (bf16_t*)take((size_t)32 * 128 * 16 * 2);
  p.CcT = (bf16_t*)take((size_t)32 * 16 * 128 * 2);
  p.lam = (float2*)take(2048 * 8);
  p.lam64 = (float2*)take(2048 * 8);
  p.rope = (float2*)take((size_t)8192 * 16 * 8);
  p.rstd_x = (float*)take((size_t)NT * 4);
  p.cq_part = (float*)take((size_t)NT * 12 * 4);
  p.ckv_part = (float*)take((size_t)NT * 4 * 4);
  p.attn_part = (float*)take((size_t)NT * 8 * 4);
  p.ssm_part = (float*)take((size_t)NT * 8 * 4);
  p.h_part = (float*)take((size_t)NT * 16 * 4);
  p.out_part = (float*)take((size_t)NT * 16 * 4);
  p.counters = (int*)take(16384);
  p.E = (float2*)take((size_t)8 * 128 * 32 * 64 * 8);
  p.S = (float2*)take((size_t)8 * 128 * 32 * 64 * 8);
  const size_t a0 = off;
  p.Kn = (bf16_t*)take((size_t)NK * 512 * 2);
  const size_t aVt = off;
  p.Vt = (bf16_t*)take((size_t)NK * 512 * 2);
  p.Q = (bf16_t*)take((size_t)NT * 768 * 2);
  p.latb = (bf16_t*)take((size_t)NK * 256 * 2);
  p.krb = (bf16_t*)take((size_t)NK * 32 * 2);
  p.ub = (bf16_t*)take((size_t)NT * 512 * 2);
  const size_t aSsmY = off;
  p.ssm_y = (bf16_t*)take((size_t)NT * 512 * 2);
  p.mix = (bf16_t*)take((size_t)NT * 1024 * 2);
  const size_t total = off;
  p.xb = (bf16_t*)(base + a0);
  p.cq = (bf16_t*)(base + aVt);
  p.ckv_raw = (float*)(base + aVt + al256((size_t)NT * 768 * 2));
  p.act = (bf16_t*)(base + a0);
  const size_t aHb = a0 + al256((size_t)NT * 4096 * 2);
  p.hb = (bf16_t*)(base + aHb);
  if (aHb + (size_t)NT * 1024 * 2 > aSsmY || total > ws_size) { fprintf(stderr, "workspace layout error: total %zu ws %zu\n", total, ws_size); return; }

  const int MULTI = 0;
  hipMemsetAsync(p.counters, 0, 16384, stream);
  if (MULTI) {
    for (int ph = 0; ph < NPHASE; ++ph) {
      p.ph_lo = ph; p.ph_hi = ph + 1;
      hipLaunchKernelGGL(mega<false>, dim3(512), dim3(256), 0, stream, p);
    }
  } else {
    static int grid_blocks = 0;
    if (!grid_blocks) {
      int dev = 0, cus = 0, per_cu = 0;
      hipGetDevice(&dev);
      hipDeviceGetAttribute(&cus, hipDeviceAttributeMultiprocessorCount, dev);
      hipOccupancyMaxActiveBlocksPerMultiprocessor(&per_cu, mega<true>, 256, 0);
      grid_blocks = cus * per_cu;
    }
    p.ph_lo = 0; p.ph_hi = NPHASE;
    void* args[] = {&p};
    hipError_t e = hipLaunchCooperativeKernel((void*)mega<true>, dim3(grid_blocks), dim3(256), args, 0, stream);
    if (e != hipSuccess) fprintf(stderr, "cooperative launch failed: %s (grid %d)\n", hipGetErrorString(e), grid_blocks);
  }
}
```

```cpp
#include <hip/hip_runtime.h>
#include <hip/hip_cooperative_groups.h>
#include <stdint.h>
#include <cstdio>
namespace cg = cooperative_groups;
#define DI __device__ __forceinline__

typedef unsigned short bf16_t;
typedef short bf16x8 __attribute__((ext_vector_type(8)));
typedef float f32x16 __attribute__((ext_vector_type(16)));
typedef float f32x4 __attribute__((ext_vector_type(4)));
typedef unsigned u32x4 __attribute__((ext_vector_type(4)));
typedef unsigned u32x2 __attribute__((ext_vector_type(2)));

constexpr int NTP = 65536, NTS = 2048, NT = NTP + NTS, NK = NTP + 32 * 4160;
constexpr int SKS = 4160;
constexpr size_t OFF_Y = 0;
constexpr size_t OFF_LATP = (size_t)NT * 1024;
constexpr size_t OFF_KRP = OFF_LATP + (size_t)NTP * 256;
constexpr size_t OFF_HRP = OFF_KRP + (size_t)NTP * 32;
constexpr size_t OFF_HIP = OFF_HRP + 8 * 32 * 64;
constexpr size_t OFF_LATS = OFF_HIP + 8 * 32 * 64;
constexpr size_t OFF_KRS = OFF_LATS + (size_t)NTS * 256;
constexpr size_t OFF_HRS = OFF_KRS + (size_t)NTS * 32;
constexpr size_t OFF_HIS = OFF_HRS + 32 * 32 * 64;
constexpr size_t VT_S_OFF = (size_t)8 * 512 * 8192;
constexpr float EPS = 1e-6f;
constexpr int LDS_BYTES = 67600;
constexpr int NPHASE = 10;
constexpr int AQT = 1, NQQ = 128 / (4 / (64 / (32 * AQT)));

struct Params {
  const float* in[28];
  float* out;
  bf16_t *WinT, *WqT, *WkT, *WvT, *WgT, *WoT, *WuT, *WdT, *BbT, *CcT;
  float2 *lam, *lam64, *rope;
  float *rstd_x, *cq_part, *ckv_part, *attn_part, *ssm_part, *h_part, *out_part;
  int* counters;
  float2 *E, *S;
  bf16_t *Kn, *Vt, *Q, *latb, *krb, *ub, *ssm_y, *mix, *xb, *cq, *hb, *act;
  float* ckv_raw;
  int ph_lo, ph_hi;
};

DI int tid() { int t = __builtin_amdgcn_workitem_id_x(); asm volatile("" : "+v"(t)); return t; }
typedef __bf16 nbf16x2 __attribute__((ext_vector_type(2)));
typedef float f32x2 __attribute__((ext_vector_type(2)));
DI unsigned pk_bf16(float lo, float hi) { f32x2 v = {lo, hi}; return __builtin_bit_cast(unsigned, __builtin_convertvector(v, nbf16x2)); }
DI bf16_t f2bf(float x) { return (bf16_t)(pk_bf16(x, 0.f) & 0xffffu); }
DI float bf2f(bf16_t v) { return __uint_as_float(((unsigned)v) << 16); }
DI int crow(int i, int hh) { return (i & 3) + 8 * (i >> 2) + 4 * hh; }
DI const float* xrow(const Params& p, int row) { return row < NTP ? p.in[0] + (size_t)row * 1024 : p.in[1] + (size_t)(row - NTP) * 1024; }
DI int pos_of(int row) { return row < NTP ? (row & 8191) : 4096 + ((row - NTP) & 63); }
DI int kr_of(int row) { return row < NTP ? row : NTP + ((row - NTP) >> 6) * SKS + 4096 + ((row - NTP) & 63); }
#define MFMA32(a, b, c) __builtin_amdgcn_mfma_f32_32x32x16_bf16((a), (b), (c), 0, 0, 0)
#define MFMA16(a, b, c) __builtin_amdgcn_mfma_f32_16x16x32_bf16((a), (b), (c), 0, 0, 0)

DI void sincos_d(double x, double& s4, double& c4) {
  double k = rint(x * 0.15915494309189535);
  double rr = fma(-k, 6.283185307179586, x);
  rr = fma(-k, 2.4492935982947064e-16, rr);
  double y = rr * 0.25, y2 = y * y;
  double s = y * (1 - y2 / 6 * (1 - y2 / 20 * (1 - y2 / 42 * (1 - y2 / 72 * (1 - y2 / 110 * (1 - y2 / 156 * (1 - y2 / 210)))))));
  double c = 1 - y2 / 2 * (1 - y2 / 12 * (1 - y2 / 30 * (1 - y2 / 56 * (1 - y2 / 90 * (1 - y2 / 132 * (1 - y2 / 182))))));
  double s2 = 2 * s * c, c2 = 1 - 2 * s * s;
  s4 = 2 * s2 * c2; c4 = 1 - 2 * s2 * s2;
}

DI void gemm_core(const bf16_t* __restrict__ A, int lda, const bf16_t* __restrict__ B, int ldb, int nk,
                  int m0, int n0, char* lds, f32x16 (&acc)[2][2], int midk, const float* ratio) {
  const int t = tid(), lane = t & 63, wid = t >> 6, wm = wid >> 1, wn = wid & 1;
  const int r = lane & 31, hh = lane >> 5;
  const int lc = t & 7, lr = t >> 3;
  const unsigned woff = lr * 128 + ((lc ^ ((lr >> 1) & 7)) << 4);
  const bf16_t* ga = A + (size_t)(m0 + lr) * lda + lc * 8;
  const bf16_t* gb = B + (size_t)(n0 + lr) * ldb + lc * 8;
  char* sA = lds; char* sB = lds + 32768;
  u32x4 ra[4], rb[4];
#pragma unroll
  for (int i = 0; i < 4; ++i) { ra[i] = *(const u32x4*)(ga + (size_t)(32 * i) * lda); rb[i] = *(const u32x4*)(gb + (size_t)(32 * i) * ldb); }
#pragma unroll
  for (int i = 0; i < 4; ++i) { *(u32x4*)(sA + woff + i * 4096) = ra[i]; *(u32x4*)(sB + woff + i * 4096) = rb[i]; }
#pragma unroll
  for (int a = 0; a < 2; ++a)
#pragma unroll
    for (int b = 0; b < 2; ++b)
#pragma unroll
      for (int i = 0; i < 16; ++i) acc[a][b][i] = 0.f;
  __syncthreads();
  const int rsw = (r >> 1) & 7;
  const unsigned aoff = (wm * 64 + r) * 128, boff = (wn * 64 + r) * 128;
  for (int kt = 0; kt < nk; ++kt) {
    const int cur = kt & 1;
    const bool more = (kt + 1 < nk);
    if (more) {
      const bf16_t* ga2 = ga + (kt + 1) * 64; const bf16_t* gb2 = gb + (kt + 1) * 64;
#pragma unroll
      for (int i = 0; i < 4; ++i) { ra[i] = *(const u32x4*)(ga2 + (size_t)(32 * i) * lda); rb[i] = *(const u32x4*)(gb2 + (size_t)(32 * i) * ldb); }
    }
    if (midk && kt == midk) {
#pragma unroll
      for (int mt = 0; mt < 2; ++mt)
      { const float f = ratio[wm * 64 + mt * 32 + r];
#pragma unroll
        for (int i = 0; i < 16; ++i) { acc[mt][0][i] *= f; acc[mt][1][i] *= f; } }
    }
    const char* cA = sA + cur * 16384; const char* cB = sB + cur * 16384;
#pragma unroll
    for (int ks = 0; ks < 4; ++ks) {
      const unsigned co = (((ks * 2 + hh) ^ rsw) << 4);
      const bf16x8 a0 = *(const bf16x8*)(cA + aoff + co), a1 = *(const bf16x8*)(cA + aoff + 4096 + co);
      const bf16x8 b0 = *(const bf16x8*)(cB + boff + co), b1 = *(const bf16x8*)(cB + boff + 4096 + co);
      acc[0][0] = MFMA32(b0, a0, acc[0][0]); acc[0][1] = MFMA32(b1, a0, acc[0][1]);
      acc[1][0] = MFMA32(b0, a1, acc[1][0]); acc[1][1] = MFMA32(b1, a1, acc[1][1]);
    }
    if (more) {
      char* nA = sA + (cur ^ 1) * 16384; char* nB = sB + (cur ^ 1) * 16384;
#pragma unroll
      for (int i = 0; i < 4; ++i) { *(u32x4*)(nA + woff + i * 4096) = ra[i]; *(u32x4*)(nB + woff + i * 4096) = rb[i]; }
    }
    __syncthreads();
  }
}

DI void rowscale_load(float* rs, const float* src, int np, float inv_dim, int m0) {
  const int t = tid();
  if (t < 128) {
    const int row = m0 + t;
    if (np == 0) rs[t] = src[row];
    else { float s = 0.f; for (int j = 0; j < np; ++j) s += src[(size_t)row * np + j]; rs[t] = rsqrtf(s * inv_dim + EPS); }
  }
}

template <bool BLKA = false, class TileFn, class RsFn, class EpiFn>
DI void gemm_stream(const bf16_t* __restrict__ A, int lda, const bf16_t* __restrict__ B, int ldb, int nk, char* lds, int midk,
                    TileFn tile_fn, RsFn rs_fn, EpiFn epi) {
  int m0, n0;
  if (!tile_fn(0, m0, n0)) return;
  const int t = tid(), lane = t & 63, wid = t >> 6, wm = wid >> 1, wn = wid & 1;
  const int r = lane & 31, hh = lane >> 5;
  const int lc = t & 7, lr = t >> 3;
  const unsigned woff = lr * 128 + ((lc ^ ((lr >> 1) & 7)) << 4);
  char* sA = lds; char* sB = lds + 32768;
  float* rsbuf = (float*)(lds + 65536);
  const int rsw = (r >> 1) & 7;
  const unsigned aoff = (wm * 64 + r) * 128, boff = (wn * 64 + r) * 128;
  int lj = 0, lkt = 0, lm0 = m0, ln0 = n0; bool lvalid = true;
  u32x4 ra0[4], rb0[4], ra1[4], rb1[4];
#define GS_LOAD(RA, RB) do {   \
        \
      const bf16_t* ga_ = BLKA ? A + ((size_t)(lm0 >> 7) * nk + lkt) * 8192 + lr * 64 + lc * 8 : A + (size_t)(lm0 + lr) * lda + lc * 8 + lkt * 64; const bf16_t* gb_ = B + (size_t)(ln0 + lr) * ldb + lc * 8 + lkt * 64; \
      _Pragma("unroll") for (int i = 0; i < 4; ++i) { RA[i] = *(const u32x4*)(ga_ + (size_t)(32 * i) * (BLKA ? 64 : lda)); RB[i] = *(const u32x4*)(gb_ + (size_t)(32 * i) * ldb); } \
      if (++lkt == nk) { lkt = 0; if (lvalid) { ++lj; lvalid = tile_fn(lj, lm0, ln0); } } } while (0)
  GS_LOAD(ra0, rb0);
  GS_LOAD(ra1, rb1);
  {
    float2 rv = make_float2(0.f, 0.f);
    if (t < 128) rv = rs_fn(m0, t);
    __syncthreads();
#pragma unroll
    for (int i = 0; i < 4; ++i) { *(u32x4*)(sA + woff + i * 4096) = ra0[i]; *(u32x4*)(sB + woff + i * 4096) = rb0[i]; }
    if (t < 128) { rsbuf[t] = rv.x; rsbuf[128 + t] = rv.y; }
    __syncthreads();
  }
  int cur = 0;
  for (int j = 0;; ++j) {
    int m1 = 0, n1 = 0;
    const bool has_next = tile_fn(j + 1, m1, n1);
    const float* rs = rsbuf + (j & 1) * 256;
    f32x16 acc[2][2];
#pragma unroll
    for (int a = 0; a < 2; ++a)
#pragma unroll
      for (int b = 0; b < 2; ++b)
#pragma unroll
        for (int i = 0; i < 16; ++i) acc[a][b][i] = 0.f;
#define GS_STEP(RL_A, RL_B, RW_A, RW_B, KT) do { \
      const bool last_ = ((KT) + 1 == nk); const bool wr_ = !last_ || has_next; \
      float2 rv_ = make_float2(0.f, 0.f); \
      if (last_ && has_next) { if (t < 128) rv_ = rs_fn(m1, t); asm volatile("" : "+v"(rv_.x), "+v"(rv_.y)); }   \
      GS_LOAD(RL_A, RL_B); \
      if (midk && (KT) == midk) { _Pragma("unroll") for (int mt = 0; mt < 2; ++mt) { const float f = rs[128 + wm * 64 + mt * 32 + r]; \
          _Pragma("unroll") for (int i = 0; i < 16; ++i) { acc[mt][0][i] *= f; acc[mt][1][i] *= f; } } } \
      const char* cA = sA + cur * 16384; const char* cB = sB + cur * 16384; \
      _Pragma("unroll") for (int ks = 0; ks < 4; ++ks) { \
        const unsigned co = (((ks * 2 + hh) ^ rsw) << 4); \
        const bf16x8 a0 = *(const bf16x8*)(cA + aoff + co), a1 = *(const bf16x8*)(cA + aoff + 4096 + co); \
        const bf16x8 b0 = *(const bf16x8*)(cB + boff + co), b1 = *(const bf16x8*)(cB + boff + 4096 + co); \
        acc[0][0] = MFMA32(b0, a0, acc[0][0]); acc[0][1] = MFMA32(b1, a0, acc[0][1]); \
        acc[1][0] = MFMA32(b0, a1, acc[1][0]); acc[1][1] = MFMA32(b1, a1, acc[1][1]); } \
      if (wr_) { char* nA = sA + (cur ^ 1) * 16384; char* nB = sB + (cur ^ 1) * 16384; \
        _Pragma("unroll") for (int i = 0; i < 4; ++i) { *(u32x4*)(nA + woff + i * 4096) = RW_A[i]; *(u32x4*)(nB + woff + i * 4096) = RW_B[i]; } \
        if (last_ && t < 128) { float* rn = rsbuf + ((j + 1) & 1) * 256; rn[t] = rv_.x; rn[128 + t] = rv_.y; } } \
      __syncthreads(); cur ^= 1; } while (0)
    for (int kt = 0; kt < nk; kt += 2) {
      GS_STEP(ra0, rb0, ra1, rb1, kt);
      GS_STEP(ra1, rb1, ra0, rb0, kt + 1);
    }
    epi(acc, m0, n0, rs);
    if (!has_next) break;
    m0 = m1; n0 = n1;
  }
#undef GS_STEP
#undef GS_LOAD
  __syncthreads();
}

DI float half_reduce(float s) {
  s += __shfl_xor(s, 1); s += __shfl_xor(s, 2); s += __shfl_xor(s, 4); s += __shfl_xor(s, 8); s += __shfl_xor(s, 16); return s;
}

#define EPI_IDS int t = tid(); asm volatile("" : "+v"(t)); const int lane = t & 63, wid = t >> 6, wm = wid >> 1, wn = wid & 1, r = lane & 31, hh = lane >> 5; (void)lane; (void)wid; (void)wm; (void)wn; (void)r; (void)hh;
#define GEMM_IDS const int t = tid(), lane = t & 63, wid = t >> 6, wm = wid >> 1, wn = wid & 1, r = lane & 31, hh = lane >> 5; (void)t; (void)wm; (void)wn; (void)r; (void)hh;

DI void transpose_tile(const float* __restrict__ src, int ld, int K, int kt, int nt, int job, const float* g0, const float* g1, bf16_t* __restrict__ dst, char* lds) {
  bf16_t* tile = (bf16_t*)lds;
  const int t = tid(), nl = t & 63, kq = t >> 6;
  const int n = nt * 64 + nl;
  int c = n;
  if (job == 0) { c = n < 1024 ? n : (n < 1536 ? 1056 + (n - 1024) : (n < 1568 ? 1024 + (n - 1536) : -1)); }
  else if (job == 2) c = (n >> 6) * 128 + (n & 63);
  else if (job == 3) c = (n >> 6) * 128 + 64 + (n & 63);
#pragma unroll 4
  for (int pass = 0; pass < 16; ++pass) {
    const int kl = pass * 4 + kq, k = kt * 64 + kl;
    float v = 0.f;
    if (c >= 0) {
      v = src[(size_t)k * ld + c];
      if (g0) { const float g = (g1 && k >= 512) ? g1[k - 512] : g0[k]; v *= g; }
    }
    tile[nl * 66 + kl] = f2bf(v);
  }
  __syncthreads();
  const int kl = t & 63;
#pragma unroll 4
  for (int pass = 0; pass < 16; ++pass) { const int nl2 = pass * 4 + kq; dst[(size_t)(nt * 64 + nl2) * K + kt * 64 + kl] = tile[nl2 * 66 + kl]; }
  __syncthreads();
}

DI void phase0(const Params& p, char* lds) {
  const int t = tid(), nb = gridDim.x, bid = blockIdx.x, lane = t & 63, wid = t >> 6;
  for (int ti = bid; ti < 2992; ti += nb) {
    int job, base, nNt, ld, K; const float* src; const float* g0 = nullptr; const float* g1 = nullptr; bf16_t* dst;
    if (ti < 416) { job = 0; base = 0; nNt = 26; ld = 1568; K = 1024; src = p.in[7]; g0 = p.in[6]; dst = p.WinT; }
    else if (ti < 560) { job = 1; base = 416; nNt = 12; ld = 768; K = 768; src = p.in[9]; g0 = p.in[8]; dst = p.WqT; }
    else if (ti < 592) { job = 2; base = 560; nNt = 8; ld = 1024; K = 256; src = p.in[11]; dst = p.WkT; }
    else if (ti < 624) { job = 3; base = 592; nNt = 8; ld = 1024; K = 256; src = p.in[11]; dst = p.WvT; }
    else if (ti < 688) { job = 4; base = 624; nNt = 8; ld = 512; K = 512; src = p.in[20]; dst = p.WgT; }
    else if (ti < 944) { job = 5; base = 688; nNt = 16; ld = 1024; K = 1024; src = p.in[23]; g0 = p.in[21]; g1 = p.in[22]; dst = p.WoT; }
    else if (ti < 1968) { job = 6; base = 944; nNt = 64; ld = 4096; K = 1024; src = p.in[25]; g0 = p.in[24]; dst = p.WuT; }
    else { job = 7; base = 1968; nNt = 16; ld = 1024; K = 4096; src = p.in[26]; dst = p.WdT; }
    const int tile = ti - base;
    transpose_tile(src, ld, K, tile / nNt, tile % nNt, job, g0, g1, dst, lds);
  }
  for (int row = bid * 4 + wid; row < NT; row += nb * 4) {
    const float* x = xrow(p, row);
    f32x4 v[4]; float ss = 0.f;
#pragma unroll
    for (int j = 0; j < 4; ++j) { v[j] = *(const f32x4*)(x + lane * 4 + 256 * j); ss += v[j][0] * v[j][0] + v[j][1] * v[j][1] + v[j][2] * v[j][2] + v[j][3] * v[j][3]; }
    ss += __shfl_xor(ss, 32); ss = half_reduce(ss);
#pragma unroll
    for (int j = 0; j < 4; ++j) { u32x2 w; w.x = pk_bf16(v[j][0], v[j][1]); w.y = pk_bf16(v[j][2], v[j][3]); *(u32x2*)(p.xb + (size_t)row * 1024 + lane * 4 + 256 * j) = w; }
    if (lane == 0) p.rstd_x[row] = rsqrtf(ss * (1.f / 1024.f) + EPS);
  }
  const int gt = bid * 256 + t, ngt = nb * 256;
  for (int v = gt; v < 32 * 4096 * 32; v += ngt) {
    const size_t e0 = (size_t)v * 8; const int b = (int)(e0 >> 20), rem = (int)(e0 & 1048575), tt = rem >> 8, c = rem & 255;
    const f32x4 a = *(const f32x4*)(p.in[2] + e0), bq = *(const f32x4*)(p.in[2] + e0 + 4);
    u32x4 w; w.x = pk_bf16(a[0], a[1]); w.y = pk_bf16(a[2], a[3]); w.z = pk_bf16(bq[0], bq[1]); w.w = pk_bf16(bq[2], bq[3]);
    *(u32x4*)(p.latb + (size_t)(NTP + b * SKS + tt) * 256 + c) = w;
  }
  for (int v = gt; v < 32 * 4096 * 4; v += ngt) {
    const size_t e0 = (size_t)v * 8; const int b = (int)(e0 >> 17), rem = (int)(e0 & 131071), tt = rem >> 5, c = rem & 31;
    const f32x4 a = *(const f32x4*)(p.in[3] + e0), bq = *(const f32x4*)(p.in[3] + e0 + 4);
    u32x4 w; w.x = pk_bf16(a[0], a[1]); w.y = pk_bf16(a[2], a[3]); w.z = pk_bf16(bq[0], bq[1]); w.w = pk_bf16(bq[2], bq[3]);
    *(u32x4*)(p.krb + (size_t)(NTP + b * SKS + tt) * 32 + c) = w;
  }
  if (gt < 2048) {
    const int g = gt >> 6, n = gt & 63;
    const double dt = (double)expf(p.in[14][g]);
    const double lr = p.in[12][gt], li = p.in[13][gt];
    const double mag = (double)expf((float)(lr * dt)); double s, c; sincos_d(li * dt, s, c);
    const double lbr = mag * c, lbi = mag * s;
    const double nr = lbr - 1.0, ni = lbi, den = lr * lr + li * li;
    const double cr = (nr * lr + ni * li) / den, ci = (ni * lr - nr * li) / den;
    p.lam[gt] = make_float2((float)lbr, (float)lbi);
    const double mag64 = (double)expf((float)(64.0 * lr * dt)); sincos_d(64.0 * li * dt, s, c);
    p.lam64[gt] = make_float2((float)(mag64 * c), (float)(mag64 * s));
    for (int q = 0; q < 16; ++q) {
      const double br = p.in[15][(size_t)gt * 16 + q], bi = p.in[16][(size_t)gt * 16 + q];
      p.BbT[(size_t)(g * 128 + n) * 16 + q] = f2bf((float)(cr * br - ci * bi));
      p.BbT[(size_t)(g * 128 + 64 + n) * 16 + q] = f2bf((float)(cr * bi + ci * br));
      p.CcT[(size_t)(g * 16 + q) * 128 + n] = f2bf(p.in[17][(size_t)(g * 16 + q) * 64 + n]);
      p.CcT[(size_t)(g * 16 + q) * 128 + 64 + n] = f2bf(-p.in[18][(size_t)(g * 16 + q) * 64 + n]);
    }
  }
  for (int e = gt; e < 8192 * 16; e += ngt) {
    const int pos = e >> 4, i = e & 15;
    const float inv = expf(-(float)i * (9.210340371976184f / 16.0f));
    const float ang = (float)pos * inv;
    double s, c; sincos_d((double)ang, s, c);
    p.rope[e] = make_float2((float)c, (float)s);
  }
}

DI void phase1(const Params& p, char* lds) {
  float* rs = (float*)(lds + 65536);
  const int ntiles = 528 * 13;
  {
    auto tile_fn = [&](int j, int& m0, int& n0) -> bool { const int li = (int)(blockIdx.x >> 3) + j * (int)(gridDim.x >> 3); const int ti_ = li / 13, tj_ = li - ti_ * 13; const int tbig = ti_ * 8 + (int)(blockIdx.x & 7); if (tbig >= 528) return false; m0 = tbig * 128; n0 = tj_ * 128; return true; };
    auto rs_fn = [&](int m0, int t) -> float2 { return make_float2(p.rstd_x[m0 + t], 0.f); };
    auto epi = [&](f32x16 (&acc)[2][2], int m0, int n0, const float* rs) {
    const int tn = n0 >> 7; (void)tn;
    { EPI_IDS
    if (tn < 8) {
#pragma unroll
      for (int mt = 0; mt < 2; ++mt) {
        const int rl = wm * 64 + mt * 32 + r, row = m0 + rl;
        const float sc = rs[rl];
        float ss = 0.f;
#pragma unroll
        for (int nt = 0; nt < 2; ++nt)
#pragma unroll
          for (int i4 = 0; i4 < 4; ++i4) {
            const float v0 = acc[mt][nt][4 * i4] * sc, v1 = acc[mt][nt][4 * i4 + 1] * sc, v2 = acc[mt][nt][4 * i4 + 2] * sc, v3 = acc[mt][nt][4 * i4 + 3] * sc;
            ss += v0 * v0 + v1 * v1 + v2 * v2 + v3 * v3;
            const int col = n0 + wn * 64 + nt * 32 + 8 * i4 + 4 * hh;
            if (tn < 6) { u32x2 w; w.x = pk_bf16(v0, v1); w.y = pk_bf16(v2, v3); *(u32x2*)(p.cq + (size_t)row * 768 + col) = w; }
            else { f32x4 w = {v0, v1, v2, v3}; *(f32x4*)(p.ckv_raw + (size_t)row * 256 + (col - 768)) = w; }
          }
        ss += __shfl_xor(ss, 32);
        if (hh == 0) { if (tn < 6) p.cq_part[(size_t)row * 12 + tn * 2 + wn] = ss; else p.ckv_part[(size_t)row * 4 + (tn - 6) * 2 + wn] = ss; }
      }
    } else if (tn < 12) {
#pragma unroll
      for (int mt = 0; mt < 2; ++mt) {
        const int rl = wm * 64 + mt * 32 + r, row = m0 + rl;
        const float sc = rs[rl];
#pragma unroll
        for (int nt = 0; nt < 2; ++nt)
#pragma unroll
          for (int i4 = 0; i4 < 4; ++i4) {
            u32x2 w; w.x = pk_bf16(acc[mt][nt][4 * i4] * sc, acc[mt][nt][4 * i4 + 1] * sc); w.y = pk_bf16(acc[mt][nt][4 * i4 + 2] * sc, acc[mt][nt][4 * i4 + 3] * sc);
            *(u32x2*)(p.ub + (size_t)row * 512 + (n0 - 1024) + wn * 64 + nt * 32 + 8 * i4 + 4 * hh) = w;
          }
      }
    } else if (wn == 0) {
#pragma unroll
      for (int mt = 0; mt < 2; ++mt) {
        const int rl = wm * 64 + mt * 32 + r, row = m0 + rl;
        const float sc = rs[rl];
        float* dst = row < NTP ? p.out + OFF_KRP + (size_t)row * 32 : p.out + OFF_KRS + (size_t)(row - NTP) * 32;
        bf16_t* dkb = p.krb + (size_t)kr_of(row) * 32;
        const float* rp = (const float*)(p.rope + pos_of(row) * 16);
#pragma unroll
        for (int ih = 0; ih < 2; ++ih) {
          const int j0 = 8 * ih + 4 * hh;
          const f32x4 c01 = *(const f32x4*)(rp + 2 * j0), c23 = *(const f32x4*)(rp + 2 * j0 + 4);
          const float cc[4] = {c01[0], c01[2], c23[0], c23[2]}, sn[4] = {c01[1], c01[3], c23[1], c23[3]};
          f32x4 o1, o2;
#pragma unroll
          for (int jj = 0; jj < 4; ++jj) {
            const float x1 = acc[mt][0][4 * ih + jj] * sc, x2 = acc[mt][0][8 + 4 * ih + jj] * sc;
            o1[jj] = x1 * cc[jj] - x2 * sn[jj]; o2[jj] = x1 * sn[jj] + x2 * cc[jj];
          }
          *(f32x4*)(dst + j0) = o1; *(f32x4*)(dst + 16 + j0) = o2;
          u32x2 w1, w2; w1.x = pk_bf16(o1[0], o1[1]); w1.y = pk_bf16(o1[2], o1[3]); w2.x = pk_bf16(o2[0], o2[1]); w2.y = pk_bf16(o2[2], o2[3]);
          *(u32x2*)(dkb + j0) = w1; *(u32x2*)(dkb + 16 + j0) = w2;
        }
      }
    }
    }

    };
    gemm_stream(p.xb, 1024, p.WinT, 1024, 16, lds, 0, tile_fn, rs_fn, epi);
  }
}

DI void ssm_chunk(const Params& p, int row0, int g, float& hr, float& hi, bool write_y, char* lds_w) {
  const int lane = tid() & 63, r = lane & 31, hh = lane >> 5;
  const float2 lm = p.lam[g * 64 + lane];
  bf16x8 bfr[4];
#pragma unroll
  for (int nt = 0; nt < 4; ++nt) bfr[nt] = *(const bf16x8*)(p.BbT + (size_t)(g * 128 + nt * 32 + r) * 16 + hh * 8);
  const int fr = lane & 15, fq = lane >> 4;
  bf16x8 cfr[4];
#pragma unroll
  for (int ks = 0; ks < 4; ++ks) cfr[ks] = *(const bf16x8*)(p.CcT + (size_t)(g * 16 + fr) * 128 + ks * 32 + fq * 8);
  const float dsk = p.in[19][g * 16 + fr];
#pragma unroll 1
  for (int sub = 0; sub < 2; ++sub) {
    const int rb = row0 + sub * 32;
    const bf16x8 uf = *(const bf16x8*)(p.ub + (size_t)(rb + r) * 512 + g * 16 + hh * 8);
    f32x16 z; for (int i = 0; i < 16; ++i) z[i] = 0.f;
    const f32x16 x0 = MFMA32(uf, bfr[0], z), x1 = MFMA32(uf, bfr[1], z), x2 = MFMA32(uf, bfr[2], z), x3 = MFMA32(uf, bfr[3], z);
    float xr0[16], xr1[16], xi0[16], xi1[16];
#pragma unroll
    for (int i = 0; i < 16; ++i) {
      const auto re = __builtin_amdgcn_permlane32_swap(__float_as_uint(x0[i]), __float_as_uint(x1[i]), false, false);
      const auto im = __builtin_amdgcn_permlane32_swap(__float_as_uint(x2[i]), __float_as_uint(x3[i]), false, false);
      xr0[i] = __uint_as_float(re[0]); xr1[i] = __uint_as_float(re[1]);
      xi0[i] = __uint_as_float(im[0]); xi1[i] = __uint_as_float(im[1]);
    }
    bf16_t* Hs = (bf16_t*)lds_w;
#pragma unroll
    for (int m = 0; m < 4; ++m) {
#pragma unroll
      for (int half = 0; half < 2; ++half) {
#pragma unroll
        for (int jj = 0; jj < 4; ++jj) {
          const int i = 4 * m + jj, tt = 8 * m + 4 * half + jj;
          const float xr = half ? xr1[i] : xr0[i], xi = half ? xi1[i] : xi0[i];
          const float nr = lm.x * hr - lm.y * hi + xr;
          const float ni = lm.x * hi + lm.y * hr + xi;
          hr = nr; hi = ni;
          if (write_y) { Hs[tt * 136 + lane] = f2bf(hr); Hs[tt * 136 + 64 + lane] = f2bf(hi); }
        }
      }
    }
    if (write_y) {
      asm volatile("s_waitcnt lgkmcnt(0)" ::: "memory");
      __builtin_amdgcn_wave_barrier();
#pragma unroll
      for (int mt = 0; mt < 2; ++mt) {
        f32x4 y = {0.f, 0.f, 0.f, 0.f};
#pragma unroll
        for (int ks = 0; ks < 4; ++ks) {
          const bf16x8 hf = *(const bf16x8*)(Hs + (mt * 16 + fr) * 136 + ks * 32 + fq * 8);
          y = MFMA16(hf, cfr[ks], y);
        }
#pragma unroll
        for (int j = 0; j < 4; ++j) {
          const int row = rb + mt * 16 + fq * 4 + j;
          const float u = bf2f(p.ub[(size_t)row * 512 + g * 16 + fr]);
          const float v = y[j] + dsk * u;
          const float zz = 0.7978845608028654f * (v + 0.044715f * v * v * v);
          const float th = 1.f - 2.f / (__expf(2.f * zz) + 1.f);
          p.ssm_y[(size_t)row * 512 + g * 16 + fr] = f2bf(0.5f * v * (1.f + th));
        }
      }
      asm volatile("s_waitcnt lgkmcnt(0)" ::: "memory");
      __builtin_amdgcn_wave_barrier();
    }
  }
}

DI void phase2(const Params& p, char* lds) {
  const int lane = tid() & 63, wid = tid() >> 6;
  const int nb = gridDim.x, bid = blockIdx.x;
  for (int row = bid * 4 + wid; row < NT; row += nb * 4) {
    const f32x4 v = *(const f32x4*)(p.ckv_raw + (size_t)row * 256 + lane * 4);
    const f32x4 pp = *(const f32x4*)(p.ckv_part + (size_t)row * 4);
    const float rstd = rsqrtf((pp[0] + pp[1] + pp[2] + pp[3]) * (1.f / 256.f) + EPS);
    const f32x4 g = *(const f32x4*)(p.in[10] + lane * 4);
    f32x4 o; o[0] = v[0] * rstd * g[0]; o[1] = v[1] * rstd * g[1]; o[2] = v[2] * rstd * g[2]; o[3] = v[3] * rstd * g[3];
    float* dst = row < NTP ? p.out + OFF_LATP + (size_t)row * 256 : p.out + OFF_LATS + (size_t)(row - NTP) * 256;
    *(f32x4*)(dst + lane * 4) = o;
    u32x2 w; w.x = pk_bf16(o[0], o[1]); w.y = pk_bf16(o[2], o[3]);
    *(u32x2*)(p.latb + (size_t)kr_of(row) * 256 + lane * 4) = w;
  }
  for (int it = bid * 4 + wid; it < 8 * 128 * 32; it += nb * 4) {
    const int g = it & 31, c = (it >> 5) & 127, b = it >> 12;
    float hr = 0.f, hi = 0.f;
    ssm_chunk(p, b * 8192 + c * 64, g, hr, hi, false, lds + wid * 8704);
    p.E[(size_t)it * 64 + lane] = make_float2(hr, hi);
  }
  float* rs = (float*)(lds + 65536);
  {
    auto tile_fn = [&](int j, int& m0, int& n0) -> bool { const int li = (int)(blockIdx.x >> 3) + j * (int)(gridDim.x >> 3); const int ti_ = li / 6, tj_ = li - ti_ * 6; const int tbig = ti_ * 8 + (int)(blockIdx.x & 7); if (tbig >= 528) return false; m0 = tbig * 128; n0 = tj_ * 128; return true; };
    auto rs_fn = [&](int m0, int t) -> float2 { float sm = 0.f; for (int q = 0; q < 3; ++q) { const f32x4 v = *(const f32x4*)(p.cq_part + (size_t)(m0 + t) * 12 + 4 * q); sm += (v[0] + v[1]) + (v[2] + v[3]); } return make_float2(rsqrtf(sm * (1.f / 768.f) + EPS), 0.f); };
    auto epi = [&](f32x16 (&acc)[2][2], int m0, int n0, const float* rs) {
    const int tn = n0 >> 7; (void)tn;
    EPI_IDS
    const float qs = 0.10206207261596577f * 1.4426950408889634f;
#pragma unroll
    for (int mt = 0; mt < 2; ++mt) {
      const int rl = wm * 64 + mt * 32 + r, row = m0 + rl;
      const float sc = rs[rl] * qs;
      const float* rp = (const float*)(p.rope + pos_of(row) * 16);
#pragma unroll
      for (int nt = 0; nt < 2; ++nt) {
        const int cb = n0 + wn * 64 + nt * 32;
        bf16_t* qd = p.Q + (size_t)row * 768 + cb;
        if ((cb % 96) == 64) {
#pragma unroll
          for (int ih = 0; ih < 2; ++ih) {
            const int j0 = 8 * ih + 4 * hh;
            const f32x4 c01 = *(const f32x4*)(rp + 2 * j0), c23 = *(const f32x4*)(rp + 2 * j0 + 4);
            const float cc[4] = {c01[0], c01[2], c23[0], c23[2]}, sn[4] = {c01[1], c01[3], c23[1], c23[3]};
            float o1[4], o2[4];
#pragma unroll
            for (int jj = 0; jj < 4; ++jj) {
              const float x1 = acc[mt][nt][4 * ih + jj] * sc, x2 = acc[mt][nt][8 + 4 * ih + jj] * sc;
              o1[jj] = x1 * cc[jj] - x2 * sn[jj]; o2[jj] = x1 * sn[jj] + x2 * cc[jj];
            }
            u32x2 w1, w2; w1.x = pk_bf16(o1[0], o1[1]); w1.y = pk_bf16(o1[2], o1[3]); w2.x = pk_bf16(o2[0], o2[1]); w2.y = pk_bf16(o2[2], o2[3]);
            *(u32x2*)(qd + j0) = w1; *(u32x2*)(qd + 16 + j0) = w2;
          }
        } else {
#pragma unroll
          for (int i4 = 0; i4 < 4; ++i4) {
            u32x2 w; w.x = pk_bf16(acc[mt][nt][4 * i4] * sc, acc[mt][nt][4 * i4 + 1] * sc); w.y = pk_bf16(acc[mt][nt][4 * i4 + 2] * sc, acc[mt][nt][4 * i4 + 3] * sc);
            *(u32x2*)(qd + 8 * i4 + 4 * hh) = w;
          }
        }
      }
    }

    };
    gemm_stream(p.cq, 768, p.WqT, 768, 12, lds, 0, tile_fn, rs_fn, epi);
  }
}

DI void phase3(const Params& p, char* lds) {
  const int lane = tid() & 63, wid = tid() >> 6;
  const int nb = gridDim.x, bid = blockIdx.x;
  for (int it = bid * 4 + wid; it < 256; it += nb * 4) {
    const int b = it >> 5, g = it & 31;
    const float2 l64 = p.lam64[g * 64 + lane];
    float sr = 0.f, si = 0.f;
    const size_t base = ((size_t)(b * 128) * 32 + g) * 64 + lane;
    for (int c0 = 0; c0 < 128; c0 += 16) {
      float2 e[16];
#pragma unroll
      for (int j = 0; j < 16; ++j) e[j] = p.E[base + (size_t)(c0 + j) * 2048];
#pragma unroll
      for (int j = 0; j < 16; ++j) {
        p.S[base + (size_t)(c0 + j) * 2048] = make_float2(sr, si);
        const float nr = l64.x * sr - l64.y * si + e[j].x, ni = l64.x * si + l64.y * sr + e[j].y;
        sr = nr; si = ni;
      }
    }
  }
  {
    auto tile_fn = [&](int j, int& m0, int& n0) -> bool { const int li = (int)(blockIdx.x >> 3) + j * (int)(gridDim.x >> 3); const int ti_ = li / 4, tj_ = li - ti_ * 4; const int tbig = ti_ * 8 + (int)(blockIdx.x & 7); if (tbig >= 1552) return false; m0 = tbig * 128; n0 = tj_ * 128; return true; };
    auto rs_fn = [&](int m0, int t) -> float2 { return make_float2(0.f, 0.f); };
    auto epi = [&](f32x16 (&acc)[2][2], int m0, int n0, const float* rs) {
    const int tn = n0 >> 7; (void)tn;
    EPI_IDS
#pragma unroll
    for (int mt = 0; mt < 2; ++mt) {
      const int row = m0 + wm * 64 + mt * 32 + r;
#pragma unroll
      for (int nt = 0; nt < 2; ++nt)
#pragma unroll
        for (int i4 = 0; i4 < 4; ++i4) {
          u32x2 w; w.x = pk_bf16(acc[mt][nt][4 * i4], acc[mt][nt][4 * i4 + 1]); w.y = pk_bf16(acc[mt][nt][4 * i4 + 2], acc[mt][nt][4 * i4 + 3]);
          *(u32x2*)(p.Kn + (size_t)row * 512 + n0 + wn * 64 + nt * 32 + 8 * i4 + 4 * hh) = w;
        }
    }

    };
    gemm_stream(p.latb, 256, p.WkT, 256, 4, lds, 0, tile_fn, rs_fn, epi);
  }
  {
    auto tile_fn = [&](int j, int& m0, int& n0) -> bool { const int li = (int)(blockIdx.x >> 3) + j * (int)(gridDim.x >> 3); const int ti_ = li / 4, tj_ = li - ti_ * 4; const int tbig = ti_ * 8 + (int)(blockIdx.x & 7); if (tbig >= 1552) return false; n0 = tbig * 128; m0 = tj_ * 128; return true; };
    auto rs_fn = [&](int m0, int t) -> float2 { return make_float2(0.f, 0.f); };
    auto epi = [&](f32x16 (&acc)[2][2], int m0, int n0, const float* rs) {
    const int tn = n0 >> 7; (void)tn;
    EPI_IDS
#pragma unroll
    for (int nt = 0; nt < 2; ++nt)
#pragma unroll
      for (int i4 = 0; i4 < 4; ++i4) {
        const int kr = n0 + wn * 64 + nt * 32 + 8 * i4 + 4 * hh;
        size_t cbase; int S;
        if (kr < NTP) { cbase = (size_t)(kr >> 13) * 512 * 8192 + (kr & 8191); S = 8192; }
        else { const int k2 = kr - NTP, b = k2 / SKS, tt = k2 - b * SKS; cbase = VT_S_OFF + (size_t)b * 512 * SKS + tt; S = SKS; }
#pragma unroll
        for (int mt = 0; mt < 2; ++mt) {
          const int hd = m0 + wm * 64 + mt * 32 + r;
          u32x2 w; w.x = pk_bf16(acc[mt][nt][4 * i4], acc[mt][nt][4 * i4 + 1]); w.y = pk_bf16(acc[mt][nt][4 * i4 + 2], acc[mt][nt][4 * i4 + 3]);
          *(u32x2*)(p.Vt + cbase + (size_t)hd * S) = w;
        }
      }

    };
    gemm_stream(p.WvT, 256, p.latb, 256, 4, lds, 0, tile_fn, rs_fn, epi);
  }
}

template <int QT, bool HALF>
DI void attn_item(const Params& p, int kind, int b, int h, int qq, char* lds) {
  const int t = tid(), lane = t & 63, wid = t >> 6, r = lane & 31, hh = lane >> 5;
  int qrow0, nkb_w, nkb_max, S; size_t kr0; const bf16_t* vt_base;
  constexpr int RW = 32 * QT, WPC = 64 / RW, CPB = 4 / WPC;
  if (kind == 0) {
    const int c = qq * CPB + wid / WPC; qrow0 = b * 8192 + c * 64 + (wid % WPC) * RW; nkb_w = c + 1; nkb_max = qq * CPB + CPB; kr0 = (size_t)b * 8192; S = 8192;
    vt_base = p.Vt + (size_t)(b * 8 + h) * 64 * 8192;
  } else {
    qrow0 = NTP + b * 64 + (wid % WPC) * RW; nkb_w = (wid < WPC) ? 65 : 0; nkb_max = 65; kr0 = (size_t)NTP + (size_t)b * SKS; S = SKS;
    vt_base = p.Vt + VT_S_OFF + (size_t)(b * 8 + h) * 64 * SKS;
  }
  bf16x8 qf[QT][6];
#pragma unroll
  for (int qt = 0; qt < QT; ++qt)
#pragma unroll
    for (int ks = 0; ks < 6; ++ks) qf[qt][ks] = *(const bf16x8*)(p.Q + (size_t)(qrow0 + qt * 32 + r) * 768 + h * 96 + ks * 16 + hh * 8);
  f32x16 o[2][QT];
  float mrun[QT], lrun[QT];
#pragma unroll
  for (int qt = 0; qt < QT; ++qt) { mrun[qt] = -1e30f; lrun[qt] = 0.f;
#pragma unroll
    for (int dt = 0; dt < 2; ++dt)
#pragma unroll
      for (int i = 0; i < 16; ++i) o[dt][qt][i] = 0.f; }
  const int kkey = t >> 3, kc = t & 7;
  const int rkey = t >> 2, rc = t & 3;
  const int vd = t >> 3, vc = t & 7;
  const bf16_t* gk = p.Kn + (kr0 + kkey) * 512 + h * 64 + kc * 8;
  const bf16_t* gr = p.krb + (kr0 + rkey) * 32 + rc * 8;
  const bf16_t* gv = vt_base + (size_t)vd * S + vc * 8;
  const unsigned kw0 = kkey * 208 + kc * 16, kw1 = kw0 + 32 * 208, rw = rkey * 208 + 128 + rc * 16;
  const unsigned vlo = vd * 144 + (vc >> 1) * 32 + (vc & 1) * 8, vhi = vlo + 16;
  constexpr int KB = 13312, VB = 9216, BUF = KB + VB;
  u32x4 k0r, k1r, rr, v0r, v1r;
  k0r = *(const u32x4*)gk; k1r = *(const u32x4*)(gk + 32 * 512); rr = *(const u32x4*)gr;
  v0r = *(const u32x4*)gv; v1r = *(const u32x4*)(gv + (size_t)32 * S);
  __syncthreads();
  {
    char* kb_ = lds; char* vb_ = lds + KB;
    *(u32x4*)(kb_ + kw0) = k0r; *(u32x4*)(kb_ + kw1) = k1r; *(u32x4*)(kb_ + rw) = rr;
    *(u32x2*)(vb_ + vlo) = (u32x2){v0r.x, v0r.y}; *(u32x2*)(vb_ + vhi) = (u32x2){v0r.z, v0r.w};
    *(u32x2*)(vb_ + vlo + 32 * 144) = (u32x2){v1r.x, v1r.y}; *(u32x2*)(vb_ + vhi + 32 * 144) = (u32x2){v1r.z, v1r.w};
  }
  __syncthreads();
  for (int kb = 0; kb < nkb_max; ++kb) {
    const int cur = kb & 1;
    const bool more = kb + 1 < nkb_max;
    if (more) {
      const size_t ko = (size_t)(kb + 1) * 64;
      k0r = *(const u32x4*)(gk + ko * 512); k1r = *(const u32x4*)(gk + (ko + 32) * 512); rr = *(const u32x4*)(gr + ko * 32);
      v0r = *(const u32x4*)(gv + ko); v1r = *(const u32x4*)(gv + (size_t)32 * S + ko);
    }
    if (HALF && kb < nkb_w) {
      const char* kt_ = lds + cur * BUF; const char* vt_ = kt_ + KB;
#pragma unroll
      for (int kt = 0; kt < 2; ++kt) {
        f32x16 sh[QT];
#pragma unroll
        for (int qt = 0; qt < QT; ++qt)
#pragma unroll
          for (int i = 0; i < 16; ++i) sh[qt][i] = 0.f;
#pragma unroll
        for (int ks = 0; ks < 6; ++ks) {
          const bf16x8 kf = *(const bf16x8*)(kt_ + (kt * 32 + r) * 208 + ks * 32 + hh * 16);
#pragma unroll
          for (int qt = 0; qt < QT; ++qt) sh[qt] = MFMA32(kf, qf[qt][ks], sh[qt]);
        }
        bf16x8 ph[QT][2];
#pragma unroll
        for (int qt = 0; qt < QT; ++qt) {
          float mx = sh[qt][0];
#pragma unroll
          for (int i = 1; i < 16; ++i) mx = fmaxf(mx, sh[qt][i]);
          mx = fmaxf(mx, __shfl_xor(mx, 32));
          const bool need = mx > mrun[qt] + 8.f;
          if (__any(need)) {
            const float mnew = need ? mx : mrun[qt];
            const float alpha = __builtin_amdgcn_exp2f(mrun[qt] - mnew);
            mrun[qt] = mnew; lrun[qt] *= alpha;
#pragma unroll
            for (int dt = 0; dt < 2; ++dt)
#pragma unroll
              for (int i = 0; i < 16; ++i) o[dt][qt][i] *= alpha;
          }
          float ls = 0.f;
#pragma unroll
          for (int i = 0; i < 16; ++i) { const float pv = __builtin_amdgcn_exp2f(sh[qt][i] - mrun[qt]); ls += pv; sh[qt][i] = pv; }
          lrun[qt] += ls;
#pragma unroll
          for (int s2 = 0; s2 < 2; ++s2) {
            u32x4 w;
            w.x = pk_bf16(sh[qt][8 * s2 + 0], sh[qt][8 * s2 + 1]); w.y = pk_bf16(sh[qt][8 * s2 + 2], sh[qt][8 * s2 + 3]);
            w.z = pk_bf16(sh[qt][8 * s2 + 4], sh[qt][8 * s2 + 5]); w.w = pk_bf16(sh[qt][8 * s2 + 6], sh[qt][8 * s2 + 7]);
            ph[qt][s2] = __builtin_bit_cast(bf16x8, w);
          }
        }
#pragma unroll
        for (int dt = 0; dt < 2; ++dt)
#pragma unroll
          for (int s2 = 0; s2 < 2; ++s2) {
            const bf16x8 vf = *(const bf16x8*)(vt_ + (dt * 32 + r) * 144 + (kt * 2 + s2) * 32 + hh * 16);
#pragma unroll
            for (int qt = 0; qt < QT; ++qt) o[dt][qt] = MFMA32(vf, ph[qt][s2], o[dt][qt]);
          }
      }
    }
    if (!HALF && kb < nkb_w) {
      const char* kt_ = lds + cur * BUF; const char* vt_ = kt_ + KB;
      f32x16 st[2][QT];
#pragma unroll
      for (int kt = 0; kt < 2; ++kt)
#pragma unroll
        for (int qt = 0; qt < QT; ++qt)
#pragma unroll
          for (int i = 0; i < 16; ++i) st[kt][qt][i] = 0.f;
#pragma unroll
      for (int ks = 0; ks < 6; ++ks)
#pragma unroll
        for (int kt = 0; kt < 2; ++kt) {
          const bf16x8 kf = *(const bf16x8*)(kt_ + (kt * 32 + r) * 208 + ks * 32 + hh * 16);
#pragma unroll
          for (int qt = 0; qt < QT; ++qt) st[kt][qt] = MFMA32(kf, qf[qt][ks], st[kt][qt]);
        }
      bf16x8 pb[2][QT][2];
#pragma unroll
      for (int qt = 0; qt < QT; ++qt) {
        float mx = mrun[qt];
#pragma unroll
        for (int kt = 0; kt < 2; ++kt)
#pragma unroll
          for (int i = 0; i < 16; ++i) mx = fmaxf(mx, st[kt][qt][i]);
        mx = fmaxf(mx, __shfl_xor(mx, 32));
        const float alpha = __builtin_amdgcn_exp2f(mrun[qt] - mx);
        mrun[qt] = mx;
        float ls = 0.f;
#pragma unroll
        for (int kt = 0; kt < 2; ++kt) {
#pragma unroll
          for (int i = 0; i < 16; ++i) { const float pv = __builtin_amdgcn_exp2f(st[kt][qt][i] - mx); ls += pv; st[kt][qt][i] = pv; }
#pragma unroll
          for (int s2 = 0; s2 < 2; ++s2) {
            u32x4 w;
            w.x = pk_bf16(st[kt][qt][8 * s2 + 0], st[kt][qt][8 * s2 + 1]); w.y = pk_bf16(st[kt][qt][8 * s2 + 2], st[kt][qt][8 * s2 + 3]);
            w.z = pk_bf16(st[kt][qt][8 * s2 + 4], st[kt][qt][8 * s2 + 5]); w.w = pk_bf16(st[kt][qt][8 * s2 + 6], st[kt][qt][8 * s2 + 7]);
            pb[kt][qt][s2] = __builtin_bit_cast(bf16x8, w);
          }
        }
        lrun[qt] = lrun[qt] * alpha + ls;
#pragma unroll
        for (int dt = 0; dt < 2; ++dt)
#pragma unroll
          for (int i = 0; i < 16; ++i) o[dt][qt][i] *= alpha;
      }
#pragma unroll
      for (int dt = 0; dt < 2; ++dt)
#pragma unroll
        for (int kt = 0; kt < 2; ++kt)
#pragma unroll
          for (int s2 = 0; s2 < 2; ++s2) {
            const bf16x8 vf = *(const bf16x8*)(vt_ + (dt * 32 + r) * 144 + (kt * 2 + s2) * 32 + hh * 16);
#pragma unroll
            for (int qt = 0; qt < QT; ++qt) o[dt][qt] = MFMA32(vf, pb[kt][qt][s2], o[dt][qt]);
          }
    }
    if (more) {
      char* kb_ = lds + (cur ^ 1) * BUF; char* vb_ = kb_ + KB;
      *(u32x4*)(kb_ + kw0) = k0r; *(u32x4*)(kb_ + kw1) = k1r; *(u32x4*)(kb_ + rw) = rr;
      *(u32x2*)(vb_ + vlo) = (u32x2){v0r.x, v0r.y}; *(u32x2*)(vb_ + vhi) = (u32x2){v0r.z, v0r.w};
      *(u32x2*)(vb_ + vlo + 32 * 144) = (u32x2){v1r.x, v1r.y}; *(u32x2*)(vb_ + vhi + 32 * 144) = (u32x2){v1r.z, v1r.w};
    }
    __syncthreads();
  }
  if (nkb_w > 0) {
#pragma unroll
    for (int qt = 0; qt < QT; ++qt) {
      const float lt = lrun[qt] + __shfl_xor(lrun[qt], 32);
      const float inv = 1.f / lt;
      const int row = qrow0 + qt * 32 + r;
      float ss = 0.f;
#pragma unroll
      for (int dt = 0; dt < 2; ++dt)
#pragma unroll
        for (int i4 = 0; i4 < 4; ++i4) {
          const float a0 = o[dt][qt][4 * i4] * inv, a1 = o[dt][qt][4 * i4 + 1] * inv, a2 = o[dt][qt][4 * i4 + 2] * inv, a3 = o[dt][qt][4 * i4 + 3] * inv;
          ss += a0 * a0 + a1 * a1 + a2 * a2 + a3 * a3;
          u32x2 w; w.x = pk_bf16(a0, a1); w.y = pk_bf16(a2, a3);
          *(u32x2*)(p.mix + (size_t)row * 1024 + h * 64 + dt * 32 + 8 * i4 + 4 * hh) = w;
        }
      ss += __shfl_xor(ss, 32);
      if (hh == 0) p.attn_part[(size_t)row * 8 + h] = ss;
    }
  }
}

DI void phase4(const Params& p, char* lds, int qidx) {
  const int t = tid(), lane = t & 63, wid = t >> 6;
  const int nb = gridDim.x, bid = blockIdx.x;
  int* nxt = (int*)(lds + 65536);
  for (;;) {
    __syncthreads();
    if (t == 0) *nxt = atomicAdd(p.counters + qidx, 1);
    __syncthreads();
    const int it = *nxt;
    if (it >= 256 + 64 * 32) break;
    if (it < 256) attn_item<1, false>(p, 1, it >> 3, it & 7, 0, lds);
    else { const int j = it - 256; const int qq = 31 - (j >> 6), bh = j & 63; attn_item<2, true>(p, 0, bh >> 3, bh & 7, qq, lds); }
  }
  __syncthreads();
  for (int it = bid * 4 + wid; it < 8 * 128 * 32 + 1024; it += nb * 4) {
    if (it < 8 * 128 * 32) {
      const int g = it & 31, c = (it >> 5) & 127, b = it >> 12;
      const float2 s0 = p.S[(size_t)it * 64 + lane];
      float hr = s0.x, hi = s0.y;
      ssm_chunk(p, b * 8192 + c * 64, g, hr, hi, true, lds + wid * 8704);
      if (c == 127) { p.out[OFF_HRP + (size_t)(b * 32 + g) * 64 + lane] = hr; p.out[OFF_HIP + (size_t)(b * 32 + g) * 64 + lane] = hi; }
    } else {
      const int j = it - 8 * 128 * 32, g = j & 31, b = j >> 5;
      float hr = p.in[4][(size_t)(b * 32 + g) * 64 + lane], hi = p.in[5][(size_t)(b * 32 + g) * 64 + lane];
      ssm_chunk(p, NTP + b * 64, g, hr, hi, true, lds + wid * 8704);
      p.out[OFF_HRS + (size_t)(b * 32 + g) * 64 + lane] = hr; p.out[OFF_HIS + (size_t)(b * 32 + g) * 64 + lane] = hi;
    }
  }
}

DI void phase5(const Params& p, char* lds) {
  {
    auto tile_fn = [&](int j, int& m0, int& n0) -> bool { const int li = (int)(blockIdx.x >> 3) + j * (int)(gridDim.x >> 3); const int ti_ = li / 4, tj_ = li - ti_ * 4; const int tbig = ti_ * 8 + (int)(blockIdx.x & 7); if (tbig >= 528) return false; m0 = tbig * 128; n0 = tj_ * 128; return true; };
    auto rs_fn = [&](int m0, int t) -> float2 { return make_float2(0.f, 0.f); };
    auto epi = [&](f32x16 (&acc)[2][2], int m0, int n0, const float* rs) {
    const int tn = n0 >> 7; (void)tn;
    { EPI_IDS
#pragma unroll
    for (int mt = 0; mt < 2; ++mt) {
      const int row = m0 + wm * 64 + mt * 32 + r;
      float ss = 0.f;
#pragma unroll
      for (int nt = 0; nt < 2; ++nt)
#pragma unroll
        for (int i4 = 0; i4 < 4; ++i4) {
          const int col = n0 + wn * 64 + nt * 32 + 8 * i4 + 4 * hh;
          const u32x2 yv = *(const u32x2*)(p.ssm_y + (size_t)row * 512 + col);
          const float y0 = __uint_as_float(yv.x << 16), y1 = __uint_as_float(yv.x & 0xffff0000u), y2 = __uint_as_float(yv.y << 16), y3 = __uint_as_float(yv.y & 0xffff0000u);
          const float o0 = y0 / (1.f + __expf(-acc[mt][nt][4 * i4])), o1 = y1 / (1.f + __expf(-acc[mt][nt][4 * i4 + 1]));
          const float o2 = y2 / (1.f + __expf(-acc[mt][nt][4 * i4 + 2])), o3 = y3 / (1.f + __expf(-acc[mt][nt][4 * i4 + 3]));
          ss += o0 * o0 + o1 * o1 + o2 * o2 + o3 * o3;
          u32x2 w; w.x = pk_bf16(o0, o1); w.y = pk_bf16(o2, o3);
          *(u32x2*)(p.mix + (size_t)row * 1024 + 512 + col) = w;
        }
      ss += __shfl_xor(ss, 32);
      if (hh == 0) p.ssm_part[(size_t)row * 8 + tn * 2 + wn] = ss;
    }
    }

    };
    gemm_stream(p.ssm_y, 512, p.WgT, 512, 8, lds, 0, tile_fn, rs_fn, epi);
  }
}

DI void phase6(const Params& p, char* lds) {
  const int xb_ = blockIdx.x & 7, xl_ = blockIdx.x >> 3, nbx_ = gridDim.x >> 3;
  {
    auto tile_fn = [&](int j, int& m0, int& n0) -> bool { const int li6 = xl_ + j * nbx_, tm = (li6 >> 3) * 8 + xb_; if (tm >= 528) return false; m0 = tm * 128; n0 = (li6 & 7) * 128; return true; };
    auto rs_fn = [&](int m0, int t) -> float2 {
      const f32x4 a0 = *(const f32x4*)(p.attn_part + (size_t)(m0 + t) * 8), a1 = *(const f32x4*)(p.attn_part + (size_t)(m0 + t) * 8 + 4);
      const float sa = (a0[0] + a0[1]) + (a0[2] + a0[3]) + (a1[0] + a1[1]) + (a1[2] + a1[3]);
      const f32x4 b0 = *(const f32x4*)(p.ssm_part + (size_t)(m0 + t) * 8), b1 = *(const f32x4*)(p.ssm_part + (size_t)(m0 + t) * 8 + 4);
      const float sb = (b0[0] + b0[1]) + (b0[2] + b0[3]) + (b1[0] + b1[1]) + (b1[2] + b1[3]);
      const float ra = rsqrtf(sa * (1.f / 512.f) + EPS), rb = rsqrtf(sb * (1.f / 512.f) + EPS);
      return make_float2(rb, ra / rb); };
    auto epi = [&](f32x16 (&acc)[2][2], int m0, int n0, const float* rs) {
    const int tn = n0 >> 7;
    { EPI_IDS
#pragma unroll
    for (int mt = 0; mt < 2; ++mt) {
      const int rl = wm * 64 + mt * 32 + r, row = m0 + rl;
      const float sc = rs[rl];
      const float* xr = xrow(p, row);
      float ss = 0.f;
#pragma unroll
      for (int nt = 0; nt < 2; ++nt)
#pragma unroll
        for (int i4 = 0; i4 < 4; ++i4) {
          const int col = n0 + wn * 64 + nt * 32 + 8 * i4 + 4 * hh;
          const f32x4 xv = *(const f32x4*)(xr + col);
          f32x4 hv;
#pragma unroll
          for (int jj = 0; jj < 4; ++jj) { hv[jj] = xv[jj] + acc[mt][nt][4 * i4 + jj] * sc; ss += hv[jj] * hv[jj]; }
          u32x2 w; w.x = pk_bf16(hv[0], hv[1]); w.y = pk_bf16(hv[2], hv[3]);
          *(u32x2*)(p.hb + (size_t)row * 1024 + col) = w;
          if (i4 == 1 || i4 == 3) __builtin_amdgcn_sched_barrier(0);
        }
      ss += __shfl_xor(ss, 32);
      if (hh == 0) p.h_part[(size_t)row * 16 + tn * 2 + wn] = ss;
    }
    }
    };
    gemm_stream(p.mix, 1024, p.WoT, 1024, 16, lds, 8, tile_fn, rs_fn, epi);
  }
}

DI void phase7(const Params& p, char* lds) {
  float* rs = (float*)(lds + 65536);
  const int xb_ = blockIdx.x & 7, xl_ = blockIdx.x >> 3, nbx_ = gridDim.x >> 3;
  {
    auto tile_fn = [&](int j, int& m0, int& n0) -> bool { const int tm = j * (nbx_ >> 2) + (xl_ >> 2); if (tm >= 528) return false; m0 = tm * 128; n0 = (xb_ * 4 + (xl_ & 3)) * 128; return true; };
    auto rs_fn = [&](int m0, int t) -> float2 { float sm = 0.f; for (int q = 0; q < 4; ++q) { const f32x4 v = *(const f32x4*)(p.h_part + (size_t)(m0 + t) * 16 + 4 * q); sm += (v[0] + v[1]) + (v[2] + v[3]); } return make_float2(rsqrtf(sm * (1.f / 1024.f) + EPS), 0.f); };
    auto epi = [&](f32x16 (&acc)[2][2], int m0, int n0, const float* rs) {
    const int tn = n0 >> 7; (void)tn;
    { EPI_IDS
#pragma unroll
    for (int mt = 0; mt < 2; ++mt) {
      const int rl = wm * 64 + mt * 32 + r, row = m0 + rl;
      const float sc = rs[rl];
#pragma unroll
      for (int nt = 0; nt < 2; ++nt)
#pragma unroll
        for (int i4 = 0; i4 < 4; ++i4) {
          float v[4];
#pragma unroll
          for (int jj = 0; jj < 4; ++jj) { const float a = fmaxf(acc[mt][nt][4 * i4 + jj] * sc, 0.f); v[jj] = a * a; }
          u32x2 w; w.x = pk_bf16(v[0], v[1]); w.y = pk_bf16(v[2], v[3]);
          { const int col = n0 + wn * 64 + nt * 32 + 8 * i4 + 4 * hh;
            *(u32x2*)(p.act + (((size_t)(row >> 7) * 64 + (col >> 6)) * 128 + (row & 127)) * 64 + (col & 63)) = w; }
        }
    }
    }

    };
    gemm_stream(p.hb, 1024, p.WuT, 1024, 16, lds, 0, tile_fn, rs_fn, epi);
  }
}

DI void phase8(const Params& p, char* lds) {
  const int xb_ = blockIdx.x & 7, xl_ = blockIdx.x >> 3, nbx_ = gridDim.x >> 3;
  {
    auto tile_fn = [&](int j, int& m0, int& n0) -> bool { const int li = (int)(blockIdx.x >> 3) + j * (int)(gridDim.x >> 3); const int ti_ = li / 8, tj_ = li - ti_ * 8; const int tbig = ti_ * 8 + (int)(blockIdx.x & 7); if (tbig >= 528) return false; m0 = tbig * 128; n0 = tj_ * 128; return true; };
    auto rs_fn = [&](int m0, int t) -> float2 { return make_float2(0.f, 0.f); };
    auto epi = [&](f32x16 (&acc)[2][2], int m0, int n0, const float* rs) {
    const int tn = n0 >> 7; (void)tn;
    { EPI_IDS
#pragma unroll
    for (int mt = 0; mt < 2; ++mt) {
      const int row = m0 + wm * 64 + mt * 32 + r;
      float ss = 0.f;
#pragma unroll
      for (int nt = 0; nt < 2; ++nt)
#pragma unroll
        for (int i4 = 0; i4 < 4; ++i4) {
          float* yp = p.out + OFF_Y + (size_t)row * 1024 + n0 + wn * 64 + nt * 32 + 8 * i4 + 4 * hh;
          const u32x2 hq = *(const u32x2*)(p.hb + (size_t)row * 1024 + n0 + wn * 64 + nt * 32 + 8 * i4 + 4 * hh);
          f32x4 ov = {__uint_as_float(hq.x << 16), __uint_as_float(hq.x & 0xffff0000u), __uint_as_float(hq.y << 16), __uint_as_float(hq.y & 0xffff0000u)};
#pragma unroll
          for (int jj = 0; jj < 4; ++jj) { ov[jj] += acc[mt][nt][4 * i4 + jj]; ss += ov[jj] * ov[jj]; }
          *(f32x4*)yp = ov;
          if (i4 == 1 || i4 == 3) __builtin_amdgcn_sched_barrier(0);
        }
      ss += __shfl_xor(ss, 32);
      if (hh == 0) p.out_part[(size_t)row * 16 + tn * 2 + wn] = ss;
    }
    }

    };
    gemm_stream<true>(p.act, 4096, p.WdT, 4096, 64, lds, 0, tile_fn, rs_fn, epi);
  }
}

DI void phase9(const Params& p) {
  const int t = tid(), lane = t & 63, wid = t >> 6;
  for (int row = blockIdx.x * 4 + wid; row < NT; row += gridDim.x * 4) {
    float s = 0.f;
    for (int j = 0; j < 16; ++j) s += p.out_part[(size_t)row * 16 + j];
    const float rstd = rsqrtf(s * (1.f / 1024.f) + EPS);
    float* y = p.out + OFF_Y + (size_t)row * 1024;
#pragma unroll
    for (int j = 0; j < 4; ++j) {
      f32x4 v = *(const f32x4*)(y + lane * 4 + 256 * j);
      const f32x4 g = *(const f32x4*)(p.in[27] + lane * 4 + 256 * j);
      v[0] *= rstd * g[0]; v[1] *= rstd * g[1]; v[2] *= rstd * g[2]; v[3] *= rstd * g[3];
      *(f32x4*)(y + lane * 4 + 256 * j) = v;
    }
  }
}

DI void grid_barrier(unsigned* cnt, unsigned target) {
  asm volatile("s_waitcnt vmcnt(0)" ::: "memory");
  __syncthreads();
  if (tid() == 0) {
    __builtin_amdgcn_fence(__ATOMIC_RELEASE, "agent");
    asm volatile("s_waitcnt vmcnt(0)" ::: "memory");
    __hip_atomic_fetch_add(cnt, 1u, __ATOMIC_RELAXED, __HIP_MEMORY_SCOPE_AGENT);
    while (__hip_atomic_load(cnt, __ATOMIC_RELAXED, __HIP_MEMORY_SCOPE_AGENT) < target) __builtin_amdgcn_s_sleep(2);
  }
  __syncthreads();
  __builtin_amdgcn_fence(__ATOMIC_ACQUIRE, "agent");
  asm volatile("s_waitcnt vmcnt(0)" ::: "memory");
}

#define XB_TMO      128
#define XB_XCNT(j)  (256  + 64 * (j))
#define XB_XSUB(j)  (1280 + 64 * (j))
#define XB_XGEN(j)  (2304 + 64 * (j))
#define XB_TOP      3328
#define XB_TOPGEN   3392
#define XCD_BAR_WORDS 3456
#define XB_SPIN_CAP (1u << 22)
#define LAS __attribute__((address_space(3)))
DI unsigned xb_ld(unsigned* p)              { return __hip_atomic_load(p, __ATOMIC_RELAXED, __HIP_MEMORY_SCOPE_AGENT); }
DI unsigned xb_add(unsigned* p, unsigned v) { return __hip_atomic_fetch_add(p, v, __ATOMIC_RELAXED, __HIP_MEMORY_SCOPE_AGENT); }
DI unsigned xb_xcc_id() { return (unsigned)__builtin_amdgcn_s_getreg((3 << 11) | 20) & 0xFu; }
#define XB_SPIN(cond, bar) do { unsigned _sp = 0; while (cond) { __builtin_amdgcn_s_sleep(1); \
    if ((++_sp & 255u) == 0u) { if (xb_ld(&(bar)[XB_TMO])) break; if (_sp > XB_SPIN_CAP) { atomicAdd(&(bar)[XB_TMO], 1u); break; } } } } while (0)
struct XcdBarrier { unsigned* bar; unsigned x; volatile LAS unsigned* st; };
DI XcdBarrier xcd_barrier_post(unsigned* bar, volatile LAS unsigned* st) {
  XcdBarrier b; b.bar = bar; b.x = xb_xcc_id(); b.st = st;
  if (tid() == 0) (void)xb_add(&bar[XB_XCNT(b.x)], 1u);
  return b;
}
DI void xcd_barrier_complete(unsigned* bar, unsigned x, unsigned& nloc, unsigned& nx) {
  const unsigned G = gridDim.x * gridDim.y * gridDim.z;
  unsigned sum, cnt, mine, sp = 0u;
  for (;;) {
    sum = 0u; cnt = 0u; mine = 0u;
#pragma unroll
    for (unsigned j = 0; j < 16; ++j) { const unsigned c = xb_ld(&bar[XB_XCNT(j)]); sum += c; cnt += (c > 0u) ? 1u : 0u; mine = (j == x) ? c : mine; }
    if (sum == G) break;
    __builtin_amdgcn_s_sleep(1);
    if ((++sp & 255u) == 0u) { if (xb_ld(&bar[XB_TMO])) break; if (sp > XB_SPIN_CAP) { atomicAdd(&bar[XB_TMO], 1u); break; } }
  }
  nloc = mine > 0u ? mine : 1u; nx = cnt > 0u ? cnt : 1u;
}
DI void xcd_barrier(const XcdBarrier& b) {
  asm volatile("s_waitcnt vmcnt(0)" ::: "memory");
  __syncthreads();
  if (tid() == 0) {
    unsigned* bar = b.bar;
    __builtin_amdgcn_s_waitcnt(0);
    unsigned nloc = b.st[0], nx = b.st[1];
    if (nloc == 0u) { xcd_barrier_complete(bar, b.x, nloc, nx); b.st[0] = nloc; b.st[1] = nx; }
    const unsigned old = xb_add(&bar[XB_XSUB(b.x)], 1u);
    const unsigned gen = old / nloc;
    if (old + 1u == (gen + 1u) * nloc) {
      __builtin_amdgcn_fence(__ATOMIC_RELEASE, "agent");
      asm volatile("s_waitcnt vmcnt(0)" ::: "memory");
      const unsigned og = xb_add(&bar[XB_TOP], 1u);
      const unsigned tg = og / nx;
      if (og + 1u == (tg + 1u) * nx) xb_add(&bar[XB_TOPGEN], 1u);
      else XB_SPIN(xb_ld(&bar[XB_TOPGEN]) == tg, bar);
      __builtin_amdgcn_fence(__ATOMIC_ACQUIRE, "agent");
      xb_add(&bar[XB_XGEN(b.x)], 1u);
      asm volatile("s_waitcnt vmcnt(0)" ::: "memory");
    } else {
      XB_SPIN(xb_ld(&bar[XB_XGEN(b.x)]) == gen, bar);
      __builtin_amdgcn_fence(__ATOMIC_ACQUIRE, "agent");
      asm volatile("s_waitcnt vmcnt(0)" ::: "memory");
    }
  }
  __syncthreads();
}

template <bool COOP>
__global__ void __launch_bounds__(256, 2) mega(Params p) {
  __shared__ __attribute__((aligned(16))) char lds[LDS_BYTES];
  XcdBarrier xb{};
  if (COOP) {
    volatile LAS unsigned* st = (volatile LAS unsigned*)(lds + 67584);
    if (tid() == 0) { st[0] = 0u; st[1] = 0u; }
    __syncthreads();
    xb = xcd_barrier_post((unsigned*)p.counters + 64, st);
  }
  for (int ph = p.ph_lo; ph < p.ph_hi; ++ph) {
#ifdef ONLY_PHASE
    if (ph != ONLY_PHASE) continue;
#endif
    switch (ph) {
      case 0: phase0(p, lds); break;
      case 1: phase1(p, lds); break;
      case 2: phase2(p, lds); break;
      case 3: phase3(p, lds); break;
      case 4: phase4(p, lds, 0); break;
      case 5: phase5(p, lds); break;
      case 6: phase6(p, lds); break;
      case 7: phase7(p, lds); break;
      case 8: phase8(p, lds); break;
      default: phase9(p); break;
    }
#ifdef DOUBLE_PHASE
    if (ph == DOUBLE_PHASE) {
      __syncthreads();
      switch (ph) { case 0: phase0(p, lds); break; case 1: phase1(p, lds); break; case 2: phase2(p, lds); break; case 3: phase3(p, lds); break; case 4: phase4(p, lds, 1); break;
                    case 5: phase5(p, lds); break; case 6: phase6(p, lds); break; case 7: phase7(p, lds); break; default: break; }
    }
#endif
    if (COOP) { if (ph + 1 < p.ph_hi) { if (ph == 0) cg::this_grid().sync(); else xcd_barrier(xb); } }
  }
}

static size_t al256(size_t x) { return (x + 255) & ~(size_t)255; }

extern "C" void kernel_launch(void* const* d_in, const int* in_sizes, int n_in, void* d_out, int out_size, void* d_ws, size_t ws_size, hipStream_t stream) {
  Params p{};
  for (int i = 0; i < 28; ++i) p.in[i] = (const float*)d_in[i];
  p.out = (float*)d_out;
  char* base = (char*)d_ws; size_t off = 0;
  auto take = [&](size_t bytes) { char* q = base + off; off = al256(off + bytes); return q; };
  p.WinT = (bf16_t*)take((size_t)1664 * 1024 * 2);
  p.WqT = (bf16_t*)take((size_t)768 * 768 * 2);
  p.WkT = (bf16_t*)take((size_t)512 * 256 * 2);
  p.WvT = (bf16_t*)take((size_t)512 * 256 * 2);
  p.WgT = (bf16_t*)take((size_t)512 * 512 * 2);
  p.WoT = (bf16_t*)take((size_t)1024 * 1024 * 2);
  p.WuT = (bf16_t*)take((size_t)4096 * 1024 * 2);
  p.WdT = (bf16_t*)take((size_t)1024 * 4096 * 2);
  p.BbT = (bf16_t*)take((size_t)32 * 128 * 16 * 2);
  p.CcT = (bf16_t*)take((size_t)32 * 16 * 128 * 2);
  p.lam = (float2*)take(2048 * 8);
  p.lam64 = (float2*)take(2048 * 8);
  p.rope = (float2*)take((size_t)8192 * 16 * 8);
  p.rstd_x = (float*)take((size_t)NT * 4);
  p.cq_part = (float*)take((size_t)NT * 12 * 4);
  p.ckv_part = (float*)take((size_t)NT * 4 * 4);
  p.attn_part = (float*)take((size_t)NT * 8 * 4);
  p.ssm_part = (float*)take((size_t)NT * 8 * 4);
  p.h_part = (float*)take((size_t)NT * 16 * 4);
  p.out_part = (float*)take((size_t)NT * 16 * 4);
  p.counters = (int*)take(16384);
  p.E = (float2*)take((size_t)8 * 128 * 32 * 64 * 8);
  p.S = (float2*)take((size_t)8 * 128 * 32 * 64 * 8);
  const size_t a0 = off;
  p.Kn = (bf16_t*)take((size_t)NK * 512 * 2);
  const size_t aVt = off;
  p.Vt = (bf16_t*)take((size_t)NK * 512 * 2);
  p.Q = (bf16_t*)take((size_t)NT * 768 * 2);
  p.latb = (bf16_t*)take((size_t)NK * 256 * 2);
  p.krb = (bf16_t*)take((size_t)NK * 32 * 2);
  p.ub = (bf16_t*)take((size_t)NT * 512 * 2);
  const size_t aSsmY = off;
  p.ssm_y = (bf16_t*)take((size_t)NT * 512 * 2);
  p.mix = (bf16_t*)take((size_t)NT * 1024 * 2);
  const size_t total = off;
  p.xb = (bf16_t*)(base + a0);
  p.cq = (bf16_t*)(base + aVt);
  p.ckv_raw = (float*)(base + aVt + al256((size_t)NT * 768 * 2));
  p.act = (bf16_t*)(base + a0);
  const size_t aHb = a0 + al256((size_t)NT * 4096 * 2);
  p.hb = (bf16_t*)(base + aHb);
  if (aHb + (size_t)NT * 1024 * 2 > aSsmY || total > ws_size) { fprintf(stderr, "workspace layout error: total %zu ws %zu\n", total, ws_size); return; }

  const int MULTI = 0;
  hipMemsetAsync(p.counters, 0, 16384, stream);
  if (MULTI) {
    for (int ph = 0; ph < NPHASE; ++ph) {
      p.ph_lo = ph; p.ph_hi = ph + 1;
      hipLaunchKernelGGL(mega<false>, dim3(512), dim3(256), 0, stream, p);
    }
  } else {
    static int grid_blocks = 0;
    if (!grid_blocks) {
      int dev = 0, cus = 0, per_cu = 0;
      hipGetDevice(&dev);
      hipDeviceGetAttribute(&cus, hipDeviceAttributeMultiprocessorCount, dev);
      hipOccupancyMaxActiveBlocksPerMultiprocessor(&per_cu, mega<true>, 256, 0);
      grid_blocks = cus * per_cu;
    }
    p.ph_lo = 0; p.ph_hi = NPHASE;
    void* args[] = {&p};
    hipError_t e = hipLaunchCooperativeKernel((void*)mega<true>, dim3(grid_blocks), dim3(256), args, 0, stream);
    if (e != hipSuccess) fprintf(stderr, "cooperative launch failed: %s (grid %d)\n", hipGetErrorString(e), grid_blocks);
  }
}
```

```cpp
#include <hip/hip_runtime.h>
#include <hip/hip_cooperative_groups.h>
#include <stdint.h>
#include <cstdio>
namespace cg = cooperative_groups;
#define DI __device__ __forceinline__

typedef unsigned short bf16_t;
typedef short bf16x8 __attribute__((ext_vector_type(8)));
typedef float f32x16 __attribute__((ext_vector_type(16)));
typedef float f32x4 __attribute__((ext_vector_type(4)));
typedef unsigned u32x4 __attribute__((ext_vector_type(4)));
typedef unsigned u32x2 __attribute__((ext_vector_type(2)));

constexpr int NTP = 65536, NTS = 2048, NT = NTP + NTS, NK = NTP + 32 * 4160;
constexpr int SKS = 4160;
constexpr size_t OFF_Y = 0;
constexpr size_t OFF_LATP = (size_t)NT * 1024;
constexpr size_t OFF_KRP = OFF_LATP + (size_t)NTP * 256;
constexpr size_t OFF_HRP = OFF_KRP + (size_t)NTP * 32;
constexpr size_t OFF_HIP = OFF_HRP + 8 * 32 * 64;
constexpr size_t OFF_LATS = OFF_HIP + 8 * 32 * 64;
constexpr size_t OFF_KRS = OFF_LATS + (size_t)NTS * 256;
constexpr size_t OFF_HRS = OFF_KRS + (size_t)NTS * 32;
constexpr size_t OFF_HIS = OFF_HRS + 32 * 32 * 64;
constexpr size_t VT_S_OFF = (size_t)8 * 512 * 8192;
constexpr float EPS = 1e-6f;
constexpr int LDS_BYTES = 67600;
constexpr int NPHASE = 10;
constexpr int AQT = 1, NQQ = 128 / (4 / (64 / (32 * AQT)));

struct Params {
  const float* in[28];
  float* out;
  bf16_t *WinT, *WqT, *WkT, *WvT, *WgT, *WoT, *WuT, *WdT, *BbT, *CcT;
  float2 *lam, *lam64, *rope;
  float *rstd_x, *cq_part, *ckv_part, *attn_part, *ssm_part, *h_part, *out_part;
  int* counters;
  float2 *E, *S;
  bf16_t *Kn, *Vt, *Q, *latb, *krb, *ub, *ssm_y, *mix, *xb, *cq, *hb, *act;
  float* ckv_raw;
  int ph_lo, ph_hi;
};

DI int tid() { int t = __builtin_amdgcn_workitem_id_x(); asm volatile("" : "+v"(t)); return t; }
typedef __bf16 nbf16x2 __attribute__((ext_vector_type(2)));
typedef float f32x2 __attribute__((ext_vector_type(2)));
DI unsigned pk_bf16(float lo, float hi) { f32x2 v = {lo, hi}; return __builtin_bit_cast(unsigned, __builtin_convertvector(v, nbf16x2)); }
DI bf16_t f2bf(float x) { return (bf16_t)(pk_bf16(x, 0.f) & 0xffffu); }
DI float bf2f(bf16_t v) { return __uint_as_float(((unsigned)v) << 16); }
DI int crow(int i, int hh) { return (i & 3) + 8 * (i >> 2) + 4 * hh; }
DI const float* xrow(const Params& p, int row) { return row < NTP ? p.in[0] + (size_t)row * 1024 : p.in[1] + (size_t)(row - NTP) * 1024; }
DI int pos_of(int row) { return row < NTP ? (row & 8191) : 4096 + ((row - NTP) & 63); }
DI int kr_of(int row) { return row < NTP ? row : NTP + ((row - NTP) >> 6) * SKS + 4096 + ((row - NTP) & 63); }
#define MFMA32(a, b, c) __builtin_amdgcn_mfma_f32_32x32x16_bf16((a), (b), (c), 0, 0, 0)
#define MFMA16(a, b, c) __builtin_amdgcn_mfma_f32_16x16x32_bf16((a), (b), (c), 0, 0, 0)

DI void sincos_d(double x, double& s4, double& c4) {
  double k = rint(x * 0.15915494309189535);
  double rr = fma(-k, 6.283185307179586, x);
  rr = fma(-k, 2.4492935982947064e-16, rr);
  double y = rr * 0.25, y2 = y * y;
  double s = y * (1 - y2 / 6 * (1 - y2 / 20 * (1 - y2 / 42 * (1 - y2 / 72 * (1 - y2 / 110 * (1 - y2 / 156 * (1 - y2 / 210)))))));
  double c = 1 - y2 / 2 * (1 - y2 / 12 * (1 - y2 / 30 * (1 - y2 / 56 * (1 - y2 / 90 * (1 - y2 / 132 * (1 - y2 / 182))))));
  double s2 = 2 * s * c, c2 = 1 - 2 * s * s;
  s4 = 2 * s2 * c2; c4 = 1 - 2 * s2 * s2;
}

DI void gemm_core(const bf16_t* __restrict__ A, int lda, const bf16_t* __restrict__ B, int ldb, int nk,
                  int m0, int n0, char* lds, f32x16 (&acc)[2][2], int midk, const float* ratio) {
  const int t = tid(), lane = t & 63, wid = t >> 6, wm = wid >> 1, wn = wid & 1;
  const int r = lane & 31, hh = lane >> 5;
  const int lc = t & 7, lr = t >> 3;
  const unsigned woff = lr * 128 + ((lc ^ ((lr >> 1) & 7)) << 4);
  const bf16_t* ga = A + (size_t)(m0 + lr) * lda + lc * 8;
  const bf16_t* gb = B + (size_t)(n0 + lr) * ldb + lc * 8;
  char* sA = lds; char* sB = lds + 32768;
  u32x4 ra[4], rb[4];
#pragma unroll
  for (int i = 0; i < 4; ++i) { ra[i] = *(const u32x4*)(ga + (size_t)(32 * i) * lda); rb[i] = *(const u32x4*)(gb + (size_t)(32 * i) * ldb); }
#pragma unroll
  for (int i = 0; i < 4; ++i) { *(u32x4*)(sA + woff + i * 4096) = ra[i]; *(u32x4*)(sB + woff + i * 4096) = rb[i]; }
#pragma unroll
  for (int a = 0; a < 2; ++a)
#pragma unroll
    for (int b = 0; b < 2; ++b)
#pragma unroll
      for (int i = 0; i < 16; ++i) acc[a][b][i] = 0.f;
  __syncthreads();
  const int rsw = (r >> 1) & 7;
  const unsigned aoff = (wm * 64 + r) * 128, boff = (wn * 64 + r) * 128;
  for (int kt = 0; kt < nk; ++kt) {
    const int cur = kt & 1;
    const bool more = (kt + 1 < nk);
    if (more) {
      const bf16_t* ga2 = ga + (kt + 1) * 64; const bf16_t* gb2 = gb + (kt + 1) * 64;
#pragma unroll
      for (int i = 0; i < 4; ++i) { ra[i] = *(const u32x4*)(ga2 + (size_t)(32 * i) * lda); rb[i] = *(const u32x4*)(gb2 + (size_t)(32 * i) * ldb); }
    }
    if (midk && kt == midk) {
#pragma unroll
      for (int mt = 0; mt < 2; ++mt)
      { const float f = ratio[wm * 64 + mt * 32 + r];
#pragma unroll
        for (int i = 0; i < 16; ++i) { acc[mt][0][i] *= f; acc[mt][1][i] *= f; } }
    }
    const char* cA = sA + cur * 16384; const char* cB = sB + cur * 16384;
#pragma unroll
    for (int ks = 0; ks < 4; ++ks) {
      const unsigned co = (((ks * 2 + hh) ^ rsw) << 4);
      const bf16x8 a0 = *(const bf16x8*)(cA + aoff + co), a1 = *(const bf16x8*)(cA + aoff + 4096 + co);
      const bf16x8 b0 = *(const bf16x8*)(cB + boff + co), b1 = *(const bf16x8*)(cB + boff + 4096 + co);
      acc[0][0] = MFMA32(b0, a0, acc[0][0]); acc[0][1] = MFMA32(b1, a0, acc[0][1]);
      acc[1][0] = MFMA32(b0, a1, acc[1][0]); acc[1][1] = MFMA32(b1, a1, acc[1][1]);
    }
    if (more) {
      char* nA = sA + (cur ^ 1) * 16384; char* nB = sB + (cur ^ 1) * 16384;
#pragma unroll
      for (int i = 0; i < 4; ++i) { *(u32x4*)(nA + woff + i * 4096) = ra[i]; *(u32x4*)(nB + woff + i * 4096) = rb[i]; }
    }
    __syncthreads();
  }
}

DI void rowscale_load(float* rs, const float* src, int np, float inv_dim, int m0) {
  const int t = tid();
  if (t < 128) {
    const int row = m0 + t;
    if (np == 0) rs[t] = src[row];
    else { float s = 0.f; for (int j = 0; j < np; ++j) s += src[(size_t)row * np + j]; rs[t] = rsqrtf(s * inv_dim + EPS); }
  }
}

template <bool BLKA = false, class TileFn, class RsFn, class EpiFn>
DI void gemm_stream(const bf16_t* __restrict__ A, int lda, const bf16_t* __restrict__ B, int ldb, int nk, char* lds, int midk,
                    TileFn tile_fn, RsFn rs_fn, EpiFn epi) {
  int m0, n0;
  if (!tile_fn(0, m0, n0)) return;
  const int t = tid(), lane = t & 63, wid = t >> 6, wm = wid >> 1, wn = wid & 1;
  const int r = lane & 31, hh = lane >> 5;
  const int lc = t & 7, lr = t >> 3;
  const unsigned woff = lr * 128 + ((lc ^ ((lr >> 1) & 7)) << 4);
  char* sA = lds; char* sB = lds + 32768;
  float* rsbuf = (float*)(lds + 65536);
  const int rsw = (r >> 1) & 7;
  const unsigned aoff = (wm * 64 + r) * 128, boff = (wn * 64 + r) * 128;
  int lj = 0, lkt = 0, lm0 = m0, ln0 = n0; bool lvalid = true;
  u32x4 ra0[4], rb0[4], ra1[4], rb1[4];
#define GS_LOAD(RA, RB) do {   \
        \
      const bf16_t* ga_ = BLKA ? A + ((size_t)(lm0 >> 7) * nk + lkt) * 8192 + lr * 64 + lc * 8 : A + (size_t)(lm0 + lr) * lda + lc * 8 + lkt * 64; const bf16_t* gb_ = B + (size_t)(ln0 + lr) * ldb + lc * 8 + lkt * 64; \
      _Pragma("unroll") for (int i = 0; i < 4; ++i) { RA[i] = *(const u32x4*)(ga_ + (size_t)(32 * i) * (BLKA ? 64 : lda)); RB[i] = *(const u32x4*)(gb_ + (size_t)(32 * i) * ldb); } \
      if (++lkt == nk) { lkt = 0; if (lvalid) { ++lj; lvalid = tile_fn(lj, lm0, ln0); } } } while (0)
  GS_LOAD(ra0, rb0);
  GS_LOAD(ra1, rb1);
  {
    float2 rv = make_float2(0.f, 0.f);
    if (t < 128) rv = rs_fn(m0, t);
    __syncthreads();
#pragma unroll
    for (int i = 0; i < 4; ++i) { *(u32x4*)(sA + woff + i * 4096) = ra0[i]; *(u32x4*)(sB + woff + i * 4096) = rb0[i]; }
    if (t < 128) { rsbuf[t] = rv.x; rsbuf[128 + t] = rv.y; }
    __syncthreads();
  }
  int cur = 0;
  for (int j = 0;; ++j) {
    int m1 = 0, n1 = 0;
    const bool has_next = tile_fn(j + 1, m1, n1);
    const float* rs = rsbuf + (j & 1) * 256;
    f32x16 acc[2][2];
#pragma unroll
    for (int a = 0; a < 2; ++a)
#pragma unroll
      for (int b = 0; b < 2; ++b)
#pragma unroll
        for (int i = 0; i < 16; ++i) acc[a][b][i] = 0.f;
#define GS_STEP(RL_A, RL_B, RW_A, RW_B, KT) do { \
      const bool last_ = ((KT) + 1 == nk); const bool wr_ = !last_ || has_next; \
      float2 rv_ = make_float2(0.f, 0.f); \
      if (last_ && has_next) { if (t < 128) rv_ = rs_fn(m1, t); asm volatile("" : "+v"(rv_.x), "+v"(rv_.y)); }   \
      GS_LOAD(RL_A, RL_B); \
      if (midk && (KT) == midk) { _Pragma("unroll") for (int mt = 0; mt < 2; ++mt) { const float f = rs[128 + wm * 64 + mt * 32 + r]; \
          _Pragma("unroll") for (int i = 0; i < 16; ++i) { acc[mt][0][i] *= f; acc[mt][1][i] *= f; } } } \
      const char* cA = sA + cur * 16384; const char* cB = sB + cur * 16384; \
      __builtin_amdgcn_iglp_opt(0); \
      _Pragma("unroll") for (int ks = 0; ks < 4; ++ks) { \
        const unsigned co = (((ks * 2 + hh) ^ rsw) << 4); \
        const bf16x8 a0 = *(const bf16x8*)(cA + aoff + co), a1 = *(const bf16x8*)(cA + aoff + 4096 + co); \
        const bf16x8 b0 = *(const bf16x8*)(cB + boff + co), b1 = *(const bf16x8*)(cB + boff + 4096 + co); \
        acc[0][0] = MFMA32(b0, a0, acc[0][0]); acc[0][1] = MFMA32(b1, a0, acc[0][1]); \
        acc[1][0] = MFMA32(b0, a1, acc[1][0]); acc[1][1] = MFMA32(b1, a1, acc[1][1]); } \
      if (wr_) { char* nA = sA + (cur ^ 1) * 16384; char* nB = sB + (cur ^ 1) * 16384; \
        _Pragma("unroll") for (int i = 0; i < 4; ++i) { *(u32x4*)(nA + woff + i * 4096) = RW_A[i]; *(u32x4*)(nB + woff + i * 4096) = RW_B[i]; } \
        if (last_ && t < 128) { float* rn = rsbuf + ((j + 1) & 1) * 256; rn[t] = rv_.x; rn[128 + t] = rv_.y; } } \
      __syncthreads(); cur ^= 1; } while (0)
    for (int kt = 0; kt < nk; kt += 2) {
      GS_STEP(ra0, rb0, ra1, rb1, kt);
      GS_STEP(ra1, rb1, ra0, rb0, kt + 1);
    }
    epi(acc, m0, n0, rs);
    if (!has_next) break;
    m0 = m1; n0 = n1;
  }
#undef GS_STEP
#undef GS_LOAD
  __syncthreads();
}

DI float half_reduce(float s) {
  s += __shfl_xor(s, 1); s += __shfl_xor(s, 2); s += __shfl_xor(s, 4); s += __shfl_xor(s, 8); s += __shfl_xor(s, 16); return s;
}

#define EPI_IDS int t = tid(); asm volatile("" : "+v"(t)); const int lane = t & 63, wid = t >> 6, wm = wid >> 1, wn = wid & 1, r = lane & 31, hh = lane >> 5; (void)lane; (void)wid; (void)wm; (void)wn; (void)r; (void)hh;
#define GEMM_IDS const int t = tid(), lane = t & 63, wid = t >> 6, wm = wid >> 1, wn = wid & 1, r = lane & 31, hh = lane >> 5; (void)t; (void)wm; (void)wn; (void)r; (void)hh;

DI void transpose_tile(const float* __restrict__ src, int ld, int K, int kt, int nt, int job, const float* g0, const float* g1, bf16_t* __restrict__ dst, char* lds) {
  bf16_t* tile = (bf16_t*)lds;
  const int t = tid(), nl = t & 63, kq = t >> 6;
  const int n = nt * 64 + nl;
  int c = n;
  if (job == 0) { c = n < 1024 ? n : (n < 1536 ? 1056 + (n - 1024) : (n < 1568 ? 1024 + (n - 1536) : -1)); }
  else if (job == 2) c = (n >> 6) * 128 + (n & 63);
  else if (job == 3) c = (n >> 6) * 128 + 64 + (n & 63);
#pragma unroll 4
  for (int pass = 0; pass < 16; ++pass) {
    const int kl = pass * 4 + kq, k = kt * 64 + kl;
    float v = 0.f;
    if (c >= 0) {
      v = src[(size_t)k * ld + c];
      if (g0) { const float g = (g1 && k >= 512) ? g1[k - 512] : g0[k]; v *= g; }
    }
    tile[nl * 66 + kl] = f2bf(v);
  }
  __syncthreads();
  const int kl = t & 63;
#pragma unroll 4
  for (int pass = 0; pass < 16; ++pass) { const int nl2 = pass * 4 + kq; dst[(size_t)(nt * 64 + nl2) * K + kt * 64 + kl] = tile[nl2 * 66 + kl]; }
  __syncthreads();
}

DI void phase0(const Params& p, char* lds) {
  const int t = tid(), nb = gridDim.x, bid = blockIdx.x, lane = t & 63, wid = t >> 6;
  for (int ti = bid; ti < 2992; ti += nb) {
    int job, base, nNt, ld, K; const float* src; const float* g0 = nullptr; const float* g1 = nullptr; bf16_t* dst;
    if (ti < 416) { job = 0; base = 0; nNt = 26; ld = 1568; K = 1024; src = p.in[7]; g0 = p.in[6]; dst = p.WinT; }
    else if (ti < 560) { job = 1; base = 416; nNt = 12; ld = 768; K = 768; src = p.in[9]; g0 = p.in[8]; dst = p.WqT; }
    else if (ti < 592) { job = 2; base = 560; nNt = 8; ld = 1024; K = 256; src = p.in[11]; dst = p.WkT; }
    else if (ti < 624) { job = 3; base = 592; nNt = 8; ld = 1024; K = 256; src = p.in[11]; dst = p.WvT; }
    else if (ti < 688) { job = 4; base = 624; nNt = 8; ld = 512; K = 512; src = p.in[20]; dst = p.WgT; }
    else if (ti < 944) { job = 5; base = 688; nNt = 16; ld = 1024; K = 1024; src = p.in[23]; g0 = p.in[21]; g1 = p.in[22]; dst = p.WoT; }
    else if (ti < 1968) { job = 6; base = 944; nNt = 64; ld = 4096; K = 1024; src = p.in[25]; g0 = p.in[24]; dst = p.WuT; }
    else { job = 7; base = 1968; nNt = 16; ld = 1024; K = 4096; src = p.in[26]; dst = p.WdT; }
    const int tile = ti - base;
    transpose_tile(src, ld, K, tile / nNt, tile % nNt, job, g0, g1, dst, lds);
  }
  for (int row = bid * 4 + wid; row < NT; row += nb * 4) {
    const float* x = xrow(p, row);
    f32x4 v[4]; float ss = 0.f;
#pragma unroll
    for (int j = 0; j < 4; ++j) { v[j] = *(const f32x4*)(x + lane * 4 + 256 * j); ss += v[j][0] * v[j][0] + v[j][1] * v[j][1] + v[j][2] * v[j][2] + v[j][3] * v[j][3]; }
    ss += __shfl_xor(ss, 32); ss = half_reduce(ss);
#pragma unroll
    for (int j = 0; j < 4; ++j) { u32x2 w; w.x = pk_bf16(v[j][0], v[j][1]); w.y = pk_bf16(v[j][2], v[j][3]); *(u32x2*)(p.xb + (size_t)row * 1024 + lane * 4 + 256 * j) = w; }
    if (lane == 0) p.rstd_x[row] = rsqrtf(ss * (1.f / 1024.f) + EPS);
  }
  const int gt = bid * 256 + t, ngt = nb * 256;
  for (int v = gt; v < 32 * 4096 * 32; v += ngt) {
    const size_t e0 = (size_t)v * 8; const int b = (int)(e0 >> 20), rem = (int)(e0 & 1048575), tt = rem >> 8, c = rem & 255;
    const f32x4 a = *(const f32x4*)(p.in[2] + e0), bq = *(const f32x4*)(p.in[2] + e0 + 4);
    u32x4 w; w.x = pk_bf16(a[0], a[1]); w.y = pk_bf16(a[2], a[3]); w.z = pk_bf16(bq[0], bq[1]); w.w = pk_bf16(bq[2], bq[3]);
    *(u32x4*)(p.latb + (size_t)(NTP + b * SKS + tt) * 256 + c) = w;
  }
  for (int v = gt; v < 32 * 4096 * 4; v += ngt) {
    const size_t e0 = (size_t)v * 8; const int b = (int)(e0 >> 17), rem = (int)(e0 & 131071), tt = rem >> 5, c = rem & 31;
    const f32x4 a = *(const f32x4*)(p.in[3] + e0), bq = *(const f32x4*)(p.in[3] + e0 + 4);
    u32x4 w; w.x = pk_bf16(a[0], a[1]); w.y = pk_bf16(a[2], a[3]); w.z = pk_bf16(bq[0], bq[1]); w.w = pk_bf16(bq[2], bq[3]);
    *(u32x4*)(p.krb + (size_t)(NTP + b * SKS + tt) * 32 + c) = w;
  }
  if (gt < 2048) {
    const int g = gt >> 6, n = gt & 63;
    const double dt = (double)expf(p.in[14][g]);
    const double lr = p.in[12][gt], li = p.in[13][gt];
    const double mag = (double)expf((float)(lr * dt)); double s, c; sincos_d(li * dt, s, c);
    const double lbr = mag * c, lbi = mag * s;
    const double nr = lbr - 1.0, ni = lbi, den = lr * lr + li * li;
    const double cr = (nr * lr + ni * li) / den, ci = (ni * lr - nr * li) / den;
    p.lam[gt] = make_float2((float)lbr, (float)lbi);
    const double mag64 = (double)expf((float)(64.0 * lr * dt)); sincos_d(64.0 * li * dt, s, c);
    p.lam64[gt] = make_float2((float)(mag64 * c), (float)(mag64 * s));
    for (int q = 0; q < 16; ++q) {
      const double br = p.in[15][(size_t)gt * 16 + q], bi = p.in[16][(size_t)gt * 16 + q];
      p.BbT[(size_t)(g * 128 + n) * 16 + q] = f2bf((float)(cr * br - ci * bi));
      p.BbT[(size_t)(g * 128 + 64 + n) * 16 + q] = f2bf((float)(cr * bi + ci * br));
      p.CcT[(size_t)(g * 16 + q) * 128 + n] = f2bf(p.in[17][(size_t)(g * 16 + q) * 64 + n]);
      p.CcT[(size_t)(g * 16 + q) * 128 + 64 + n] = f2bf(-p.in[18][(size_t)(g * 16 + q) * 64 + n]);
    }
  }
  for (int e = gt; e < 8192 * 16; e += ngt) {
    const int pos = e >> 4, i = e & 15;
    const float inv = expf(-(float)i * (9.210340371976184f / 16.0f));
    const float ang = (float)pos * inv;
    double s, c; sincos_d((double)ang, s, c);
    p.rope[e] = make_float2((float)c, (float)s);
  }
}

DI void phase1(const Params& p, char* lds) {
  float* rs = (float*)(lds + 65536);
  const int ntiles = 528 * 13;
  {
    auto tile_fn = [&](int j, int& m0, int& n0) -> bool { const int li = (int)(blockIdx.x >> 3) + j * (int)(gridDim.x >> 3); const int ti_ = li / 13, tj_ = li - ti_ * 13; const int tbig = ti_ * 8 + (int)(blockIdx.x & 7); if (tbig >= 528) return false; m0 = tbig * 128; n0 = tj_ * 128; return true; };
    auto rs_fn = [&](int m0, int t) -> float2 { return make_float2(p.rstd_x[m0 + t], 0.f); };
    auto epi = [&](f32x16 (&acc)[2][2], int m0, int n0, const float* rs) {
    const int tn = n0 >> 7; (void)tn;
    { EPI_IDS
    if (tn < 8) {
#pragma unroll
      for (int mt = 0; mt < 2; ++mt) {
        const int rl = wm * 64 + mt * 32 + r, row = m0 + rl;
        const float sc = rs[rl];
        float ss = 0.f;
#pragma unroll
        for (int nt = 0; nt < 2; ++nt)
#pragma unroll
          for (int i4 = 0; i4 < 4; ++i4) {
            const float v0 = acc[mt][nt][4 * i4] * sc, v1 = acc[mt][nt][4 * i4 + 1] * sc, v2 = acc[mt][nt][4 * i4 + 2] * sc, v3 = acc[mt][nt][4 * i4 + 3] * sc;
            ss += v0 * v0 + v1 * v1 + v2 * v2 + v3 * v3;
            const int col = n0 + wn * 64 + nt * 32 + 8 * i4 + 4 * hh;
            if (tn < 6) { u32x2 w; w.x = pk_bf16(v0, v1); w.y = pk_bf16(v2, v3); *(u32x2*)(p.cq + (size_t)row * 768 + col) = w; }
            else { f32x4 w = {v0, v1, v2, v3}; *(f32x4*)(p.ckv_raw + (size_t)row * 256 + (col - 768)) = w; }
          }
        ss += __shfl_xor(ss, 32);
        if (hh == 0) { if (tn < 6) p.cq_part[(size_t)row * 12 + tn * 2 + wn] = ss; else p.ckv_part[(size_t)row * 4 + (tn - 6) * 2 + wn] = ss; }
      }
    } else if (tn < 12) {
#pragma unroll
      for (int mt = 0; mt < 2; ++mt) {
        const int rl = wm * 64 + mt * 32 + r, row = m0 + rl;
        const float sc = rs[rl];
#pragma unroll
        for (int nt = 0; nt < 2; ++nt)
#pragma unroll
          for (int i4 = 0; i4 < 4; ++i4) {
            u32x2 w; w.x = pk_bf16(acc[mt][nt][4 * i4] * sc, acc[mt][nt][4 * i4 + 1] * sc); w.y = pk_bf16(acc[mt][nt][4 * i4 + 2] * sc, acc[mt][nt][4 * i4 + 3] * sc);
            *(u32x2*)(p.ub + (size_t)row * 512 + (n0 - 1024) + wn * 64 + nt * 32 + 8 * i4 + 4 * hh) = w;
          }
      }
    } else if (wn == 0) {
#pragma unroll
      for (int mt = 0; mt < 2; ++mt) {
        const int rl = wm * 64 + mt * 32 + r, row = m0 + rl;
        const float sc = rs[rl];
        float* dst = row < NTP ? p.out + OFF_KRP + (size_t)row * 32 : p.out + OFF_KRS + (size_t)(row - NTP) * 32;
        bf16_t* dkb = p.krb + (size_t)kr_of(row) * 32;
        const float* rp = (const float*)(p.rope + pos_of(row) * 16);
#pragma unroll
        for (int ih = 0; ih < 2; ++ih) {
          const int j0 = 8 * ih + 4 * hh;
          const f32x4 c01 = *(const f32x4*)(rp + 2 * j0), c23 = *(const f32x4*)(rp + 2 * j0 + 4);
          const float cc[4] = {c01[0], c01[2], c23[0], c23[2]}, sn[4] = {c01[1], c01[3], c23[1], c23[3]};
          f32x4 o1, o2;
#pragma unroll
          for (int jj = 0; jj < 4; ++jj) {
            const float x1 = acc[mt][0][4 * ih + jj] * sc, x2 = acc[mt][0][8 + 4 * ih + jj] * sc;
            o1[jj] = x1 * cc[jj] - x2 * sn[jj]; o2[jj] = x1 * sn[jj] + x2 * cc[jj];
          }
          *(f32x4*)(dst + j0) = o1; *(f32x4*)(dst + 16 + j0) = o2;
          u32x2 w1, w2; w1.x = pk_bf16(o1[0], o1[1]); w1.y = pk_bf16(o1[2], o1[3]); w2.x = pk_bf16(o2[0], o2[1]); w2.y = pk_bf16(o2[2], o2[3]);
          *(u32x2*)(dkb + j0) = w1; *(u32x2*)(dkb + 16 + j0) = w2;
        }
      }
    }
    }

    };
    gemm_stream(p.xb, 1024, p.WinT, 1024, 16, lds, 0, tile_fn, rs_fn, epi);
  }
}

DI void ssm_chunk(const Params& p, int row0, int g, float& hr, float& hi, bool write_y, char* lds_w) {
  const int lane = tid() & 63, r = lane & 31, hh = lane >> 5;
  const float2 lm = p.lam[g * 64 + lane];
  bf16x8 bfr[4];
#pragma unroll
  for (int nt = 0; nt < 4; ++nt) bfr[nt] = *(const bf16x8*)(p.BbT + (size_t)(g * 128 + nt * 32 + r) * 16 + hh * 8);
  const int fr = lane & 15, fq = lane >> 4;
  bf16x8 cfr[4];
#pragma unroll
  for (int ks = 0; ks < 4; ++ks) cfr[ks] = *(const bf16x8*)(p.CcT + (size_t)(g * 16 + fr) * 128 + ks * 32 + fq * 8);
  const float dsk = p.in[19][g * 16 + fr];
#pragma unroll 1
  for (int sub = 0; sub < 2; ++sub) {
    const int rb = row0 + sub * 32;
    const bf16x8 uf = *(const bf16x8*)(p.ub + (size_t)(rb + r) * 512 + g * 16 + hh * 8);
    f32x16 z; for (int i = 0; i < 16; ++i) z[i] = 0.f;
    const f32x16 x0 = MFMA32(uf, bfr[0], z), x1 = MFMA32(uf, bfr[1], z), x2 = MFMA32(uf, bfr[2], z), x3 = MFMA32(uf, bfr[3], z);
    float xr0[16], xr1[16], xi0[16], xi1[16];
#pragma unroll
    for (int i = 0; i < 16; ++i) {
      const auto re = __builtin_amdgcn_permlane32_swap(__float_as_uint(x0[i]), __float_as_uint(x1[i]), false, false);
      const auto im = __builtin_amdgcn_permlane32_swap(__float_as_uint(x2[i]), __float_as_uint(x3[i]), false, false);
      xr0[i] = __uint_as_float(re[0]); xr1[i] = __uint_as_float(re[1]);
      xi0[i] = __uint_as_float(im[0]); xi1[i] = __uint_as_float(im[1]);
    }
    bf16_t* Hs = (bf16_t*)lds_w;
#pragma unroll
    for (int m = 0; m < 4; ++m) {
#pragma unroll
      for (int half = 0; half < 2; ++half) {
#pragma unroll
        for (int jj = 0; jj < 4; ++jj) {
          const int i = 4 * m + jj, tt = 8 * m + 4 * half + jj;
          const float xr = half ? xr1[i] : xr0[i], xi = half ? xi1[i] : xi0[i];
          const float nr = lm.x * hr - lm.y * hi + xr;
          const float ni = lm.x * hi + lm.y * hr + xi;
          hr = nr; hi = ni;
          if (write_y) { Hs[tt * 136 + lane] = f2bf(hr); Hs[tt * 136 + 64 + lane] = f2bf(hi); }
        }
      }
    }
    if (write_y) {
      asm volatile("s_waitcnt lgkmcnt(0)" ::: "memory");
      __builtin_amdgcn_wave_barrier();
#pragma unroll
      for (int mt = 0; mt < 2; ++mt) {
        f32x4 y = {0.f, 0.f, 0.f, 0.f};
#pragma unroll
        for (int ks = 0; ks < 4; ++ks) {
          const bf16x8 hf = *(const bf16x8*)(Hs + (mt * 16 + fr) * 136 + ks * 32 + fq * 8);
          y = MFMA16(hf, cfr[ks], y);
        }
#pragma unroll
        for (int j = 0; j < 4; ++j) {
          const int row = rb + mt * 16 + fq * 4 + j;
          const float u = bf2f(p.ub[(size_t)row * 512 + g * 16 + fr]);
          const float v = y[j] + dsk * u;
          const float zz = 0.7978845608028654f * (v + 0.044715f * v * v * v);
          const float th = 1.f - 2.f / (__expf(2.f * zz) + 1.f);
          p.ssm_y[(size_t)row * 512 + g * 16 + fr] = f2bf(0.5f * v * (1.f + th));
        }
      }
      asm volatile("s_waitcnt lgkmcnt(0)" ::: "memory");
      __builtin_amdgcn_wave_barrier();
    }
  }
}

DI void phase2(const Params& p, char* lds) {
  const int lane = tid() & 63, wid = tid() >> 6;
  const int nb = gridDim.x, bid = blockIdx.x;
  for (int row = bid * 4 + wid; row < NT; row += nb * 4) {
    const f32x4 v = *(const f32x4*)(p.ckv_raw + (size_t)row * 256 + lane * 4);
    const f32x4 pp = *(const f32x4*)(p.ckv_part + (size_t)row * 4);
    const float rstd = rsqrtf((pp[0] + pp[1] + pp[2] + pp[3]) * (1.f / 256.f) + EPS);
    const f32x4 g = *(const f32x4*)(p.in[10] + lane * 4);
    f32x4 o; o[0] = v[0] * rstd * g[0]; o[1] = v[1] * rstd * g[1]; o[2] = v[2] * rstd * g[2]; o[3] = v[3] * rstd * g[3];
    float* dst = row < NTP ? p.out + OFF_LATP + (size_t)row * 256 : p.out + OFF_LATS + (size_t)(row - NTP) * 256;
    *(f32x4*)(dst + lane * 4) = o;
    u32x2 w; w.x = pk_bf16(o[0], o[1]); w.y = pk_bf16(o[2], o[3]);
    *(u32x2*)(p.latb + (size_t)kr_of(row) * 256 + lane * 4) = w;
  }
  for (int it = bid * 4 + wid; it < 8 * 128 * 32; it += nb * 4) {
    const int g = it & 31, c = (it >> 5) & 127, b = it >> 12;
    float hr = 0.f, hi = 0.f;
    ssm_chunk(p, b * 8192 + c * 64, g, hr, hi, false, lds + wid * 8704);
    p.E[(size_t)it * 64 + lane] = make_float2(hr, hi);
  }
  float* rs = (float*)(lds + 65536);
  {
    auto tile_fn = [&](int j, int& m0, int& n0) -> bool { const int li = (int)(blockIdx.x >> 3) + j * (int)(gridDim.x >> 3); const int ti_ = li / 6, tj_ = li - ti_ * 6; const int tbig = ti_ * 8 + (int)(blockIdx.x & 7); if (tbig >= 528) return false; m0 = tbig * 128; n0 = tj_ * 128; return true; };
    auto rs_fn = [&](int m0, int t) -> float2 { float sm = 0.f; for (int q = 0; q < 3; ++q) { const f32x4 v = *(const f32x4*)(p.cq_part + (size_t)(m0 + t) * 12 + 4 * q); sm += (v[0] + v[1]) + (v[2] + v[3]); } return make_float2(rsqrtf(sm * (1.f / 768.f) + EPS), 0.f); };
    auto epi = [&](f32x16 (&acc)[2][2], int m0, int n0, const float* rs) {
    const int tn = n0 >> 7; (void)tn;
    EPI_IDS
    const float qs = 0.10206207261596577f * 1.4426950408889634f;
#pragma unroll
    for (int mt = 0; mt < 2; ++mt) {
      const int rl = wm * 64 + mt * 32 + r, row = m0 + rl;
      const float sc = rs[rl] * qs;
      const float* rp = (const float*)(p.rope + pos_of(row) * 16);
#pragma unroll
      for (int nt = 0; nt < 2; ++nt) {
        const int cb = n0 + wn * 64 + nt * 32;
        bf16_t* qd = p.Q + (size_t)row * 768 + cb;
        if ((cb % 96) == 64) {
#pragma unroll
          for (int ih = 0; ih < 2; ++ih) {
            const int j0 = 8 * ih + 4 * hh;
            const f32x4 c01 = *(const f32x4*)(rp + 2 * j0), c23 = *(const f32x4*)(rp + 2 * j0 + 4);
            const float cc[4] = {c01[0], c01[2], c23[0], c23[2]}, sn[4] = {c01[1], c01[3], c23[1], c23[3]};
            float o1[4], o2[4];
#pragma unroll
            for (int jj = 0; jj < 4; ++jj) {
              const float x1 = acc[mt][nt][4 * ih + jj] * sc, x2 = acc[mt][nt][8 + 4 * ih + jj] * sc;
              o1[jj] = x1 * cc[jj] - x2 * sn[jj]; o2[jj] = x1 * sn[jj] + x2 * cc[jj];
            }
            u32x2 w1, w2; w1.x = pk_bf16(o1[0], o1[1]); w1.y = pk_bf16(o1[2], o1[3]); w2.x = pk_bf16(o2[0], o2[1]); w2.y = pk_bf16(o2[2], o2[3]);
            *(u32x2*)(qd + j0) = w1; *(u32x2*)(qd + 16 + j0) = w2;
          }
        } else {
#pragma unroll
          for (int i4 = 0; i4 < 4; ++i4) {
            u32x2 w; w.x = pk_bf16(acc[mt][nt][4 * i4] * sc, acc[mt][nt][4 * i4 + 1] * sc); w.y = pk_bf16(acc[mt][nt][4 * i4 + 2] * sc, acc[mt][nt][4 * i4 + 3] * sc);
            *(u32x2*)(qd + 8 * i4 + 4 * hh) = w;
          }
        }
      }
    }

    };
    gemm_stream(p.cq, 768, p.WqT, 768, 12, lds, 0, tile_fn, rs_fn, epi);
  }
}

DI void phase3(const Params& p, char* lds) {
  const int lane = tid() & 63, wid = tid() >> 6;
  const int nb = gridDim.x, bid = blockIdx.x;
  for (int it = bid * 4 + wid; it < 256; it += nb * 4) {
    const int b = it >> 5, g = it & 31;
    const float2 l64 = p.lam64[g * 64 + lane];
    float sr = 0.f, si = 0.f;
    const size_t base = ((size_t)(b * 128) * 32 + g) * 64 + lane;
    for (int c0 = 0; c0 < 128; c0 += 16) {
      float2 e[16];
#pragma unroll
      for (int j = 0; j < 16; ++j) e[j] = p.E[base + (size_t)(c0 + j) * 2048];
#pragma unroll
      for (int j = 0; j < 16; ++j) {
        p.S[base + (size_t)(c0 + j) * 2048] = make_float2(sr, si);
        const float nr = l64.x * sr - l64.y * si + e[j].x, ni = l64.x * si + l64.y * sr + e[j].y;
        sr = nr; si = ni;
      }
    }
  }
  {
    auto tile_fn = [&](int j, int& m0, int& n0) -> bool { const int li = (int)(blockIdx.x >> 3) + j * (int)(gridDim.x >> 3); const int ti_ = li / 4, tj_ = li - ti_ * 4; const int tbig = ti_ * 8 + (int)(blockIdx.x & 7); if (tbig >= 1552) return false; m0 = tbig * 128; n0 = tj_ * 128; return true; };
    auto rs_fn = [&](int m0, int t) -> float2 { return make_float2(0.f, 0.f); };
    auto epi = [&](f32x16 (&acc)[2][2], int m0, int n0, const float* rs) {
    const int tn = n0 >> 7; (void)tn;
    EPI_IDS
#pragma unroll
    for (int mt = 0; mt < 2; ++mt) {
      const int row = m0 + wm * 64 + mt * 32 + r;
#pragma unroll
      for (int nt = 0; nt < 2; ++nt)
#pragma unroll
        for (int i4 = 0; i4 < 4; ++i4) {
          u32x2 w; w.x = pk_bf16(acc[mt][nt][4 * i4], acc[mt][nt][4 * i4 + 1]); w.y = pk_bf16(acc[mt][nt][4 * i4 + 2], acc[mt][nt][4 * i4 + 3]);
          *(u32x2*)(p.Kn + (size_t)row * 512 + n0 + wn * 64 + nt * 32 + 8 * i4 + 4 * hh) = w;
        }
    }

    };
    gemm_stream(p.latb, 256, p.WkT, 256, 4, lds, 0, tile_fn, rs_fn, epi);
  }
  {
    auto tile_fn = [&](int j, int& m0, int& n0) -> bool { const int li = (int)(blockIdx.x >> 3) + j * (int)(gridDim.x >> 3); const int ti_ = li / 4, tj_ = li - ti_ * 4; const int tbig = ti_ * 8 + (int)(blockIdx.x & 7); if (tbig >= 1552) return false; n0 = tbig * 128; m0 = tj_ * 128; return true; };
    auto rs_fn = [&](int m0, int t) -> float2 { return make_float2(0.f, 0.f); };
    auto epi = [&](f32x16 (&acc)[2][2], int m0, int n0, const float* rs) {
    const int tn = n0 >> 7; (void)tn;
    EPI_IDS
#pragma unroll
    for (int nt = 0; nt < 2; ++nt)
#pragma unroll
      for (int i4 = 0; i4 < 4; ++i4) {
        const int kr = n0 + wn * 64 + nt * 32 + 8 * i4 + 4 * hh;
        size_t cbase; int S;
        if (kr < NTP) { cbase = (size_t)(kr >> 13) * 512 * 8192 + (kr & 8191); S = 8192; }
        else { const int k2 = kr - NTP, b = k2 / SKS, tt = k2 - b * SKS; cbase = VT_S_OFF + (size_t)b * 512 * SKS + tt; S = SKS; }
#pragma unroll
        for (int mt = 0; mt < 2; ++mt) {
          const int hd = m0 + wm * 64 + mt * 32 + r;
          u32x2 w; w.x = pk_bf16(acc[mt][nt][4 * i4], acc[mt][nt][4 * i4 + 1]); w.y = pk_bf16(acc[mt][nt][4 * i4 + 2], acc[mt][nt][4 * i4 + 3]);
          *(u32x2*)(p.Vt + cbase + (size_t)hd * S) = w;
        }
      }

    };
    gemm_stream(p.WvT, 256, p.latb, 256, 4, lds, 0, tile_fn, rs_fn, epi);
  }
}

template <int QT, bool HALF>
DI void attn_item(const Params& p, int kind, int b, int h, int qq, char* lds) {
  const int t = tid(), lane = t & 63, wid = t >> 6, r = lane & 31, hh = lane >> 5;
  int qrow0, nkb_w, nkb_max, S; size_t kr0; const bf16_t* vt_base;
  constexpr int RW = 32 * QT, WPC = 64 / RW, CPB = 4 / WPC;
  if (kind == 0) {
    const int c = qq * CPB + wid / WPC; qrow0 = b * 8192 + c * 64 + (wid % WPC) * RW; nkb_w = c + 1; nkb_max = qq * CPB + CPB; kr0 = (size_t)b * 8192; S = 8192;
    vt_base = p.Vt + (size_t)(b * 8 + h) * 64 * 8192;
  } else {
    qrow0 = NTP + b * 64 + (wid % WPC) * RW; nkb_w = (wid < WPC) ? 65 : 0; nkb_max = 65; kr0 = (size_t)NTP + (size_t)b * SKS; S = SKS;
    vt_base = p.Vt + VT_S_OFF + (size_t)(b * 8 + h) * 64 * SKS;
  }
  bf16x8 qf[QT][6];
#pragma unroll
  for (int qt = 0; qt < QT; ++qt)
#pragma unroll
    for (int ks = 0; ks < 6; ++ks) qf[qt][ks] = *(const bf16x8*)(p.Q + (size_t)(qrow0 + qt * 32 + r) * 768 + h * 96 + ks * 16 + hh * 8);
  f32x16 o[2][QT];
  float mrun[QT], lrun[QT];
#pragma unroll
  for (int qt = 0; qt < QT; ++qt) { mrun[qt] = -1e30f; lrun[qt] = 0.f;
#pragma unroll
    for (int dt = 0; dt < 2; ++dt)
#pragma unroll
      for (int i = 0; i < 16; ++i) o[dt][qt][i] = 0.f; }
  const int kkey = t >> 3, kc = t & 7;
  const int rkey = t >> 2, rc = t & 3;
  const int vd = t >> 3, vc = t & 7;
  const bf16_t* gk = p.Kn + (kr0 + kkey) * 512 + h * 64 + kc * 8;
  const bf16_t* gr = p.krb + (kr0 + rkey) * 32 + rc * 8;
  const bf16_t* gv = vt_base + (size_t)vd * S + vc * 8;
  const unsigned kw0 = kkey * 208 + kc * 16, kw1 = kw0 + 32 * 208, rw = rkey * 208 + 128 + rc * 16;
  const unsigned vlo = vd * 144 + (vc >> 1) * 32 + (vc & 1) * 8, vhi = vlo + 16;
  constexpr int KB = 13312, VB = 9216, BUF = KB + VB;
  u32x4 k0r, k1r, rr, v0r, v1r;
  k0r = *(const u32x4*)gk; k1r = *(const u32x4*)(gk + 32 * 512); rr = *(const u32x4*)gr;
  v0r = *(const u32x4*)gv; v1r = *(const u32x4*)(gv + (size_t)32 * S);
  __syncthreads();
  {
    char* kb_ = lds; char* vb_ = lds + KB;
    *(u32x4*)(kb_ + kw0) = k0r; *(u32x4*)(kb_ + kw1) = k1r; *(u32x4*)(kb_ + rw) = rr;
    *(u32x2*)(vb_ + vlo) = (u32x2){v0r.x, v0r.y}; *(u32x2*)(vb_ + vhi) = (u32x2){v0r.z, v0r.w};
    *(u32x2*)(vb_ + vlo + 32 * 144) = (u32x2){v1r.x, v1r.y}; *(u32x2*)(vb_ + vhi + 32 * 144) = (u32x2){v1r.z, v1r.w};
  }
  __syncthreads();
  for (int kb = 0; kb < nkb_max; ++kb) {
    const int cur = kb & 1;
    const bool more = kb + 1 < nkb_max;
    if (more) {
      const size_t ko = (size_t)(kb + 1) * 64;
      k0r = *(const u32x4*)(gk + ko * 512); k1r = *(const u32x4*)(gk + (ko + 32) * 512); rr = *(const u32x4*)(gr + ko * 32);
      v0r = *(const u32x4*)(gv + ko); v1r = *(const u32x4*)(gv + (size_t)32 * S + ko);
    }
    if (HALF && kb < nkb_w) {
      const char* kt_ = lds + cur * BUF; const char* vt_ = kt_ + KB;
#pragma unroll
      for (int kt = 0; kt < 2; ++kt) {
        __builtin_amdgcn_iglp_opt(0);
        f32x16 sh[QT];
#pragma unroll
        for (int qt = 0; qt < QT; ++qt)
#pragma unroll
          for (int i = 0; i < 16; ++i) sh[qt][i] = 0.f;
#pragma unroll
        for (int ks = 0; ks < 6; ++ks) {
          const bf16x8 kf = *(const bf16x8*)(kt_ + (kt * 32 + r) * 208 + ks * 32 + hh * 16);
#pragma unroll
          for (int qt = 0; qt < QT; ++qt) sh[qt] = MFMA32(kf, qf[qt][ks], sh[qt]);
        }
        bf16x8 ph[QT][2];
#pragma unroll
        for (int qt = 0; qt < QT; ++qt) {
          float mx = sh[qt][0];
#pragma unroll
          for (int i = 1; i < 16; ++i) mx = fmaxf(mx, sh[qt][i]);
          mx = fmaxf(mx, __shfl_xor(mx, 32));
          const bool need = mx > mrun[qt] + 8.f;
          if (__any(need)) {
            const float mnew = need ? mx : mrun[qt];
            const float alpha = __builtin_amdgcn_exp2f(mrun[qt] - mnew);
            mrun[qt] = mnew; lrun[qt] *= alpha;
#pragma unroll
            for (int dt = 0; dt < 2; ++dt)
#pragma unroll
              for (int i = 0; i < 16; ++i) o[dt][qt][i] *= alpha;
          }
          float ls = 0.f;
#pragma unroll
          for (int i = 0; i < 16; ++i) { const float pv = __builtin_amdgcn_exp2f(sh[qt][i] - mrun[qt]); ls += pv; sh[qt][i] = pv; }
          lrun[qt] += ls;
#pragma unroll
          for (int s2 = 0; s2 < 2; ++s2) {
            u32x4 w;
            w.x = pk_bf16(sh[qt][8 * s2 + 0], sh[qt][8 * s2 + 1]); w.y = pk_bf16(sh[qt][8 * s2 + 2], sh[qt][8 * s2 + 3]);
            w.z = pk_bf16(sh[qt][8 * s2 + 4], sh[qt][8 * s2 + 5]); w.w = pk_bf16(sh[qt][8 * s2 + 6], sh[qt][8 * s2 + 7]);
            ph[qt][s2] = __builtin_bit_cast(bf16x8, w);
          }
        }
#pragma unroll
        for (int dt = 0; dt < 2; ++dt)
#pragma unroll
          for (int s2 = 0; s2 < 2; ++s2) {
            const bf16x8 vf = *(const bf16x8*)(vt_ + (dt * 32 + r) * 144 + (kt * 2 + s2) * 32 + hh * 16);
#pragma unroll
            for (int qt = 0; qt < QT; ++qt) o[dt][qt] = MFMA32(vf, ph[qt][s2], o[dt][qt]);
          }
      }
    }
    if (!HALF && kb < nkb_w) {
      const char* kt_ = lds + cur * BUF; const char* vt_ = kt_ + KB;
      f32x16 st[2][QT];
#pragma unroll
      for (int kt = 0; kt < 2; ++kt)
#pragma unroll
        for (int qt = 0; qt < QT; ++qt)
#pragma unroll
          for (int i = 0; i < 16; ++i) st[kt][qt][i] = 0.f;
#pragma unroll
      for (int ks = 0; ks < 6; ++ks)
#pragma unroll
        for (int kt = 0; kt < 2; ++kt) {
          const bf16x8 kf = *(const bf16x8*)(kt_ + (kt * 32 + r) * 208 + ks * 32 + hh * 16);
#pragma unroll
          for (int qt = 0; qt < QT; ++qt) st[kt][qt] = MFMA32(kf, qf[qt][ks], st[kt][qt]);
        }
      bf16x8 pb[2][QT][2];
#pragma unroll
      for (int qt = 0; qt < QT; ++qt) {
        float mx = mrun[qt];
#pragma unroll
        for (int kt = 0; kt < 2; ++kt)
#pragma unroll
          for (int i = 0; i < 16; ++i) mx = fmaxf(mx, st[kt][qt][i]);
        mx = fmaxf(mx, __shfl_xor(mx, 32));
        const float alpha = __builtin_amdgcn_exp2f(mrun[qt] - mx);
        mrun[qt] = mx;
        float ls = 0.f;
#pragma unroll
        for (int kt = 0; kt < 2; ++kt) {
#pragma unroll
          for (int i = 0; i < 16; ++i) { const float pv = __builtin_amdgcn_exp2f(st[kt][qt][i] - mx); ls += pv; st[kt][qt][i] = pv; }
#pragma unroll
          for (int s2 = 0; s2 < 2; ++s2) {
            u32x4 w;
            w.x = pk_bf16(st[kt][qt][8 * s2 + 0], st[kt][qt][8 * s2 + 1]); w.y = pk_bf16(st[kt][qt][8 * s2 + 2], st[kt][qt][8 * s2 + 3]);
            w.z = pk_bf16(st[kt][qt][8 * s2 + 4], st[kt][qt][8 * s2 + 5]); w.w = pk_bf16(st[kt][qt][8 * s2 + 6], st[kt][qt][8 * s2 + 7]);
            pb[kt][qt][s2] = __builtin_bit_cast(bf16x8, w);
          }
        }
        lrun[qt] = lrun[qt] * alpha + ls;
#pragma unroll
        for (int dt = 0; dt < 2; ++dt)
#pragma unroll
          for (int i = 0; i < 16; ++i) o[dt][qt][i] *= alpha;
      }
#pragma unroll
      for (int dt = 0; dt < 2; ++dt)
#pragma unroll
        for (int kt = 0; kt < 2; ++kt)
#pragma unroll
          for (int s2 = 0; s2 < 2; ++s2) {
            const bf16x8 vf = *(const bf16x8*)(vt_ + (dt * 32 + r) * 144 + (kt * 2 + s2) * 32 + hh * 16);
#pragma unroll
            for (int qt = 0; qt < QT; ++qt) o[dt][qt] = MFMA32(vf, pb[kt][qt][s2], o[dt][qt]);
          }
    }
    if (more) {
      char* kb_ = lds + (cur ^ 1) * BUF; char* vb_ = kb_ + KB;
      *(u32x4*)(kb_ + kw0) = k0r; *(u32x4*)(kb_ + kw1) = k1r; *(u32x4*)(kb_ + rw) = rr;
      *(u32x2*)(vb_ + vlo) = (u32x2){v0r.x, v0r.y}; *(u32x2*)(vb_ + vhi) = (u32x2){v0r.z, v0r.w};
      *(u32x2*)(vb_ + vlo + 32 * 144) = (u32x2){v1r.x, v1r.y}; *(u32x2*)(vb_ + vhi + 32 * 144) = (u32x2){v1r.z, v1r.w};
    }
    __syncthreads();
  }
  if (nkb_w > 0) {
#pragma unroll
    for (int qt = 0; qt < QT; ++qt) {
      const float lt = lrun[qt] + __shfl_xor(lrun[qt], 32);
      const float inv = 1.f / lt;
      const int row = qrow0 + qt * 32 + r;
      float ss = 0.f;
#pragma unroll
      for (int dt = 0; dt < 2; ++dt)
#pragma unroll
        for (int i4 = 0; i4 < 4; ++i4) {
          const float a0 = o[dt][qt][4 * i4] * inv, a1 = o[dt][qt][4 * i4 + 1] * inv, a2 = o[dt][qt][4 * i4 + 2] * inv, a3 = o[dt][qt][4 * i4 + 3] * inv;
          ss += a0 * a0 + a1 * a1 + a2 * a2 + a3 * a3;
          u32x2 w; w.x = pk_bf16(a0, a1); w.y = pk_bf16(a2, a3);
          *(u32x2*)(p.mix + (size_t)row * 1024 + h * 64 + dt * 32 + 8 * i4 + 4 * hh) = w;
        }
      ss += __shfl_xor(ss, 32);
      if (hh == 0) p.attn_part[(size_t)row * 8 + h] = ss;
    }
  }
}

DI void phase4(const Params& p, char* lds, int qidx) {
  const int t = tid(), lane = t & 63, wid = t >> 6;
  const int nb = gridDim.x, bid = blockIdx.x;
  int* nxt = (int*)(lds + 65536);
  for (;;) {
    __syncthreads();
    if (t == 0) *nxt = atomicAdd(p.counters + qidx, 1);
    __syncthreads();
    const int it = *nxt;
    if (it >= 256 + 64 * 32) break;
    if (it < 256) attn_item<1, false>(p, 1, it >> 3, it & 7, 0, lds);
    else { const int j = it - 256; const int qq = 31 - (j >> 6), bh = j & 63; attn_item<2, true>(p, 0, bh >> 3, bh & 7, qq, lds); }
  }
  __syncthreads();
  for (int it = bid * 4 + wid; it < 8 * 128 * 32 + 1024; it += nb * 4) {
    if (it < 8 * 128 * 32) {
      const int g = it & 31, c = (it >> 5) & 127, b = it >> 12;
      const float2 s0 = p.S[(size_t)it * 64 + lane];
      float hr = s0.x, hi = s0.y;
      ssm_chunk(p, b * 8192 + c * 64, g, hr, hi, true, lds + wid * 8704);
      if (c == 127) { p.out[OFF_HRP + (size_t)(b * 32 + g) * 64 + lane] = hr; p.out[OFF_HIP + (size_t)(b * 32 + g) * 64 + lane] = hi; }
    } else {
      const int j = it - 8 * 128 * 32, g = j & 31, b = j >> 5;
      float hr = p.in[4][(size_t)(b * 32 + g) * 64 + lane], hi = p.in[5][(size_t)(b * 32 + g) * 64 + lane];
      ssm_chunk(p, NTP + b * 64, g, hr, hi, true, lds + wid * 8704);
      p.out[OFF_HRS + (size_t)(b * 32 + g) * 64 + lane] = hr; p.out[OFF_HIS + (size_t)(b * 32 + g) * 64 + lane] = hi;
    }
  }
}

DI void phase5(const Params& p, char* lds) {
  {
    auto tile_fn = [&](int j, int& m0, int& n0) -> bool { const int li = (int)(blockIdx.x >> 3) + j * (int)(gridDim.x >> 3); const int ti_ = li / 4, tj_ = li - ti_ * 4; const int tbig = ti_ * 8 + (int)(blockIdx.x & 7); if (tbig >= 528) return false; m0 = tbig * 128; n0 = tj_ * 128; return true; };
    auto rs_fn = [&](int m0, int t) -> float2 { return make_float2(0.f, 0.f); };
    auto epi = [&](f32x16 (&acc)[2][2], int m0, int n0, const float* rs) {
    const int tn = n0 >> 7; (void)tn;
    { EPI_IDS
#pragma unroll
    for (int mt = 0; mt < 2; ++mt) {
      const int row = m0 + wm * 64 + mt * 32 + r;
      float ss = 0.f;
#pragma unroll
      for (int nt = 0; nt < 2; ++nt)
#pragma unroll
        for (int i4 = 0; i4 < 4; ++i4) {
          const int col = n0 + wn * 64 + nt * 32 + 8 * i4 + 4 * hh;
          const u32x2 yv = *(const u32x2*)(p.ssm_y + (size_t)row * 512 + col);
          const float y0 = __uint_as_float(yv.x << 16), y1 = __uint_as_float(yv.x & 0xffff0000u), y2 = __uint_as_float(yv.y << 16), y3 = __uint_as_float(yv.y & 0xffff0000u);
          const float o0 = y0 / (1.f + __expf(-acc[mt][nt][4 * i4])), o1 = y1 / (1.f + __expf(-acc[mt][nt][4 * i4 + 1]));
          const float o2 = y2 / (1.f + __expf(-acc[mt][nt][4 * i4 + 2])), o3 = y3 / (1.f + __expf(-acc[mt][nt][4 * i4 + 3]));
          ss += o0 * o0 + o1 * o1 + o2 * o2 + o3 * o3;
          u32x2 w; w.x = pk_bf16(o0, o1); w.y = pk_bf16(o2, o3);
          *(u32x2*)(p.mix + (size_t)row * 1024 + 512 + col) = w;
        }
      ss += __shfl_xor(ss, 32);
      if (hh == 0) p.ssm_part[(size_t)row * 8 + tn * 2 + wn] = ss;
    }
    }

    };
    gemm_stream(p.ssm_y, 512, p.WgT, 512, 8, lds, 0, tile_fn, rs_fn, epi);
  }
}

DI void phase6(const Params& p, char* lds) {
  const int xb_ = blockIdx.x & 7, xl_ = blockIdx.x >> 3, nbx_ = gridDim.x >> 3;
  {
    auto tile_fn = [&](int j, int& m0, int& n0) -> bool { const int li6 = xl_ + j * nbx_, tm = (li6 >> 3) * 8 + xb_; if (tm >= 528) return false; m0 = tm * 128; n0 = (li6 & 7) * 128; return true; };
    auto rs_fn = [&](int m0, int t) -> float2 {
      const f32x4 a0 = *(const f32x4*)(p.attn_part + (size_t)(m0 + t) * 8), a1 = *(const f32x4*)(p.attn_part + (size_t)(m0 + t) * 8 + 4);
      const float sa = (a0[0] + a0[1]) + (a0[2] + a0[3]) + (a1[0] + a1[1]) + (a1[2] + a1[3]);
      const f32x4 b0 = *(const f32x4*)(p.ssm_part + (size_t)(m0 + t) * 8), b1 = *(const f32x4*)(p.ssm_part + (size_t)(m0 + t) * 8 + 4);
      const float sb = (b0[0] + b0[1]) + (b0[2] + b0[3]) + (b1[0] + b1[1]) + (b1[2] + b1[3]);
      const float ra = rsqrtf(sa * (1.f / 512.f) + EPS), rb = rsqrtf(sb * (1.f / 512.f) + EPS);
      return make_float2(rb, ra / rb); };
    auto epi = [&](f32x16 (&acc)[2][2], int m0, int n0, const float* rs) {
    const int tn = n0 >> 7;
    { EPI_IDS
#pragma unroll
    for (int mt = 0; mt < 2; ++mt) {
      const int rl = wm * 64 + mt * 32 + r, row = m0 + rl;
      const float sc = rs[rl];
      const float* xr = xrow(p, row);
      float ss = 0.f;
#pragma unroll
      for (int nt = 0; nt < 2; ++nt)
#pragma unroll
        for (int i4 = 0; i4 < 4; ++i4) {
          const int col = n0 + wn * 64 + nt * 32 + 8 * i4 + 4 * hh;
          const f32x4 xv = *(const f32x4*)(xr + col);
          f32x4 hv;
#pragma unroll
          for (int jj = 0; jj < 4; ++jj) { hv[jj] = xv[jj] + acc[mt][nt][4 * i4 + jj] * sc; ss += hv[jj] * hv[jj]; }
          u32x2 w; w.x = pk_bf16(hv[0], hv[1]); w.y = pk_bf16(hv[2], hv[3]);
          *(u32x2*)(p.hb + (size_t)row * 1024 + col) = w;
          if (i4 == 1 || i4 == 3) __builtin_amdgcn_sched_barrier(0);
        }
      ss += __shfl_xor(ss, 32);
      if (hh == 0) p.h_part[(size_t)row * 16 + tn * 2 + wn] = ss;
    }
    }
    };
    gemm_stream(p.mix, 1024, p.WoT, 1024, 16, lds, 8, tile_fn, rs_fn, epi);
  }
}

DI void phase7(const Params& p, char* lds) {
  float* rs = (float*)(lds + 65536);
  const int xb_ = blockIdx.x & 7, xl_ = blockIdx.x >> 3, nbx_ = gridDim.x >> 3;
  {
    auto tile_fn = [&](int j, int& m0, int& n0) -> bool { const int tm = j * (nbx_ >> 2) + (xl_ >> 2); if (tm >= 528) return false; m0 = tm * 128; n0 = (xb_ * 4 + (xl_ & 3)) * 128; return true; };
    auto rs_fn = [&](int m0, int t) -> float2 { float sm = 0.f; for (int q = 0; q < 4; ++q) { const f32x4 v = *(const f32x4*)(p.h_part + (size_t)(m0 + t) * 16 + 4 * q); sm += (v[0] + v[1]) + (v[2] + v[3]); } return make_float2(rsqrtf(sm * (1.f / 1024.f) + EPS), 0.f); };
    auto epi = [&](f32x16 (&acc)[2][2], int m0, int n0, const float* rs) {
    const int tn = n0 >> 7; (void)tn;
    { EPI_IDS
#pragma unroll
    for (int mt = 0; mt < 2; ++mt) {
      const int rl = wm * 64 + mt * 32 + r, row = m0 + rl;
      const float sc = rs[rl];
#pragma unroll
      for (int nt = 0; nt < 2; ++nt)
#pragma unroll
        for (int i4 = 0; i4 < 4; ++i4) {
          float v[4];
#pragma unroll
          for (int jj = 0; jj < 4; ++jj) { const float a = fmaxf(acc[mt][nt][4 * i4 + jj] * sc, 0.f); v[jj] = a * a; }
          u32x2 w; w.x = pk_bf16(v[0], v[1]); w.y = pk_bf16(v[2], v[3]);
          { const int col = n0 + wn * 64 + nt * 32 + 8 * i4 + 4 * hh;
            *(u32x2*)(p.act + (((size_t)(row >> 7) * 64 + (col >> 6)) * 128 + (row & 127)) * 64 + (col & 63)) = w; }
        }
    }
    }

    };
    gemm_stream(p.hb, 1024, p.WuT, 1024, 16, lds, 0, tile_fn, rs_fn, epi);
  }
}

DI void phase8(const Params& p, char* lds) {
  const int xb_ = blockIdx.x & 7, xl_ = blockIdx.x >> 3, nbx_ = gridDim.x >> 3;
  {
    auto tile_fn = [&](int j, int& m0, int& n0) -> bool { const int li = (int)(blockIdx.x >> 3) + j * (int)(gridDim.x >> 3); const int ti_ = li / 8, tj_ = li - ti_ * 8; const int tbig = ti_ * 8 + (int)(blockIdx.x & 7); if (tbig >= 528) return false; m0 = tbig * 128; n0 = tj_ * 128; return true; };
    auto rs_fn = [&](int m0, int t) -> float2 { return make_float2(0.f, 0.f); };
    auto epi = [&](f32x16 (&acc)[2][2], int m0, int n0, const float* rs) {
    const int tn = n0 >> 7; (void)tn;
    { EPI_IDS
#pragma unroll
    for (int mt = 0; mt < 2; ++mt) {
      const int row = m0 + wm * 64 + mt * 32 + r;
      float ss = 0.f;
#pragma unroll
      for (int nt = 0; nt < 2; ++nt)
#pragma unroll
        for (int i4 = 0; i4 < 4; ++i4) {
          float* yp = p.out + OFF_Y + (size_t)row * 1024 + n0 + wn * 64 + nt * 32 + 8 * i4 + 4 * hh;
          const u32x2 hq = *(const u32x2*)(p.hb + (size_t)row * 1024 + n0 + wn * 64 + nt * 32 + 8 * i4 + 4 * hh);
          f32x4 ov = {__uint_as_float(hq.x << 16), __uint_as_float(hq.x & 0xffff0000u), __uint_as_float(hq.y << 16), __uint_as_float(hq.y & 0xffff0000u)};
#pragma unroll
          for (int jj = 0; jj < 4; ++jj) { ov[jj] += acc[mt][nt][4 * i4 + jj]; ss += ov[jj] * ov[jj]; }
          *(f32x4*)yp = ov;
          if (i4 == 1 || i4 == 3) __builtin_amdgcn_sched_barrier(0);
        }
      ss += __shfl_xor(ss, 32);
      if (hh == 0) p.out_part[(size_t)row * 16 + tn * 2 + wn] = ss;
    }
    }

    };
    gemm_stream<true>(p.act, 4096, p.WdT, 4096, 64, lds, 0, tile_fn, rs_fn, epi);
  }
}

DI void phase9(const Params& p) {
  const int t = tid(), lane = t & 63, wid = t >> 6;
  for (int row = blockIdx.x * 4 + wid; row < NT; row += gridDim.x * 4) {
    float s = 0.f;
    for (int j = 0; j < 16; ++j) s += p.out_part[(size_t)row * 16 + j];
    const float rstd = rsqrtf(s * (1.f / 1024.f) + EPS);
    float* y = p.out + OFF_Y + (size_t)row * 1024;
#pragma unroll
    for (int j = 0; j < 4; ++j) {
      f32x4 v = *(const f32x4*)(y + lane * 4 + 256 * j);
      const f32x4 g = *(const f32x4*)(p.in[27] + lane * 4 + 256 * j);
      v[0] *= rstd * g[0]; v[1] *= rstd * g[1]; v[2] *= rstd * g[2]; v[3] *= rstd * g[3];
      *(f32x4*)(y + lane * 4 + 256 * j) = v;
    }
  }
}

DI void grid_barrier(unsigned* cnt, unsigned target) {
  asm volatile("s_waitcnt vmcnt(0)" ::: "memory");
  __syncthreads();
  if (tid() == 0) {
    __builtin_amdgcn_fence(__ATOMIC_RELEASE, "agent");
    asm volatile("s_waitcnt vmcnt(0)" ::: "memory");
    __hip_atomic_fetch_add(cnt, 1u, __ATOMIC_RELAXED, __HIP_MEMORY_SCOPE_AGENT);
    while (__hip_atomic_load(cnt, __ATOMIC_RELAXED, __HIP_MEMORY_SCOPE_AGENT) < target) __builtin_amdgcn_s_sleep(2);
  }
  __syncthreads();
  __builtin_amdgcn_fence(__ATOMIC_ACQUIRE, "agent");
  asm volatile("s_waitcnt vmcnt(0)" ::: "memory");
}

#define XB_TMO      128
#define XB_XCNT(j)  (256  + 64 * (j))
#define XB_XSUB(j)  (1280 + 64 * (j))
#define XB_XGEN(j)  (2304 + 64 * (j))
#define XB_TOP      3328
#define XB_TOPGEN   3392
#define XCD_BAR_WORDS 3456
#define XB_SPIN_CAP (1u << 22)
#define LAS __attribute__((address_space(3)))
DI unsigned xb_ld(unsigned* p)              { return __hip_atomic_load(p, __ATOMIC_RELAXED, __HIP_MEMORY_SCOPE_AGENT); }
DI unsigned xb_add(unsigned* p, unsigned v) { return __hip_atomic_fetch_add(p, v, __ATOMIC_RELAXED, __HIP_MEMORY_SCOPE_AGENT); }
DI unsigned xb_xcc_id() { return (unsigned)__builtin_amdgcn_s_getreg((3 << 11) | 20) & 0xFu; }
#define XB_SPIN(cond, bar) do { unsigned _sp = 0; while (cond) { __builtin_amdgcn_s_sleep(1); \
    if ((++_sp & 255u) == 0u) { if (xb_ld(&(bar)[XB_TMO])) break; if (_sp > XB_SPIN_CAP) { atomicAdd(&(bar)[XB_TMO], 1u); break; } } } } while (0)
struct XcdBarrier { unsigned* bar; unsigned x; volatile LAS unsigned* st; };
DI XcdBarrier xcd_barrier_post(unsigned* bar, volatile LAS unsigned* st) {
  XcdBarrier b; b.bar = bar; b.x = xb_xcc_id(); b.st = st;
  if (tid() == 0) (void)xb_add(&bar[XB_XCNT(b.x)], 1u);
  return b;
}
DI void xcd_barrier_complete(unsigned* bar, unsigned x, unsigned& nloc, unsigned& nx) {
  const unsigned G = gridDim.x * gridDim.y * gridDim.z;
  unsigned sum, cnt, mine, sp = 0u;
  for (;;) {
    sum = 0u; cnt = 0u; mine = 0u;
#pragma unroll
    for (unsigned j = 0; j < 16; ++j) { const unsigned c = xb_ld(&bar[XB_XCNT(j)]); sum += c; cnt += (c > 0u) ? 1u : 0u; mine = (j == x) ? c : mine; }
    if (sum == G) break;
    __builtin_amdgcn_s_sleep(1);
    if ((++sp & 255u) == 0u) { if (xb_ld(&bar[XB_TMO])) break; if (sp > XB_SPIN_CAP) { atomicAdd(&bar[XB_TMO], 1u); break; } }
  }
  nloc = mine > 0u ? mine : 1u; nx = cnt > 0u ? cnt : 1u;
}
DI void xcd_barrier(const XcdBarrier& b) {
  asm volatile("s_waitcnt vmcnt(0)" ::: "memory");
  __syncthreads();
  if (tid() == 0) {
    unsigned* bar = b.bar;
    __builtin_amdgcn_s_waitcnt(0);
    unsigned nloc = b.st[0], nx = b.st[1];
    if (nloc == 0u) { xcd_barrier_complete(bar, b.x, nloc, nx); b.st[0] = nloc; b.st[1] = nx; }
    const unsigned old = xb_add(&bar[XB_XSUB(b.x)], 1u);
    const unsigned gen = old / nloc;
    if (old + 1u == (gen + 1u) * nloc) {
      __builtin_amdgcn_fence(__ATOMIC_RELEASE, "agent");
      asm volatile("s_waitcnt vmcnt(0)" ::: "memory");
      const unsigned og = xb_add(&bar[XB_TOP], 1u);
      const unsigned tg = og / nx;
      if (og + 1u == (tg + 1u) * nx) xb_add(&bar[XB_TOPGEN], 1u);
      else XB_SPIN(xb_ld(&bar[XB_TOPGEN]) == tg, bar);
      __builtin_amdgcn_fence(__ATOMIC_ACQUIRE, "agent");
      xb_add(&bar[XB_XGEN(b.x)], 1u);
      asm volatile("s_waitcnt vmcnt(0)" ::: "memory");
    } else {
      XB_SPIN(xb_ld(&bar[XB_XGEN(b.x)]) == gen, bar);
      __builtin_amdgcn_fence(__ATOMIC_ACQUIRE, "agent");
      asm volatile("s_waitcnt vmcnt(0)" ::: "memory");
    }
  }
  __syncthreads();
}

template <bool COOP>
__global__ void __launch_bounds__(256, 2) mega(Params p) {
  __shared__ __attribute__((aligned(16))) char lds[LDS_BYTES];
  XcdBarrier xb{};
  if (COOP) {
    volatile LAS unsigned* st = (volatile LAS unsigned*)(lds + 67584);
    if (tid() == 0) { st[0] = 0u; st[1] = 0u; }
    __syncthreads();
    xb = xcd_barrier_post((unsigned*)p.counters + 64, st);
  }
  for (int ph = p.ph_lo; ph < p.ph_hi; ++ph) {
#ifdef ONLY_PHASE
    if (ph != ONLY_PHASE) continue;
#endif
    switch (ph) {
      case 0: phase0(p, lds); break;
      case 1: phase1(p, lds); break;
      case 2: phase2(p, lds); break;
      case 3: phase3(p, lds); break;
      case 4: phase4(p, lds, 0); break;
      case 5: phase5(p, lds); break;
      case 6: phase6(p, lds); break;
      case 7: phase7(p, lds); break;
      case 8: phase8(p, lds); break;
      default: phase9(p); break;
    }
#ifdef DOUBLE_PHASE
    if (ph == DOUBLE_PHASE) {
      __syncthreads();
      switch (ph) { case 0: phase0(p, lds); break; case 1: phase1(p, lds); break; case 2: phase2(p, lds); break; case 3: phase3(p, lds); break; case 4: phase4(p, lds, 1); break;
                    case 5: phase5(p, lds); break; case 6: phase6(p, lds); break; case 7: phase7(p, lds); break; default: break; }
    }
#endif
    if (COOP) { if (ph + 1 < p.ph_hi) { if (ph == 0) cg::this_grid().sync(); else xcd_barrier(xb); } }
  }
}

static size_t al256(size_t x) { return (x + 255) & ~(size_t)255; }

extern "C" void kernel_launch(void* const* d_in, const int* in_sizes, int n_in, void* d_out, int out_size, void* d_ws, size_t ws_size, hipStream_t stream) {
  Params p{};
  for (int i = 0; i < 28; ++i) p.in[i] = (const float*)d_in[i];
  p.out = (float*)d_out;
  char* base = (char*)d_ws; size_t off = 0;
  auto take = [&](size_t bytes) { char* q = base + off; off = al256(off + bytes); return q; };
  p.WinT = (bf16_t*)take((size_t)1664 * 1024 * 2);
  p.WqT = (bf16_t*)take((size_t)768 * 768 * 2);
  p.WkT = (bf16_t*)take((size_t)512 * 256 * 2);
  p.WvT = (bf16_t*)take((size_t)512 * 256 * 2);
  p.WgT = (bf16_t*)take((size_t)512 * 512 * 2);
  p.WoT = (bf16_t*)take((size_t)1024 * 1024 * 2);
  p.WuT = (bf16_t*)take((size_t)4096 * 1024 * 2);
  p.WdT = (bf16_t*)take((size_t)1024 * 4096 * 2);
  p.BbT = (bf16_t*)take((size_t)32 * 128 * 16 * 2);
  p.CcT = (bf16_t*)take((size_t)32 * 16 * 128 * 2);
  p.lam = (float2*)take(2048 * 8);
  p.lam64 = (float2*)take(2048 * 8);
  p.rope = (float2*)take((size_t)8192 * 16 * 8);
  p.rstd_x = (float*)take((size_t)NT * 4);
  p.cq_part = (float*)take((size_t)NT * 12 * 4);
  p.ckv_part = (float*)take((size_t)NT * 4 * 4);
  p.attn_part = (float*)take((size_t)NT * 8 * 4);
  p.ssm_part = (float*)take((size_t)NT * 8 * 4);
  p.h_part = (float*)take((size_t)NT * 16 * 4);
  p.out_part = (float*)take((size_t)NT * 16 * 4);
  p.counters = (int*)take(16384);
  p.E = (float2*)take((size_t)8 * 128 * 32 * 64 * 8);
  p.S = (float2*)take((size_t)8 * 128 * 32 * 64 * 8);
  const size_t a0 = off;
  p.Kn = (bf16_t*)take((size_t)NK * 512 * 2);
  const size_t aVt = off;
  p.Vt = (bf16_t*)take((size_t)NK * 512 * 2);
  p.Q = (bf16_t*)take((size_t)NT * 768 * 2);
  p.latb = (bf16_t*)take((size_t)NK * 256 * 2);
  p.krb = (bf16_t*)take((size_t)NK * 32 * 2);
  p.ub = (bf16_t*)take((size_t)NT * 512 * 2);
  const size_t aSsmY = off;
  p.ssm_y = (bf16_t*)take((size_t)NT * 512 * 2);
  p.mix = (bf16_t*)take((size_t)NT * 1024 * 2);
  const size_t total = off;
  p.xb = (bf16_t*)(base + a0);
  p.cq = (bf16_t*)(base + aVt);
  p.ckv_raw = (float*)(base + aVt + al256((size_t)NT * 768 * 2));
  p.act = (bf16_t*)(base + a0);
  const size_t aHb = a0 + al256((size_t)NT * 4096 * 2);
  p.hb = (bf16_t*)(base + aHb);
  if (aHb + (size_t)NT * 1024 * 2 > aSsmY || total > ws_size) { fprintf(stderr, "workspace layout error: total %zu ws %zu\n", total, ws_size); return; }

  const int MULTI = 0;
  hipMemsetAsync(p.counters, 0, 16384, stream);
  if (MULTI) {
    for (int ph = 0; ph < NPHASE; ++ph) {
      p.ph_lo = ph; p.ph_hi = ph + 1;
      hipLaunchKernelGGL(mega<false>, dim3(512), dim3(256), 0, stream, p);
    }
  } else {
    static int grid_blocks = 0;
    if (!grid_blocks) {
      int dev = 0, cus = 0, per_cu = 0;
      hipGetDevice(&dev);
      hipDeviceGetAttribute(&cus, hipDeviceAttributeMultiprocessorCount, dev);
      hipOccupancyMaxActiveBlocksPerMultiprocessor(&per_cu, mega<true>, 256, 0);
      grid_blocks = cus * per_cu;
    }
    p.ph_lo = 0; p.ph_hi = NPHASE;
    void* args[] = {&p};
    hipError_t e = hipLaunchCooperativeKernel((void*)mega<true>, dim3(grid_blocks), dim3(256), args, 0, stream);
    if (e != hipSuccess) fprintf(stderr, "cooperative launch failed: %s (grid %d)\n", hipGetErrorString(e), grid_blocks);
  }
}
```

```cpp
#include <hip/hip_runtime.h>
#include <hip/hip_cooperative_groups.h>
#include <stdint.h>
#include <cstdio>
namespace cg = cooperative_groups;
#define DI __device__ __forceinline__

typedef unsigned short bf16_t;
typedef short bf16x8 __attribute__((ext_vector_type(8)));
typedef float f32x16 __attribute__((ext_vector_type(16)));
typedef float f32x4 __attribute__((ext_vector_type(4)));
typedef unsigned u32x4 __attribute__((ext_vector_type(4)));
typedef unsigned u32x2 __attribute__((ext_vector_type(2)));

constexpr int NTP = 65536, NTS = 2048, NT = NTP + NTS, NK = NTP + 32 * 4160;
constexpr int SKS = 4160;
constexpr size_t OFF_Y = 0;
constexpr size_t OFF_LATP = (size_t)NT * 1024;
constexpr size_t OFF_KRP = OFF_LATP + (size_t)NTP * 256;
constexpr size_t OFF_HRP = OFF_KRP + (size_t)NTP * 32;
constexpr size_t OFF_HIP = OFF_HRP + 8 * 32 * 64;
constexpr size_t OFF_LATS = OFF_HIP + 8 * 32 * 64;
constexpr size_t OFF_KRS = OFF_LATS + (size_t)NTS * 256;
constexpr size_t OFF_HRS = OFF_KRS + (size_t)NTS * 32;
constexpr size_t OFF_HIS = OFF_HRS + 32 * 32 * 64;
constexpr size_t VT_S_OFF = (size_t)8 * 512 * 8192;
constexpr float EPS = 1e-6f;
constexpr int LDS_BYTES = 67600;
constexpr int NPHASE = 10;
constexpr int AQT = 1, NQQ = 128 / (4 / (64 / (32 * AQT)));

struct Params {
  const float* in[28];
  float* out;
  bf16_t *WinT, *WqT, *WkT, *WvT, *WgT, *WoT, *WuT, *WdT, *BbT, *CcT;
  float2 *lam, *lam64, *rope;
  float *rstd_x, *cq_part, *ckv_part, *attn_part, *ssm_part, *h_part, *out_part;
  int* counters;
  float2 *E, *S;
  bf16_t *Kn, *Vt, *Q, *latb, *krb, *ub, *ssm_y, *mix, *xb, *cq, *hb, *act;
  float* ckv_raw;
  int ph_lo, ph_hi;
};

DI int tid() { int t = __builtin_amdgcn_workitem_id_x(); asm volatile("" : "+v"(t)); return t; }
typedef __bf16 nbf16x2 __attribute__((ext_vector_type(2)));
typedef float f32x2 __attribute__((ext_vector_type(2)));
DI unsigned pk_bf16(float lo, float hi) { f32x2 v = {lo, hi}; return __builtin_bit_cast(unsigned, __builtin_convertvector(v, nbf16x2)); }
DI bf16_t f2bf(float x) { return (bf16_t)(pk_bf16(x, 0.f) & 0xffffu); }
DI float bf2f(bf16_t v) { return __uint_as_float(((unsigned)v) << 16); }
DI int crow(int i, int hh) { return (i & 3) + 8 * (i >> 2) + 4 * hh; }
DI const float* xrow(const Params& p, int row) { return row < NTP ? p.in[0] + (size_t)row * 1024 : p.in[1] + (size_t)(row - NTP) * 1024; }
DI int pos_of(int row) { return row < NTP ? (row & 8191) : 4096 + ((row - NTP) & 63); }
DI int kr_of(int row) { return row < NTP ? row : NTP + ((row - NTP) >> 6) * SKS + 4096 + ((row - NTP) & 63); }
#define MFMA32(a, b, c) __builtin_amdgcn_mfma_f32_32x32x16_bf16((a), (b), (c), 0, 0, 0)
#define MFMA16(a, b, c) __builtin_amdgcn_mfma_f32_16x16x32_bf16((a), (b), (c), 0, 0, 0)

DI void sincos_d(double x, double& s4, double& c4) {
  double k = rint(x * 0.15915494309189535);
  double rr = fma(-k, 6.283185307179586, x);
  rr = fma(-k, 2.4492935982947064e-16, rr);
  double y = rr * 0.25, y2 = y * y;
  double s = y * (1 - y2 / 6 * (1 - y2 / 20 * (1 - y2 / 42 * (1 - y2 / 72 * (1 - y2 / 110 * (1 - y2 / 156 * (1 - y2 / 210)))))));
  double c = 1 - y2 / 2 * (1 - y2 / 12 * (1 - y2 / 30 * (1 - y2 / 56 * (1 - y2 / 90 * (1 - y2 / 132 * (1 - y2 / 182))))));
  double s2 = 2 * s * c, c2 = 1 - 2 * s * s;
  s4 = 2 * s2 * c2; c4 = 1 - 2 * s2 * s2;
}

DI void gemm_core(const bf16_t* __restrict__ A, int lda, const bf16_t* __restrict__ B, int ldb, int nk,
                  int m0, int n0, char* lds, f32x16 (&acc)[2][2], int midk, const float* ratio) {
  const int t = tid(), lane = t & 63, wid = t >> 6, wm = wid >> 1, wn = wid & 1;
  const int r = lane & 31, hh = lane >> 5;
  const int lc = t & 7, lr = t >> 3;
  const unsigned woff = lr * 128 + ((lc ^ ((lr >> 1) & 7)) << 4);
  const bf16_t* ga = A + (size_t)(m0 + lr) * lda + lc * 8;
  const bf16_t* gb = B + (size_t)(n0 + lr) * ldb + lc * 8;
  char* sA = lds; char* sB = lds + 32768;
  u32x4 ra[4], rb[4];
#pragma unroll
  for (int i = 0; i < 4; ++i) { ra[i] = *(const u32x4*)(ga + (size_t)(32 * i) * lda); rb[i] = *(const u32x4*)(gb + (size_t)(32 * i) * ldb); }
#pragma unroll
  for (int i = 0; i < 4; ++i) { *(u32x4*)(sA + woff + i * 4096) = ra[i]; *(u32x4*)(sB + woff + i * 4096) = rb[i]; }
#pragma unroll
  for (int a = 0; a < 2; ++a)
#pragma unroll
    for (int b = 0; b < 2; ++b)
#pragma unroll
      for (int i = 0; i < 16; ++i) acc[a][b][i] = 0.f;
  __syncthreads();
  const int rsw = (r >> 1) & 7;
  const unsigned aoff = (wm * 64 + r) * 128, boff = (wn * 64 + r) * 128;
  for (int kt = 0; kt < nk; ++kt) {
    const int cur = kt & 1;
    const bool more = (kt + 1 < nk);
    if (more) {
      const bf16_t* ga2 = ga + (kt + 1) * 64; const bf16_t* gb2 = gb + (kt + 1) * 64;
#pragma unroll
      for (int i = 0; i < 4; ++i) { ra[i] = *(const u32x4*)(ga2 + (size_t)(32 * i) * lda); rb[i] = *(const u32x4*)(gb2 + (size_t)(32 * i) * ldb); }
    }
    if (midk && kt == midk) {
#pragma unroll
      for (int mt = 0; mt < 2; ++mt)
      { const float f = ratio[wm * 64 + mt * 32 + r];
#pragma unroll
        for (int i = 0; i < 16; ++i) { acc[mt][0][i] *= f; acc[mt][1][i] *= f; } }
    }
    const char* cA = sA + cur * 16384; const char* cB = sB + cur * 16384;
#pragma unroll
    for (int ks = 0; ks < 4; ++ks) {
      const unsigned co = (((ks * 2 + hh) ^ rsw) << 4);
      const bf16x8 a0 = *(const bf16x8*)(cA + aoff + co), a1 = *(const bf16x8*)(cA + aoff + 4096 + co);
      const bf16x8 b0 = *(const bf16x8*)(cB + boff + co), b1 = *(const bf16x8*)(cB + boff + 4096 + co);
      acc[0][0] = MFMA32(b0, a0, acc[0][0]); acc[0][1] = MFMA32(b1, a0, acc[0][1]);
      acc[1][0] = MFMA32(b0, a1, acc[1][0]); acc[1][1] = MFMA32(b1, a1, acc[1][1]);
    }
    if (more) {
      char* nA = sA + (cur ^ 1) * 16384; char* nB = sB + (cur ^ 1) * 16384;
#pragma unroll
      for (int i = 0; i < 4; ++i) { *(u32x4*)(nA + woff + i * 4096) = ra[i]; *(u32x4*)(nB + woff + i * 4096) = rb[i]; }
    }
    __syncthreads();
  }
}

DI void rowscale_load(float* rs, const float* src, int np, float inv_dim, int m0) {
  const int t = tid();
  if (t < 128) {
    const int row = m0 + t;
    if (np == 0) rs[t] = src[row];
    else { float s = 0.f; for (int j = 0; j < np; ++j) s += src[(size_t)row * np + j]; rs[t] = rsqrtf(s * inv_dim + EPS); }
  }
}

template <bool BLKA = false, class TileFn, class RsFn, class EpiFn>
DI void gemm_stream(const bf16_t* __restrict__ A, int lda, const bf16_t* __restrict__ B, int ldb, int nk, char* lds, int midk,
                    TileFn tile_fn, RsFn rs_fn, EpiFn epi) {
  int m0, n0;
  if (!tile_fn(0, m0, n0)) return;
  const int t = tid(), lane = t & 63, wid = t >> 6, wm = wid >> 1, wn = wid & 1;
  const int r = lane & 31, hh = lane >> 5;
  const int lc = t & 7, lr = t >> 3;
  const unsigned woff = lr * 128 + ((lc ^ ((lr >> 1) & 7)) << 4);
  char* sA = lds; char* sB = lds + 32768;
  float* rsbuf = (float*)(lds + 65536);
  const int rsw = (r >> 1) & 7;
  const unsigned aoff = (wm * 64 + r) * 128, boff = (wn * 64 + r) * 128;
  int lj = 0, lkt = 0, lm0 = m0, ln0 = n0; bool lvalid = true;
  u32x4 ra0[4], rb0[4], ra1[4], rb1[4];
#define GS_LOAD(RA, RB) do {   \
        \
      const bf16_t* ga_ = BLKA ? A + ((size_t)(lm0 >> 7) * nk + lkt) * 8192 + lr * 64 + lc * 8 : A + (size_t)(lm0 + lr) * lda + lc * 8 + lkt * 64; const bf16_t* gb_ = B + (size_t)(ln0 + lr) * ldb + lc * 8 + lkt * 64; \
      _Pragma("unroll") for (int i = 0; i < 4; ++i) { RA[i] = *(const u32x4*)(ga_ + (size_t)(32 * i) * (BLKA ? 64 : lda)); RB[i] = *(const u32x4*)(gb_ + (size_t)(32 * i) * ldb); } \
      if (++lkt == nk) { lkt = 0; if (lvalid) { ++lj; lvalid = tile_fn(lj, lm0, ln0); } } } while (0)
  GS_LOAD(ra0, rb0);
  GS_LOAD(ra1, rb1);
  {
    float2 rv = make_float2(0.f, 0.f);
    if (t < 128) rv = rs_fn(m0, t);
    __syncthreads();
#pragma unroll
    for (int i = 0; i < 4; ++i) { *(u32x4*)(sA + woff + i * 4096) = ra0[i]; *(u32x4*)(sB + woff + i * 4096) = rb0[i]; }
    if (t < 128) { rsbuf[t] = rv.x; rsbuf[128 + t] = rv.y; }
    __syncthreads();
  }
  int cur = 0;
  for (int j = 0;; ++j) {
    int m1 = 0, n1 = 0;
    const bool has_next = tile_fn(j + 1, m1, n1);
    const float* rs = rsbuf + (j & 1) * 256;
    f32x16 acc[2][2];
#pragma unroll
    for (int a = 0; a < 2; ++a)
#pragma unroll
      for (int b = 0; b < 2; ++b)
#pragma unroll
        for (int i = 0; i < 16; ++i) acc[a][b][i] = 0.f;
#define GS_STEP(RL_A, RL_B, RW_A, RW_B, KT) do { \
      const bool last_ = ((KT) + 1 == nk); const bool wr_ = !last_ || has_next; \
      float2 rv_ = make_float2(0.f, 0.f); \
      if (last_ && has_next) { if (t < 128) rv_ = rs_fn(m1, t); asm volatile("" : "+v"(rv_.x), "+v"(rv_.y)); }   \
      GS_LOAD(RL_A, RL_B); \
      if (midk && (KT) == midk) { _Pragma("unroll") for (int mt = 0; mt < 2; ++mt) { const float f = rs[128 + wm * 64 + mt * 32 + r]; \
          _Pragma("unroll") for (int i = 0; i < 16; ++i) { acc[mt][0][i] *= f; acc[mt][1][i] *= f; } } } \
      const char* cA = sA + cur * 16384; const char* cB = sB + cur * 16384; \
      __builtin_amdgcn_iglp_opt(0); \
      _Pragma("unroll") for (int ks = 0; ks < 4; ++ks) { \
        const unsigned co = (((ks * 2 + hh) ^ rsw) << 4); \
        const bf16x8 a0 = *(const bf16x8*)(cA + aoff + co), a1 = *(const bf16x8*)(cA + aoff + 4096 + co); \
        const bf16x8 b0 = *(const bf16x8*)(cB + boff + co), b1 = *(const bf16x8*)(cB + boff + 4096 + co); \
        acc[0][0] = MFMA32(b0, a0, acc[0][0]); acc[0][1] = MFMA32(b1, a0, acc[0][1]); \
        acc[1][0] = MFMA32(b0, a1, acc[1][0]); acc[1][1] = MFMA32(b1, a1, acc[1][1]); } \
      if (wr_) { char* nA = sA + (cur ^ 1) * 16384; char* nB = sB + (cur ^ 1) * 16384; \
        _Pragma("unroll") for (int i = 0; i < 4; ++i) { *(u32x4*)(nA + woff + i * 4096) = RW_A[i]; *(u32x4*)(nB + woff + i * 4096) = RW_B[i]; } \
        if (last_ && t < 128) { float* rn = rsbuf + ((j + 1) & 1) * 256; rn[t] = rv_.x; rn[128 + t] = rv_.y; } } \
      __syncthreads(); cur ^= 1; } while (0)
    for (int kt = 0; kt < nk; kt += 2) {
      GS_STEP(ra0, rb0, ra1, rb1, kt);
      GS_STEP(ra1, rb1, ra0, rb0, kt + 1);
    }
    epi(acc, m0, n0, rs, cur ^ 1);
    if (!has_next) break;
    m0 = m1; n0 = n1;
  }
#undef GS_STEP
#undef GS_LOAD
  __syncthreads();
}

DI float half_reduce(float s) {
  s += __shfl_xor(s, 1); s += __shfl_xor(s, 2); s += __shfl_xor(s, 4); s += __shfl_xor(s, 8); s += __shfl_xor(s, 16); return s;
}

#define EPI_IDS int t = tid(); asm volatile("" : "+v"(t)); const int lane = t & 63, wid = t >> 6, wm = wid >> 1, wn = wid & 1, r = lane & 31, hh = lane >> 5; (void)lane; (void)wid; (void)wm; (void)wn; (void)r; (void)hh;
#define GEMM_IDS const int t = tid(), lane = t & 63, wid = t >> 6, wm = wid >> 1, wn = wid & 1, r = lane & 31, hh = lane >> 5; (void)t; (void)wm; (void)wn; (void)r; (void)hh;

DI void transpose_tile(const float* __restrict__ src, int ld, int K, int kt, int nt, int job, const float* g0, const float* g1, bf16_t* __restrict__ dst, char* lds) {
  bf16_t* tile = (bf16_t*)lds;
  const int t = tid(), nl = t & 63, kq = t >> 6;
  const int n = nt * 64 + nl;
  int c = n;
  if (job == 0) { c = n < 1024 ? n : (n < 1536 ? 1056 + (n - 1024) : (n < 1568 ? 1024 + (n - 1536) : -1)); }
  else if (job == 2) c = (n >> 6) * 128 + (n & 63);
  else if (job == 3) c = (n >> 6) * 128 + 64 + (n & 63);
#pragma unroll 4
  for (int pass = 0; pass < 16; ++pass) {
    const int kl = pass * 4 + kq, k = kt * 64 + kl;
    float v = 0.f;
    if (c >= 0) {
      v = src[(size_t)k * ld + c];
      if (g0) { const float g = (g1 && k >= 512) ? g1[k - 512] : g0[k]; v *= g; }
    }
    tile[nl * 66 + kl] = f2bf(v);
  }
  __syncthreads();
  const int kl = t & 63;
#pragma unroll 4
  for (int pass = 0; pass < 16; ++pass) { const int nl2 = pass * 4 + kq; dst[(size_t)(nt * 64 + nl2) * K + kt * 64 + kl] = tile[nl2 * 66 + kl]; }
  __syncthreads();
}

DI void phase0(const Params& p, char* lds) {
  const int t = tid(), nb = gridDim.x, bid = blockIdx.x, lane = t & 63, wid = t >> 6;
  for (int ti = bid; ti < 2992; ti += nb) {
    int job, base, nNt, ld, K; const float* src; const float* g0 = nullptr; const float* g1 = nullptr; bf16_t* dst;
    if (ti < 416) { job = 0; base = 0; nNt = 26; ld = 1568; K = 1024; src = p.in[7]; g0 = p.in[6]; dst = p.WinT; }
    else if (ti < 560) { job = 1; base = 416; nNt = 12; ld = 768; K = 768; src = p.in[9]; g0 = p.in[8]; dst = p.WqT; }
    else if (ti < 592) { job = 2; base = 560; nNt = 8; ld = 1024; K = 256; src = p.in[11]; dst = p.WkT; }
    else if (ti < 624) { job = 3; base = 592; nNt = 8; ld = 1024; K = 256; src = p.in[11]; dst = p.WvT; }
    else if (ti < 688) { job = 4; base = 624; nNt = 8; ld = 512; K = 512; src = p.in[20]; dst = p.WgT; }
    else if (ti < 944) { job = 5; base = 688; nNt = 16; ld = 1024; K = 1024; src = p.in[23]; g0 = p.in[21]; g1 = p.in[22]; dst = p.WoT; }
    else if (ti < 1968) { job = 6; base = 944; nNt = 64; ld = 4096; K = 1024; src = p.in[25]; g0 = p.in[24]; dst = p.WuT; }
    else { job = 7; base = 1968; nNt = 16; ld = 1024; K = 4096; src = p.in[26]; dst = p.WdT; }
    const int tile = ti - base;
    transpose_tile(src, ld, K, tile / nNt, tile % nNt, job, g0, g1, dst, lds);
  }
  for (int row = bid * 4 + wid; row < NT; row += nb * 4) {
    const float* x = xrow(p, row);
    f32x4 v[4]; float ss = 0.f;
#pragma unroll
    for (int j = 0; j < 4; ++j) { v[j] = *(const f32x4*)(x + lane * 4 + 256 * j); ss += v[j][0] * v[j][0] + v[j][1] * v[j][1] + v[j][2] * v[j][2] + v[j][3] * v[j][3]; }
    ss += __shfl_xor(ss, 32); ss = half_reduce(ss);
#pragma unroll
    for (int j = 0; j < 4; ++j) { u32x2 w; w.x = pk_bf16(v[j][0], v[j][1]); w.y = pk_bf16(v[j][2], v[j][3]); *(u32x2*)(p.xb + (size_t)row * 1024 + lane * 4 + 256 * j) = w; }
    if (lane == 0) p.rstd_x[row] = rsqrtf(ss * (1.f / 1024.f) + EPS);
  }
  const int gt = bid * 256 + t, ngt = nb * 256;
  for (int v = gt; v < 32 * 4096 * 32; v += ngt) {
    const size_t e0 = (size_t)v * 8; const int b = (int)(e0 >> 20), rem = (int)(e0 & 1048575), tt = rem >> 8, c = rem & 255;
    const f32x4 a = *(const f32x4*)(p.in[2] + e0), bq = *(const f32x4*)(p.in[2] + e0 + 4);
    u32x4 w; w.x = pk_bf16(a[0], a[1]); w.y = pk_bf16(a[2], a[3]); w.z = pk_bf16(bq[0], bq[1]); w.w = pk_bf16(bq[2], bq[3]);
    *(u32x4*)(p.latb + (size_t)(NTP + b * SKS + tt) * 256 + c) = w;
  }
  for (int v = gt; v < 32 * 4096 * 4; v += ngt) {
    const size_t e0 = (size_t)v * 8; const int b = (int)(e0 >> 17), rem = (int)(e0 & 131071), tt = rem >> 5, c = rem & 31;
    const f32x4 a = *(const f32x4*)(p.in[3] + e0), bq = *(const f32x4*)(p.in[3] + e0 + 4);
    u32x4 w; w.x = pk_bf16(a[0], a[1]); w.y = pk_bf16(a[2], a[3]); w.z = pk_bf16(bq[0], bq[1]); w.w = pk_bf16(bq[2], bq[3]);
    *(u32x4*)(p.krb + (size_t)(NTP + b * SKS + tt) * 32 + c) = w;
  }
  if (gt < 2048) {
    const int g = gt >> 6, n = gt & 63;
    const double dt = (double)expf(p.in[14][g]);
    const double lr = p.in[12][gt], li = p.in[13][gt];
    const double mag = (double)expf((float)(lr * dt)); double s, c; sincos_d(li * dt, s, c);
    const double lbr = mag * c, lbi = mag * s;
    const double nr = lbr - 1.0, ni = lbi, den = lr * lr + li * li;
    const double cr = (nr * lr + ni * li) / den, ci = (ni * lr - nr * li) / den;
    p.lam[gt] = make_float2((float)lbr, (float)lbi);
    const double mag64 = (double)expf((float)(64.0 * lr * dt)); sincos_d(64.0 * li * dt, s, c);
    p.lam64[gt] = make_float2((float)(mag64 * c), (float)(mag64 * s));
    for (int q = 0; q < 16; ++q) {
      const double br = p.in[15][(size_t)gt * 16 + q], bi = p.in[16][(size_t)gt * 16 + q];
      p.BbT[(size_t)(g * 128 + n) * 16 + q] = f2bf((float)(cr * br - ci * bi));
      p.BbT[(size_t)(g * 128 + 64 + n) * 16 + q] = f2bf((float)(cr * bi + ci * br));
      p.CcT[(size_t)(g * 16 + q) * 128 + n] = f2bf(p.in[17][(size_t)(g * 16 + q) * 64 + n]);
      p.CcT[(size_t)(g * 16 + q) * 128 + 64 + n] = f2bf(-p.in[18][(size_t)(g * 16 + q) * 64 + n]);
    }
  }
  for (int e = gt; e < 8192 * 16; e += ngt) {
    const int pos = e >> 4, i = e & 15;
    const float inv = expf(-(float)i * (9.210340371976184f / 16.0f));
    const float ang = (float)pos * inv;
    double s, c; sincos_d((double)ang, s, c);
    p.rope[e] = make_float2((float)c, (float)s);
  }
}

DI void phase1(const Params& p, char* lds) {
  float* rs = (float*)(lds + 65536);
  const int ntiles = 528 * 13;
  {
    auto tile_fn = [&](int j, int& m0, int& n0) -> bool { const int li = (int)(blockIdx.x >> 3) + j * (int)(gridDim.x >> 3); const int ti_ = li / 13, tj_ = li - ti_ * 13; const int tbig = ti_ * 8 + (int)(blockIdx.x & 7); if (tbig >= 528) return false; m0 = tbig * 128; n0 = tj_ * 128; return true; };
    auto rs_fn = [&](int m0, int t) -> float2 { return make_float2(p.rstd_x[m0 + t], 0.f); };
    auto epi = [&](f32x16 (&acc)[2][2], int m0, int n0, const float* rs, int fstage) { (void)fstage;
    const int tn = n0 >> 7; (void)tn;
    { EPI_IDS
    if (tn < 8) {
#pragma unroll
      for (int mt = 0; mt < 2; ++mt) {
        const int rl = wm * 64 + mt * 32 + r, row = m0 + rl;
        const float sc = rs[rl];
        float ss = 0.f;
#pragma unroll
        for (int nt = 0; nt < 2; ++nt)
#pragma unroll
          for (int i4 = 0; i4 < 4; ++i4) {
            const float v0 = acc[mt][nt][4 * i4] * sc, v1 = acc[mt][nt][4 * i4 + 1] * sc, v2 = acc[mt][nt][4 * i4 + 2] * sc, v3 = acc[mt][nt][4 * i4 + 3] * sc;
            ss += v0 * v0 + v1 * v1 + v2 * v2 + v3 * v3;
            const int col = n0 + wn * 64 + nt * 32 + 8 * i4 + 4 * hh;
            if (tn < 6) { u32x2 w; w.x = pk_bf16(v0, v1); w.y = pk_bf16(v2, v3); *(u32x2*)(p.cq + (size_t)row * 768 + col) = w; }
            else { f32x4 w = {v0, v1, v2, v3}; *(f32x4*)(p.ckv_raw + (size_t)row * 256 + (col - 768)) = w; }
          }
        ss += __shfl_xor(ss, 32);
        if (hh == 0) { if (tn < 6) p.cq_part[(size_t)row * 12 + tn * 2 + wn] = ss; else p.ckv_part[(size_t)row * 4 + (tn - 6) * 2 + wn] = ss; }
      }
    } else if (tn < 12) {
#pragma unroll
      for (int mt = 0; mt < 2; ++mt) {
        const int rl = wm * 64 + mt * 32 + r, row = m0 + rl;
        const float sc = rs[rl];
#pragma unroll
        for (int nt = 0; nt < 2; ++nt)
#pragma unroll
          for (int i4 = 0; i4 < 4; ++i4) {
            u32x2 w; w.x = pk_bf16(acc[mt][nt][4 * i4] * sc, acc[mt][nt][4 * i4 + 1] * sc); w.y = pk_bf16(acc[mt][nt][4 * i4 + 2] * sc, acc[mt][nt][4 * i4 + 3] * sc);
            *(u32x2*)(p.ub + (size_t)row * 512 + (n0 - 1024) + wn * 64 + nt * 32 + 8 * i4 + 4 * hh) = w;
          }
      }
    } else if (wn == 0) {
#pragma unroll
      for (int mt = 0; mt < 2; ++mt) {
        const int rl = wm * 64 + mt * 32 + r, row = m0 + rl;
        const float sc = rs[rl];
        float* dst = row < NTP ? p.out + OFF_KRP + (size_t)row * 32 : p.out + OFF_KRS + (size_t)(row - NTP) * 32;
        bf16_t* dkb = p.krb + (size_t)kr_of(row) * 32;
        const float* rp = (const float*)(p.rope + pos_of(row) * 16);
#pragma unroll
        for (int ih = 0; ih < 2; ++ih) {
          const int j0 = 8 * ih + 4 * hh;
          const f32x4 c01 = *(const f32x4*)(rp + 2 * j0), c23 = *(const f32x4*)(rp + 2 * j0 + 4);
          const float cc[4] = {c01[0], c01[2], c23[0], c23[2]}, sn[4] = {c01[1], c01[3], c23[1], c23[3]};
          f32x4 o1, o2;
#pragma unroll
          for (int jj = 0; jj < 4; ++jj) {
            const float x1 = acc[mt][0][4 * ih + jj] * sc, x2 = acc[mt][0][8 + 4 * ih + jj] * sc;
            o1[jj] = x1 * cc[jj] - x2 * sn[jj]; o2[jj] = x1 * sn[jj] + x2 * cc[jj];
          }
          *(f32x4*)(dst + j0) = o1; *(f32x4*)(dst + 16 + j0) = o2;
          u32x2 w1, w2; w1.x = pk_bf16(o1[0], o1[1]); w1.y = pk_bf16(o1[2], o1[3]); w2.x = pk_bf16(o2[0], o2[1]); w2.y = pk_bf16(o2[2], o2[3]);
          *(u32x2*)(dkb + j0) = w1; *(u32x2*)(dkb + 16 + j0) = w2;
        }
      }
    }
    }

    };
    gemm_stream(p.xb, 1024, p.WinT, 1024, 16, lds, 0, tile_fn, rs_fn, epi);
  }
}

DI void ssm_chunk(const Params& p, int row0, int g, float& hr, float& hi, bool write_y, char* lds_w) {
  const int lane = tid() & 63, r = lane & 31, hh = lane >> 5;
  const float2 lm = p.lam[g * 64 + lane];
  bf16x8 bfr[4];
#pragma unroll
  for (int nt = 0; nt < 4; ++nt) bfr[nt] = *(const bf16x8*)(p.BbT + (size_t)(g * 128 + nt * 32 + r) * 16 + hh * 8);
  const int fr = lane & 15, fq = lane >> 4;
  bf16x8 cfr[4];
#pragma unroll
  for (int ks = 0; ks < 4; ++ks) cfr[ks] = *(const bf16x8*)(p.CcT + (size_t)(g * 16 + fr) * 128 + ks * 32 + fq * 8);
  const float dsk = p.in[19][g * 16 + fr];
#pragma unroll 1
  for (int sub = 0; sub < 2; ++sub) {
    const int rb = row0 + sub * 32;
    const bf16x8 uf = *(const bf16x8*)(p.ub + (size_t)(rb + r) * 512 + g * 16 + hh * 8);
    f32x16 z; for (int i = 0; i < 16; ++i) z[i] = 0.f;
    const f32x16 x0 = MFMA32(uf, bfr[0], z), x1 = MFMA32(uf, bfr[1], z), x2 = MFMA32(uf, bfr[2], z), x3 = MFMA32(uf, bfr[3], z);
    float xr0[16], xr1[16], xi0[16], xi1[16];
#pragma unroll
    for (int i = 0; i < 16; ++i) {
      const auto re = __builtin_amdgcn_permlane32_swap(__float_as_uint(x0[i]), __float_as_uint(x1[i]), false, false);
      const auto im = __builtin_amdgcn_permlane32_swap(__float_as_uint(x2[i]), __float_as_uint(x3[i]), false, false);
      xr0[i] = __uint_as_float(re[0]); xr1[i] = __uint_as_float(re[1]);
      xi0[i] = __uint_as_float(im[0]); xi1[i] = __uint_as_float(im[1]);
    }
    bf16_t* Hs = (bf16_t*)lds_w;
#pragma unroll
    for (int m = 0; m < 4; ++m) {
#pragma unroll
      for (int half = 0; half < 2; ++half) {
#pragma unroll
        for (int jj = 0; jj < 4; ++jj) {
          const int i = 4 * m + jj, tt = 8 * m + 4 * half + jj;
          const float xr = half ? xr1[i] : xr0[i], xi = half ? xi1[i] : xi0[i];
          const float nr = lm.x * hr - lm.y * hi + xr;
          const float ni = lm.x * hi + lm.y * hr + xi;
          hr = nr; hi = ni;
          if (write_y) { Hs[tt * 136 + lane] = f2bf(hr); Hs[tt * 136 + 64 + lane] = f2bf(hi); }
        }
      }
    }
    if (write_y) {
      asm volatile("s_waitcnt lgkmcnt(0)" ::: "memory");
      __builtin_amdgcn_wave_barrier();
#pragma unroll
      for (int mt = 0; mt < 2; ++mt) {
        f32x4 y = {0.f, 0.f, 0.f, 0.f};
#pragma unroll
        for (int ks = 0; ks < 4; ++ks) {
          const bf16x8 hf = *(const bf16x8*)(Hs + (mt * 16 + fr) * 136 + ks * 32 + fq * 8);
          y = MFMA16(hf, cfr[ks], y);
        }
#pragma unroll
        for (int j = 0; j < 4; ++j) {
          const int row = rb + mt * 16 + fq * 4 + j;
          const float u = bf2f(p.ub[(size_t)row * 512 + g * 16 + fr]);
          const float v = y[j] + dsk * u;
          const float zz = 0.7978845608028654f * (v + 0.044715f * v * v * v);
          const float th = 1.f - 2.f / (__expf(2.f * zz) + 1.f);
          p.ssm_y[(size_t)row * 512 + g * 16 + fr] = f2bf(0.5f * v * (1.f + th));
        }
      }
      asm volatile("s_waitcnt lgkmcnt(0)" ::: "memory");
      __builtin_amdgcn_wave_barrier();
    }
  }
}

DI void phase2(const Params& p, char* lds) {
  const int lane = tid() & 63, wid = tid() >> 6;
  const int nb = gridDim.x, bid = blockIdx.x;
  for (int row = bid * 4 + wid; row < NT; row += nb * 4) {
    const f32x4 v = *(const f32x4*)(p.ckv_raw + (size_t)row * 256 + lane * 4);
    const f32x4 pp = *(const f32x4*)(p.ckv_part + (size_t)row * 4);
    const float rstd = rsqrtf((pp[0] + pp[1] + pp[2] + pp[3]) * (1.f / 256.f) + EPS);
    const f32x4 g = *(const f32x4*)(p.in[10] + lane * 4);
    f32x4 o; o[0] = v[0] * rstd * g[0]; o[1] = v[1] * rstd * g[1]; o[2] = v[2] * rstd * g[2]; o[3] = v[3] * rstd * g[3];
    float* dst = row < NTP ? p.out + OFF_LATP + (size_t)row * 256 : p.out + OFF_LATS + (size_t)(row - NTP) * 256;
    *(f32x4*)(dst + lane * 4) = o;
    u32x2 w; w.x = pk_bf16(o[0], o[1]); w.y = pk_bf16(o[2], o[3]);
    *(u32x2*)(p.latb + (size_t)kr_of(row) * 256 + lane * 4) = w;
  }
  for (int it = bid * 4 + wid; it < 8 * 128 * 32; it += nb * 4) {
    const int g = it & 31, c = (it >> 5) & 127, b = it >> 12;
    float hr = 0.f, hi = 0.f;
    ssm_chunk(p, b * 8192 + c * 64, g, hr, hi, false, lds + wid * 8704);
    p.E[(size_t)it * 64 + lane] = make_float2(hr, hi);
  }
  float* rs = (float*)(lds + 65536);
  {
    auto tile_fn = [&](int j, int& m0, int& n0) -> bool { const int li = (int)(blockIdx.x >> 3) + j * (int)(gridDim.x >> 3); const int ti_ = li / 6, tj_ = li - ti_ * 6; const int tbig = ti_ * 8 + (int)(blockIdx.x & 7); if (tbig >= 528) return false; m0 = tbig * 128; n0 = tj_ * 128; return true; };
    auto rs_fn = [&](int m0, int t) -> float2 { float sm = 0.f; for (int q = 0; q < 3; ++q) { const f32x4 v = *(const f32x4*)(p.cq_part + (size_t)(m0 + t) * 12 + 4 * q); sm += (v[0] + v[1]) + (v[2] + v[3]); } return make_float2(rsqrtf(sm * (1.f / 768.f) + EPS), 0.f); };
    auto epi = [&](f32x16 (&acc)[2][2], int m0, int n0, const float* rs, int fstage) { (void)fstage;
    const int tn = n0 >> 7; (void)tn;
    EPI_IDS
    const float qs = 0.10206207261596577f * 1.4426950408889634f;
#pragma unroll
    for (int mt = 0; mt < 2; ++mt) {
      const int rl = wm * 64 + mt * 32 + r, row = m0 + rl;
      const float sc = rs[rl] * qs;
      const float* rp = (const float*)(p.rope + pos_of(row) * 16);
#pragma unroll
      for (int nt = 0; nt < 2; ++nt) {
        const int cb = n0 + wn * 64 + nt * 32;
        bf16_t* qd = p.Q + (size_t)row * 768 + cb;
        if ((cb % 96) == 64) {
#pragma unroll
          for (int ih = 0; ih < 2; ++ih) {
            const int j0 = 8 * ih + 4 * hh;
            const f32x4 c01 = *(const f32x4*)(rp + 2 * j0), c23 = *(const f32x4*)(rp + 2 * j0 + 4);
            const float cc[4] = {c01[0], c01[2], c23[0], c23[2]}, sn[4] = {c01[1], c01[3], c23[1], c23[3]};
            float o1[4], o2[4];
#pragma unroll
            for (int jj = 0; jj < 4; ++jj) {
              const float x1 = acc[mt][nt][4 * ih + jj] * sc, x2 = acc[mt][nt][8 + 4 * ih + jj] * sc;
              o1[jj] = x1 * cc[jj] - x2 * sn[jj]; o2[jj] = x1 * sn[jj] + x2 * cc[jj];
            }
            u32x2 w1, w2; w1.x = pk_bf16(o1[0], o1[1]); w1.y = pk_bf16(o1[2], o1[3]); w2.x = pk_bf16(o2[0], o2[1]); w2.y = pk_bf16(o2[2], o2[3]);
            *(u32x2*)(qd + j0) = w1; *(u32x2*)(qd + 16 + j0) = w2;
          }
        } else {
#pragma unroll
          for (int i4 = 0; i4 < 4; ++i4) {
            u32x2 w; w.x = pk_bf16(acc[mt][nt][4 * i4] * sc, acc[mt][nt][4 * i4 + 1] * sc); w.y = pk_bf16(acc[mt][nt][4 * i4 + 2] * sc, acc[mt][nt][4 * i4 + 3] * sc);
            *(u32x2*)(qd + 8 * i4 + 4 * hh) = w;
          }
        }
      }
    }

    };
    gemm_stream(p.cq, 768, p.WqT, 768, 12, lds, 0, tile_fn, rs_fn, epi);
  }
}

DI void phase3(const Params& p, char* lds) {
  const int lane = tid() & 63, wid = tid() >> 6;
  const int nb = gridDim.x, bid = blockIdx.x;
  for (int it = bid * 4 + wid; it < 256; it += nb * 4) {
    const int b = it >> 5, g = it & 31;
    const float2 l64 = p.lam64[g * 64 + lane];
    float sr = 0.f, si = 0.f;
    const size_t base = ((size_t)(b * 128) * 32 + g) * 64 + lane;
    for (int c0 = 0; c0 < 128; c0 += 16) {
      float2 e[16];
#pragma unroll
      for (int j = 0; j < 16; ++j) e[j] = p.E[base + (size_t)(c0 + j) * 2048];
#pragma unroll
      for (int j = 0; j < 16; ++j) {
        p.S[base + (size_t)(c0 + j) * 2048] = make_float2(sr, si);
        const float nr = l64.x * sr - l64.y * si + e[j].x, ni = l64.x * si + l64.y * sr + e[j].y;
        sr = nr; si = ni;
      }
    }
  }
  {
    auto tile_fn = [&](int j, int& m0, int& n0) -> bool { const int li = (int)(blockIdx.x >> 3) + j * (int)(gridDim.x >> 3); const int ti_ = li / 4, tj_ = li - ti_ * 4; const int tbig = ti_ * 8 + (int)(blockIdx.x & 7); if (tbig >= 1552) return false; m0 = tbig * 128; n0 = tj_ * 128; return true; };
    auto rs_fn = [&](int m0, int t) -> float2 { return make_float2(0.f, 0.f); };
    auto epi = [&](f32x16 (&acc)[2][2], int m0, int n0, const float* rs, int fstage) { (void)fstage;
    const int tn = n0 >> 7; (void)tn;
    EPI_IDS
#pragma unroll
    for (int mt = 0; mt < 2; ++mt) {
      const int row = m0 + wm * 64 + mt * 32 + r;
#pragma unroll
      for (int nt = 0; nt < 2; ++nt)
#pragma unroll
        for (int i4 = 0; i4 < 4; ++i4) {
          u32x2 w; w.x = pk_bf16(acc[mt][nt][4 * i4], acc[mt][nt][4 * i4 + 1]); w.y = pk_bf16(acc[mt][nt][4 * i4 + 2], acc[mt][nt][4 * i4 + 3]);
          *(u32x2*)(p.Kn + (size_t)row * 512 + n0 + wn * 64 + nt * 32 + 8 * i4 + 4 * hh) = w;
        }
    }

    };
    gemm_stream(p.latb, 256, p.WkT, 256, 4, lds, 0, tile_fn, rs_fn, epi);
  }
  {
    auto tile_fn = [&](int j, int& m0, int& n0) -> bool { const int li = (int)(blockIdx.x >> 3) + j * (int)(gridDim.x >> 3); const int ti_ = li / 4, tj_ = li - ti_ * 4; const int tbig = ti_ * 8 + (int)(blockIdx.x & 7); if (tbig >= 1552) return false; n0 = tbig * 128; m0 = tj_ * 128; return true; };
    auto rs_fn = [&](int m0, int t) -> float2 { return make_float2(0.f, 0.f); };
    auto epi = [&](f32x16 (&acc)[2][2], int m0, int n0, const float* rs, int fstage) { (void)fstage;
    const int tn = n0 >> 7; (void)tn;
    EPI_IDS
#pragma unroll
    for (int nt = 0; nt < 2; ++nt)
#pragma unroll
      for (int i4 = 0; i4 < 4; ++i4) {
        const int kr = n0 + wn * 64 + nt * 32 + 8 * i4 + 4 * hh;
        size_t cbase; int S;
        if (kr < NTP) { cbase = (size_t)(kr >> 13) * 512 * 8192 + (kr & 8191); S = 8192; }
        else { const int k2 = kr - NTP, b = k2 / SKS, tt = k2 - b * SKS; cbase = VT_S_OFF + (size_t)b * 512 * SKS + tt; S = SKS; }
#pragma unroll
        for (int mt = 0; mt < 2; ++mt) {
          const int hd = m0 + wm * 64 + mt * 32 + r;
          u32x2 w; w.x = pk_bf16(acc[mt][nt][4 * i4], acc[mt][nt][4 * i4 + 1]); w.y = pk_bf16(acc[mt][nt][4 * i4 + 2], acc[mt][nt][4 * i4 + 3]);
          *(u32x2*)(p.Vt + cbase + (size_t)hd * S) = w;
        }
      }

    };
    gemm_stream(p.WvT, 256, p.latb, 256, 4, lds, 0, tile_fn, rs_fn, epi);
  }
}

template <int QT, bool HALF>
DI void attn_item(const Params& p, int kind, int b, int h, int qq, char* lds) {
  const int t = tid(), lane = t & 63, wid = t >> 6, r = lane & 31, hh = lane >> 5;
  int qrow0, nkb_w, nkb_max, S; size_t kr0; const bf16_t* vt_base;
  constexpr int RW = 32 * QT, WPC = 64 / RW, CPB = 4 / WPC;
  if (kind == 0) {
    const int c = qq * CPB + wid / WPC; qrow0 = b * 8192 + c * 64 + (wid % WPC) * RW; nkb_w = c + 1; nkb_max = qq * CPB + CPB; kr0 = (size_t)b * 8192; S = 8192;
    vt_base = p.Vt + (size_t)(b * 8 + h) * 64 * 8192;
  } else {
    qrow0 = NTP + b * 64 + (wid % WPC) * RW; nkb_w = (wid < WPC) ? 65 : 0; nkb_max = 65; kr0 = (size_t)NTP + (size_t)b * SKS; S = SKS;
    vt_base = p.Vt + VT_S_OFF + (size_t)(b * 8 + h) * 64 * SKS;
  }
  bf16x8 qf[QT][6];
#pragma unroll
  for (int qt = 0; qt < QT; ++qt)
#pragma unroll
    for (int ks = 0; ks < 6; ++ks) qf[qt][ks] = *(const bf16x8*)(p.Q + (size_t)(qrow0 + qt * 32 + r) * 768 + h * 96 + ks * 16 + hh * 8);
  f32x16 o[2][QT];
  float mrun[QT], lrun[QT];
#pragma unroll
  for (int qt = 0; qt < QT; ++qt) { mrun[qt] = -1e30f; lrun[qt] = 0.f;
#pragma unroll
    for (int dt = 0; dt < 2; ++dt)
#pragma unroll
      for (int i = 0; i < 16; ++i) o[dt][qt][i] = 0.f; }
  const int kkey = t >> 3, kc = t & 7;
  const int rkey = t >> 2, rc = t & 3;
  const int vd = t >> 3, vc = t & 7;
  const bf16_t* gk = p.Kn + (kr0 + kkey) * 512 + h * 64 + kc * 8;
  const bf16_t* gr = p.krb + (kr0 + rkey) * 32 + rc * 8;
  const bf16_t* gv = vt_base + (size_t)vd * S + vc * 8;
  const unsigned kw0 = kkey * 208 + kc * 16, kw1 = kw0 + 32 * 208, rw = rkey * 208 + 128 + rc * 16;
  const unsigned vlo = vd * 144 + (vc >> 1) * 32 + (vc & 1) * 8, vhi = vlo + 16;
  constexpr int KB = 13312, VB = 9216, BUF = KB + VB;
  u32x4 k0r, k1r, rr, v0r, v1r;
  k0r = *(const u32x4*)gk; k1r = *(const u32x4*)(gk + 32 * 512); rr = *(const u32x4*)gr;
  v0r = *(const u32x4*)gv; v1r = *(const u32x4*)(gv + (size_t)32 * S);
  __syncthreads();
  {
    char* kb_ = lds; char* vb_ = lds + KB;
    *(u32x4*)(kb_ + kw0) = k0r; *(u32x4*)(kb_ + kw1) = k1r; *(u32x4*)(kb_ + rw) = rr;
    *(u32x2*)(vb_ + vlo) = (u32x2){v0r.x, v0r.y}; *(u32x2*)(vb_ + vhi) = (u32x2){v0r.z, v0r.w};
    *(u32x2*)(vb_ + vlo + 32 * 144) = (u32x2){v1r.x, v1r.y}; *(u32x2*)(vb_ + vhi + 32 * 144) = (u32x2){v1r.z, v1r.w};
  }
  __syncthreads();
  for (int kb = 0; kb < nkb_max; ++kb) {
    const int cur = kb & 1;
    const bool more = kb + 1 < nkb_max;
    if (more) {
      const size_t ko = (size_t)(kb + 1) * 64;
      k0r = *(const u32x4*)(gk + ko * 512); k1r = *(const u32x4*)(gk + (ko + 32) * 512); rr = *(const u32x4*)(gr + ko * 32);
      v0r = *(const u32x4*)(gv + ko); v1r = *(const u32x4*)(gv + (size_t)32 * S + ko);
    }
    if (HALF && kb < nkb_w) {
      const char* kt_ = lds + cur * BUF; const char* vt_ = kt_ + KB;
#pragma unroll
      for (int kt = 0; kt < 2; ++kt) {
        __builtin_amdgcn_iglp_opt(0);
        f32x16 sh[QT];
#pragma unroll
        for (int qt = 0; qt < QT; ++qt)
#pragma unroll
          for (int i = 0; i < 16; ++i) sh[qt][i] = 0.f;
#pragma unroll
        for (int ks = 0; ks < 6; ++ks) {
          const bf16x8 kf = *(const bf16x8*)(kt_ + (kt * 32 + r) * 208 + ks * 32 + hh * 16);
#pragma unroll
          for (int qt = 0; qt < QT; ++qt) sh[qt] = MFMA32(kf, qf[qt][ks], sh[qt]);
        }
        bf16x8 ph[QT][2];
#pragma unroll
        for (int qt = 0; qt < QT; ++qt) {
          float mx = sh[qt][0];
#pragma unroll
          for (int i = 1; i < 16; ++i) mx = fmaxf(mx, sh[qt][i]);
          mx = fmaxf(mx, __shfl_xor(mx, 32));
          const bool need = mx > mrun[qt] + 8.f;
          if (__any(need)) {
            const float mnew = need ? mx : mrun[qt];
            const float alpha = __builtin_amdgcn_exp2f(mrun[qt] - mnew);
            mrun[qt] = mnew; lrun[qt] *= alpha;
#pragma unroll
            for (int dt = 0; dt < 2; ++dt)
#pragma unroll
              for (int i = 0; i < 16; ++i) o[dt][qt][i] *= alpha;
          }
          float ls = 0.f;
#pragma unroll
          for (int i = 0; i < 16; ++i) { const float pv = __builtin_amdgcn_exp2f(sh[qt][i] - mrun[qt]); ls += pv; sh[qt][i] = pv; }
          lrun[qt] += ls;
#pragma unroll
          for (int s2 = 0; s2 < 2; ++s2) {
            u32x4 w;
            w.x = pk_bf16(sh[qt][8 * s2 + 0], sh[qt][8 * s2 + 1]); w.y = pk_bf16(sh[qt][8 * s2 + 2], sh[qt][8 * s2 + 3]);
            w.z = pk_bf16(sh[qt][8 * s2 + 4], sh[qt][8 * s2 + 5]); w.w = pk_bf16(sh[qt][8 * s2 + 6], sh[qt][8 * s2 + 7]);
            ph[qt][s2] = __builtin_bit_cast(bf16x8, w);
          }
        }
#pragma unroll
        for (int dt = 0; dt < 2; ++dt)
#pragma unroll
          for (int s2 = 0; s2 < 2; ++s2) {
            const bf16x8 vf = *(const bf16x8*)(vt_ + (dt * 32 + r) * 144 + (kt * 2 + s2) * 32 + hh * 16);
#pragma unroll
            for (int qt = 0; qt < QT; ++qt) o[dt][qt] = MFMA32(vf, ph[qt][s2], o[dt][qt]);
          }
      }
    }
    if (!HALF && kb < nkb_w) {
      const char* kt_ = lds + cur * BUF; const char* vt_ = kt_ + KB;
      f32x16 st[2][QT];
#pragma unroll
      for (int kt = 0; kt < 2; ++kt)
#pragma unroll
        for (int qt = 0; qt < QT; ++qt)
#pragma unroll
          for (int i = 0; i < 16; ++i) st[kt][qt][i] = 0.f;
#pragma unroll
      for (int ks = 0; ks < 6; ++ks)
#pragma unroll
        for (int kt = 0; kt < 2; ++kt) {
          const bf16x8 kf = *(const bf16x8*)(kt_ + (kt * 32 + r) * 208 + ks * 32 + hh * 16);
#pragma unroll
          for (int qt = 0; qt < QT; ++qt) st[kt][qt] = MFMA32(kf, qf[qt][ks], st[kt][qt]);
        }
      bf16x8 pb[2][QT][2];
#pragma unroll
      for (int qt = 0; qt < QT; ++qt) {
        float mx = mrun[qt];
#pragma unroll
        for (int kt = 0; kt < 2; ++kt)
#pragma unroll
          for (int i = 0; i < 16; ++i) mx = fmaxf(mx, st[kt][qt][i]);
        mx = fmaxf(mx, __shfl_xor(mx, 32));
        const float alpha = __builtin_amdgcn_exp2f(mrun[qt] - mx);
        mrun[qt] = mx;
        float ls = 0.f;
#pragma unroll
        for (int kt = 0; kt < 2; ++kt) {
#pragma unroll
          for (int i = 0; i < 16; ++i) { const float pv = __builtin_amdgcn_exp2f(st[kt][qt][i] - mx); ls += pv; st[kt][qt][i] = pv; }
#pragma unroll
          for (int s2 = 0; s2 < 2; ++s2) {
            u32x4 w;
            w.x = pk_bf16(st[kt][qt][8 * s2 + 0], st[kt][qt][8 * s2 + 1]); w.y = pk_bf16(st[kt][qt][8 * s2 + 2], st[kt][qt][8 * s2 + 3]);
            w.z = pk_bf16(st[kt][qt][8 * s2 + 4], st[kt][qt][8 * s2 + 5]); w.w = pk_bf16(st[kt][qt][8 * s2 + 6], st[kt][qt][8 * s2 + 7]);
            pb[kt][qt][s2] = __builtin_bit_cast(bf16x8, w);
          }
        }
        lrun[qt] = lrun[qt] * alpha + ls;
#pragma unroll
        for (int dt = 0; dt < 2; ++dt)
#pragma unroll
          for (int i = 0; i < 16; ++i) o[dt][qt][i] *= alpha;
      }
#pragma unroll
      for (int dt = 0; dt < 2; ++dt)
#pragma unroll
        for (int kt = 0; kt < 2; ++kt)
#pragma unroll
          for (int s2 = 0; s2 < 2; ++s2) {
            const bf16x8 vf = *(const bf16x8*)(vt_ + (dt * 32 + r) * 144 + (kt * 2 + s2) * 32 + hh * 16);
#pragma unroll
            for (int qt = 0; qt < QT; ++qt) o[dt][qt] = MFMA32(vf, pb[kt][qt][s2], o[dt][qt]);
          }
    }
    if (more) {
      char* kb_ = lds + (cur ^ 1) * BUF; char* vb_ = kb_ + KB;
      *(u32x4*)(kb_ + kw0) = k0r; *(u32x4*)(kb_ + kw1) = k1r; *(u32x4*)(kb_ + rw) = rr;
      *(u32x2*)(vb_ + vlo) = (u32x2){v0r.x, v0r.y}; *(u32x2*)(vb_ + vhi) = (u32x2){v0r.z, v0r.w};
      *(u32x2*)(vb_ + vlo + 32 * 144) = (u32x2){v1r.x, v1r.y}; *(u32x2*)(vb_ + vhi + 32 * 144) = (u32x2){v1r.z, v1r.w};
    }
    __syncthreads();
  }
  if (nkb_w > 0) {
#pragma unroll
    for (int qt = 0; qt < QT; ++qt) {
      const float lt = lrun[qt] + __shfl_xor(lrun[qt], 32);
      const float inv = 1.f / lt;
      const int row = qrow0 + qt * 32 + r;
      float ss = 0.f;
#pragma unroll
      for (int dt = 0; dt < 2; ++dt)
#pragma unroll
        for (int i4 = 0; i4 < 4; ++i4) {
          const float a0 = o[dt][qt][4 * i4] * inv, a1 = o[dt][qt][4 * i4 + 1] * inv, a2 = o[dt][qt][4 * i4 + 2] * inv, a3 = o[dt][qt][4 * i4 + 3] * inv;
          ss += a0 * a0 + a1 * a1 + a2 * a2 + a3 * a3;
          u32x2 w; w.x = pk_bf16(a0, a1); w.y = pk_bf16(a2, a3);
          *(u32x2*)(p.mix + (size_t)row * 1024 + h * 64 + dt * 32 + 8 * i4 + 4 * hh) = w;
        }
      ss += __shfl_xor(ss, 32);
      if (hh == 0) p.attn_part[(size_t)row * 8 + h] = ss;
    }
  }
}

DI void phase4(const Params& p, char* lds, int qidx) {
  const int t = tid(), lane = t & 63, wid = t >> 6;
  const int nb = gridDim.x, bid = blockIdx.x;
  int* nxt = (int*)(lds + 65536);
  for (;;) {
    __syncthreads();
    if (t == 0) *nxt = atomicAdd(p.counters + qidx, 1);
    __syncthreads();
    const int it = *nxt;
    if (it >= 256 + 64 * 32) break;
    if (it < 256) attn_item<1, false>(p, 1, it >> 3, it & 7, 0, lds);
    else { const int j = it - 256; const int qq = 31 - (j >> 6), bh = j & 63; attn_item<2, true>(p, 0, bh >> 3, bh & 7, qq, lds); }
  }
  __syncthreads();
  for (int it = bid * 4 + wid; it < 8 * 128 * 32 + 1024; it += nb * 4) {
    if (it < 8 * 128 * 32) {
      const int g = it & 31, c = (it >> 5) & 127, b = it >> 12;
      const float2 s0 = p.S[(size_t)it * 64 + lane];
      float hr = s0.x, hi = s0.y;
      ssm_chunk(p, b * 8192 + c * 64, g, hr, hi, true, lds + wid * 8704);
      if (c == 127) { p.out[OFF_HRP + (size_t)(b * 32 + g) * 64 + lane] = hr; p.out[OFF_HIP + (size_t)(b * 32 + g) * 64 + lane] = hi; }
    } else {
      const int j = it - 8 * 128 * 32, g = j & 31, b = j >> 5;
      float hr = p.in[4][(size_t)(b * 32 + g) * 64 + lane], hi = p.in[5][(size_t)(b * 32 + g) * 64 + lane];
      ssm_chunk(p, NTP + b * 64, g, hr, hi, true, lds + wid * 8704);
      p.out[OFF_HRS + (size_t)(b * 32 + g) * 64 + lane] = hr; p.out[OFF_HIS + (size_t)(b * 32 + g) * 64 + lane] = hi;
    }
  }
}

DI void phase5(const Params& p, char* lds) {
  {
    auto tile_fn = [&](int j, int& m0, int& n0) -> bool { const int li = (int)(blockIdx.x >> 3) + j * (int)(gridDim.x >> 3); const int ti_ = li / 4, tj_ = li - ti_ * 4; const int tbig = ti_ * 8 + (int)(blockIdx.x & 7); if (tbig >= 528) return false; m0 = tbig * 128; n0 = tj_ * 128; return true; };
    auto rs_fn = [&](int m0, int t) -> float2 { return make_float2(0.f, 0.f); };
    auto epi = [&](f32x16 (&acc)[2][2], int m0, int n0, const float* rs, int fstage) { (void)fstage;
    const int tn = n0 >> 7; (void)tn;
    { EPI_IDS
#pragma unroll
    for (int mt = 0; mt < 2; ++mt) {
      const int row = m0 + wm * 64 + mt * 32 + r;
      float ss = 0.f;
#pragma unroll
      for (int nt = 0; nt < 2; ++nt)
#pragma unroll
        for (int i4 = 0; i4 < 4; ++i4) {
          const int col = n0 + wn * 64 + nt * 32 + 8 * i4 + 4 * hh;
          const u32x2 yv = *(const u32x2*)(p.ssm_y + (size_t)row * 512 + col);
          const float y0 = __uint_as_float(yv.x << 16), y1 = __uint_as_float(yv.x & 0xffff0000u), y2 = __uint_as_float(yv.y << 16), y3 = __uint_as_float(yv.y & 0xffff0000u);
          const float o0 = y0 / (1.f + __expf(-acc[mt][nt][4 * i4])), o1 = y1 / (1.f + __expf(-acc[mt][nt][4 * i4 + 1]));
          const float o2 = y2 / (1.f + __expf(-acc[mt][nt][4 * i4 + 2])), o3 = y3 / (1.f + __expf(-acc[mt][nt][4 * i4 + 3]));
          ss += o0 * o0 + o1 * o1 + o2 * o2 + o3 * o3;
          u32x2 w; w.x = pk_bf16(o0, o1); w.y = pk_bf16(o2, o3);
          *(u32x2*)(p.mix + (size_t)row * 1024 + 512 + col) = w;
        }
      ss += __shfl_xor(ss, 32);
      if (hh == 0) p.ssm_part[(size_t)row * 8 + tn * 2 + wn] = ss;
    }
    }

    };
    gemm_stream(p.ssm_y, 512, p.WgT, 512, 8, lds, 0, tile_fn, rs_fn, epi);
  }
}

DI void phase6(const Params& p, char* lds) {
  const int xb_ = blockIdx.x & 7, xl_ = blockIdx.x >> 3, nbx_ = gridDim.x >> 3;
  {
    auto tile_fn = [&](int j, int& m0, int& n0) -> bool { const int li6 = xl_ + j * nbx_, tm = (li6 >> 3) * 8 + xb_; if (tm >= 528) return false; m0 = tm * 128; n0 = (li6 & 7) * 128; return true; };
    auto rs_fn = [&](int m0, int t) -> float2 {
      const f32x4 a0 = *(const f32x4*)(p.attn_part + (size_t)(m0 + t) * 8), a1 = *(const f32x4*)(p.attn_part + (size_t)(m0 + t) * 8 + 4);
      const float sa = (a0[0] + a0[1]) + (a0[2] + a0[3]) + (a1[0] + a1[1]) + (a1[2] + a1[3]);
      const f32x4 b0 = *(const f32x4*)(p.ssm_part + (size_t)(m0 + t) * 8), b1 = *(const f32x4*)(p.ssm_part + (size_t)(m0 + t) * 8 + 4);
      const float sb = (b0[0] + b0[1]) + (b0[2] + b0[3]) + (b1[0] + b1[1]) + (b1[2] + b1[3]);
      const float ra = rsqrtf(sa * (1.f / 512.f) + EPS), rb = rsqrtf(sb * (1.f / 512.f) + EPS);
      return make_float2(rb, ra / rb); };
    auto epi = [&](f32x16 (&acc)[2][2], int m0, int n0, const float* rs, int fstage) { (void)fstage;
    const int tn = n0 >> 7;
    { EPI_IDS
#pragma unroll
    for (int mt = 0; mt < 2; ++mt) {
      const int rl = wm * 64 + mt * 32 + r, row = m0 + rl;
      const float sc = rs[rl];
      const float* xr = xrow(p, row);
      float ss = 0.f;
#pragma unroll
      for (int nt = 0; nt < 2; ++nt)
#pragma unroll
        for (int i4 = 0; i4 < 4; ++i4) {
          const int col = n0 + wn * 64 + nt * 32 + 8 * i4 + 4 * hh;
          const f32x4 xv = *(const f32x4*)(xr + col);
          f32x4 hv;
#pragma unroll
          for (int jj = 0; jj < 4; ++jj) { hv[jj] = xv[jj] + acc[mt][nt][4 * i4 + jj] * sc; ss += hv[jj] * hv[jj]; }
          u32x2 w; w.x = pk_bf16(hv[0], hv[1]); w.y = pk_bf16(hv[2], hv[3]);
          *(u32x2*)(p.hb + (size_t)row * 1024 + col) = w;
          if (i4 == 1 || i4 == 3) __builtin_amdgcn_sched_barrier(0);
        }
      ss += __shfl_xor(ss, 32);
      if (hh == 0) p.h_part[(size_t)row * 16 + tn * 2 + wn] = ss;
    }
    }
    };
    gemm_stream(p.mix, 1024, p.WoT, 1024, 16, lds, 8, tile_fn, rs_fn, epi);
  }
}

DI void phase7(const Params& p, char* lds) {
  float* rs = (float*)(lds + 65536);
  const int xb_ = blockIdx.x & 7, xl_ = blockIdx.x >> 3, nbx_ = gridDim.x >> 3;
  {
    auto tile_fn = [&](int j, int& m0, int& n0) -> bool { const int tm = j * (nbx_ >> 2) + (xl_ >> 2); if (tm >= 528) return false; m0 = tm * 128; n0 = (xb_ * 4 + (xl_ & 3)) * 128; return true; };
    auto rs_fn = [&](int m0, int t) -> float2 { float sm = 0.f; for (int q = 0; q < 4; ++q) { const f32x4 v = *(const f32x4*)(p.h_part + (size_t)(m0 + t) * 16 + 4 * q); sm += (v[0] + v[1]) + (v[2] + v[3]); } return make_float2(rsqrtf(sm * (1.f / 1024.f) + EPS), 0.f); };
    auto epi = [&](f32x16 (&acc)[2][2], int m0, int n0, const float* rs, int fstage) { (void)fstage;
    const int tn = n0 >> 7; (void)tn;
    { EPI_IDS
    char* stg = lds + (wid < 2 ? 0 : 32768) + fstage * 16384 + (wid & 1) * 8192;
#pragma unroll
    for (int mt = 0; mt < 2; ++mt) {
      const int rloc = mt * 32 + r;
      const float sc = rs[wm * 64 + rloc];
#pragma unroll
      for (int nt = 0; nt < 2; ++nt)
#pragma unroll
        for (int i4 = 0; i4 < 4; ++i4) {
          float v[4];
#pragma unroll
          for (int jj = 0; jj < 4; ++jj) { const float a_ = fmaxf(acc[mt][nt][4 * i4 + jj] * sc, 0.f); v[jj] = a_ * a_; }
          u32x2 w; w.x = pk_bf16(v[0], v[1]); w.y = pk_bf16(v[2], v[3]);
          *(u32x2*)(stg + rloc * 128 + (((nt * 4 + i4) ^ (rloc & 7)) << 4) + hh * 8) = w;
        }
    }
    asm volatile("s_waitcnt lgkmcnt(0)" ::: "memory");
    __builtin_amdgcn_wave_barrier();
    bf16_t* gdst = p.act + ((((size_t)(m0 >> 7) * 64 + (n0 >> 6) + wn) * 128 + wm * 64) * 64);
#pragma unroll
    for (int s8 = 0; s8 < 8; ++s8) {
      const int rloc = s8 * 8 + (lane >> 3), c = lane & 7;
      const u32x4 q = *(const u32x4*)(stg + rloc * 128 + ((c ^ (rloc & 7)) << 4));
      *(u32x4*)(gdst + rloc * 64 + c * 8) = q;
    }
    }
    __syncthreads();
    };
    gemm_stream(p.hb, 1024, p.WuT, 1024, 16, lds, 0, tile_fn, rs_fn, epi);
  }
}

DI void phase8(const Params& p, char* lds) {
  const int xb_ = blockIdx.x & 7, xl_ = blockIdx.x >> 3, nbx_ = gridDim.x >> 3;
  {
    auto tile_fn = [&](int j, int& m0, int& n0) -> bool { const int li = (int)(blockIdx.x >> 3) + j * (int)(gridDim.x >> 3); const int ti_ = li / 8, tj_ = li - ti_ * 8; const int tbig = ti_ * 8 + (int)(blockIdx.x & 7); if (tbig >= 528) return false; m0 = tbig * 128; n0 = tj_ * 128; return true; };
    auto rs_fn = [&](int m0, int t) -> float2 { return make_float2(0.f, 0.f); };
    auto epi = [&](f32x16 (&acc)[2][2], int m0, int n0, const float* rs, int fstage) { (void)fstage;
    const int tn = n0 >> 7; (void)tn;
    { EPI_IDS
#pragma unroll
    for (int mt = 0; mt < 2; ++mt) {
      const int row = m0 + wm * 64 + mt * 32 + r;
      float ss = 0.f;
#pragma unroll
      for (int nt = 0; nt < 2; ++nt)
#pragma unroll
        for (int i4 = 0; i4 < 4; ++i4) {
          float* yp = p.out + OFF_Y + (size_t)row * 1024 + n0 + wn * 64 + nt * 32 + 8 * i4 + 4 * hh;
          const u32x2 hq = *(const u32x2*)(p.hb + (size_t)row * 1024 + n0 + wn * 64 + nt * 32 + 8 * i4 + 4 * hh);
          f32x4 ov = {__uint_as_float(hq.x << 16), __uint_as_float(hq.x & 0xffff0000u), __uint_as_float(hq.y << 16), __uint_as_float(hq.y & 0xffff0000u)};
#pragma unroll
          for (int jj = 0; jj < 4; ++jj) { ov[jj] += acc[mt][nt][4 * i4 + jj]; ss += ov[jj] * ov[jj]; }
          *(f32x4*)yp = ov;
          if (i4 == 1 || i4 == 3) __builtin_amdgcn_sched_barrier(0);
        }
      ss += __shfl_xor(ss, 32);
      if (hh == 0) p.out_part[(size_t)row * 16 + tn * 2 + wn] = ss;
    }
    }

    };
    gemm_stream<true>(p.act, 4096, p.WdT, 4096, 64, lds, 0, tile_fn, rs_fn, epi);
  }
}

DI void phase9(const Params& p) {
  const int t = tid(), lane = t & 63, wid = t >> 6;
  for (int row = blockIdx.x * 4 + wid; row < NT; row += gridDim.x * 4) {
    float s = 0.f;
    for (int j = 0; j < 16; ++j) s += p.out_part[(size_t)row * 16 + j];
    const float rstd = rsqrtf(s * (1.f / 1024.f) + EPS);
    float* y = p.out + OFF_Y + (size_t)row * 1024;
#pragma unroll
    for (int j = 0; j < 4; ++j) {
      f32x4 v = *(const f32x4*)(y + lane * 4 + 256 * j);
      const f32x4 g = *(const f32x4*)(p.in[27] + lane * 4 + 256 * j);
      v[0] *= rstd * g[0]; v[1] *= rstd * g[1]; v[2] *= rstd * g[2]; v[3] *= rstd * g[3];
      *(f32x4*)(y + lane * 4 + 256 * j) = v;
    }
  }
}

DI void grid_barrier(unsigned* cnt, unsigned target) {
  asm volatile("s_waitcnt vmcnt(0)" ::: "memory");
  __syncthreads();
  if (tid() == 0) {
    __builtin_amdgcn_fence(__ATOMIC_RELEASE, "agent");
    asm volatile("s_waitcnt vmcnt(0)" ::: "memory");
    __hip_atomic_fetch_add(cnt, 1u, __ATOMIC_RELAXED, __HIP_MEMORY_SCOPE_AGENT);
    while (__hip_atomic_load(cnt, __ATOMIC_RELAXED, __HIP_MEMORY_SCOPE_AGENT) < target) __builtin_amdgcn_s_sleep(2);
  }
  __syncthreads();
  __builtin_amdgcn_fence(__ATOMIC_ACQUIRE, "agent");
  asm volatile("s_waitcnt vmcnt(0)" ::: "memory");
}

#define XB_TMO      128
#define XB_XCNT(j)  (256  + 64 * (j))
#define XB_XSUB(j)  (1280 + 64 * (j))
#define XB_XGEN(j)  (2304 + 64 * (j))
#define XB_TOP      3328
#define XB_TOPGEN   3392
#define XCD_BAR_WORDS 3456
#define XB_SPIN_CAP (1u << 22)
#define LAS __attribute__((address_space(3)))
DI unsigned xb_ld(unsigned* p)              { return __hip_atomic_load(p, __ATOMIC_RELAXED, __HIP_MEMORY_SCOPE_AGENT); }
DI unsigned xb_add(unsigned* p, unsigned v) { return __hip_atomic_fetch_add(p, v, __ATOMIC_RELAXED, __HIP_MEMORY_SCOPE_AGENT); }
DI unsigned xb_xcc_id() { return (unsigned)__builtin_amdgcn_s_getreg((3 << 11) | 20) & 0xFu; }
#define XB_SPIN(cond, bar) do { unsigned _sp = 0; while (cond) { __builtin_amdgcn_s_sleep(1); \
    if ((++_sp & 255u) == 0u) { if (xb_ld(&(bar)[XB_TMO])) break; if (_sp > XB_SPIN_CAP) { atomicAdd(&(bar)[XB_TMO], 1u); break; } } } } while (0)
struct XcdBarrier { unsigned* bar; unsigned x; volatile LAS unsigned* st; };
DI XcdBarrier xcd_barrier_post(unsigned* bar, volatile LAS unsigned* st) {
  XcdBarrier b; b.bar = bar; b.x = xb_xcc_id(); b.st = st;
  if (tid() == 0) (void)xb_add(&bar[XB_XCNT(b.x)], 1u);
  return b;
}
DI void xcd_barrier_complete(unsigned* bar, unsigned x, unsigned& nloc, unsigned& nx) {
  const unsigned G = gridDim.x * gridDim.y * gridDim.z;
  unsigned sum, cnt, mine, sp = 0u;
  for (;;) {
    sum = 0u; cnt = 0u; mine = 0u;
#pragma unroll
    for (unsigned j = 0; j < 16; ++j) { const unsigned c = xb_ld(&bar[XB_XCNT(j)]); sum += c; cnt += (c > 0u) ? 1u : 0u; mine = (j == x) ? c : mine; }
    if (sum == G) break;
    __builtin_amdgcn_s_sleep(1);
    if ((++sp & 255u) == 0u) { if (xb_ld(&bar[XB_TMO])) break; if (sp > XB_SPIN_CAP) { atomicAdd(&bar[XB_TMO], 1u); break; } }
  }
  nloc = mine > 0u ? mine : 1u; nx = cnt > 0u ? cnt : 1u;
}
DI void xcd_barrier(const XcdBarrier& b) {
  asm volatile("s_waitcnt vmcnt(0)" ::: "memory");
  __syncthreads();
  if (tid() == 0) {
    unsigned* bar = b.bar;
    __builtin_amdgcn_s_waitcnt(0);
    unsigned nloc = b.st[0], nx = b.st[1];
    if (nloc == 0u) { xcd_barrier_complete(bar, b.x, nloc, nx); b.st[0] = nloc; b.st[1] = nx; }
    const unsigned old = xb_add(&bar[XB_XSUB(b.x)], 1u);
    const unsigned gen = old / nloc;
    if (old + 1u == (gen + 1u) * nloc) {
      __builtin_amdgcn_fence(__ATOMIC_RELEASE, "agent");
      asm volatile("s_waitcnt vmcnt(0)" ::: "memory");
      const unsigned og = xb_add(&bar[XB_TOP], 1u);
      const unsigned tg = og / nx;
      if (og + 1u == (tg + 1u) * nx) xb_add(&bar[XB_TOPGEN], 1u);
      else XB_SPIN(xb_ld(&bar[XB_TOPGEN]) == tg, bar);
      __builtin_amdgcn_fence(__ATOMIC_ACQUIRE, "agent");
      xb_add(&bar[XB_XGEN(b.x)], 1u);
      asm volatile("s_waitcnt vmcnt(0)" ::: "memory");
    } else {
      XB_SPIN(xb_ld(&bar[XB_XGEN(b.x)]) == gen, bar);
      __builtin_amdgcn_fence(__ATOMIC_ACQUIRE, "agent");
      asm volatile("s_waitcnt vmcnt(0)" ::: "memory");
    }
  }
  __syncthreads();
}

template <bool COOP>
__global__ void __launch_bounds__(256, 2) mega(Params p) {
  __shared__ __attribute__((aligned(16))) char lds[LDS_BYTES];
  XcdBarrier xb{};
  if (COOP) {
    volatile LAS unsigned* st = (volatile LAS unsigned*)(lds + 67584);
    if (tid() == 0) { st[0] = 0u; st[1] = 0u; }
    __syncthreads();
    xb = xcd_barrier_post((unsigned*)p.counters + 64, st);
  }
  for (int ph = p.ph_lo; ph < p.ph_hi; ++ph) {
#ifdef ONLY_PHASE
    if (ph != ONLY_PHASE) continue;
#endif
    switch (ph) {
      case 0: phase0(p, lds); break;
      case 1: phase1(p, lds); break;
      case 2: phase2(p, lds); break;
      case 3: phase3(p, lds); break;
      case 4: phase4(p, lds, 0); break;
      case 5: phase5(p, lds); break;
      case 6: phase6(p, lds); break;
      case 7: phase7(p, lds); break;
      case 8: phase8(p, lds); break;
      default: phase9(p); break;
    }
#ifdef DOUBLE_PHASE
    if (ph == DOUBLE_PHASE) {
      __syncthreads();
      switch (ph) { case 0: phase0(p, lds); break; case 1: phase1(p, lds); break; case 2: phase2(p, lds); break; case 3: phase3(p, lds); break; case 4: phase4(p, lds, 1); break;
                    case 5: phase5(p, lds); break; case 6: phase6(p, lds); break; case 7: phase7(p, lds); break; default: break; }
    }
#endif
    if (COOP) { if (ph + 1 < p.ph_hi) { if (ph == 0) cg::this_grid().sync(); else xcd_barrier(xb); } }
  }
}

static size_t al256(size_t x) { return (x + 255) & ~(size_t)255; }

extern "C" void kernel_launch(void* const* d_in, const int* in_sizes, int n_in, void* d_out, int out_size, void* d_ws, size_t ws_size, hipStream_t stream) {
  Params p{};
  for (int i = 0; i < 28; ++i) p.in[i] = (const float*)d_in[i];
  p.out = (float*)d_out;
  char* base = (char*)d_ws; size_t off = 0;
  auto take = [&](size_t bytes) { char* q = base + off; off = al256(off + bytes); return q; };
  p.WinT = (bf16_t*)take((size_t)1664 * 1024 * 2);
  p.WqT = (bf16_t*)take((size_t)768 * 768 * 2);
  p.WkT = (bf16_t*)take((size_t)512 * 256 * 2);
  p.WvT = (bf16_t*)take((size_t)512 * 256 * 2);
  p.WgT = (bf16_t*)take((size_t)512 * 512 * 2);
  p.WoT = (bf16_t*)take((size_t)1024 * 1024 * 2);
  p.WuT = (bf16_t*)take((size_t)4096 * 1024 * 2);
  p.WdT = (bf16_t*)take((size_t)1024 * 4096 * 2);
  p.BbT = (bf16_t*)take((size_t)32 * 128 * 16 * 2);
  p.CcT = (bf16_t*)take((size_t)32 * 16 * 128 * 2);
  p.lam = (float2*)take(2048 * 8);
  p.lam64 = (float2*)take(2048 * 8);
  p.rope = (float2*)take((size_t)8192 * 16 * 8);
  p.rstd_x = (float*)take((size_t)NT * 4);
  p.cq_part = (float*)take((size_t)NT * 12 * 4);
  p.ckv_part = (float*)take((size_t)NT * 4 * 4);
  p.attn_part = (float*)take((size_t)NT * 8 * 4);
  p.ssm_part = (float*)take((size_t)NT * 8 * 4);
  p.h_part = (float*)take((size_t)NT * 16 * 4);
  p.out_part = (float*)take((size_t)NT * 16 * 4);
  p.counters = (int*)take(16384);
  p.E = (float2*)take((size_t)8 * 128 * 32 * 64 * 8);
  p.S = (float2*)take((size_t)8 * 128 * 32 * 64 * 8);
  const size_t a0 = off;
  p.Kn = (bf16_t*)take((size_t)NK * 512 * 2);
  const size_t aVt = off;
  p.Vt = (bf16_t*)take((size_t)NK * 512 * 2);
  p.Q = (bf16_t*)take((size_t)NT * 768 * 2);
  p.latb = (bf16_t*)take((size_t)NK * 256 * 2);
  p.krb = (bf16_t*)take((size_t)NK * 32 * 2);
  p.ub = (bf16_t*)take((size_t)NT * 512 * 2);
  const size_t aSsmY = off;
  p.ssm_y = (bf16_t*)take((size_t)NT * 512 * 2);
  p.mix = (bf16_t*)take((size_t)NT * 1024 * 2);
  const size_t total = off;
  p.xb = (bf16_t*)(base + a0);
  p.cq = (bf16_t*)(base + aVt);
  p.ckv_raw = (float*)(base + aVt + al256((size_t)NT * 768 * 2));
  p.act = (bf16_t*)(base + a0);
  const size_t aHb = a0 + al256((size_t)NT * 4096 * 2);
  p.hb = (bf16_t*)(base + aHb);
  if (aHb + (size_t)NT * 1024 * 2 > aSsmY || total > ws_size) { fprintf(stderr, "workspace layout error: total %zu ws %zu\n", total, ws_size); return; }

  const int MULTI = 0;
  hipMemsetAsync(p.counters, 0, 16384, stream);
  if (MULTI) {
    for (int ph = 0; ph < NPHASE; ++ph) {
      p.ph_lo = ph; p.ph_hi = ph + 1;
      hipLaunchKernelGGL(mega<false>, dim3(512), dim3(256), 0, stream, p);
    }
  } else {
    static int grid_blocks = 0;
    if (!grid_blocks) {
      int dev = 0, cus = 0, per_cu = 0;
      hipGetDevice(&dev);
      hipDeviceGetAttribute(&cus, hipDeviceAttributeMultiprocessorCount, dev);
      hipOccupancyMaxActiveBlocksPerMultiprocessor(&per_cu, mega<true>, 256, 0);
      grid_blocks = cus * per_cu;
    }
    p.ph_lo = 0; p.ph_hi = NPHASE;
    void* args[] = {&p};
    hipError_t e = hipLaunchCooperativeKernel((void*)mega<true>, dim3(grid_blocks), dim3(256), args, 0, stream);
    if (e != hipSuccess) fprintf(stderr, "cooperative launch failed: %s (grid %d)\n", hipGetErrorString(e), grid_blocks);
  }
}
```

```cpp
#include <hip/hip_runtime.h>
#include <hip/hip_cooperative_groups.h>
#include <stdint.h>
#include <cstdio>
namespace cg = cooperative_groups;
#define DI __device__ __forceinline__

typedef unsigned short bf16_t;
typedef short bf16x8 __attribute__((ext_vector_type(8)));
typedef float f32x16 __attribute__((ext_vector_type(16)));
typedef float f32x4 __attribute__((ext_vector_type(4)));
typedef unsigned u32x4 __attribute__((ext_vector_type(4)));
typedef unsigned u32x2 __attribute__((ext_vector_type(2)));

constexpr int NTP = 65536, NTS = 2048, NT = NTP + NTS, NK = NTP + 32 * 4160;
constexpr int SKS = 4160;
constexpr size_t OFF_Y = 0;
constexpr size_t OFF_LATP = (size_t)NT * 1024;
constexpr size_t OFF_KRP = OFF_LATP + (size_t)NTP * 256;
constexpr size_t OFF_HRP = OFF_KRP + (size_t)NTP * 32;
constexpr size_t OFF_HIP = OFF_HRP + 8 * 32 * 64;
constexpr size_t OFF_LATS = OFF_HIP + 8 * 32 * 64;
constexpr size_t OFF_KRS = OFF_LATS + (size_t)NTS * 256;
constexpr size_t OFF_HRS = OFF_KRS + (size_t)NTS * 32;
constexpr size_t OFF_HIS = OFF_HRS + 32 * 32 * 64;
constexpr size_t VT_S_OFF = (size_t)8 * 512 * 8192;
constexpr float EPS = 1e-6f;
constexpr int LDS_BYTES = 67600;
constexpr int NPHASE = 10;
constexpr int AQT = 1, NQQ = 128 / (4 / (64 / (32 * AQT)));

struct Params {
  const float* in[28];
  float* out;
  bf16_t *WinT, *WqT, *WkT, *WvT, *WgT, *WoT, *WuT, *WdT, *BbT, *CcT;
  float2 *lam, *lam64, *rope;
  float *rstd_x, *cq_part, *ckv_part, *attn_part, *ssm_part, *h_part, *out_part;
  int* counters;
  float2 *E, *S;
  bf16_t *Kn, *Vt, *Q, *latb, *krb, *ub, *ssm_y, *mix, *xb, *cq, *hb, *act;
  float* ckv_raw;
  int ph_lo, ph_hi;
};

DI int tid() { int t = __builtin_amdgcn_workitem_id_x(); asm volatile("" : "+v"(t)); return t; }
typedef __bf16 nbf16x2 __attribute__((ext_vector_type(2)));
typedef float f32x2 __attribute__((ext_vector_type(2)));
DI unsigned pk_bf16(float lo, float hi) { f32x2 v = {lo, hi}; return __builtin_bit_cast(unsigned, __builtin_convertvector(v, nbf16x2)); }
DI bf16_t f2bf(float x) { return (bf16_t)(pk_bf16(x, 0.f) & 0xffffu); }
DI float bf2f(bf16_t v) { return __uint_as_float(((unsigned)v) << 16); }
DI int crow(int i, int hh) { return (i & 3) + 8 * (i >> 2) + 4 * hh; }
DI const float* xrow(const Params& p, int row) { return row < NTP ? p.in[0] + (size_t)row * 1024 : p.in[1] + (size_t)(row - NTP) * 1024; }
DI int pos_of(int row) { return row < NTP ? (row & 8191) : 4096 + ((row - NTP) & 63); }
DI int kr_of(int row) { return row < NTP ? row : NTP + ((row - NTP) >> 6) * SKS + 4096 + ((row - NTP) & 63); }
#define MFMA32(a, b, c) __builtin_amdgcn_mfma_f32_32x32x16_bf16((a), (b), (c), 0, 0, 0)
#define MFMA16(a, b, c) __builtin_amdgcn_mfma_f32_16x16x32_bf16((a), (b), (c), 0, 0, 0)

DI void sincos_d(double x, double& s4, double& c4) {
  double k = rint(x * 0.15915494309189535);
  double rr = fma(-k, 6.283185307179586, x);
  rr = fma(-k, 2.4492935982947064e-16, rr);
  double y = rr * 0.25, y2 = y * y;
  double s = y * (1 - y2 / 6 * (1 - y2 / 20 * (1 - y2 / 42 * (1 - y2 / 72 * (1 - y2 / 110 * (1 - y2 / 156 * (1 - y2 / 210)))))));
  double c = 1 - y2 / 2 * (1 - y2 / 12 * (1 - y2 / 30 * (1 - y2 / 56 * (1 - y2 / 90 * (1 - y2 / 132 * (1 - y2 / 182))))));
  double s2 = 2 * s * c, c2 = 1 - 2 * s * s;
  s4 = 2 * s2 * c2; c4 = 1 - 2 * s2 * s2;
}

DI void gemm_core(const bf16_t* __restrict__ A, int lda, const bf16_t* __restrict__ B, int ldb, int nk,
                  int m0, int n0, char* lds, f32x16 (&acc)[2][2], int midk, const float* ratio) {
  const int t = tid(), lane = t & 63, wid = t >> 6, wm = wid >> 1, wn = wid & 1;
  const int r = lane & 31, hh = lane >> 5;
  const int lc = t & 7, lr = t >> 3;
  const unsigned woff = lr * 128 + ((lc ^ ((lr >> 1) & 7)) << 4);
  const bf16_t* ga = A + (size_t)(m0 + lr) * lda + lc * 8;
  const bf16_t* gb = B + (size_t)(n0 + lr) * ldb + lc * 8;
  char* sA = lds; char* sB = lds + 32768;
  u32x4 ra[4], rb[4];
#pragma unroll
  for (int i = 0; i < 4; ++i) { ra[i] = *(const u32x4*)(ga + (size_t)(32 * i) * lda); rb[i] = *(const u32x4*)(gb + (size_t)(32 * i) * ldb); }
#pragma unroll
  for (int i = 0; i < 4; ++i) { *(u32x4*)(sA + woff + i * 4096) = ra[i]; *(u32x4*)(sB + woff + i * 4096) = rb[i]; }
#pragma unroll
  for (int a = 0; a < 2; ++a)
#pragma unroll
    for (int b = 0; b < 2; ++b)
#pragma unroll
      for (int i = 0; i < 16; ++i) acc[a][b][i] = 0.f;
  __syncthreads();
  const int rsw = (r >> 1) & 7;
  const unsigned aoff = (wm * 64 + r) * 128, boff = (wn * 64 + r) * 128;
  for (int kt = 0; kt < nk; ++kt) {
    const int cur = kt & 1;
    const bool more = (kt + 1 < nk);
    if (more) {
      const bf16_t* ga2 = ga + (kt + 1) * 64; const bf16_t* gb2 = gb + (kt + 1) * 64;
#pragma unroll
      for (int i = 0; i < 4; ++i) { ra[i] = *(const u32x4*)(ga2 + (size_t)(32 * i) * lda); rb[i] = *(const u32x4*)(gb2 + (size_t)(32 * i) * ldb); }
    }
    if (midk && kt == midk) {
#pragma unroll
      for (int mt = 0; mt < 2; ++mt)
      { const float f = ratio[wm * 64 + mt * 32 + r];
#pragma unroll
        for (int i = 0; i < 16; ++i) { acc[mt][0][i] *= f; acc[mt][1][i] *= f; } }
    }
    const char* cA = sA + cur * 16384; const char* cB = sB + cur * 16384;
#pragma unroll
    for (int ks = 0; ks < 4; ++ks) {
      const unsigned co = (((ks * 2 + hh) ^ rsw) << 4);
      const bf16x8 a0 = *(const bf16x8*)(cA + aoff + co), a1 = *(const bf16x8*)(cA + aoff + 4096 + co);
      const bf16x8 b0 = *(const bf16x8*)(cB + boff + co), b1 = *(const bf16x8*)(cB + boff + 4096 + co);
      acc[0][0] = MFMA32(b0, a0, acc[0][0]); acc[0][1] = MFMA32(b1, a0, acc[0][1]);
      acc[1][0] = MFMA32(b0, a1, acc[1][0]); acc[1][1] = MFMA32(b1, a1, acc[1][1]);
    }
    if (more) {
      char* nA = sA + (cur ^ 1) * 16384; char* nB = sB + (cur ^ 1) * 16384;
#pragma unroll
      for (int i = 0; i < 4; ++i) { *(u32x4*)(nA + woff + i * 4096) = ra[i]; *(u32x4*)(nB + woff + i * 4096) = rb[i]; }
    }
    __syncthreads();
  }
}

DI void rowscale_load(float* rs, const float* src, int np, float inv_dim, int m0) {
  const int t = tid();
  if (t < 128) {
    const int row = m0 + t;
    if (np == 0) rs[t] = src[row];
    else { float s = 0.f; for (int j = 0; j < np; ++j) s += src[(size_t)row * np + j]; rs[t] = rsqrtf(s * inv_dim + EPS); }
  }
}

template <bool BLKA = false, class TileFn, class RsFn, class EpiFn>
DI void gemm_stream(const bf16_t* __restrict__ A, int lda, const bf16_t* __restrict__ B, int ldb, int nk, char* lds, int midk,
                    TileFn tile_fn, RsFn rs_fn, EpiFn epi) {
  int m0, n0;
  if (!tile_fn(0, m0, n0)) return;
  const int t = tid(), lane = t & 63, wid = t >> 6, wm = wid >> 1, wn = wid & 1;
  const int r = lane & 31, hh = lane >> 5;
  const int lc = t & 7, lr = t >> 3;
  const unsigned woff = lr * 128 + ((lc ^ ((lr >> 1) & 7)) << 4);
  char* sA = lds; char* sB = lds + 32768;
  float* rsbuf = (float*)(lds + 65536);
  const int rsw = (r >> 1) & 7;
  const unsigned aoff = (wm * 64 + r) * 128, boff = (wn * 64 + r) * 128;
  int lj = 0, lkt = 0, lm0 = m0, ln0 = n0; bool lvalid = true;
  u32x4 ra0[4], rb0[4], ra1[4], rb1[4];
#define GS_LOAD(RA, RB) do {   \
        \
      const bf16_t* ga_ = BLKA ? A + ((size_t)(lm0 >> 7) * nk + lkt) * 8192 + lr * 64 + lc * 8 : A + (size_t)(lm0 + lr) * lda + lc * 8 + lkt * 64; const bf16_t* gb_ = B + (size_t)(ln0 + lr) * ldb + lc * 8 + lkt * 64; \
      _Pragma("unroll") for (int i = 0; i < 4; ++i) { RA[i] = *(const u32x4*)(ga_ + (size_t)(32 * i) * (BLKA ? 64 : lda)); RB[i] = *(const u32x4*)(gb_ + (size_t)(32 * i) * ldb); } \
      if (++lkt == nk) { lkt = 0; if (lvalid) { ++lj; lvalid = tile_fn(lj, lm0, ln0); } } } while (0)
  GS_LOAD(ra0, rb0);
  GS_LOAD(ra1, rb1);
  {
    float2 rv = make_float2(0.f, 0.f);
    if (t < 128) rv = rs_fn(m0, t);
    __syncthreads();
#pragma unroll
    for (int i = 0; i < 4; ++i) { *(u32x4*)(sA + woff + i * 4096) = ra0[i]; *(u32x4*)(sB + woff + i * 4096) = rb0[i]; }
    if (t < 128) { rsbuf[t] = rv.x; rsbuf[128 + t] = rv.y; }
    __syncthreads();
  }
  int cur = 0;
  for (int j = 0;; ++j) {
    int m1 = 0, n1 = 0;
    const bool has_next = tile_fn(j + 1, m1, n1);
    const float* rs = rsbuf + (j & 1) * 256;
    f32x16 acc[2][2];
#pragma unroll
    for (int a = 0; a < 2; ++a)
#pragma unroll
      for (int b = 0; b < 2; ++b)
#pragma unroll
        for (int i = 0; i < 16; ++i) acc[a][b][i] = 0.f;
#define GS_STEP(RL_A, RL_B, RW_A, RW_B, KT) do { \
      const bool last_ = ((KT) + 1 == nk); const bool wr_ = !last_ || has_next; \
      float2 rv_ = make_float2(0.f, 0.f); \
      if (last_ && has_next) { if (t < 128) rv_ = rs_fn(m1, t); asm volatile("" : "+v"(rv_.x), "+v"(rv_.y)); }   \
      GS_LOAD(RL_A, RL_B); \
      if (midk && (KT) == midk) { _Pragma("unroll") for (int mt = 0; mt < 2; ++mt) { const float f = rs[128 + wm * 64 + mt * 32 + r]; \
          _Pragma("unroll") for (int i = 0; i < 16; ++i) { acc[mt][0][i] *= f; acc[mt][1][i] *= f; } } } \
      const char* cA = sA + cur * 16384; const char* cB = sB + cur * 16384; \
      __builtin_amdgcn_iglp_opt(0); \
      _Pragma("unroll") for (int ks = 0; ks < 4; ++ks) { \
        const unsigned co = (((ks * 2 + hh) ^ rsw) << 4); \
        const bf16x8 a0 = *(const bf16x8*)(cA + aoff + co), a1 = *(const bf16x8*)(cA + aoff + 4096 + co); \
        const bf16x8 b0 = *(const bf16x8*)(cB + boff + co), b1 = *(const bf16x8*)(cB + boff + 4096 + co); \
        acc[0][0] = MFMA32(b0, a0, acc[0][0]); acc[0][1] = MFMA32(b1, a0, acc[0][1]); \
        acc[1][0] = MFMA32(b0, a1, acc[1][0]); acc[1][1] = MFMA32(b1, a1, acc[1][1]); } \
      if (wr_) { char* nA = sA + (cur ^ 1) * 16384; char* nB = sB + (cur ^ 1) * 16384; \
        _Pragma("unroll") for (int i = 0; i < 4; ++i) { *(u32x4*)(nA + woff + i * 4096) = RW_A[i]; *(u32x4*)(nB + woff + i * 4096) = RW_B[i]; } \
        if (last_ && t < 128) { float* rn = rsbuf + ((j + 1) & 1) * 256; rn[t] = rv_.x; rn[128 + t] = rv_.y; } } \
      __syncthreads(); cur ^= 1; } while (0)
    for (int kt = 0; kt < nk; kt += 2) {
      GS_STEP(ra0, rb0, ra1, rb1, kt);
      GS_STEP(ra1, rb1, ra0, rb0, kt + 1);
    }
    epi(acc, m0, n0, rs, cur ^ 1);
    if (!has_next) break;
    m0 = m1; n0 = n1;
  }
#undef GS_STEP
#undef GS_LOAD
  __syncthreads();
}

DI float half_reduce(float s) {
  s += __shfl_xor(s, 1); s += __shfl_xor(s, 2); s += __shfl_xor(s, 4); s += __shfl_xor(s, 8); s += __shfl_xor(s, 16); return s;
}

#define EPI_IDS int t = tid(); asm volatile("" : "+v"(t)); const int lane = t & 63, wid = t >> 6, wm = wid >> 1, wn = wid & 1, r = lane & 31, hh = lane >> 5; (void)lane; (void)wid; (void)wm; (void)wn; (void)r; (void)hh;
#define GEMM_IDS const int t = tid(), lane = t & 63, wid = t >> 6, wm = wid >> 1, wn = wid & 1, r = lane & 31, hh = lane >> 5; (void)t; (void)wm; (void)wn; (void)r; (void)hh;

DI char* wave_stage(char* lds, int fstage, int wid) { return lds + (wid < 2 ? 0 : 32768) + fstage * 16384 + (wid & 1) * 8192; }
DI void wave_store64(char* stg, const u32x2 (&w)[2][2][4], bf16_t* gdst, size_t row_stride, int lane, int r, int hh) {
#pragma unroll
  for (int mt = 0; mt < 2; ++mt)
#pragma unroll
    for (int nt = 0; nt < 2; ++nt)
#pragma unroll
      for (int i4 = 0; i4 < 4; ++i4) { const int rloc = mt * 32 + r; *(u32x2*)(stg + rloc * 128 + (((nt * 4 + i4) ^ (rloc & 7)) << 4) + hh * 8) = w[mt][nt][i4]; }
  asm volatile("s_waitcnt lgkmcnt(0)" ::: "memory");
  __builtin_amdgcn_wave_barrier();
#pragma unroll
  for (int s8 = 0; s8 < 8; ++s8) {
    const int rloc = s8 * 8 + (lane >> 3), c = lane & 7;
    const u32x4 q = *(const u32x4*)(stg + rloc * 128 + ((c ^ (rloc & 7)) << 4));
    *(u32x4*)(gdst + (size_t)rloc * row_stride + c * 8) = q;
  }
}

DI void transpose_tile(const float* __restrict__ src, int ld, int K, int kt, int nt, int job, const float* g0, const float* g1, bf16_t* __restrict__ dst, char* lds) {
  bf16_t* tile = (bf16_t*)lds;
  const int t = tid(), nl = t & 63, kq = t >> 6;
  const int n = nt * 64 + nl;
  int c = n;
  if (job == 0) { c = n < 1024 ? n : (n < 1536 ? 1056 + (n - 1024) : (n < 1568 ? 1024 + (n - 1536) : -1)); }
  else if (job == 2) c = (n >> 6) * 128 + (n & 63);
  else if (job == 3) c = (n >> 6) * 128 + 64 + (n & 63);
#pragma unroll 4
  for (int pass = 0; pass < 16; ++pass) {
    const int kl = pass * 4 + kq, k = kt * 64 + kl;
    float v = 0.f;
    if (c >= 0) {
      v = src[(size_t)k * ld + c];
      if (g0) { const float g = (g1 && k >= 512) ? g1[k - 512] : g0[k]; v *= g; }
    }
    tile[nl * 66 + kl] = f2bf(v);
  }
  __syncthreads();
  const int kl = t & 63;
#pragma unroll 4
  for (int pass = 0; pass < 16; ++pass) { const int nl2 = pass * 4 + kq; dst[(size_t)(nt * 64 + nl2) * K + kt * 64 + kl] = tile[nl2 * 66 + kl]; }
  __syncthreads();
}

DI void phase0(const Params& p, char* lds) {
  const int t = tid(), nb = gridDim.x, bid = blockIdx.x, lane = t & 63, wid = t >> 6;
  for (int ti = bid; ti < 2992; ti += nb) {
    int job, base, nNt, ld, K; const float* src; const float* g0 = nullptr; const float* g1 = nullptr; bf16_t* dst;
    if (ti < 416) { job = 0; base = 0; nNt = 26; ld = 1568; K = 1024; src = p.in[7]; g0 = p.in[6]; dst = p.WinT; }
    else if (ti < 560) { job = 1; base = 416; nNt = 12; ld = 768; K = 768; src = p.in[9]; g0 = p.in[8]; dst = p.WqT; }
    else if (ti < 592) { job = 2; base = 560; nNt = 8; ld = 1024; K = 256; src = p.in[11]; dst = p.WkT; }
    else if (ti < 624) { job = 3; base = 592; nNt = 8; ld = 1024; K = 256; src = p.in[11]; dst = p.WvT; }
    else if (ti < 688) { job = 4; base = 624; nNt = 8; ld = 512; K = 512; src = p.in[20]; dst = p.WgT; }
    else if (ti < 944) { job = 5; base = 688; nNt = 16; ld = 1024; K = 1024; src = p.in[23]; g0 = p.in[21]; g1 = p.in[22]; dst = p.WoT; }
    else if (ti < 1968) { job = 6; base = 944; nNt = 64; ld = 4096; K = 1024; src = p.in[25]; g0 = p.in[24]; dst = p.WuT; }
    else { job = 7; base = 1968; nNt = 16; ld = 1024; K = 4096; src = p.in[26]; dst = p.WdT; }
    const int tile = ti - base;
    transpose_tile(src, ld, K, tile / nNt, tile % nNt, job, g0, g1, dst, lds);
  }
  for (int row = bid * 4 + wid; row < NT; row += nb * 4) {
    const float* x = xrow(p, row);
    f32x4 v[4]; float ss = 0.f;
#pragma unroll
    for (int j = 0; j < 4; ++j) { v[j] = *(const f32x4*)(x + lane * 4 + 256 * j); ss += v[j][0] * v[j][0] + v[j][1] * v[j][1] + v[j][2] * v[j][2] + v[j][3] * v[j][3]; }
    ss += __shfl_xor(ss, 32); ss = half_reduce(ss);
#pragma unroll
    for (int j = 0; j < 4; ++j) { u32x2 w; w.x = pk_bf16(v[j][0], v[j][1]); w.y = pk_bf16(v[j][2], v[j][3]); *(u32x2*)(p.xb + (size_t)row * 1024 + lane * 4 + 256 * j) = w; }
    if (lane == 0) p.rstd_x[row] = rsqrtf(ss * (1.f / 1024.f) + EPS);
  }
  const int gt = bid * 256 + t, ngt = nb * 256;
  for (int v = gt; v < 32 * 4096 * 32; v += ngt) {
    const size_t e0 = (size_t)v * 8; const int b = (int)(e0 >> 20), rem = (int)(e0 & 1048575), tt = rem >> 8, c = rem & 255;
    const f32x4 a = *(const f32x4*)(p.in[2] + e0), bq = *(const f32x4*)(p.in[2] + e0 + 4);
    u32x4 w; w.x = pk_bf16(a[0], a[1]); w.y = pk_bf16(a[2], a[3]); w.z = pk_bf16(bq[0], bq[1]); w.w = pk_bf16(bq[2], bq[3]);
    *(u32x4*)(p.latb + (size_t)(NTP + b * SKS + tt) * 256 + c) = w;
  }
  for (int v = gt; v < 32 * 4096 * 4; v += ngt) {
    const size_t e0 = (size_t)v * 8; const int b = (int)(e0 >> 17), rem = (int)(e0 & 131071), tt = rem >> 5, c = rem & 31;
    const f32x4 a = *(const f32x4*)(p.in[3] + e0), bq = *(const f32x4*)(p.in[3] + e0 + 4);
    u32x4 w; w.x = pk_bf16(a[0], a[1]); w.y = pk_bf16(a[2], a[3]); w.z = pk_bf16(bq[0], bq[1]); w.w = pk_bf16(bq[2], bq[3]);
    *(u32x4*)(p.krb + (size_t)(NTP + b * SKS + tt) * 32 + c) = w;
  }
  if (gt < 2048) {
    const int g = gt >> 6, n = gt & 63;
    const double dt = (double)expf(p.in[14][g]);
    const double lr = p.in[12][gt], li = p.in[13][gt];
    const double mag = (double)expf((float)(lr * dt)); double s, c; sincos_d(li * dt, s, c);
    const double lbr = mag * c, lbi = mag * s;
    const double nr = lbr - 1.0, ni = lbi, den = lr * lr + li * li;
    const double cr = (nr * lr + ni * li) / den, ci = (ni * lr - nr * li) / den;
    p.lam[gt] = make_float2((float)lbr, (float)lbi);
    const double mag64 = (double)expf((float)(64.0 * lr * dt)); sincos_d(64.0 * li * dt, s, c);
    p.lam64[gt] = make_float2((float)(mag64 * c), (float)(mag64 * s));
    for (int q = 0; q < 16; ++q) {
      const double br = p.in[15][(size_t)gt * 16 + q], bi = p.in[16][(size_t)gt * 16 + q];
      p.BbT[(size_t)(g * 128 + n) * 16 + q] = f2bf((float)(cr * br - ci * bi));
      p.BbT[(size_t)(g * 128 + 64 + n) * 16 + q] = f2bf((float)(cr * bi + ci * br));
      p.CcT[(size_t)(g * 16 + q) * 128 + n] = f2bf(p.in[17][(size_t)(g * 16 + q) * 64 + n]);
      p.CcT[(size_t)(g * 16 + q) * 128 + 64 + n] = f2bf(-p.in[18][(size_t)(g * 16 + q) * 64 + n]);
    }
  }
  for (int e = gt; e < 8192 * 16; e += ngt) {
    const int pos = e >> 4, i = e & 15;
    const float inv = expf(-(float)i * (9.210340371976184f / 16.0f));
    const float ang = (float)pos * inv;
    double s, c; sincos_d((double)ang, s, c);
    p.rope[e] = make_float2((float)c, (float)s);
  }
}

DI void phase1(const Params& p, char* lds) {
  float* rs = (float*)(lds + 65536);
  const int ntiles = 528 * 13;
  {
    auto tile_fn = [&](int j, int& m0, int& n0) -> bool { const int li = (int)(blockIdx.x >> 3) + j * (int)(gridDim.x >> 3); const int ti_ = li / 13, tj_ = li - ti_ * 13; const int tbig = ti_ * 8 + (int)(blockIdx.x & 7); if (tbig >= 528) return false; m0 = tbig * 128; n0 = tj_ * 128; return true; };
    auto rs_fn = [&](int m0, int t) -> float2 { return make_float2(p.rstd_x[m0 + t], 0.f); };
    auto epi = [&](f32x16 (&acc)[2][2], int m0, int n0, const float* rs, int fstage) { (void)fstage;
    const int tn = n0 >> 7; (void)tn;
    { EPI_IDS
    u32x2 wq[2][2][4];
    if (tn < 8) {
#pragma unroll
      for (int mt = 0; mt < 2; ++mt) {
        const int rl = wm * 64 + mt * 32 + r, row = m0 + rl;
        const float sc = rs[rl];
        float ss = 0.f;
#pragma unroll
        for (int nt = 0; nt < 2; ++nt)
#pragma unroll
          for (int i4 = 0; i4 < 4; ++i4) {
            const float v0 = acc[mt][nt][4 * i4] * sc, v1 = acc[mt][nt][4 * i4 + 1] * sc, v2 = acc[mt][nt][4 * i4 + 2] * sc, v3 = acc[mt][nt][4 * i4 + 3] * sc;
            ss += v0 * v0 + v1 * v1 + v2 * v2 + v3 * v3;
            const int col = n0 + wn * 64 + nt * 32 + 8 * i4 + 4 * hh;
            if (tn < 6) { wq[mt][nt][i4].x = pk_bf16(v0, v1); wq[mt][nt][i4].y = pk_bf16(v2, v3); }
            else { f32x4 w = {v0, v1, v2, v3}; *(f32x4*)(p.ckv_raw + (size_t)row * 256 + (col - 768)) = w; }
          }
        ss += __shfl_xor(ss, 32);
        if (hh == 0) { if (tn < 6) p.cq_part[(size_t)row * 12 + tn * 2 + wn] = ss; else p.ckv_part[(size_t)row * 4 + (tn - 6) * 2 + wn] = ss; }
      }
      if (tn < 6) wave_store64(wave_stage(lds, fstage, wid), wq, p.cq + (size_t)(m0 + wm * 64) * 768 + n0 + wn * 64, 768, lane, r, hh);
    } else if (tn < 12) {
#pragma unroll
      for (int mt = 0; mt < 2; ++mt) {
        const int rl = wm * 64 + mt * 32 + r, row = m0 + rl;
        const float sc = rs[rl];
#pragma unroll
        for (int nt = 0; nt < 2; ++nt)
#pragma unroll
          for (int i4 = 0; i4 < 4; ++i4) {
            wq[mt][nt][i4].x = pk_bf16(acc[mt][nt][4 * i4] * sc, acc[mt][nt][4 * i4 + 1] * sc); wq[mt][nt][i4].y = pk_bf16(acc[mt][nt][4 * i4 + 2] * sc, acc[mt][nt][4 * i4 + 3] * sc);
          }
      }
      wave_store64(wave_stage(lds, fstage, wid), wq, p.ub + (size_t)(m0 + wm * 64) * 512 + (n0 - 1024) + wn * 64, 512, lane, r, hh);
    } else if (wn == 0) {
#pragma unroll
      for (int mt = 0; mt < 2; ++mt) {
        const int rl = wm * 64 + mt * 32 + r, row = m0 + rl;
        const float sc = rs[rl];
        float* dst = row < NTP ? p.out + OFF_KRP + (size_t)row * 32 : p.out + OFF_KRS + (size_t)(row - NTP) * 32;
        bf16_t* dkb = p.krb + (size_t)kr_of(row) * 32;
        const float* rp = (const float*)(p.rope + pos_of(row) * 16);
#pragma unroll
        for (int ih = 0; ih < 2; ++ih) {
          const int j0 = 8 * ih + 4 * hh;
          const f32x4 c01 = *(const f32x4*)(rp + 2 * j0), c23 = *(const f32x4*)(rp + 2 * j0 + 4);
          const float cc[4] = {c01[0], c01[2], c23[0], c23[2]}, sn[4] = {c01[1], c01[3], c23[1], c23[3]};
          f32x4 o1, o2;
#pragma unroll
          for (int jj = 0; jj < 4; ++jj) {
            const float x1 = acc[mt][0][4 * ih + jj] * sc, x2 = acc[mt][0][8 + 4 * ih + jj] * sc;
            o1[jj] = x1 * cc[jj] - x2 * sn[jj]; o2[jj] = x1 * sn[jj] + x2 * cc[jj];
          }
          *(f32x4*)(dst + j0) = o1; *(f32x4*)(dst + 16 + j0) = o2;
          u32x2 w1, w2; w1.x = pk_bf16(o1[0], o1[1]); w1.y = pk_bf16(o1[2], o1[3]); w2.x = pk_bf16(o2[0], o2[1]); w2.y = pk_bf16(o2[2], o2[3]);
          *(u32x2*)(dkb + j0) = w1; *(u32x2*)(dkb + 16 + j0) = w2;
        }
      }
    }
    }
    __syncthreads();
    };
    gemm_stream(p.xb, 1024, p.WinT, 1024, 16, lds, 0, tile_fn, rs_fn, epi);
  }
}

DI void ssm_chunk(const Params& p, int row0, int g, float& hr, float& hi, bool write_y, char* lds_w) {
  const int lane = tid() & 63, r = lane & 31, hh = lane >> 5;
  const float2 lm = p.lam[g * 64 + lane];
  bf16x8 bfr[4];
#pragma unroll
  for (int nt = 0; nt < 4; ++nt) bfr[nt] = *(const bf16x8*)(p.BbT + (size_t)(g * 128 + nt * 32 + r) * 16 + hh * 8);
  const int fr = lane & 15, fq = lane >> 4;
  bf16x8 cfr[4];
#pragma unroll
  for (int ks = 0; ks < 4; ++ks) cfr[ks] = *(const bf16x8*)(p.CcT + (size_t)(g * 16 + fr) * 128 + ks * 32 + fq * 8);
  const float dsk = p.in[19][g * 16 + fr];
#pragma unroll 1
  for (int sub = 0; sub < 2; ++sub) {
    const int rb = row0 + sub * 32;
    const bf16x8 uf = *(const bf16x8*)(p.ub + (size_t)(rb + r) * 512 + g * 16 + hh * 8);
    f32x16 z; for (int i = 0; i < 16; ++i) z[i] = 0.f;
    const f32x16 x0 = MFMA32(uf, bfr[0], z), x1 = MFMA32(uf, bfr[1], z), x2 = MFMA32(uf, bfr[2], z), x3 = MFMA32(uf, bfr[3], z);
    float xr0[16], xr1[16], xi0[16], xi1[16];
#pragma unroll
    for (int i = 0; i < 16; ++i) {
      const auto re = __builtin_amdgcn_permlane32_swap(__float_as_uint(x0[i]), __float_as_uint(x1[i]), false, false);
      const auto im = __builtin_amdgcn_permlane32_swap(__float_as_uint(x2[i]), __float_as_uint(x3[i]), false, false);
      xr0[i] = __uint_as_float(re[0]); xr1[i] = __uint_as_float(re[1]);
      xi0[i] = __uint_as_float(im[0]); xi1[i] = __uint_as_float(im[1]);
    }
    bf16_t* Hs = (bf16_t*)lds_w;
#pragma unroll
    for (int m = 0; m < 4; ++m) {
#pragma unroll
      for (int half = 0; half < 2; ++half) {
#pragma unroll
        for (int jj = 0; jj < 4; ++jj) {
          const int i = 4 * m + jj, tt = 8 * m + 4 * half + jj;
          const float xr = half ? xr1[i] : xr0[i], xi = half ? xi1[i] : xi0[i];
          const float nr = lm.x * hr - lm.y * hi + xr;
          const float ni = lm.x * hi + lm.y * hr + xi;
          hr = nr; hi = ni;
          if (write_y) { Hs[tt * 136 + lane] = f2bf(hr); Hs[tt * 136 + 64 + lane] = f2bf(hi); }
        }
      }
    }
    if (write_y) {
      asm volatile("s_waitcnt lgkmcnt(0)" ::: "memory");
      __builtin_amdgcn_wave_barrier();
#pragma unroll
      for (int mt = 0; mt < 2; ++mt) {
        f32x4 y = {0.f, 0.f, 0.f, 0.f};
#pragma unroll
        for (int ks = 0; ks < 4; ++ks) {
          const bf16x8 hf = *(const bf16x8*)(Hs + (mt * 16 + fr) * 136 + ks * 32 + fq * 8);
          y = MFMA16(hf, cfr[ks], y);
        }
#pragma unroll
        for (int j = 0; j < 4; ++j) {
          const int row = rb + mt * 16 + fq * 4 + j;
          const float u = bf2f(p.ub[(size_t)row * 512 + g * 16 + fr]);
          const float v = y[j] + dsk * u;
          const float zz = 0.7978845608028654f * (v + 0.044715f * v * v * v);
          const float th = 1.f - 2.f / (__expf(2.f * zz) + 1.f);
          p.ssm_y[(size_t)row * 512 + g * 16 + fr] = f2bf(0.5f * v * (1.f + th));
        }
      }
      asm volatile("s_waitcnt lgkmcnt(0)" ::: "memory");
      __builtin_amdgcn_wave_barrier();
    }
  }
}

DI void phase2(const Params& p, char* lds) {
  const int lane = tid() & 63, wid = tid() >> 6;
  const int nb = gridDim.x, bid = blockIdx.x;
  for (int row = bid * 4 + wid; row < NT; row += nb * 4) {
    const f32x4 v = *(const f32x4*)(p.ckv_raw + (size_t)row * 256 + lane * 4);
    const f32x4 pp = *(const f32x4*)(p.ckv_part + (size_t)row * 4);
    const float rstd = rsqrtf((pp[0] + pp[1] + pp[2] + pp[3]) * (1.f / 256.f) + EPS);
    const f32x4 g = *(const f32x4*)(p.in[10] + lane * 4);
    f32x4 o; o[0] = v[0] * rstd * g[0]; o[1] = v[1] * rstd * g[1]; o[2] = v[2] * rstd * g[2]; o[3] = v[3] * rstd * g[3];
    float* dst = row < NTP ? p.out + OFF_LATP + (size_t)row * 256 : p.out + OFF_LATS + (size_t)(row - NTP) * 256;
    *(f32x4*)(dst + lane * 4) = o;
    u32x2 w; w.x = pk_bf16(o[0], o[1]); w.y = pk_bf16(o[2], o[3]);
    *(u32x2*)(p.latb + (size_t)kr_of(row) * 256 + lane * 4) = w;
  }
  for (int it = bid * 4 + wid; it < 8 * 128 * 32; it += nb * 4) {
    const int g = it & 31, c = (it >> 5) & 127, b = it >> 12;
    float hr = 0.f, hi = 0.f;
    ssm_chunk(p, b * 8192 + c * 64, g, hr, hi, false, lds + wid * 8704);
    p.E[(size_t)it * 64 + lane] = make_float2(hr, hi);
  }
  float* rs = (float*)(lds + 65536);
  {
    auto tile_fn = [&](int j, int& m0, int& n0) -> bool { const int li = (int)(blockIdx.x >> 3) + j * (int)(gridDim.x >> 3); const int ti_ = li / 6, tj_ = li - ti_ * 6; const int tbig = ti_ * 8 + (int)(blockIdx.x & 7); if (tbig >= 528) return false; m0 = tbig * 128; n0 = tj_ * 128; return true; };
    auto rs_fn = [&](int m0, int t) -> float2 { float sm = 0.f; for (int q = 0; q < 3; ++q) { const f32x4 v = *(const f32x4*)(p.cq_part + (size_t)(m0 + t) * 12 + 4 * q); sm += (v[0] + v[1]) + (v[2] + v[3]); } return make_float2(rsqrtf(sm * (1.f / 768.f) + EPS), 0.f); };
    auto epi = [&](f32x16 (&acc)[2][2], int m0, int n0, const float* rs, int fstage) { (void)fstage;
    const int tn = n0 >> 7; (void)tn;
    EPI_IDS
    const float qs = 0.10206207261596577f * 1.4426950408889634f;
    u32x2 wq[2][2][4];
#pragma unroll
    for (int mt = 0; mt < 2; ++mt) {
      const int rl = wm * 64 + mt * 32 + r, row = m0 + rl;
      const float sc = rs[rl] * qs;
      const float* rp = (const float*)(p.rope + pos_of(row) * 16);
#pragma unroll
      for (int nt = 0; nt < 2; ++nt) {
        const int cb = n0 + wn * 64 + nt * 32;
        if ((cb % 96) == 64) {
#pragma unroll
          for (int ih = 0; ih < 2; ++ih) {
            const int j0 = 8 * ih + 4 * hh;
            const f32x4 c01 = *(const f32x4*)(rp + 2 * j0), c23 = *(const f32x4*)(rp + 2 * j0 + 4);
            const float cc[4] = {c01[0], c01[2], c23[0], c23[2]}, sn[4] = {c01[1], c01[3], c23[1], c23[3]};
            float o1[4], o2[4];
#pragma unroll
            for (int jj = 0; jj < 4; ++jj) {
              const float x1 = acc[mt][nt][4 * ih + jj] * sc, x2 = acc[mt][nt][8 + 4 * ih + jj] * sc;
              o1[jj] = x1 * cc[jj] - x2 * sn[jj]; o2[jj] = x1 * sn[jj] + x2 * cc[jj];
            }
            wq[mt][nt][ih].x = pk_bf16(o1[0], o1[1]); wq[mt][nt][ih].y = pk_bf16(o1[2], o1[3]); wq[mt][nt][ih + 2].x = pk_bf16(o2[0], o2[1]); wq[mt][nt][ih + 2].y = pk_bf16(o2[2], o2[3]);
          }
        } else {
#pragma unroll
          for (int i4 = 0; i4 < 4; ++i4) {
            wq[mt][nt][i4].x = pk_bf16(acc[mt][nt][4 * i4] * sc, acc[mt][nt][4 * i4 + 1] * sc); wq[mt][nt][i4].y = pk_bf16(acc[mt][nt][4 * i4 + 2] * sc, acc[mt][nt][4 * i4 + 3] * sc);
          }
        }
      }
    }

    wave_store64(wave_stage(lds, fstage, wid), wq, p.Q + (size_t)(m0 + wm * 64) * 768 + n0 + wn * 64, 768, lane, r, hh);
    __syncthreads();
    };
    gemm_stream(p.cq, 768, p.WqT, 768, 12, lds, 0, tile_fn, rs_fn, epi);
  }
}

DI void phase3(const Params& p, char* lds) {
  const int lane = tid() & 63, wid = tid() >> 6;
  const int nb = gridDim.x, bid = blockIdx.x;
  for (int it = bid * 4 + wid; it < 256; it += nb * 4) {
    const int b = it >> 5, g = it & 31;
    const float2 l64 = p.lam64[g * 64 + lane];
    float sr = 0.f, si = 0.f;
    const size_t base = ((size_t)(b * 128) * 32 + g) * 64 + lane;
    for (int c0 = 0; c0 < 128; c0 += 16) {
      float2 e[16];
#pragma unroll
      for (int j = 0; j < 16; ++j) e[j] = p.E[base + (size_t)(c0 + j) * 2048];
#pragma unroll
      for (int j = 0; j < 16; ++j) {
        p.S[base + (size_t)(c0 + j) * 2048] = make_float2(sr, si);
        const float nr = l64.x * sr - l64.y * si + e[j].x, ni = l64.x * si + l64.y * sr + e[j].y;
        sr = nr; si = ni;
      }
    }
  }
  {
    auto tile_fn = [&](int j, int& m0, int& n0) -> bool { const int li = (int)(blockIdx.x >> 3) + j * (int)(gridDim.x >> 3); const int ti_ = li / 4, tj_ = li - ti_ * 4; const int tbig = ti_ * 8 + (int)(blockIdx.x & 7); if (tbig >= 1552) return false; m0 = tbig * 128; n0 = tj_ * 128; return true; };
    auto rs_fn = [&](int m0, int t) -> float2 { return make_float2(0.f, 0.f); };
    auto epi = [&](f32x16 (&acc)[2][2], int m0, int n0, const float* rs, int fstage) { (void)fstage;
    const int tn = n0 >> 7; (void)tn;
    EPI_IDS
    u32x2 w[2][2][4];
#pragma unroll
    for (int mt = 0; mt < 2; ++mt)
#pragma unroll
      for (int nt = 0; nt < 2; ++nt)
#pragma unroll
        for (int i4 = 0; i4 < 4; ++i4) { w[mt][nt][i4].x = pk_bf16(acc[mt][nt][4 * i4], acc[mt][nt][4 * i4 + 1]); w[mt][nt][i4].y = pk_bf16(acc[mt][nt][4 * i4 + 2], acc[mt][nt][4 * i4 + 3]); }
    wave_store64(wave_stage(lds, fstage, wid), w, p.Kn + (size_t)(m0 + wm * 64) * 512 + n0 + wn * 64, 512, lane, r, hh);
    __syncthreads();
    };
    gemm_stream(p.latb, 256, p.WkT, 256, 4, lds, 0, tile_fn, rs_fn, epi);
  }
  {
    auto tile_fn = [&](int j, int& m0, int& n0) -> bool { const int li = (int)(blockIdx.x >> 3) + j * (int)(gridDim.x >> 3); const int ti_ = li / 4, tj_ = li - ti_ * 4; const int tbig = ti_ * 8 + (int)(blockIdx.x & 7); if (tbig >= 1552) return false; n0 = tbig * 128; m0 = tj_ * 128; return true; };
    auto rs_fn = [&](int m0, int t) -> float2 { return make_float2(0.f, 0.f); };
    auto epi = [&](f32x16 (&acc)[2][2], int m0, int n0, const float* rs, int fstage) { (void)fstage;
    const int tn = n0 >> 7; (void)tn;
    EPI_IDS
    u32x2 w[2][2][4];
#pragma unroll
    for (int mt = 0; mt < 2; ++mt)
#pragma unroll
      for (int nt = 0; nt < 2; ++nt)
#pragma unroll
        for (int i4 = 0; i4 < 4; ++i4) { w[mt][nt][i4].x = pk_bf16(acc[mt][nt][4 * i4], acc[mt][nt][4 * i4 + 1]); w[mt][nt][i4].y = pk_bf16(acc[mt][nt][4 * i4 + 2], acc[mt][nt][4 * i4 + 3]); }
    const int kr0 = n0 + wn * 64;
    size_t cbase; int S;
    if (kr0 < NTP) { cbase = (size_t)(kr0 >> 13) * 512 * 8192 + (kr0 & 8191); S = 8192; }
    else { const int k2 = kr0 - NTP, b = k2 / SKS, tt = k2 - b * SKS; cbase = VT_S_OFF + (size_t)b * 512 * SKS + tt; S = SKS; }
    wave_store64(wave_stage(lds, fstage, wid), w, p.Vt + cbase + (size_t)(m0 + wm * 64) * S, (size_t)S, lane, r, hh);
    __syncthreads();
    };
    gemm_stream(p.WvT, 256, p.latb, 256, 4, lds, 0, tile_fn, rs_fn, epi);
  }
}

template <int QT, bool HALF>
DI void attn_item(const Params& p, int kind, int b, int h, int qq, char* lds) {
  const int t = tid(), lane = t & 63, wid = t >> 6, r = lane & 31, hh = lane >> 5;
  int qrow0, nkb_w, nkb_max, S; size_t kr0; const bf16_t* vt_base;
  constexpr int RW = 32 * QT, WPC = 64 / RW, CPB = 4 / WPC;
  if (kind == 0) {
    const int c = qq * CPB + wid / WPC; qrow0 = b * 8192 + c * 64 + (wid % WPC) * RW; nkb_w = c + 1; nkb_max = qq * CPB + CPB; kr0 = (size_t)b * 8192; S = 8192;
    vt_base = p.Vt + (size_t)(b * 8 + h) * 64 * 8192;
  } else {
    qrow0 = NTP + b * 64 + (wid % WPC) * RW; nkb_w = (wid < WPC) ? 65 : 0; nkb_max = 65; kr0 = (size_t)NTP + (size_t)b * SKS; S = SKS;
    vt_base = p.Vt + VT_S_OFF + (size_t)(b * 8 + h) * 64 * SKS;
  }
  bf16x8 qf[QT][6];
#pragma unroll
  for (int qt = 0; qt < QT; ++qt)
#pragma unroll
    for (int ks = 0; ks < 6; ++ks) qf[qt][ks] = *(const bf16x8*)(p.Q + (size_t)(qrow0 + qt * 32 + r) * 768 + h * 96 + ks * 16 + hh * 8);
  f32x16 o[2][QT];
  float mrun[QT], lrun[QT];
#pragma unroll
  for (int qt = 0; qt < QT; ++qt) { mrun[qt] = -1e30f; lrun[qt] = 0.f;
#pragma unroll
    for (int dt = 0; dt < 2; ++dt)
#pragma unroll
      for (int i = 0; i < 16; ++i) o[dt][qt][i] = 0.f; }
  const int kkey = t >> 3, kc = t & 7;
  const int rkey = t >> 2, rc = t & 3;
  const int vd = t >> 3, vc = t & 7;
  const bf16_t* gk = p.Kn + (kr0 + kkey) * 512 + h * 64 + kc * 8;
  const bf16_t* gr = p.krb + (kr0 + rkey) * 32 + rc * 8;
  const bf16_t* gv = vt_base + (size_t)vd * S + vc * 8;
  const unsigned kw0 = kkey * 208 + kc * 16, kw1 = kw0 + 32 * 208, rw = rkey * 208 + 128 + rc * 16;
  const unsigned vlo = vd * 144 + (vc >> 1) * 32 + (vc & 1) * 8, vhi = vlo + 16;
  constexpr int KB = 13312, VB = 9216, BUF = KB + VB;
  u32x4 k0r, k1r, rr, v0r, v1r;
  k0r = *(const u32x4*)gk; k1r = *(const u32x4*)(gk + 32 * 512); rr = *(const u32x4*)gr;
  v0r = *(const u32x4*)gv; v1r = *(const u32x4*)(gv + (size_t)32 * S);
  __syncthreads();
  {
    char* kb_ = lds; char* vb_ = lds + KB;
    *(u32x4*)(kb_ + kw0) = k0r; *(u32x4*)(kb_ + kw1) = k1r; *(u32x4*)(kb_ + rw) = rr;
    *(u32x2*)(vb_ + vlo) = (u32x2){v0r.x, v0r.y}; *(u32x2*)(vb_ + vhi) = (u32x2){v0r.z, v0r.w};
    *(u32x2*)(vb_ + vlo + 32 * 144) = (u32x2){v1r.x, v1r.y}; *(u32x2*)(vb_ + vhi + 32 * 144) = (u32x2){v1r.z, v1r.w};
  }
  __syncthreads();
  for (int kb = 0; kb < nkb_max; ++kb) {
    const int cur = kb & 1;
    const bool more = kb + 1 < nkb_max;
    if (more) {
      const size_t ko = (size_t)(kb + 1) * 64;
      k0r = *(const u32x4*)(gk + ko * 512); k1r = *(const u32x4*)(gk + (ko + 32) * 512); rr = *(const u32x4*)(gr + ko * 32);
      v0r = *(const u32x4*)(gv + ko); v1r = *(const u32x4*)(gv + (size_t)32 * S + ko);
    }
    if (HALF && kb < nkb_w) {
      const char* kt_ = lds + cur * BUF; const char* vt_ = kt_ + KB;
#pragma unroll
      for (int kt = 0; kt < 2; ++kt) {
        __builtin_amdgcn_iglp_opt(0);
        f32x16 sh[QT];
#pragma unroll
        for (int qt = 0; qt < QT; ++qt)
#pragma unroll
          for (int i = 0; i < 16; ++i) sh[qt][i] = 0.f;
#pragma unroll
        for (int ks = 0; ks < 6; ++ks) {
          const bf16x8 kf = *(const bf16x8*)(kt_ + (kt * 32 + r) * 208 + ks * 32 + hh * 16);
#pragma unroll
          for (int qt = 0; qt < QT; ++qt) sh[qt] = MFMA32(kf, qf[qt][ks], sh[qt]);
        }
        bf16x8 ph[QT][2];
#pragma unroll
        for (int qt = 0; qt < QT; ++qt) {
          float mx = sh[qt][0];
#pragma unroll
          for (int i = 1; i < 16; ++i) mx = fmaxf(mx, sh[qt][i]);
          mx = fmaxf(mx, __shfl_xor(mx, 32));
          const bool need = mx > mrun[qt] + 8.f;
          if (__any(need)) {
            const float mnew = need ? mx : mrun[qt];
            const float alpha = __builtin_amdgcn_exp2f(mrun[qt] - mnew);
            mrun[qt] = mnew; lrun[qt] *= alpha;
#pragma unroll
            for (int dt = 0; dt < 2; ++dt)
#pragma unroll
              for (int i = 0; i < 16; ++i) o[dt][qt][i] *= alpha;
          }
          float ls = 0.f;
#pragma unroll
          for (int i = 0; i < 16; ++i) { const float pv = __builtin_amdgcn_exp2f(sh[qt][i] - mrun[qt]); ls += pv; sh[qt][i] = pv; }
          lrun[qt] += ls;
#pragma unroll
          for (int s2 = 0; s2 < 2; ++s2) {
            u32x4 w;
            w.x = pk_bf16(sh[qt][8 * s2 + 0], sh[qt][8 * s2 + 1]); w.y = pk_bf16(sh[qt][8 * s2 + 2], sh[qt][8 * s2 + 3]);
            w.z = pk_bf16(sh[qt][8 * s2 + 4], sh[qt][8 * s2 + 5]); w.w = pk_bf16(sh[qt][8 * s2 + 6], sh[qt][8 * s2 + 7]);
            ph[qt][s2] = __builtin_bit_cast(bf16x8, w);
          }
        }
#pragma unroll
        for (int dt = 0; dt < 2; ++dt)
#pragma unroll
          for (int s2 = 0; s2 < 2; ++s2) {
            const bf16x8 vf = *(const bf16x8*)(vt_ + (dt * 32 + r) * 144 + (kt * 2 + s2) * 32 + hh * 16);
#pragma unroll
            for (int qt = 0; qt < QT; ++qt) o[dt][qt] = MFMA32(vf, ph[qt][s2], o[dt][qt]);
          }
      }
    }
    if (!HALF && kb < nkb_w) {
      const char* kt_ = lds + cur * BUF; const char* vt_ = kt_ + KB;
      f32x16 st[2][QT];
#pragma unroll
      for (int kt = 0; kt < 2; ++kt)
#pragma unroll
        for (int qt = 0; qt < QT; ++qt)
#pragma unroll
          for (int i = 0; i < 16; ++i) st[kt][qt][i] = 0.f;
#pragma unroll
      for (int ks = 0; ks < 6; ++ks)
#pragma unroll
        for (int kt = 0; kt < 2; ++kt) {
          const bf16x8 kf = *(const bf16x8*)(kt_ + (kt * 32 + r) * 208 + ks * 32 + hh * 16);
#pragma unroll
          for (int qt = 0; qt < QT; ++qt) st[kt][qt] = MFMA32(kf, qf[qt][ks], st[kt][qt]);
        }
      bf16x8 pb[2][QT][2];
#pragma unroll
      for (int qt = 0; qt < QT; ++qt) {
        float mx = mrun[qt];
#pragma unroll
        for (int kt = 0; kt < 2; ++kt)
#pragma unroll
          for (int i = 0; i < 16; ++i) mx = fmaxf(mx, st[kt][qt][i]);
        mx = fmaxf(mx, __shfl_xor(mx, 32));
        const float alpha = __builtin_amdgcn_exp2f(mrun[qt] - mx);
        mrun[qt] = mx;
        float ls = 0.f;
#pragma unroll
        for (int kt = 0; kt < 2; ++kt) {
#pragma unroll
          for (int i = 0; i < 16; ++i) { const float pv = __builtin_amdgcn_exp2f(st[kt][qt][i] - mx); ls += pv; st[kt][qt][i] = pv; }
#pragma unroll
          for (int s2 = 0; s2 < 2; ++s2) {
            u32x4 w;
            w.x = pk_bf16(st[kt][qt][8 * s2 + 0], st[kt][qt][8 * s2 + 1]); w.y = pk_bf16(st[kt][qt][8 * s2 + 2], st[kt][qt][8 * s2 + 3]);
            w.z = pk_bf16(st[kt][qt][8 * s2 + 4], st[kt][qt][8 * s2 + 5]); w.w = pk_bf16(st[kt][qt][8 * s2 + 6], st[kt][qt][8 * s2 + 7]);
            pb[kt][qt][s2] = __builtin_bit_cast(bf16x8, w);
          }
        }
        lrun[qt] = lrun[qt] * alpha + ls;
#pragma unroll
        for (int dt = 0; dt < 2; ++dt)
#pragma unroll
          for (int i = 0; i < 16; ++i) o[dt][qt][i] *= alpha;
      }
#pragma unroll
      for (int dt = 0; dt < 2; ++dt)
#pragma unroll
        for (int kt = 0; kt < 2; ++kt)
#pragma unroll
          for (int s2 = 0; s2 < 2; ++s2) {
            const bf16x8 vf = *(const bf16x8*)(vt_ + (dt * 32 + r) * 144 + (kt * 2 + s2) * 32 + hh * 16);
#pragma unroll
            for (int qt = 0; qt < QT; ++qt) o[dt][qt] = MFMA32(vf, pb[kt][qt][s2], o[dt][qt]);
          }
    }
    if (more) {
      char* kb_ = lds + (cur ^ 1) * BUF; char* vb_ = kb_ + KB;
      *(u32x4*)(kb_ + kw0) = k0r; *(u32x4*)(kb_ + kw1) = k1r; *(u32x4*)(kb_ + rw) = rr;
      *(u32x2*)(vb_ + vlo) = (u32x2){v0r.x, v0r.y}; *(u32x2*)(vb_ + vhi) = (u32x2){v0r.z, v0r.w};
      *(u32x2*)(vb_ + vlo + 32 * 144) = (u32x2){v1r.x, v1r.y}; *(u32x2*)(vb_ + vhi + 32 * 144) = (u32x2){v1r.z, v1r.w};
    }
    __syncthreads();
  }
  if (nkb_w > 0) {
#pragma unroll
    for (int qt = 0; qt < QT; ++qt) {
      const float lt = lrun[qt] + __shfl_xor(lrun[qt], 32);
      const float inv = 1.f / lt;
      const int row = qrow0 + qt * 32 + r;
      float ss = 0.f;
#pragma unroll
      for (int dt = 0; dt < 2; ++dt)
#pragma unroll
        for (int i4 = 0; i4 < 4; ++i4) {
          const float a0 = o[dt][qt][4 * i4] * inv, a1 = o[dt][qt][4 * i4 + 1] * inv, a2 = o[dt][qt][4 * i4 + 2] * inv, a3 = o[dt][qt][4 * i4 + 3] * inv;
          ss += a0 * a0 + a1 * a1 + a2 * a2 + a3 * a3;
          u32x2 w; w.x = pk_bf16(a0, a1); w.y = pk_bf16(a2, a3);
          *(u32x2*)(p.mix + (size_t)row * 1024 + h * 64 + dt * 32 + 8 * i4 + 4 * hh) = w;
        }
      ss += __shfl_xor(ss, 32);
      if (hh == 0) p.attn_part[(size_t)row * 8 + h] = ss;
    }
  }
}

DI void phase4(const Params& p, char* lds, int qidx) {
  const int t = tid(), lane = t & 63, wid = t >> 6;
  const int nb = gridDim.x, bid = blockIdx.x;
  int* nxt = (int*)(lds + 65536);
  for (;;) {
    __syncthreads();
    if (t == 0) *nxt = atomicAdd(p.counters + qidx, 1);
    __syncthreads();
    const int it = *nxt;
    if (it >= 256 + 64 * 32) break;
    if (it < 256) attn_item<1, false>(p, 1, it >> 3, it & 7, 0, lds);
    else { const int j = it - 256; const int qq = 31 - (j >> 6), bh = j & 63; attn_item<2, true>(p, 0, bh >> 3, bh & 7, qq, lds); }
  }
  __syncthreads();
  for (int it = bid * 4 + wid; it < 8 * 128 * 32 + 1024; it += nb * 4) {
    if (it < 8 * 128 * 32) {
      const int g = it & 31, c = (it >> 5) & 127, b = it >> 12;
      const float2 s0 = p.S[(size_t)it * 64 + lane];
      float hr = s0.x, hi = s0.y;
      ssm_chunk(p, b * 8192 + c * 64, g, hr, hi, true, lds + wid * 8704);
      if (c == 127) { p.out[OFF_HRP + (size_t)(b * 32 + g) * 64 + lane] = hr; p.out[OFF_HIP + (size_t)(b * 32 + g) * 64 + lane] = hi; }
    } else {
      const int j = it - 8 * 128 * 32, g = j & 31, b = j >> 5;
      float hr = p.in[4][(size_t)(b * 32 + g) * 64 + lane], hi = p.in[5][(size_t)(b * 32 + g) * 64 + lane];
      ssm_chunk(p, NTP + b * 64, g, hr, hi, true, lds + wid * 8704);
      p.out[OFF_HRS + (size_t)(b * 32 + g) * 64 + lane] = hr; p.out[OFF_HIS + (size_t)(b * 32 + g) * 64 + lane] = hi;
    }
  }
}

DI void phase5(const Params& p, char* lds) {
  {
    auto tile_fn = [&](int j, int& m0, int& n0) -> bool { const int li = (int)(blockIdx.x >> 3) + j * (int)(gridDim.x >> 3); const int ti_ = li / 4, tj_ = li - ti_ * 4; const int tbig = ti_ * 8 + (int)(blockIdx.x & 7); if (tbig >= 528) return false; m0 = tbig * 128; n0 = tj_ * 128; return true; };
    auto rs_fn = [&](int m0, int t) -> float2 { return make_float2(0.f, 0.f); };
    auto epi = [&](f32x16 (&acc)[2][2], int m0, int n0, const float* rs, int fstage) { (void)fstage;
    const int tn = n0 >> 7; (void)tn;
    { EPI_IDS
#pragma unroll
    for (int mt = 0; mt < 2; ++mt) {
      const int row = m0 + wm * 64 + mt * 32 + r;
      float ss = 0.f;
#pragma unroll
      for (int nt = 0; nt < 2; ++nt)
#pragma unroll
        for (int i4 = 0; i4 < 4; ++i4) {
          const int col = n0 + wn * 64 + nt * 32 + 8 * i4 + 4 * hh;
          const u32x2 yv = *(const u32x2*)(p.ssm_y + (size_t)row * 512 + col);
          const float y0 = __uint_as_float(yv.x << 16), y1 = __uint_as_float(yv.x & 0xffff0000u), y2 = __uint_as_float(yv.y << 16), y3 = __uint_as_float(yv.y & 0xffff0000u);
          const float o0 = y0 / (1.f + __expf(-acc[mt][nt][4 * i4])), o1 = y1 / (1.f + __expf(-acc[mt][nt][4 * i4 + 1]));
          const float o2 = y2 / (1.f + __expf(-acc[mt][nt][4 * i4 + 2])), o3 = y3 / (1.f + __expf(-acc[mt][nt][4 * i4 + 3]));
          ss += o0 * o0 + o1 * o1 + o2 * o2 + o3 * o3;
          u32x2 w; w.x = pk_bf16(o0, o1); w.y = pk_bf16(o2, o3);
          *(u32x2*)(p.mix + (size_t)row * 1024 + 512 + col) = w;
        }
      ss += __shfl_xor(ss, 32);
      if (hh == 0) p.ssm_part[(size_t)row * 8 + tn * 2 + wn] = ss;
    }
    }

    };
    gemm_stream(p.ssm_y, 512, p.WgT, 512, 8, lds, 0, tile_fn, rs_fn, epi);
  }
}

DI void phase6(const Params& p, char* lds) {
  const int xb_ = blockIdx.x & 7, xl_ = blockIdx.x >> 3, nbx_ = gridDim.x >> 3;
  {
    auto tile_fn = [&](int j, int& m0, int& n0) -> bool { const int li6 = xl_ + j * nbx_, tm = (li6 >> 3) * 8 + xb_; if (tm >= 528) return false; m0 = tm * 128; n0 = (li6 & 7) * 128; return true; };
    auto rs_fn = [&](int m0, int t) -> float2 {
      const f32x4 a0 = *(const f32x4*)(p.attn_part + (size_t)(m0 + t) * 8), a1 = *(const f32x4*)(p.attn_part + (size_t)(m0 + t) * 8 + 4);
      const float sa = (a0[0] + a0[1]) + (a0[2] + a0[3]) + (a1[0] + a1[1]) + (a1[2] + a1[3]);
      const f32x4 b0 = *(const f32x4*)(p.ssm_part + (size_t)(m0 + t) * 8), b1 = *(const f32x4*)(p.ssm_part + (size_t)(m0 + t) * 8 + 4);
      const float sb = (b0[0] + b0[1]) + (b0[2] + b0[3]) + (b1[0] + b1[1]) + (b1[2] + b1[3]);
      const float ra = rsqrtf(sa * (1.f / 512.f) + EPS), rb = rsqrtf(sb * (1.f / 512.f) + EPS);
      return make_float2(rb, ra / rb); };
    auto epi = [&](f32x16 (&acc)[2][2], int m0, int n0, const float* rs, int fstage) { (void)fstage;
    const int tn = n0 >> 7;
    { EPI_IDS
    u32x2 w[2][2][4];
#pragma unroll
    for (int mt = 0; mt < 2; ++mt) {
      const int rl = wm * 64 + mt * 32 + r, row = m0 + rl;
      const float sc = rs[rl];
      const float* xr = xrow(p, row);
      float ss = 0.f;
#pragma unroll
      for (int nt = 0; nt < 2; ++nt)
#pragma unroll
        for (int i4 = 0; i4 < 4; ++i4) {
          const int col = n0 + wn * 64 + nt * 32 + 8 * i4 + 4 * hh;
          const f32x4 xv = *(const f32x4*)(xr + col);
          f32x4 hv;
#pragma unroll
          for (int jj = 0; jj < 4; ++jj) { hv[jj] = xv[jj] + acc[mt][nt][4 * i4 + jj] * sc; ss += hv[jj] * hv[jj]; }
          w[mt][nt][i4].x = pk_bf16(hv[0], hv[1]); w[mt][nt][i4].y = pk_bf16(hv[2], hv[3]);
          if (i4 == 1 || i4 == 3) __builtin_amdgcn_sched_barrier(0);
        }
      ss += __shfl_xor(ss, 32);
      if (hh == 0) p.h_part[(size_t)row * 16 + tn * 2 + wn] = ss;
    }
    wave_store64(wave_stage(lds, fstage, wid), w, p.hb + (size_t)(m0 + wm * 64) * 1024 + n0 + wn * 64, 1024, lane, r, hh);
    }
    __syncthreads();
    };
    gemm_stream(p.mix, 1024, p.WoT, 1024, 16, lds, 8, tile_fn, rs_fn, epi);
  }
}

DI void phase7(const Params& p, char* lds) {
  float* rs = (float*)(lds + 65536);
  const int xb_ = blockIdx.x & 7, xl_ = blockIdx.x >> 3, nbx_ = gridDim.x >> 3;
  {
    auto tile_fn = [&](int j, int& m0, int& n0) -> bool { const int tm = j * (nbx_ >> 2) + (xl_ >> 2); if (tm >= 528) return false; m0 = tm * 128; n0 = (xb_ * 4 + (xl_ & 3)) * 128; return true; };
    auto rs_fn = [&](int m0, int t) -> float2 { float sm = 0.f; for (int q = 0; q < 4; ++q) { const f32x4 v = *(const f32x4*)(p.h_part + (size_t)(m0 + t) * 16 + 4 * q); sm += (v[0] + v[1]) + (v[2] + v[3]); } return make_float2(rsqrtf(sm * (1.f / 1024.f) + EPS), 0.f); };
    auto epi = [&](f32x16 (&acc)[2][2], int m0, int n0, const float* rs, int fstage) { (void)fstage;
    const int tn = n0 >> 7; (void)tn;
    { EPI_IDS
    char* stg = lds + (wid < 2 ? 0 : 32768) + fstage * 16384 + (wid & 1) * 8192;
#pragma unroll
    for (int mt = 0; mt < 2; ++mt) {
      const int rloc = mt * 32 + r;
      const float sc = rs[wm * 64 + rloc];
#pragma unroll
      for (int nt = 0; nt < 2; ++nt)
#pragma unroll
        for (int i4 = 0; i4 < 4; ++i4) {
          float v[4];
#pragma unroll
          for (int jj = 0; jj < 4; ++jj) { const float a_ = fmaxf(acc[mt][nt][4 * i4 + jj] * sc, 0.f); v[jj] = a_ * a_; }
          u32x2 w; w.x = pk_bf16(v[0], v[1]); w.y = pk_bf16(v[2], v[3]);
          *(u32x2*)(stg + rloc * 128 + (((nt * 4 + i4) ^ (rloc & 7)) << 4) + hh * 8) = w;
        }
    }
    asm volatile("s_waitcnt lgkmcnt(0)" ::: "memory");
    __builtin_amdgcn_wave_barrier();
    bf16_t* gdst = p.act + ((((size_t)(m0 >> 7) * 64 + (n0 >> 6) + wn) * 128 + wm * 64) * 64);
#pragma unroll
    for (int s8 = 0; s8 < 8; ++s8) {
      const int rloc = s8 * 8 + (lane >> 3), c = lane & 7;
      const u32x4 q = *(const u32x4*)(stg + rloc * 128 + ((c ^ (rloc & 7)) << 4));
      *(u32x4*)(gdst + rloc * 64 + c * 8) = q;
    }
    }
    __syncthreads();
    };
    gemm_stream(p.hb, 1024, p.WuT, 1024, 16, lds, 0, tile_fn, rs_fn, epi);
  }
}

DI void phase8(const Params& p, char* lds) {
  const int xb_ = blockIdx.x & 7, xl_ = blockIdx.x >> 3, nbx_ = gridDim.x >> 3;
  {
    auto tile_fn = [&](int j, int& m0, int& n0) -> bool { const int li = (int)(blockIdx.x >> 3) + j * (int)(gridDim.x >> 3); const int ti_ = li / 8, tj_ = li - ti_ * 8; const int tbig = ti_ * 8 + (int)(blockIdx.x & 7); if (tbig >= 528) return false; m0 = tbig * 128; n0 = tj_ * 128; return true; };
    auto rs_fn = [&](int m0, int t) -> float2 { return make_float2(0.f, 0.f); };
    auto epi = [&](f32x16 (&acc)[2][2], int m0, int n0, const float* rs, int fstage) { (void)fstage;
    const int tn = n0 >> 7; (void)tn;
    { EPI_IDS
#pragma unroll
    for (int mt = 0; mt < 2; ++mt) {
      const int row = m0 + wm * 64 + mt * 32 + r;
      float ss = 0.f;
#pragma unroll
      for (int nt = 0; nt < 2; ++nt)
#pragma unroll
        for (int i4 = 0; i4 < 4; ++i4) {
          float* yp = p.out + OFF_Y + (size_t)row * 1024 + n0 + wn * 64 + nt * 32 + 8 * i4 + 4 * hh;
          const u32x2 hq = *(const u32x2*)(p.hb + (size_t)row * 1024 + n0 + wn * 64 + nt * 32 + 8 * i4 + 4 * hh);
          f32x4 ov = {__uint_as_float(hq.x << 16), __uint_as_float(hq.x & 0xffff0000u), __uint_as_float(hq.y << 16), __uint_as_float(hq.y & 0xffff0000u)};
#pragma unroll
          for (int jj = 0; jj < 4; ++jj) { ov[jj] += acc[mt][nt][4 * i4 + jj]; ss += ov[jj] * ov[jj]; }
          *(f32x4*)yp = ov;
          if (i4 == 1 || i4 == 3) __builtin_amdgcn_sched_barrier(0);
        }
      ss += __shfl_xor(ss, 32);
      if (hh == 0) p.out_part[(size_t)row * 16 + tn * 2 + wn] = ss;
    }
    }

    };
    gemm_stream<true>(p.act, 4096, p.WdT, 4096, 64, lds, 0, tile_fn, rs_fn, epi);
  }
}

DI void phase9(const Params& p) {
  const int t = tid(), lane = t & 63, wid = t >> 6;
  for (int row = blockIdx.x * 4 + wid; row < NT; row += gridDim.x * 4) {
    float s = 0.f;
    for (int j = 0; j < 16; ++j) s += p.out_part[(size_t)row * 16 + j];
    const float rstd = rsqrtf(s * (1.f / 1024.f) + EPS);
    float* y = p.out + OFF_Y + (size_t)row * 1024;
#pragma unroll
    for (int j = 0; j < 4; ++j) {
      f32x4 v = *(const f32x4*)(y + lane * 4 + 256 * j);
      const f32x4 g = *(const f32x4*)(p.in[27] + lane * 4 + 256 * j);
      v[0] *= rstd * g[0]; v[1] *= rstd * g[1]; v[2] *= rstd * g[2]; v[3] *= rstd * g[3];
      *(f32x4*)(y + lane * 4 + 256 * j) = v;
    }
  }
}

DI void grid_barrier(unsigned* cnt, unsigned target) {
  asm volatile("s_waitcnt vmcnt(0)" ::: "memory");
  __syncthreads();
  if (tid() == 0) {
    __builtin_amdgcn_fence(__ATOMIC_RELEASE, "agent");
    asm volatile("s_waitcnt vmcnt(0)" ::: "memory");
    __hip_atomic_fetch_add(cnt, 1u, __ATOMIC_RELAXED, __HIP_MEMORY_SCOPE_AGENT);
    while (__hip_atomic_load(cnt, __ATOMIC_RELAXED, __HIP_MEMORY_SCOPE_AGENT) < target) __builtin_amdgcn_s_sleep(2);
  }
  __syncthreads();
  __builtin_amdgcn_fence(__ATOMIC_ACQUIRE, "agent");
  asm volatile("s_waitcnt vmcnt(0)" ::: "memory");
}

#define XB_TMO      128
#define XB_XCNT(j)  (256  + 64 * (j))
#define XB_XSUB(j)  (1280 + 64 * (j))
#define XB_XGEN(j)  (2304 + 64 * (j))
#define XB_TOP      3328
#define XB_TOPGEN   3392
#define XCD_BAR_WORDS 3456
#define XB_SPIN_CAP (1u << 22)
#define LAS __attribute__((address_space(3)))
DI unsigned xb_ld(unsigned* p)              { return __hip_atomic_load(p, __ATOMIC_RELAXED, __HIP_MEMORY_SCOPE_AGENT); }
DI unsigned xb_add(unsigned* p, unsigned v) { return __hip_atomic_fetch_add(p, v, __ATOMIC_RELAXED, __HIP_MEMORY_SCOPE_AGENT); }
DI unsigned xb_xcc_id() { return (unsigned)__builtin_amdgcn_s_getreg((3 << 11) | 20) & 0xFu; }
#define XB_SPIN(cond, bar) do { unsigned _sp = 0; while (cond) { __builtin_amdgcn_s_sleep(1); \
    if ((++_sp & 255u) == 0u) { if (xb_ld(&(bar)[XB_TMO])) break; if (_sp > XB_SPIN_CAP) { atomicAdd(&(bar)[XB_TMO], 1u); break; } } } } while (0)
struct XcdBarrier { unsigned* bar; unsigned x; volatile LAS unsigned* st; };
DI XcdBarrier xcd_barrier_post(unsigned* bar, volatile LAS unsigned* st) {
  XcdBarrier b; b.bar = bar; b.x = xb_xcc_id(); b.st = st;
  if (tid() == 0) (void)xb_add(&bar[XB_XCNT(b.x)], 1u);
  return b;
}
DI void xcd_barrier_complete(unsigned* bar, unsigned x, unsigned& nloc, unsigned& nx) {
  const unsigned G = gridDim.x * gridDim.y * gridDim.z;
  unsigned sum, cnt, mine, sp = 0u;
  for (;;) {
    sum = 0u; cnt = 0u; mine = 0u;
#pragma unroll
    for (unsigned j = 0; j < 16; ++j) { const unsigned c = xb_ld(&bar[XB_XCNT(j)]); sum += c; cnt += (c > 0u) ? 1u : 0u; mine = (j == x) ? c : mine; }
    if (sum == G) break;
    __builtin_amdgcn_s_sleep(1);
    if ((++sp & 255u) == 0u) { if (xb_ld(&bar[XB_TMO])) break; if (sp > XB_SPIN_CAP) { atomicAdd(&bar[XB_TMO], 1u); break; } }
  }
  nloc = mine > 0u ? mine : 1u; nx = cnt > 0u ? cnt : 1u;
}
DI void xcd_barrier(const XcdBarrier& b) {
  asm volatile("s_waitcnt vmcnt(0)" ::: "memory");
  __syncthreads();
  if (tid() == 0) {
    unsigned* bar = b.bar;
    __builtin_amdgcn_s_waitcnt(0);
    unsigned nloc = b.st[0], nx = b.st[1];
    if (nloc == 0u) { xcd_barrier_complete(bar, b.x, nloc, nx); b.st[0] = nloc; b.st[1] = nx; }
    const unsigned old = xb_add(&bar[XB_XSUB(b.x)], 1u);
    const unsigned gen = old / nloc;
    if (old + 1u == (gen + 1u) * nloc) {
      __builtin_amdgcn_fence(__ATOMIC_RELEASE, "agent");
      asm volatile("s_waitcnt vmcnt(0)" ::: "memory");
      const unsigned og = xb_add(&bar[XB_TOP], 1u);
      const unsigned tg = og / nx;
      if (og + 1u == (tg + 1u) * nx) xb_add(&bar[XB_TOPGEN], 1u);
      else XB_SPIN(xb_ld(&bar[XB_TOPGEN]) == tg, bar);
      __builtin_amdgcn_fence(__ATOMIC_ACQUIRE, "agent");
      xb_add(&bar[XB_XGEN(b.x)], 1u);
      asm volatile("s_waitcnt vmcnt(0)" ::: "memory");
    } else {
      XB_SPIN(xb_ld(&bar[XB_XGEN(b.x)]) == gen, bar);
      __builtin_amdgcn_fence(__ATOMIC_ACQUIRE, "agent");
      asm volatile("s_waitcnt vmcnt(0)" ::: "memory");
    }
  }
  __syncthreads();
}

template <bool COOP>
__global__ void __launch_bounds__(256, 2) mega(Params p) {
  __shared__ __attribute__((aligned(16))) char lds[LDS_BYTES];
  XcdBarrier xb{};
  if (COOP) {
    volatile LAS unsigned* st = (volatile LAS unsigned*)(lds + 67584);
    if (tid() == 0) { st[0] = 0u; st[1] = 0u; }
    __syncthreads();
    xb = xcd_barrier_post((unsigned*)p.counters + 64, st);
  }
  for (int ph = p.ph_lo; ph < p.ph_hi; ++ph) {
#ifdef ONLY_PHASE
    if (ph != ONLY_PHASE) continue;
#endif
    switch (ph) {
      case 0: phase0(p, lds); break;
      case 1: phase1(p, lds); break;
      case 2: phase2(p, lds); break;
      case 3: phase3(p, lds); break;
      case 4: phase4(p, lds, 0); break;
      case 5: phase5(p, lds); break;
      case 6: phase6(p, lds); break;
      case 7: phase7(p, lds); break;
      case 8: phase8(p, lds); break;
      default: phase9(p); break;
    }
#ifdef DOUBLE_PHASE
    if (ph == DOUBLE_PHASE) {
      __syncthreads();
      switch (ph) { case 0: phase0(p, lds); break; case 1: phase1(p, lds); break; case 2: phase2(p, lds); break; case 3: phase3(p, lds); break; case 4: phase4(p, lds, 1); break;
                    case 5: phase5(p, lds); break; case 6: phase6(p, lds); break; case 7: phase7(p, lds); break; default: break; }
    }
#endif
    if (COOP) { if (ph + 1 < p.ph_hi) { if (ph == 0) cg::this_grid().sync(); else xcd_barrier(xb); } }
  }
}

static size_t al256(size_t x) { return (x + 255) & ~(size_t)255; }

extern "C" void kernel_launch(void* const* d_in, const int* in_sizes, int n_in, void* d_out, int out_size, void* d_ws, size_t ws_size, hipStream_t stream) {
  Params p{};
  for (int i = 0; i < 28; ++i) p.in[i] = (const float*)d_in[i];
  p.out = (float*)d_out;
  char* base = (char*)d_ws; size_t off = 0;
  auto take = [&](size_t bytes) { char* q = base + off; off = al256(off + bytes); return q; };
  p.WinT = (bf16_t*)take((size_t)1664 * 1024 * 2);
  p.WqT = (bf16_t*)take((size_t)768 * 768 * 2);
  p.WkT = (bf16_t*)take((size_t)512 * 256 * 2);
  p.WvT = (bf16_t*)take((size_t)512 * 256 * 2);
  p.WgT = (bf16_t*)take((size_t)512 * 512 * 2);
  p.WoT = (bf16_t*)take((size_t)1024 * 1024 * 2);
  p.WuT = (bf16_t*)take((size_t)4096 * 1024 * 2);
  p.WdT = (bf16_t*)take((size_t)1024 * 4096 * 2);
  p.BbT = (bf16_t*)take((size_t)32 * 128 * 16 * 2);
  p.CcT = (bf16_t*)take((size_t)32 * 16 * 128 * 2);
  p.lam = (float2*)take(2048 * 8);
  p.lam64 = (float2*)take(2048 * 8);
  p.rope = (float2*)take((size_t)8192 * 16 * 8);
  p.rstd_x = (float*)take((size_t)NT * 4);
  p.cq_part = (float*)take((size_t)NT * 12 * 4);
  p.ckv_part = (float*)take((size_t)NT * 4 * 4);
  p.attn_part = (float*)take((size_t)NT * 8 * 4);
  p.ssm_part = (float*)take((size_t)NT * 8 * 4);
  p.h_part = (float*)take((size_t)NT * 16 * 4);
  p.out_part = (float*)take((size_t)NT * 16 * 4);
  p.counters = (int*)take(16384);
  p.E = (float2*)take((size_t)8 * 128 * 32 * 64 * 8);
  p.S = (float2*)take((size_t)8 * 128 * 32 * 64 * 8);
  const size_t a0 = off;
  p.Kn = (bf16_t*)take((size_t)NK * 512 * 2);
  const size_t aVt = off;
  p.Vt = (bf16_t*)take((size_t)NK * 512 * 2);
  p.Q = (bf16_t*)take((size_t)NT * 768 * 2);
  p.latb = (bf16_t*)take((size_t)NK * 256 * 2);
  p.krb = (bf16_t*)take((size_t)NK * 32 * 2);
  p.ub = (bf16_t*)take((size_t)NT * 512 * 2);
  const size_t aSsmY = off;
  p.ssm_y = (bf16_t*)take((size_t)NT * 512 * 2);
  p.mix = (bf16_t*)take((size_t)NT * 1024 * 2);
  const size_t total = off;
  p.xb = (bf16_t*)(base + a0);
  p.cq = (bf16_t*)(base + aVt);
  p.ckv_raw = (float*)(base + aVt + al256((size_t)NT * 768 * 2));
  p.act = (bf16_t*)(base + a0);
  const size_t aHb = a0 + al256((size_t)NT * 4096 * 2);
  p.hb = (bf16_t*)(base + aHb);
  if (aHb + (size_t)NT * 1024 * 2 > aSsmY || total > ws_size) { fprintf(stderr, "workspace layout error: total %zu ws %zu\n", total, ws_size); return; }

  const int MULTI = 0;
  hipMemsetAsync(p.counters, 0, 16384, stream);
  if (MULTI) {
    for (int ph = 0; ph < NPHASE; ++ph) {
      p.ph_lo = ph; p.ph_hi = ph + 1;
      hipLaunchKernelGGL(mega<false>, dim3(512), dim3(256), 0, stream, p);
    }
  } else {
    static int grid_blocks = 0;
    if (!grid_blocks) {
      int dev = 0, cus = 0, per_cu = 0;
      hipGetDevice(&dev);
      hipDeviceGetAttribute(&cus, hipDeviceAttributeMultiprocessorCount, dev);
      hipOccupancyMaxActiveBlocksPerMultiprocessor(&per_cu, mega<true>, 256, 0);
      grid_blocks = cus * per_cu;
    }
    p.ph_lo = 0; p.ph_hi = NPHASE;
    void* args[] = {&p};
    hipError_t e = hipLaunchCooperativeKernel((void*)mega<true>, dim3(grid_blocks), dim3(256), args, 0, stream);
    if (e != hipSuccess) fprintf(stderr, "cooperative launch failed: %s (grid %d)\n", hipGetErrorString(e), grid_blocks);
  }
}
```

```cpp
#include <hip/hip_runtime.h>
#include <hip/hip_cooperative_groups.h>
#include <stdint.h>
#include <cstdio>
namespace cg = cooperative_groups;
#define DI __device__ __forceinline__

typedef unsigned short bf16_t;
typedef short bf16x8 __attribute__((ext_vector_type(8)));
typedef float f32x16 __attribute__((ext_vector_type(16)));
typedef float f32x4 __attribute__((ext_vector_type(4)));
typedef unsigned u32x4 __attribute__((ext_vector_type(4)));
typedef unsigned u32x2 __attribute__((ext_vector_type(2)));

constexpr int NTP = 65536, NTS = 2048, NT = NTP + NTS, NK = NTP + 32 * 4160;
constexpr int SKS = 4160;
constexpr size_t OFF_Y = 0;
constexpr size_t OFF_LATP = (size_t)NT * 1024;
constexpr size_t OFF_KRP = OFF_LATP + (size_t)NTP * 256;
constexpr size_t OFF_HRP = OFF_KRP + (size_t)NTP * 32;
constexpr size_t OFF_HIP = OFF_HRP + 8 * 32 * 64;
constexpr size_t OFF_LATS = OFF_HIP + 8 * 32 * 64;
constexpr size_t OFF_KRS = OFF_LATS + (size_t)NTS * 256;
constexpr size_t OFF_HRS = OFF_KRS + (size_t)NTS * 32;
constexpr size_t OFF_HIS = OFF_HRS + 32 * 32 * 64;
constexpr size_t VT_S_OFF = (size_t)8 * 512 * 8192;
constexpr float EPS = 1e-6f;
constexpr int LDS_BYTES = 67600;
constexpr int NPHASE = 10;
constexpr int AQT = 1, NQQ = 128 / (4 / (64 / (32 * AQT)));

struct Params {
  const float* in[28];
  float* out;
  bf16_t *WinT, *WqT, *WkT, *WvT, *WgT, *WoT, *WuT, *WdT, *BbT, *CcT;
  float2 *lam, *lam64, *rope;
  float *rstd_x, *cq_part, *ckv_part, *attn_part, *ssm_part, *h_part, *out_part;
  int* counters;
  float2 *E, *S;
  bf16_t *Kn, *Vt, *Q, *latb, *krb, *ub, *ssm_y, *mix, *xb, *cq, *hb, *act;
  float* ckv_raw;
  int ph_lo, ph_hi;
};

DI int tid() { int t = __builtin_amdgcn_workitem_id_x(); asm volatile("" : "+v"(t)); return t; }
typedef __bf16 nbf16x2 __attribute__((ext_vector_type(2)));
typedef float f32x2 __attribute__((ext_vector_type(2)));
DI unsigned pk_bf16(float lo, float hi) { f32x2 v = {lo, hi}; return __builtin_bit_cast(unsigned, __builtin_convertvector(v, nbf16x2)); }
DI bf16_t f2bf(float x) { return (bf16_t)(pk_bf16(x, 0.f) & 0xffffu); }
DI float bf2f(bf16_t v) { return __uint_as_float(((unsigned)v) << 16); }
DI int crow(int i, int hh) { return (i & 3) + 8 * (i >> 2) + 4 * hh; }
DI const float* xrow(const Params& p, int row) { return row < NTP ? p.in[0] + (size_t)row * 1024 : p.in[1] + (size_t)(row - NTP) * 1024; }
DI int pos_of(int row) { return row < NTP ? (row & 8191) : 4096 + ((row - NTP) & 63); }
DI int kr_of(int row) { return row < NTP ? row : NTP + ((row - NTP) >> 6) * SKS + 4096 + ((row - NTP) & 63); }
#define MFMA32(a, b, c) __builtin_amdgcn_mfma_f32_32x32x16_bf16((a), (b), (c), 0, 0, 0)
#define MFMA16(a, b, c) __builtin_amdgcn_mfma_f32_16x16x32_bf16((a), (b), (c), 0, 0, 0)

DI void sincos_d(double x, double& s4, double& c4) {
  double k = rint(x * 0.15915494309189535);
  double rr = fma(-k, 6.283185307179586, x);
  rr = fma(-k, 2.4492935982947064e-16, rr);
  double y = rr * 0.25, y2 = y * y;
  double s = y * (1 - y2 / 6 * (1 - y2 / 20 * (1 - y2 / 42 * (1 - y2 / 72 * (1 - y2 / 110 * (1 - y2 / 156 * (1 - y2 / 210)))))));
  double c = 1 - y2 / 2 * (1 - y2 / 12 * (1 - y2 / 30 * (1 - y2 / 56 * (1 - y2 / 90 * (1 - y2 / 132 * (1 - y2 / 182))))));
  double s2 = 2 * s * c, c2 = 1 - 2 * s * s;
  s4 = 2 * s2 * c2; c4 = 1 - 2 * s2 * s2;
}

DI void gemm_core(const bf16_t* __restrict__ A, int lda, const bf16_t* __restrict__ B, int ldb, int nk,
                  int m0, int n0, char* lds, f32x16 (&acc)[2][2], int midk, const float* ratio) {
  const int t = tid(), lane = t & 63, wid = t >> 6, wm = wid >> 1, wn = wid & 1;
  const int r = lane & 31, hh = lane >> 5;
  const int lc = t & 7, lr = t >> 3;
  const unsigned woff = lr * 128 + ((lc ^ ((lr >> 1) & 7)) << 4);
  const bf16_t* ga = A + (size_t)(m0 + lr) * lda + lc * 8;
  const bf16_t* gb = B + (size_t)(n0 + lr) * ldb + lc * 8;
  char* sA = lds; char* sB = lds + 32768;
  u32x4 ra[4], rb[4];
#pragma unroll
  for (int i = 0; i < 4; ++i) { ra[i] = *(const u32x4*)(ga + (size_t)(32 * i) * lda); rb[i] = *(const u32x4*)(gb + (size_t)(32 * i) * ldb); }
#pragma unroll
  for (int i = 0; i < 4; ++i) { *(u32x4*)(sA + woff + i * 4096) = ra[i]; *(u32x4*)(sB + woff + i * 4096) = rb[i]; }
#pragma unroll
  for (int a = 0; a < 2; ++a)
#pragma unroll
    for (int b = 0; b < 2; ++b)
#pragma unroll
      for (int i = 0; i < 16; ++i) acc[a][b][i] = 0.f;
  __syncthreads();
  const int rsw = (r >> 1) & 7;
  const unsigned aoff = (wm * 64 + r) * 128, boff = (wn * 64 + r) * 128;
  for (int kt = 0; kt < nk; ++kt) {
    const int cur = kt & 1;
    const bool more = (kt + 1 < nk);
    if (more) {
      const bf16_t* ga2 = ga + (kt + 1) * 64; const bf16_t* gb2 = gb + (kt + 1) * 64;
#pragma unroll
      for (int i = 0; i < 4; ++i) { ra[i] = *(const u32x4*)(ga2 + (size_t)(32 * i) * lda); rb[i] = *(const u32x4*)(gb2 + (size_t)(32 * i) * ldb); }
    }
    if (midk && kt == midk) {
#pragma unroll
      for (int mt = 0; mt < 2; ++mt)
      { const float f = ratio[wm * 64 + mt * 32 + r];
#pragma unroll
        for (int i = 0; i < 16; ++i) { acc[mt][0][i] *= f; acc[mt][1][i] *= f; } }
    }
    const char* cA = sA + cur * 16384; const char* cB = sB + cur * 16384;
#pragma unroll
    for (int ks = 0; ks < 4; ++ks) {
      const unsigned co = (((ks * 2 + hh) ^ rsw) << 4);
      const bf16x8 a0 = *(const bf16x8*)(cA + aoff + co), a1 = *(const bf16x8*)(cA + aoff + 4096 + co);
      const bf16x8 b0 = *(const bf16x8*)(cB + boff + co), b1 = *(const bf16x8*)(cB + boff + 4096 + co);
      acc[0][0] = MFMA32(b0, a0, acc[0][0]); acc[0][1] = MFMA32(b1, a0, acc[0][1]);
      acc[1][0] = MFMA32(b0, a1, acc[1][0]); acc[1][1] = MFMA32(b1, a1, acc[1][1]);
    }
    if (more) {
      char* nA = sA + (cur ^ 1) * 16384; char* nB = sB + (cur ^ 1) * 16384;
#pragma unroll
      for (int i = 0; i < 4; ++i) { *(u32x4*)(nA + woff + i * 4096) = ra[i]; *(u32x4*)(nB + woff + i * 4096) = rb[i]; }
    }
    __syncthreads();
  }
}

DI void rowscale_load(float* rs, const float* src, int np, float inv_dim, int m0) {
  const int t = tid();
  if (t < 128) {
    const int row = m0 + t;
    if (np == 0) rs[t] = src[row];
    else { float s = 0.f; for (int j = 0; j < np; ++j) s += src[(size_t)row * np + j]; rs[t] = rsqrtf(s * inv_dim + EPS); }
  }
}

template <bool BLKA = false, class TileFn, class RsFn, class EpiFn>
DI void gemm_stream(const bf16_t* __restrict__ A, int lda, const bf16_t* __restrict__ B, int ldb, int nk, char* lds, int midk,
                    TileFn tile_fn, RsFn rs_fn, EpiFn epi) {
  int m0, n0;
  if (!tile_fn(0, m0, n0)) return;
  const int t = tid(), lane = t & 63, wid = t >> 6, wm = wid >> 1, wn = wid & 1;
  const int r = lane & 31, hh = lane >> 5;
  const int lc = t & 7, lr = t >> 3;
  const unsigned woff = lr * 128 + ((lc ^ ((lr >> 1) & 7)) << 4);
  char* sA = lds; char* sB = lds + 32768;
  float* rsbuf = (float*)(lds + 65536);
  const int rsw = (r >> 1) & 7;
  const unsigned aoff = (wm * 64 + r) * 128, boff = (wn * 64 + r) * 128;
  int lj = 0, lkt = 0, lm0 = m0, ln0 = n0; bool lvalid = true;
  u32x4 ra0[4], rb0[4], ra1[4], rb1[4];
#define GS_LOAD(RA, RB) do {   \
        \
      const bf16_t* ga_ = BLKA ? A + ((size_t)(lm0 >> 7) * nk + lkt) * 8192 + lr * 64 + lc * 8 : A + (size_t)(lm0 + lr) * lda + lc * 8 + lkt * 64; const bf16_t* gb_ = B + (size_t)(ln0 + lr) * ldb + lc * 8 + lkt * 64; \
      _Pragma("unroll") for (int i = 0; i < 4; ++i) { RA[i] = *(const u32x4*)(ga_ + (size_t)(32 * i) * (BLKA ? 64 : lda)); RB[i] = *(const u32x4*)(gb_ + (size_t)(32 * i) * ldb); } \
      if (++lkt == nk) { lkt = 0; if (lvalid) { ++lj; lvalid = tile_fn(lj, lm0, ln0); } } } while (0)
  GS_LOAD(ra0, rb0);
  GS_LOAD(ra1, rb1);
  {
    float2 rv = make_float2(0.f, 0.f);
    if (t < 128) rv = rs_fn(m0, t);
    __syncthreads();
#pragma unroll
    for (int i = 0; i < 4; ++i) { *(u32x4*)(sA + woff + i * 4096) = ra0[i]; *(u32x4*)(sB + woff + i * 4096) = rb0[i]; }
    if (t < 128) { rsbuf[t] = rv.x; rsbuf[128 + t] = rv.y; }
    __syncthreads();
  }
  int cur = 0;
  for (int j = 0;; ++j) {
    int m1 = 0, n1 = 0;
    const bool has_next = tile_fn(j + 1, m1, n1);
    const float* rs = rsbuf + (j & 1) * 256;
    f32x16 acc[2][2];
#pragma unroll
    for (int a = 0; a < 2; ++a)
#pragma unroll
      for (int b = 0; b < 2; ++b)
#pragma unroll
        for (int i = 0; i < 16; ++i) acc[a][b][i] = 0.f;
#define GS_STEP(RL_A, RL_B, RW_A, RW_B, KT) do { \
      const bool last_ = ((KT) + 1 == nk); const bool wr_ = !last_ || has_next; \
      float2 rv_ = make_float2(0.f, 0.f); \
      if (last_ && has_next) { if (t < 128) rv_ = rs_fn(m1, t); asm volatile("" : "+v"(rv_.x), "+v"(rv_.y)); }   \
      GS_LOAD(RL_A, RL_B); \
      if (midk && (KT) == midk) { _Pragma("unroll") for (int mt = 0; mt < 2; ++mt) { const float f = rs[128 + wm * 64 + mt * 32 + r]; \
          _Pragma("unroll") for (int i = 0; i < 16; ++i) { acc[mt][0][i] *= f; acc[mt][1][i] *= f; } } } \
      const char* cA = sA + cur * 16384; const char* cB = sB + cur * 16384; \
      __builtin_amdgcn_iglp_opt(0); \
      _Pragma("unroll") for (int ks = 0; ks < 4; ++ks) { \
        const unsigned co = (((ks * 2 + hh) ^ rsw) << 4); \
        const bf16x8 a0 = *(const bf16x8*)(cA + aoff + co), a1 = *(const bf16x8*)(cA + aoff + 4096 + co); \
        const bf16x8 b0 = *(const bf16x8*)(cB + boff + co), b1 = *(const bf16x8*)(cB + boff + 4096 + co); \
        acc[0][0] = MFMA32(b0, a0, acc[0][0]); acc[0][1] = MFMA32(b1, a0, acc[0][1]); \
        acc[1][0] = MFMA32(b0, a1, acc[1][0]); acc[1][1] = MFMA32(b1, a1, acc[1][1]); } \
      if (wr_) { char* nA = sA + (cur ^ 1) * 16384; char* nB = sB + (cur ^ 1) * 16384; \
        _Pragma("unroll") for (int i = 0; i < 4; ++i) { *(u32x4*)(nA + woff + i * 4096) = RW_A[i]; *(u32x4*)(nB + woff + i * 4096) = RW_B[i]; } \
        if (last_ && t < 128) { float* rn = rsbuf + ((j + 1) & 1) * 256; rn[t] = rv_.x; rn[128 + t] = rv_.y; } } \
      __syncthreads(); cur ^= 1; } while (0)
    for (int kt = 0; kt < nk; kt += 2) {
      GS_STEP(ra0, rb0, ra1, rb1, kt);
      GS_STEP(ra1, rb1, ra0, rb0, kt + 1);
    }
    epi(acc, m0, n0, rs, cur ^ 1);
    if (!has_next) break;
    m0 = m1; n0 = n1;
  }
#undef GS_STEP
#undef GS_LOAD
  __syncthreads();
}

DI float half_reduce(float s) {
  s += __shfl_xor(s, 1); s += __shfl_xor(s, 2); s += __shfl_xor(s, 4); s += __shfl_xor(s, 8); s += __shfl_xor(s, 16); return s;
}

#define EPI_IDS int t = tid(); asm volatile("" : "+v"(t)); const int lane = t & 63, wid = t >> 6, wm = wid >> 1, wn = wid & 1, r = lane & 31, hh = lane >> 5; (void)lane; (void)wid; (void)wm; (void)wn; (void)r; (void)hh;
#define GEMM_IDS const int t = tid(), lane = t & 63, wid = t >> 6, wm = wid >> 1, wn = wid & 1, r = lane & 31, hh = lane >> 5; (void)t; (void)wm; (void)wn; (void)r; (void)hh;

DI char* wave_stage(char* lds, int fstage, int wid) { return lds + (wid < 2 ? 0 : 32768) + fstage * 16384 + (wid & 1) * 8192; }
DI void wave_store64(char* stg, const u32x2 (&w)[2][2][4], bf16_t* gdst, size_t row_stride, int lane, int r, int hh) {
#pragma unroll
  for (int mt = 0; mt < 2; ++mt)
#pragma unroll
    for (int nt = 0; nt < 2; ++nt)
#pragma unroll
      for (int i4 = 0; i4 < 4; ++i4) { const int rloc = mt * 32 + r; *(u32x2*)(stg + rloc * 128 + (((nt * 4 + i4) ^ (rloc & 7)) << 4) + hh * 8) = w[mt][nt][i4]; }
  asm volatile("s_waitcnt lgkmcnt(0)" ::: "memory");
  __builtin_amdgcn_wave_barrier();
#pragma unroll
  for (int s8 = 0; s8 < 8; ++s8) {
    const int rloc = s8 * 8 + (lane >> 3), c = lane & 7;
    const u32x4 q = *(const u32x4*)(stg + rloc * 128 + ((c ^ (rloc & 7)) << 4));
    *(u32x4*)(gdst + (size_t)rloc * row_stride + c * 8) = q;
  }
}

DI void transpose_tile(const float* __restrict__ src, int ld, int K, int kt, int nt, int job, const float* g0, const float* g1, bf16_t* __restrict__ dst, char* lds) {
  bf16_t* tile = (bf16_t*)lds;
  const int t = tid(), nl = t & 63, kq = t >> 6;
  const int n = nt * 64 + nl;
  int c = n;
  if (job == 0) { c = n < 1024 ? n : (n < 1536 ? 1056 + (n - 1024) : (n < 1568 ? 1024 + (n - 1536) : -1)); }
  else if (job == 2) c = (n >> 6) * 128 + (n & 63);
  else if (job == 3) c = (n >> 6) * 128 + 64 + (n & 63);
#pragma unroll 4
  for (int pass = 0; pass < 16; ++pass) {
    const int kl = pass * 4 + kq, k = kt * 64 + kl;
    float v = 0.f;
    if (c >= 0) {
      v = src[(size_t)k * ld + c];
      if (g0) { const float g = (g1 && k >= 512) ? g1[k - 512] : g0[k]; v *= g; }
    }
    tile[nl * 66 + kl] = f2bf(v);
  }
  __syncthreads();
  const int kl = t & 63;
#pragma unroll 4
  for (int pass = 0; pass < 16; ++pass) { const int nl2 = pass * 4 + kq; dst[(size_t)(nt * 64 + nl2) * K + kt * 64 + kl] = tile[nl2 * 66 + kl]; }
  __syncthreads();
}

DI void phase0(const Params& p, char* lds) {
  const int t = tid(), nb = gridDim.x, bid = blockIdx.x, lane = t & 63, wid = t >> 6;
  for (int ti = bid; ti < 2992; ti += nb) {
    int job, base, nNt, ld, K; const float* src; const float* g0 = nullptr; const float* g1 = nullptr; bf16_t* dst;
    if (ti < 416) { job = 0; base = 0; nNt = 26; ld = 1568; K = 1024; src = p.in[7]; g0 = p.in[6]; dst = p.WinT; }
    else if (ti < 560) { job = 1; base = 416; nNt = 12; ld = 768; K = 768; src = p.in[9]; g0 = p.in[8]; dst = p.WqT; }
    else if (ti < 592) { job = 2; base = 560; nNt = 8; ld = 1024; K = 256; src = p.in[11]; dst = p.WkT; }
    else if (ti < 624) { job = 3; base = 592; nNt = 8; ld = 1024; K = 256; src = p.in[11]; dst = p.WvT; }
    else if (ti < 688) { job = 4; base = 624; nNt = 8; ld = 512; K = 512; src = p.in[20]; dst = p.WgT; }
    else if (ti < 944) { job = 5; base = 688; nNt = 16; ld = 1024; K = 1024; src = p.in[23]; g0 = p.in[21]; g1 = p.in[22]; dst = p.WoT; }
    else if (ti < 1968) { job = 6; base = 944; nNt = 64; ld = 4096; K = 1024; src = p.in[25]; g0 = p.in[24]; dst = p.WuT; }
    else { job = 7; base = 1968; nNt = 16; ld = 1024; K = 4096; src = p.in[26]; dst = p.WdT; }
    const int tile = ti - base;
    transpose_tile(src, ld, K, tile / nNt, tile % nNt, job, g0, g1, dst, lds);
  }
  for (int row = bid * 4 + wid; row < NT; row += nb * 4) {
    const float* x = xrow(p, row);
    f32x4 v[4]; float ss = 0.f;
#pragma unroll
    for (int j = 0; j < 4; ++j) { v[j] = *(const f32x4*)(x + lane * 4 + 256 * j); ss += v[j][0] * v[j][0] + v[j][1] * v[j][1] + v[j][2] * v[j][2] + v[j][3] * v[j][3]; }
    ss += __shfl_xor(ss, 32); ss = half_reduce(ss);
#pragma unroll
    for (int j = 0; j < 4; ++j) { u32x2 w; w.x = pk_bf16(v[j][0], v[j][1]); w.y = pk_bf16(v[j][2], v[j][3]); *(u32x2*)(p.xb + (size_t)row * 1024 + lane * 4 + 256 * j) = w; }
    if (lane == 0) p.rstd_x[row] = rsqrtf(ss * (1.f / 1024.f) + EPS);
  }
  const int gt = bid * 256 + t, ngt = nb * 256;
  for (int v = gt; v < 32 * 4096 * 32; v += ngt) {
    const size_t e0 = (size_t)v * 8; const int b = (int)(e0 >> 20), rem = (int)(e0 & 1048575), tt = rem >> 8, c = rem & 255;
    const f32x4 a = *(const f32x4*)(p.in[2] + e0), bq = *(const f32x4*)(p.in[2] + e0 + 4);
    u32x4 w; w.x = pk_bf16(a[0], a[1]); w.y = pk_bf16(a[2], a[3]); w.z = pk_bf16(bq[0], bq[1]); w.w = pk_bf16(bq[2], bq[3]);
    *(u32x4*)(p.latb + (size_t)(NTP + b * SKS + tt) * 256 + c) = w;
  }
  for (int v = gt; v < 32 * 4096 * 4; v += ngt) {
    const size_t e0 = (size_t)v * 8; const int b = (int)(e0 >> 17), rem = (int)(e0 & 131071), tt = rem >> 5, c = rem & 31;
    const f32x4 a = *(const f32x4*)(p.in[3] + e0), bq = *(const f32x4*)(p.in[3] + e0 + 4);
    u32x4 w; w.x = pk_bf16(a[0], a[1]); w.y = pk_bf16(a[2], a[3]); w.z = pk_bf16(bq[0], bq[1]); w.w = pk_bf16(bq[2], bq[3]);
    *(u32x4*)(p.krb + (size_t)(NTP + b * SKS + tt) * 32 + c) = w;
  }
  if (gt < 2048) {
    const int g = gt >> 6, n = gt & 63;
    const double dt = (double)expf(p.in[14][g]);
    const double lr = p.in[12][gt], li = p.in[13][gt];
    const double mag = (double)expf((float)(lr * dt)); double s, c; sincos_d(li * dt, s, c);
    const double lbr = mag * c, lbi = mag * s;
    const double nr = lbr - 1.0, ni = lbi, den = lr * lr + li * li;
    const double cr = (nr * lr + ni * li) / den, ci = (ni * lr - nr * li) / den;
    p.lam[gt] = make_float2((float)lbr, (float)lbi);
    const double mag64 = (double)expf((float)(64.0 * lr * dt)); sincos_d(64.0 * li * dt, s, c);
    p.lam64[gt] = make_float2((float)(mag64 * c), (float)(mag64 * s));
    for (int q = 0; q < 16; ++q) {
      const double br = p.in[15][(size_t)gt * 16 + q], bi = p.in[16][(size_t)gt * 16 + q];
      p.BbT[(size_t)(g * 128 + n) * 16 + q] = f2bf((float)(cr * br - ci * bi));
      p.BbT[(size_t)(g * 128 + 64 + n) * 16 + q] = f2bf((float)(cr * bi + ci * br));
      p.CcT[(size_t)(g * 16 + q) * 128 + n] = f2bf(p.in[17][(size_t)(g * 16 + q) * 64 + n]);
      p.CcT[(size_t)(g * 16 + q) * 128 + 64 + n] = f2bf(-p.in[18][(size_t)(g * 16 + q) * 64 + n]);
    }
  }
  for (int e = gt; e < 8192 * 16; e += ngt) {
    const int pos = e >> 4, i = e & 15;
    const float inv = expf(-(float)i * (9.210340371976184f / 16.0f));
    const float ang = (float)pos * inv;
    double s, c; sincos_d((double)ang, s, c);
    p.rope[e] = make_float2((float)c, (float)s);
  }
}

DI void phase1(const Params& p, char* lds) {
  float* rs = (float*)(lds + 65536);
  const int ntiles = 528 * 13;
  {
    auto tile_fn = [&](int j, int& m0, int& n0) -> bool { const int li = (int)(blockIdx.x >> 3) + j * (int)(gridDim.x >> 3); const int ti_ = li / 13, tj_ = li - ti_ * 13; const int tbig = ti_ * 8 + (int)(blockIdx.x & 7); if (tbig >= 528) return false; m0 = tbig * 128; n0 = tj_ * 128; return true; };
    auto rs_fn = [&](int m0, int t) -> float2 { return make_float2(p.rstd_x[m0 + t], 0.f); };
    auto epi = [&](f32x16 (&acc)[2][2], int m0, int n0, const float* rs, int fstage) { (void)fstage;
    const int tn = n0 >> 7; (void)tn;
    { EPI_IDS
    u32x2 wq[2][2][4];
    if (tn < 8) {
#pragma unroll
      for (int mt = 0; mt < 2; ++mt) {
        const int rl = wm * 64 + mt * 32 + r, row = m0 + rl;
        const float sc = rs[rl];
        float ss = 0.f;
#pragma unroll
        for (int nt = 0; nt < 2; ++nt)
#pragma unroll
          for (int i4 = 0; i4 < 4; ++i4) {
            const float v0 = acc[mt][nt][4 * i4] * sc, v1 = acc[mt][nt][4 * i4 + 1] * sc, v2 = acc[mt][nt][4 * i4 + 2] * sc, v3 = acc[mt][nt][4 * i4 + 3] * sc;
            ss += v0 * v0 + v1 * v1 + v2 * v2 + v3 * v3;
            const int col = n0 + wn * 64 + nt * 32 + 8 * i4 + 4 * hh;
            if (tn < 6) { wq[mt][nt][i4].x = pk_bf16(v0, v1); wq[mt][nt][i4].y = pk_bf16(v2, v3); }
            else { f32x4 w = {v0, v1, v2, v3}; *(f32x4*)(p.ckv_raw + (size_t)row * 256 + (col - 768)) = w; }
          }
        ss += __shfl_xor(ss, 32);
        if (hh == 0) { if (tn < 6) p.cq_part[(size_t)row * 12 + tn * 2 + wn] = ss; else p.ckv_part[(size_t)row * 4 + (tn - 6) * 2 + wn] = ss; }
      }
      if (tn < 6) wave_store64(wave_stage(lds, fstage, wid), wq, p.cq + (size_t)(m0 + wm * 64) * 768 + n0 + wn * 64, 768, lane, r, hh);
    } else if (tn < 12) {
#pragma unroll
      for (int mt = 0; mt < 2; ++mt) {
        const int rl = wm * 64 + mt * 32 + r, row = m0 + rl;
        const float sc = rs[rl];
#pragma unroll
        for (int nt = 0; nt < 2; ++nt)
#pragma unroll
          for (int i4 = 0; i4 < 4; ++i4) {
            wq[mt][nt][i4].x = pk_bf16(acc[mt][nt][4 * i4] * sc, acc[mt][nt][4 * i4 + 1] * sc); wq[mt][nt][i4].y = pk_bf16(acc[mt][nt][4 * i4 + 2] * sc, acc[mt][nt][4 * i4 + 3] * sc);
          }
      }
      wave_store64(wave_stage(lds, fstage, wid), wq, p.ub + (size_t)(m0 + wm * 64) * 512 + (n0 - 1024) + wn * 64, 512, lane, r, hh);
    } else if (wn == 0) {
#pragma unroll
      for (int mt = 0; mt < 2; ++mt) {
        const int rl = wm * 64 + mt * 32 + r, row = m0 + rl;
        const float sc = rs[rl];
        float* dst = row < NTP ? p.out + OFF_KRP + (size_t)row * 32 : p.out + OFF_KRS + (size_t)(row - NTP) * 32;
        bf16_t* dkb = p.krb + (size_t)kr_of(row) * 32;
        const float* rp = (const float*)(p.rope + pos_of(row) * 16);
#pragma unroll
        for (int ih = 0; ih < 2; ++ih) {
          const int j0 = 8 * ih + 4 * hh;
          const f32x4 c01 = *(const f32x4*)(rp + 2 * j0), c23 = *(const f32x4*)(rp + 2 * j0 + 4);
          const float cc[4] = {c01[0], c01[2], c23[0], c23[2]}, sn[4] = {c01[1], c01[3], c23[1], c23[3]};
          f32x4 o1, o2;
#pragma unroll
          for (int jj = 0; jj < 4; ++jj) {
            const float x1 = acc[mt][0][4 * ih + jj] * sc, x2 = acc[mt][0][8 + 4 * ih + jj] * sc;
            o1[jj] = x1 * cc[jj] - x2 * sn[jj]; o2[jj] = x1 * sn[jj] + x2 * cc[jj];
          }
          *(f32x4*)(dst + j0) = o1; *(f32x4*)(dst + 16 + j0) = o2;
          u32x2 w1, w2; w1.x = pk_bf16(o1[0], o1[1]); w1.y = pk_bf16(o1[2], o1[3]); w2.x = pk_bf16(o2[0], o2[1]); w2.y = pk_bf16(o2[2], o2[3]);
          *(u32x2*)(dkb + j0) = w1; *(u32x2*)(dkb + 16 + j0) = w2;
        }
      }
    }
    }
    __syncthreads();
    };
    gemm_stream(p.xb, 1024, p.WinT, 1024, 16, lds, 0, tile_fn, rs_fn, epi);
  }
}

DI void ssm_chunk(const Params& p, int row0, int g, float& hr, float& hi, bool write_y, char* lds_w) {
  const int lane = tid() & 63, r = lane & 31, hh = lane >> 5;
  const float2 lm = p.lam[g * 64 + lane];
  bf16x8 bfr[4];
#pragma unroll
  for (int nt = 0; nt < 4; ++nt) bfr[nt] = *(const bf16x8*)(p.BbT + (size_t)(g * 128 + nt * 32 + r) * 16 + hh * 8);
  const int fr = lane & 15, fq = lane >> 4;
  bf16x8 cfr[4];
#pragma unroll
  for (int ks = 0; ks < 4; ++ks) cfr[ks] = *(const bf16x8*)(p.CcT + (size_t)(g * 16 + fr) * 128 + ks * 32 + fq * 8);
  const float dsk = p.in[19][g * 16 + fr];
#pragma unroll 1
  for (int sub = 0; sub < 2; ++sub) {
    const int rb = row0 + sub * 32;
    const bf16x8 uf = *(const bf16x8*)(p.ub + (size_t)(rb + r) * 512 + g * 16 + hh * 8);
    f32x16 z; for (int i = 0; i < 16; ++i) z[i] = 0.f;
    const f32x16 x0 = MFMA32(uf, bfr[0], z), x1 = MFMA32(uf, bfr[1], z), x2 = MFMA32(uf, bfr[2], z), x3 = MFMA32(uf, bfr[3], z);
    float xr0[16], xr1[16], xi0[16], xi1[16];
#pragma unroll
    for (int i = 0; i < 16; ++i) {
      const auto re = __builtin_amdgcn_permlane32_swap(__float_as_uint(x0[i]), __float_as_uint(x1[i]), false, false);
      const auto im = __builtin_amdgcn_permlane32_swap(__float_as_uint(x2[i]), __float_as_uint(x3[i]), false, false);
      xr0[i] = __uint_as_float(re[0]); xr1[i] = __uint_as_float(re[1]);
      xi0[i] = __uint_as_float(im[0]); xi1[i] = __uint_as_float(im[1]);
    }
    bf16_t* Hs = (bf16_t*)lds_w;
#pragma unroll
    for (int m = 0; m < 4; ++m) {
#pragma unroll
      for (int half = 0; half < 2; ++half) {
#pragma unroll
        for (int jj = 0; jj < 4; ++jj) {
          const int i = 4 * m + jj, tt = 8 * m + 4 * half + jj;
          const float xr = half ? xr1[i] : xr0[i], xi = half ? xi1[i] : xi0[i];
          const float nr = lm.x * hr - lm.y * hi + xr;
          const float ni = lm.x * hi + lm.y * hr + xi;
          hr = nr; hi = ni;
          if (write_y) { Hs[tt * 136 + lane] = f2bf(hr); Hs[tt * 136 + 64 + lane] = f2bf(hi); }
        }
      }
    }
    if (write_y) {
      asm volatile("s_waitcnt lgkmcnt(0)" ::: "memory");
      __builtin_amdgcn_wave_barrier();
#pragma unroll
      for (int mt = 0; mt < 2; ++mt) {
        f32x4 y = {0.f, 0.f, 0.f, 0.f};
#pragma unroll
        for (int ks = 0; ks < 4; ++ks) {
          const bf16x8 hf = *(const bf16x8*)(Hs + (mt * 16 + fr) * 136 + ks * 32 + fq * 8);
          y = MFMA16(hf, cfr[ks], y);
        }
#pragma unroll
        for (int j = 0; j < 4; ++j) {
          const int row = rb + mt * 16 + fq * 4 + j;
          const float u = bf2f(p.ub[(size_t)row * 512 + g * 16 + fr]);
          const float v = y[j] + dsk * u;
          const float zz = 0.7978845608028654f * (v + 0.044715f * v * v * v);
          const float th = 1.f - 2.f / (__expf(2.f * zz) + 1.f);
          p.ssm_y[(size_t)row * 512 + g * 16 + fr] = f2bf(0.5f * v * (1.f + th));
        }
      }
      asm volatile("s_waitcnt lgkmcnt(0)" ::: "memory");
      __builtin_amdgcn_wave_barrier();
    }
  }
}

DI void phase2(const Params& p, char* lds) {
  const int lane = tid() & 63, wid = tid() >> 6;
  const int nb = gridDim.x, bid = blockIdx.x;
  for (int row = bid * 4 + wid; row < NT; row += nb * 4) {
    const f32x4 v = *(const f32x4*)(p.ckv_raw + (size_t)row * 256 + lane * 4);
    const f32x4 pp = *(const f32x4*)(p.ckv_part + (size_t)row * 4);
    const float rstd = rsqrtf((pp[0] + pp[1] + pp[2] + pp[3]) * (1.f / 256.f) + EPS);
    const f32x4 g = *(const f32x4*)(p.in[10] + lane * 4);
    f32x4 o; o[0] = v[0] * rstd * g[0]; o[1] = v[1] * rstd * g[1]; o[2] = v[2] * rstd * g[2]; o[3] = v[3] * rstd * g[3];
    float* dst = row < NTP ? p.out + OFF_LATP + (size_t)row * 256 : p.out + OFF_LATS + (size_t)(row - NTP) * 256;
    *(f32x4*)(dst + lane * 4) = o;
    u32x2 w; w.x = pk_bf16(o[0], o[1]); w.y = pk_bf16(o[2], o[3]);
    *(u32x2*)(p.latb + (size_t)kr_of(row) * 256 + lane * 4) = w;
  }
  for (int it = bid * 4 + wid; it < 8 * 128 * 32; it += nb * 4) {
    const int g = it & 31, c = (it >> 5) & 127, b = it >> 12;
    float hr = 0.f, hi = 0.f;
    ssm_chunk(p, b * 8192 + c * 64, g, hr, hi, false, lds + wid * 8704);
    p.E[(size_t)it * 64 + lane] = make_float2(hr, hi);
  }
  float* rs = (float*)(lds + 65536);
  {
    auto tile_fn = [&](int j, int& m0, int& n0) -> bool { const int li = (int)(blockIdx.x >> 3) + j * (int)(gridDim.x >> 3); const int ti_ = li / 6, tj_ = li - ti_ * 6; const int tbig = ti_ * 8 + (int)(blockIdx.x & 7); if (tbig >= 528) return false; m0 = tbig * 128; n0 = tj_ * 128; return true; };
    auto rs_fn = [&](int m0, int t) -> float2 { float sm = 0.f; for (int q = 0; q < 3; ++q) { const f32x4 v = *(const f32x4*)(p.cq_part + (size_t)(m0 + t) * 12 + 4 * q); sm += (v[0] + v[1]) + (v[2] + v[3]); } return make_float2(rsqrtf(sm * (1.f / 768.f) + EPS), 0.f); };
    auto epi = [&](f32x16 (&acc)[2][2], int m0, int n0, const float* rs, int fstage) { (void)fstage;
    const int tn = n0 >> 7; (void)tn;
    EPI_IDS
    const float qs = 0.10206207261596577f * 1.4426950408889634f;
    u32x2 wq[2][2][4];
#pragma unroll
    for (int mt = 0; mt < 2; ++mt) {
      const int rl = wm * 64 + mt * 32 + r, row = m0 + rl;
      const float sc = rs[rl] * qs;
      const float* rp = (const float*)(p.rope + pos_of(row) * 16);
#pragma unroll
      for (int nt = 0; nt < 2; ++nt) {
        const int cb = n0 + wn * 64 + nt * 32;
        if ((cb % 96) == 64) {
#pragma unroll
          for (int ih = 0; ih < 2; ++ih) {
            const int j0 = 8 * ih + 4 * hh;
            const f32x4 c01 = *(const f32x4*)(rp + 2 * j0), c23 = *(const f32x4*)(rp + 2 * j0 + 4);
            const float cc[4] = {c01[0], c01[2], c23[0], c23[2]}, sn[4] = {c01[1], c01[3], c23[1], c23[3]};
            float o1[4], o2[4];
#pragma unroll
            for (int jj = 0; jj < 4; ++jj) {
              const float x1 = acc[mt][nt][4 * ih + jj] * sc, x2 = acc[mt][nt][8 + 4 * ih + jj] * sc;
              o1[jj] = x1 * cc[jj] - x2 * sn[jj]; o2[jj] = x1 * sn[jj] + x2 * cc[jj];
            }
            wq[mt][nt][ih].x = pk_bf16(o1[0], o1[1]); wq[mt][nt][ih].y = pk_bf16(o1[2], o1[3]); wq[mt][nt][ih + 2].x = pk_bf16(o2[0], o2[1]); wq[mt][nt][ih + 2].y = pk_bf16(o2[2], o2[3]);
          }
        } else {
#pragma unroll
          for (int i4 = 0; i4 < 4; ++i4) {
            wq[mt][nt][i4].x = pk_bf16(acc[mt][nt][4 * i4] * sc, acc[mt][nt][4 * i4 + 1] * sc); wq[mt][nt][i4].y = pk_bf16(acc[mt][nt][4 * i4 + 2] * sc, acc[mt][nt][4 * i4 + 3] * sc);
          }
        }
      }
    }

    wave_store64(wave_stage(lds, fstage, wid), wq, p.Q + (size_t)(m0 + wm * 64) * 768 + n0 + wn * 64, 768, lane, r, hh);
    __syncthreads();
    };
    gemm_stream(p.cq, 768, p.WqT, 768, 12, lds, 0, tile_fn, rs_fn, epi);
  }
}

DI void phase3(const Params& p, char* lds) {
  const int lane = tid() & 63, wid = tid() >> 6;
  const int nb = gridDim.x, bid = blockIdx.x;
  for (int it = bid * 4 + wid; it < 256; it += nb * 4) {
    const int b = it >> 5, g = it & 31;
    const float2 l64 = p.lam64[g * 64 + lane];
    float sr = 0.f, si = 0.f;
    const size_t base = ((size_t)(b * 128) * 32 + g) * 64 + lane;
    for (int c0 = 0; c0 < 128; c0 += 16) {
      float2 e[16];
#pragma unroll
      for (int j = 0; j < 16; ++j) e[j] = p.E[base + (size_t)(c0 + j) * 2048];
#pragma unroll
      for (int j = 0; j < 16; ++j) {
        p.S[base + (size_t)(c0 + j) * 2048] = make_float2(sr, si);
        const float nr = l64.x * sr - l64.y * si + e[j].x, ni = l64.x * si + l64.y * sr + e[j].y;
        sr = nr; si = ni;
      }
    }
  }
  {
    auto tile_fn = [&](int j, int& m0, int& n0) -> bool { const int li = (int)(blockIdx.x >> 3) + j * (int)(gridDim.x >> 3); const int ti_ = li / 4, tj_ = li - ti_ * 4; const int tbig = ti_ * 8 + (int)(blockIdx.x & 7); if (tbig >= 1552) return false; m0 = tbig * 128; n0 = tj_ * 128; return true; };
    auto rs_fn = [&](int m0, int t) -> float2 { return make_float2(0.f, 0.f); };
    auto epi = [&](f32x16 (&acc)[2][2], int m0, int n0, const float* rs, int fstage) { (void)fstage;
    const int tn = n0 >> 7; (void)tn;
    EPI_IDS
    u32x2 w[2][2][4];
#pragma unroll
    for (int mt = 0; mt < 2; ++mt)
#pragma unroll
      for (int nt = 0; nt < 2; ++nt)
#pragma unroll
        for (int i4 = 0; i4 < 4; ++i4) { w[mt][nt][i4].x = pk_bf16(acc[mt][nt][4 * i4], acc[mt][nt][4 * i4 + 1]); w[mt][nt][i4].y = pk_bf16(acc[mt][nt][4 * i4 + 2], acc[mt][nt][4 * i4 + 3]); }
    wave_store64(wave_stage(lds, fstage, wid), w, p.Kn + (size_t)(m0 + wm * 64) * 512 + n0 + wn * 64, 512, lane, r, hh);
    __syncthreads();
    };
    gemm_stream(p.latb, 256, p.WkT, 256, 4, lds, 0, tile_fn, rs_fn, epi);
  }
  {
    auto tile_fn = [&](int j, int& m0, int& n0) -> bool { const int li = (int)(blockIdx.x >> 3) + j * (int)(gridDim.x >> 3); const int ti_ = li / 4, tj_ = li - ti_ * 4; const int tbig = ti_ * 8 + (int)(blockIdx.x & 7); if (tbig >= 1552) return false; n0 = tbig * 128; m0 = tj_ * 128; return true; };
    auto rs_fn = [&](int m0, int t) -> float2 { return make_float2(0.f, 0.f); };
    auto epi = [&](f32x16 (&acc)[2][2], int m0, int n0, const float* rs, int fstage) { (void)fstage;
    const int tn = n0 >> 7; (void)tn;
    EPI_IDS
    u32x2 w[2][2][4];
#pragma unroll
    for (int mt = 0; mt < 2; ++mt)
#pragma unroll
      for (int nt = 0; nt < 2; ++nt)
#pragma unroll
        for (int i4 = 0; i4 < 4; ++i4) { w[mt][nt][i4].x = pk_bf16(acc[mt][nt][4 * i4], acc[mt][nt][4 * i4 + 1]); w[mt][nt][i4].y = pk_bf16(acc[mt][nt][4 * i4 + 2], acc[mt][nt][4 * i4 + 3]); }
    const int kr0 = n0 + wn * 64;
    size_t cbase; int S;
    if (kr0 < NTP) { cbase = (size_t)(kr0 >> 13) * 512 * 8192 + (kr0 & 8191); S = 8192; }
    else { const int k2 = kr0 - NTP, b = k2 / SKS, tt = k2 - b * SKS; cbase = VT_S_OFF + (size_t)b * 512 * SKS + tt; S = SKS; }
    wave_store64(wave_stage(lds, fstage, wid), w, p.Vt + cbase + (size_t)(m0 + wm * 64) * S, (size_t)S, lane, r, hh);
    __syncthreads();
    };
    gemm_stream(p.WvT, 256, p.latb, 256, 4, lds, 0, tile_fn, rs_fn, epi);
  }
}

template <int QT, bool HALF>
DI void attn_item(const Params& p, int kind, int b, int h, int qq, char* lds) {
  const int t = tid(), lane = t & 63, wid = t >> 6, r = lane & 31, hh = lane >> 5;
  int qrow0, nkb_w, nkb_max, S; size_t kr0; const bf16_t* vt_base;
  constexpr int RW = 32 * QT, WPC = 64 / RW, CPB = 4 / WPC;
  if (kind == 0) {
    const int c = qq * CPB + wid / WPC; qrow0 = b * 8192 + c * 64 + (wid % WPC) * RW; nkb_w = c + 1; nkb_max = qq * CPB + CPB; kr0 = (size_t)b * 8192; S = 8192;
    vt_base = p.Vt + (size_t)(b * 8 + h) * 64 * 8192;
  } else {
    qrow0 = NTP + b * 64 + (wid % WPC) * RW; nkb_w = (wid < WPC) ? 65 : 0; nkb_max = 65; kr0 = (size_t)NTP + (size_t)b * SKS; S = SKS;
    vt_base = p.Vt + VT_S_OFF + (size_t)(b * 8 + h) * 64 * SKS;
  }
  bf16x8 qf[QT][6];
#pragma unroll
  for (int qt = 0; qt < QT; ++qt)
#pragma unroll
    for (int ks = 0; ks < 6; ++ks) qf[qt][ks] = *(const bf16x8*)(p.Q + (size_t)(qrow0 + qt * 32 + r) * 768 + h * 96 + ks * 16 + hh * 8);
  f32x16 o[2][QT];
  float mrun[QT], lrun[QT];
#pragma unroll
  for (int qt = 0; qt < QT; ++qt) { mrun[qt] = -1e30f; lrun[qt] = 0.f;
#pragma unroll
    for (int dt = 0; dt < 2; ++dt)
#pragma unroll
      for (int i = 0; i < 16; ++i) o[dt][qt][i] = 0.f; }
  const int kkey = t >> 3, kc = t & 7;
  const int rkey = t >> 2, rc = t & 3;
  const int vd = t >> 3, vc = t & 7;
  const bf16_t* gk = p.Kn + (kr0 + kkey) * 512 + h * 64 + kc * 8;
  const bf16_t* gr = p.krb + (kr0 + rkey) * 32 + rc * 8;
  const bf16_t* gv = vt_base + (size_t)vd * S + vc * 8;
  const unsigned kw0 = kkey * 208 + kc * 16, kw1 = kw0 + 32 * 208, rw = rkey * 208 + 128 + rc * 16;
  const unsigned vlo = vd * 144 + (vc >> 1) * 32 + (vc & 1) * 8, vhi = vlo + 16;
  constexpr int KB = 13312, VB = 9216, BUF = KB + VB;
  u32x4 k0r, k1r, rr, v0r, v1r;
  k0r = *(const u32x4*)gk; k1r = *(const u32x4*)(gk + 32 * 512); rr = *(const u32x4*)gr;
  v0r = *(const u32x4*)gv; v1r = *(const u32x4*)(gv + (size_t)32 * S);
  __syncthreads();
  {
    char* kb_ = lds; char* vb_ = lds + KB;
    *(u32x4*)(kb_ + kw0) = k0r; *(u32x4*)(kb_ + kw1) = k1r; *(u32x4*)(kb_ + rw) = rr;
    *(u32x2*)(vb_ + vlo) = (u32x2){v0r.x, v0r.y}; *(u32x2*)(vb_ + vhi) = (u32x2){v0r.z, v0r.w};
    *(u32x2*)(vb_ + vlo + 32 * 144) = (u32x2){v1r.x, v1r.y}; *(u32x2*)(vb_ + vhi + 32 * 144) = (u32x2){v1r.z, v1r.w};
  }
  __syncthreads();
  for (int kb = 0; kb < nkb_max; ++kb) {
    const int cur = kb & 1;
    const bool more = kb + 1 < nkb_max;
    if (more) {
      const size_t ko = (size_t)(kb + 1) * 64;
      k0r = *(const u32x4*)(gk + ko * 512); k1r = *(const u32x4*)(gk + (ko + 32) * 512); rr = *(const u32x4*)(gr + ko * 32);
      v0r = *(const u32x4*)(gv + ko); v1r = *(const u32x4*)(gv + (size_t)32 * S + ko);
    }
    if (HALF && kb < nkb_w) {
      const char* kt_ = lds + cur * BUF; const char* vt_ = kt_ + KB;
#pragma unroll
      for (int kt = 0; kt < 2; ++kt) {
        __builtin_amdgcn_iglp_opt(0);
        f32x16 sh[QT];
#pragma unroll
        for (int qt = 0; qt < QT; ++qt)
#pragma unroll
          for (int i = 0; i < 16; ++i) sh[qt][i] = 0.f;
#pragma unroll
        for (int ks = 0; ks < 6; ++ks) {
          const bf16x8 kf = *(const bf16x8*)(kt_ + (kt * 32 + r) * 208 + ks * 32 + hh * 16);
#pragma unroll
          for (int qt = 0; qt < QT; ++qt) sh[qt] = MFMA32(kf, qf[qt][ks], sh[qt]);
        }
        bf16x8 ph[QT][2];
#pragma unroll
        for (int qt = 0; qt < QT; ++qt) {
          float mx = sh[qt][0];
#pragma unroll
          for (int i = 1; i < 16; ++i) mx = fmaxf(mx, sh[qt][i]);
          mx = fmaxf(mx, __shfl_xor(mx, 32));
          const bool need = mx > mrun[qt] + 8.f;
          if (__any(need)) {
            const float mnew = need ? mx : mrun[qt];
            const float alpha = __builtin_amdgcn_exp2f(mrun[qt] - mnew);
            mrun[qt] = mnew; lrun[qt] *= alpha;
#pragma unroll
            for (int dt = 0; dt < 2; ++dt)
#pragma unroll
              for (int i = 0; i < 16; ++i) o[dt][qt][i] *= alpha;
          }
          float ls = 0.f;
#pragma unroll
          for (int i = 0; i < 16; ++i) { const float pv = __builtin_amdgcn_exp2f(sh[qt][i] - mrun[qt]); ls += pv; sh[qt][i] = pv; }
          lrun[qt] += ls;
#pragma unroll
          for (int s2 = 0; s2 < 2; ++s2) {
            u32x4 w;
            w.x = pk_bf16(sh[qt][8 * s2 + 0], sh[qt][8 * s2 + 1]); w.y = pk_bf16(sh[qt][8 * s2 + 2], sh[qt][8 * s2 + 3]);
            w.z = pk_bf16(sh[qt][8 * s2 + 4], sh[qt][8 * s2 + 5]); w.w = pk_bf16(sh[qt][8 * s2 + 6], sh[qt][8 * s2 + 7]);
            ph[qt][s2] = __builtin_bit_cast(bf16x8, w);
          }
        }
#pragma unroll
        for (int dt = 0; dt < 2; ++dt)
#pragma unroll
          for (int s2 = 0; s2 < 2; ++s2) {
            const bf16x8 vf = *(const bf16x8*)(vt_ + (dt * 32 + r) * 144 + (kt * 2 + s2) * 32 + hh * 16);
#pragma unroll
            for (int qt = 0; qt < QT; ++qt) o[dt][qt] = MFMA32(vf, ph[qt][s2], o[dt][qt]);
          }
      }
    }
    if (!HALF && kb < nkb_w) {
      const char* kt_ = lds + cur * BUF; const char* vt_ = kt_ + KB;
      f32x16 st[2][QT];
#pragma unroll
      for (int kt = 0; kt < 2; ++kt)
#pragma unroll
        for (int qt = 0; qt < QT; ++qt)
#pragma unroll
          for (int i = 0; i < 16; ++i) st[kt][qt][i] = 0.f;
#pragma unroll
      for (int ks = 0; ks < 6; ++ks)
#pragma unroll
        for (int kt = 0; kt < 2; ++kt) {
          const bf16x8 kf = *(const bf16x8*)(kt_ + (kt * 32 + r) * 208 + ks * 32 + hh * 16);
#pragma unroll
          for (int qt = 0; qt < QT; ++qt) st[kt][qt] = MFMA32(kf, qf[qt][ks], st[kt][qt]);
        }
      bf16x8 pb[2][QT][2];
#pragma unroll
      for (int qt = 0; qt < QT; ++qt) {
        float mx = mrun[qt];
#pragma unroll
        for (int kt = 0; kt < 2; ++kt)
#pragma unroll
          for (int i = 0; i < 16; ++i) mx = fmaxf(mx, st[kt][qt][i]);
        mx = fmaxf(mx, __shfl_xor(mx, 32));
        const float alpha = __builtin_amdgcn_exp2f(mrun[qt] - mx);
        mrun[qt] = mx;
        float ls = 0.f;
#pragma unroll
        for (int kt = 0; kt < 2; ++kt) {
#pragma unroll
          for (int i = 0; i < 16; ++i) { const float pv = __builtin_amdgcn_exp2f(st[kt][qt][i] - mx); ls += pv; st[kt][qt][i] = pv; }
#pragma unroll
          for (int s2 = 0; s2 < 2; ++s2) {
            u32x4 w;
            w.x = pk_bf16(st[kt][qt][8 * s2 + 0], st[kt][qt][8 * s2 + 1]); w.y = pk_bf16(st[kt][qt][8 * s2 + 2], st[kt][qt][8 * s2 + 3]);
            w.z = pk_bf16(st[kt][qt][8 * s2 + 4], st[kt][qt][8 * s2 + 5]); w.w = pk_bf16(st[kt][qt][8 * s2 + 6], st[kt][qt][8 * s2 + 7]);
            pb[kt][qt][s2] = __builtin_bit_cast(bf16x8, w);
          }
        }
        lrun[qt] = lrun[qt] * alpha + ls;
#pragma unroll
        for (int dt = 0; dt < 2; ++dt)
#pragma unroll
          for (int i = 0; i < 16; ++i) o[dt][qt][i] *= alpha;
      }
#pragma unroll
      for (int dt = 0; dt < 2; ++dt)
#pragma unroll
        for (int kt = 0; kt < 2; ++kt)
#pragma unroll
          for (int s2 = 0; s2 < 2; ++s2) {
            const bf16x8 vf = *(const bf16x8*)(vt_ + (dt * 32 + r) * 144 + (kt * 2 + s2) * 32 + hh * 16);
#pragma unroll
            for (int qt = 0; qt < QT; ++qt) o[dt][qt] = MFMA32(vf, pb[kt][qt][s2], o[dt][qt]);
          }
    }
    if (more) {
      char* kb_ = lds + (cur ^ 1) * BUF; char* vb_ = kb_ + KB;
      *(u32x4*)(kb_ + kw0) = k0r; *(u32x4*)(kb_ + kw1) = k1r; *(u32x4*)(kb_ + rw) = rr;
      *(u32x2*)(vb_ + vlo) = (u32x2){v0r.x, v0r.y}; *(u32x2*)(vb_ + vhi) = (u32x2){v0r.z, v0r.w};
      *(u32x2*)(vb_ + vlo + 32 * 144) = (u32x2){v1r.x, v1r.y}; *(u32x2*)(vb_ + vhi + 32 * 144) = (u32x2){v1r.z, v1r.w};
    }
    __syncthreads();
  }
  if (nkb_w > 0) {
    u32x2 wo[2][2][4];
#pragma unroll
    for (int qt = 0; qt < QT; ++qt) {
      const float lt = lrun[qt] + __shfl_xor(lrun[qt], 32);
      const float inv = 1.f / lt;
      const int row = qrow0 + qt * 32 + r;
      float ss = 0.f;
#pragma unroll
      for (int dt = 0; dt < 2; ++dt)
#pragma unroll
        for (int i4 = 0; i4 < 4; ++i4) {
          const float a0 = o[dt][qt][4 * i4] * inv, a1 = o[dt][qt][4 * i4 + 1] * inv, a2 = o[dt][qt][4 * i4 + 2] * inv, a3 = o[dt][qt][4 * i4 + 3] * inv;
          ss += a0 * a0 + a1 * a1 + a2 * a2 + a3 * a3;
          u32x2 w; w.x = pk_bf16(a0, a1); w.y = pk_bf16(a2, a3);
          if (QT == 2) wo[qt][dt][i4] = w;
          else *(u32x2*)(p.mix + (size_t)row * 1024 + h * 64 + dt * 32 + 8 * i4 + 4 * hh) = w;
        }
      ss += __shfl_xor(ss, 32);
      if (hh == 0) p.attn_part[(size_t)row * 8 + h] = ss;
    }
    if (QT == 2) wave_store64(lds + wid * 8192, wo, p.mix + (size_t)qrow0 * 1024 + h * 64, 1024, lane, r, hh);
  }
}

DI void phase4(const Params& p, char* lds, int qidx) {
  const int t = tid(), lane = t & 63, wid = t >> 6;
  const int nb = gridDim.x, bid = blockIdx.x;
  int* nxt = (int*)(lds + 65536);
  for (;;) {
    __syncthreads();
    if (t == 0) *nxt = atomicAdd(p.counters + qidx, 1);
    __syncthreads();
    const int it = *nxt;
    if (it >= 256 + 64 * 32) break;
    if (it < 256) attn_item<1, false>(p, 1, it >> 3, it & 7, 0, lds);
    else { const int j = it - 256; const int qq = 31 - (j >> 6), bh = j & 63; attn_item<2, true>(p, 0, bh >> 3, bh & 7, qq, lds); }
  }
  __syncthreads();
  for (int it = bid * 4 + wid; it < 8 * 128 * 32 + 1024; it += nb * 4) {
    if (it < 8 * 128 * 32) {
      const int g = it & 31, c = (it >> 5) & 127, b = it >> 12;
      const float2 s0 = p.S[(size_t)it * 64 + lane];
      float hr = s0.x, hi = s0.y;
      ssm_chunk(p, b * 8192 + c * 64, g, hr, hi, true, lds + wid * 8704);
      if (c == 127) { p.out[OFF_HRP + (size_t)(b * 32 + g) * 64 + lane] = hr; p.out[OFF_HIP + (size_t)(b * 32 + g) * 64 + lane] = hi; }
    } else {
      const int j = it - 8 * 128 * 32, g = j & 31, b = j >> 5;
      float hr = p.in[4][(size_t)(b * 32 + g) * 64 + lane], hi = p.in[5][(size_t)(b * 32 + g) * 64 + lane];
      ssm_chunk(p, NTP + b * 64, g, hr, hi, true, lds + wid * 8704);
      p.out[OFF_HRS + (size_t)(b * 32 + g) * 64 + lane] = hr; p.out[OFF_HIS + (size_t)(b * 32 + g) * 64 + lane] = hi;
    }
  }
}

DI void phase5(const Params& p, char* lds) {
  {
    auto tile_fn = [&](int j, int& m0, int& n0) -> bool { const int li = (int)(blockIdx.x >> 3) + j * (int)(gridDim.x >> 3); const int ti_ = li / 4, tj_ = li - ti_ * 4; const int tbig = ti_ * 8 + (int)(blockIdx.x & 7); if (tbig >= 528) return false; m0 = tbig * 128; n0 = tj_ * 128; return true; };
    auto rs_fn = [&](int m0, int t) -> float2 { return make_float2(0.f, 0.f); };
    auto epi = [&](f32x16 (&acc)[2][2], int m0, int n0, const float* rs, int fstage) { (void)fstage;
    const int tn = n0 >> 7; (void)tn;
    { EPI_IDS
    u32x2 wq[2][2][4];
#pragma unroll
    for (int mt = 0; mt < 2; ++mt) {
      const int row = m0 + wm * 64 + mt * 32 + r;
      float ss = 0.f;
#pragma unroll
      for (int nt = 0; nt < 2; ++nt)
#pragma unroll
        for (int i4 = 0; i4 < 4; ++i4) {
          const int col = n0 + wn * 64 + nt * 32 + 8 * i4 + 4 * hh;
          const u32x2 yv = *(const u32x2*)(p.ssm_y + (size_t)row * 512 + col);
          const float y0 = __uint_as_float(yv.x << 16), y1 = __uint_as_float(yv.x & 0xffff0000u), y2 = __uint_as_float(yv.y << 16), y3 = __uint_as_float(yv.y & 0xffff0000u);
          const float o0 = y0 / (1.f + __expf(-acc[mt][nt][4 * i4])), o1 = y1 / (1.f + __expf(-acc[mt][nt][4 * i4 + 1]));
          const float o2 = y2 / (1.f + __expf(-acc[mt][nt][4 * i4 + 2])), o3 = y3 / (1.f + __expf(-acc[mt][nt][4 * i4 + 3]));
          ss += o0 * o0 + o1 * o1 + o2 * o2 + o3 * o3;
          wq[mt][nt][i4].x = pk_bf16(o0, o1); wq[mt][nt][i4].y = pk_bf16(o2, o3);
        }
      ss += __shfl_xor(ss, 32);
      if (hh == 0) p.ssm_part[(size_t)row * 8 + tn * 2 + wn] = ss;
    }
    wave_store64(wave_stage(lds, fstage, wid), wq, p.mix + (size_t)(m0 + wm * 64) * 1024 + 512 + n0 + wn * 64, 1024, lane, r, hh);
    }
    __syncthreads();
    };
    gemm_stream(p.ssm_y, 512, p.WgT, 512, 8, lds, 0, tile_fn, rs_fn, epi);
  }
}

DI void phase6(const Params& p, char* lds) {
  const int xb_ = blockIdx.x & 7, xl_ = blockIdx.x >> 3, nbx_ = gridDim.x >> 3;
  {
    auto tile_fn = [&](int j, int& m0, int& n0) -> bool { const int li6 = xl_ + j * nbx_, tm = (li6 >> 3) * 8 + xb_; if (tm >= 528) return false; m0 = tm * 128; n0 = (li6 & 7) * 128; return true; };
    auto rs_fn = [&](int m0, int t) -> float2 {
      const f32x4 a0 = *(const f32x4*)(p.attn_part + (size_t)(m0 + t) * 8), a1 = *(const f32x4*)(p.attn_part + (size_t)(m0 + t) * 8 + 4);
      const float sa = (a0[0] + a0[1]) + (a0[2] + a0[3]) + (a1[0] + a1[1]) + (a1[2] + a1[3]);
      const f32x4 b0 = *(const f32x4*)(p.ssm_part + (size_t)(m0 + t) * 8), b1 = *(const f32x4*)(p.ssm_part + (size_t)(m0 + t) * 8 + 4);
      const float sb = (b0[0] + b0[1]) + (b0[2] + b0[3]) + (b1[0] + b1[1]) + (b1[2] + b1[3]);
      const float ra = rsqrtf(sa * (1.f / 512.f) + EPS), rb = rsqrtf(sb * (1.f / 512.f) + EPS);
      return make_float2(rb, ra / rb); };
    auto epi = [&](f32x16 (&acc)[2][2], int m0, int n0, const float* rs, int fstage) { (void)fstage;
    const int tn = n0 >> 7;
    { EPI_IDS
    u32x2 w[2][2][4];
#pragma unroll
    for (int mt = 0; mt < 2; ++mt) {
      const int rl = wm * 64 + mt * 32 + r, row = m0 + rl;
      const float sc = rs[rl];
      const float* xr = xrow(p, row);
      float ss = 0.f;
#pragma unroll
      for (int nt = 0; nt < 2; ++nt)
#pragma unroll
        for (int i4 = 0; i4 < 4; ++i4) {
          const int col = n0 + wn * 64 + nt * 32 + 8 * i4 + 4 * hh;
          const f32x4 xv = *(const f32x4*)(xr + col);
          f32x4 hv;
#pragma unroll
          for (int jj = 0; jj < 4; ++jj) { hv[jj] = xv[jj] + acc[mt][nt][4 * i4 + jj] * sc; ss += hv[jj] * hv[jj]; }
          w[mt][nt][i4].x = pk_bf16(hv[0], hv[1]); w[mt][nt][i4].y = pk_bf16(hv[2], hv[3]);
          if (i4 == 1 || i4 == 3) __builtin_amdgcn_sched_barrier(0);
        }
      ss += __shfl_xor(ss, 32);
      if (hh == 0) p.h_part[(size_t)row * 16 + tn * 2 + wn] = ss;
    }
    wave_store64(wave_stage(lds, fstage, wid), w, p.hb + (size_t)(m0 + wm * 64) * 1024 + n0 + wn * 64, 1024, lane, r, hh);
    }
    __syncthreads();
    };
    gemm_stream(p.mix, 1024, p.WoT, 1024, 16, lds, 8, tile_fn, rs_fn, epi);
  }
}

DI void phase7(const Params& p, char* lds) {
  float* rs = (float*)(lds + 65536);
  const int xb_ = blockIdx.x & 7, xl_ = blockIdx.x >> 3, nbx_ = gridDim.x >> 3;
  {
    auto tile_fn = [&](int j, int& m0, int& n0) -> bool { const int tm = j * (nbx_ >> 2) + (xl_ >> 2); if (tm >= 528) return false; m0 = tm * 128; n0 = (xb_ * 4 + (xl_ & 3)) * 128; return true; };
    auto rs_fn = [&](int m0, int t) -> float2 { float sm = 0.f; for (int q = 0; q < 4; ++q) { const f32x4 v = *(const f32x4*)(p.h_part + (size_t)(m0 + t) * 16 + 4 * q); sm += (v[0] + v[1]) + (v[2] + v[3]); } return make_float2(rsqrtf(sm * (1.f / 1024.f) + EPS), 0.f); };
    auto epi = [&](f32x16 (&acc)[2][2], int m0, int n0, const float* rs, int fstage) { (void)fstage;
    const int tn = n0 >> 7; (void)tn;
    { EPI_IDS
    char* stg = lds + (wid < 2 ? 0 : 32768) + fstage * 16384 + (wid & 1) * 8192;
#pragma unroll
    for (int mt = 0; mt < 2; ++mt) {
      const int rloc = mt * 32 + r;
      const float sc = rs[wm * 64 + rloc];
#pragma unroll
      for (int nt = 0; nt < 2; ++nt)
#pragma unroll
        for (int i4 = 0; i4 < 4; ++i4) {
          float v[4];
#pragma unroll
          for (int jj = 0; jj < 4; ++jj) { const float a_ = fmaxf(acc[mt][nt][4 * i4 + jj] * sc, 0.f); v[jj] = a_ * a_; }
          u32x2 w; w.x = pk_bf16(v[0], v[1]); w.y = pk_bf16(v[2], v[3]);
          *(u32x2*)(stg + rloc * 128 + (((nt * 4 + i4) ^ (rloc & 7)) << 4) + hh * 8) = w;
        }
    }
    asm volatile("s_waitcnt lgkmcnt(0)" ::: "memory");
    __builtin_amdgcn_wave_barrier();
    bf16_t* gdst = p.act + ((((size_t)(m0 >> 7) * 64 + (n0 >> 6) + wn) * 128 + wm * 64) * 64);
#pragma unroll
    for (int s8 = 0; s8 < 8; ++s8) {
      const int rloc = s8 * 8 + (lane >> 3), c = lane & 7;
      const u32x4 q = *(const u32x4*)(stg + rloc * 128 + ((c ^ (rloc & 7)) << 4));
      *(u32x4*)(gdst + rloc * 64 + c * 8) = q;
    }
    }
    __syncthreads();
    };
    gemm_stream(p.hb, 1024, p.WuT, 1024, 16, lds, 0, tile_fn, rs_fn, epi);
  }
}

DI void phase8(const Params& p, char* lds) {
  const int xb_ = blockIdx.x & 7, xl_ = blockIdx.x >> 3, nbx_ = gridDim.x >> 3;
  {
    auto tile_fn = [&](int j, int& m0, int& n0) -> bool { const int li = (int)(blockIdx.x >> 3) + j * (int)(gridDim.x >> 3); const int ti_ = li / 8, tj_ = li - ti_ * 8; const int tbig = ti_ * 8 + (int)(blockIdx.x & 7); if (tbig >= 528) return false; m0 = tbig * 128; n0 = tj_ * 128; return true; };
    auto rs_fn = [&](int m0, int t) -> float2 { return make_float2(0.f, 0.f); };
    auto epi = [&](f32x16 (&acc)[2][2], int m0, int n0, const float* rs, int fstage) { (void)fstage;
    const int tn = n0 >> 7; (void)tn;
    { EPI_IDS
#pragma unroll
    for (int mt = 0; mt < 2; ++mt) {
      const int row = m0 + wm * 64 + mt * 32 + r;
      float ss = 0.f;
#pragma unroll
      for (int nt = 0; nt < 2; ++nt)
#pragma unroll
        for (int i4 = 0; i4 < 4; ++i4) {
          float* yp = p.out + OFF_Y + (size_t)row * 1024 + n0 + wn * 64 + nt * 32 + 8 * i4 + 4 * hh;
          const u32x2 hq = *(const u32x2*)(p.hb + (size_t)row * 1024 + n0 + wn * 64 + nt * 32 + 8 * i4 + 4 * hh);
          f32x4 ov = {__uint_as_float(hq.x << 16), __uint_as_float(hq.x & 0xffff0000u), __uint_as_float(hq.y << 16), __uint_as_float(hq.y & 0xffff0000u)};
#pragma unroll
          for (int jj = 0; jj < 4; ++jj) { ov[jj] += acc[mt][nt][4 * i4 + jj]; ss += ov[jj] * ov[jj]; }
          *(f32x4*)yp = ov;
          if (i4 == 1 || i4 == 3) __builtin_amdgcn_sched_barrier(0);
        }
      ss += __shfl_xor(ss, 32);
      if (hh == 0) p.out_part[(size_t)row * 16 + tn * 2 + wn] = ss;
    }
    }

    };
    gemm_stream<true>(p.act, 4096, p.WdT, 4096, 64, lds, 0, tile_fn, rs_fn, epi);
  }
}

DI void phase9(const Params& p) {
  const int t = tid(), lane = t & 63, wid = t >> 6;
  for (int row = blockIdx.x * 4 + wid; row < NT; row += gridDim.x * 4) {
    float s = 0.f;
    for (int j = 0; j < 16; ++j) s += p.out_part[(size_t)row * 16 + j];
    const float rstd = rsqrtf(s * (1.f / 1024.f) + EPS);
    float* y = p.out + OFF_Y + (size_t)row * 1024;
#pragma unroll
    for (int j = 0; j < 4; ++j) {
      f32x4 v = *(const f32x4*)(y + lane * 4 + 256 * j);
      const f32x4 g = *(const f32x4*)(p.in[27] + lane * 4 + 256 * j);
      v[0] *= rstd * g[0]; v[1] *= rstd * g[1]; v[2] *= rstd * g[2]; v[3] *= rstd * g[3];
      *(f32x4*)(y + lane * 4 + 256 * j) = v;
    }
  }
}

DI void grid_barrier(unsigned* cnt, unsigned target) {
  asm volatile("s_waitcnt vmcnt(0)" ::: "memory");
  __syncthreads();
  if (tid() == 0) {
    __builtin_amdgcn_fence(__ATOMIC_RELEASE, "agent");
    asm volatile("s_waitcnt vmcnt(0)" ::: "memory");
    __hip_atomic_fetch_add(cnt, 1u, __ATOMIC_RELAXED, __HIP_MEMORY_SCOPE_AGENT);
    while (__hip_atomic_load(cnt, __ATOMIC_RELAXED, __HIP_MEMORY_SCOPE_AGENT) < target) __builtin_amdgcn_s_sleep(2);
  }
  __syncthreads();
  __builtin_amdgcn_fence(__ATOMIC_ACQUIRE, "agent");
  asm volatile("s_waitcnt vmcnt(0)" ::: "memory");
}

#define XB_TMO      128
#define XB_XCNT(j)  (256  + 64 * (j))
#define XB_XSUB(j)  (1280 + 64 * (j))
#define XB_XGEN(j)  (2304 + 64 * (j))
#define XB_TOP      3328
#define XB_TOPGEN   3392
#define XCD_BAR_WORDS 3456
#define XB_SPIN_CAP (1u << 22)
#define LAS __attribute__((address_space(3)))
DI unsigned xb_ld(unsigned* p)              { return __hip_atomic_load(p, __ATOMIC_RELAXED, __HIP_MEMORY_SCOPE_AGENT); }
DI unsigned xb_add(unsigned* p, unsigned v) { return __hip_atomic_fetch_add(p, v, __ATOMIC_RELAXED, __HIP_MEMORY_SCOPE_AGENT); }
DI unsigned xb_xcc_id() { return (unsigned)__builtin_amdgcn_s_getreg((3 << 11) | 20) & 0xFu; }
#define XB_SPIN(cond, bar) do { unsigned _sp = 0; while (cond) { __builtin_amdgcn_s_sleep(1); \
    if ((++_sp & 255u) == 0u) { if (xb_ld(&(bar)[XB_TMO])) break; if (_sp > XB_SPIN_CAP) { atomicAdd(&(bar)[XB_TMO], 1u); break; } } } } while (0)
struct XcdBarrier { unsigned* bar; unsigned x; volatile LAS unsigned* st; };
DI XcdBarrier xcd_barrier_post(unsigned* bar, volatile LAS unsigned* st) {
  XcdBarrier b; b.bar = bar; b.x = xb_xcc_id(); b.st = st;
  if (tid() == 0) (void)xb_add(&bar[XB_XCNT(b.x)], 1u);
  return b;
}
DI void xcd_barrier_complete(unsigned* bar, unsigned x, unsigned& nloc, unsigned& nx) {
  const unsigned G = gridDim.x * gridDim.y * gridDim.z;
  unsigned sum, cnt, mine, sp = 0u;
  for (;;) {
    sum = 0u; cnt = 0u; mine = 0u;
#pragma unroll
    for (unsigned j = 0; j < 16; ++j) { const unsigned c = xb_ld(&bar[XB_XCNT(j)]); sum += c; cnt += (c > 0u) ? 1u : 0u; mine = (j == x) ? c : mine; }
    if (sum == G) break;
    __builtin_amdgcn_s_sleep(1);
    if ((++sp & 255u) == 0u) { if (xb_ld(&bar[XB_TMO])) break; if (sp > XB_SPIN_CAP) { atomicAdd(&bar[XB_TMO], 1u); break; } }
  }
  nloc = mine > 0u ? mine : 1u; nx = cnt > 0u ? cnt : 1u;
}
DI void xcd_barrier(const XcdBarrier& b) {
  asm volatile("s_waitcnt vmcnt(0)" ::: "memory");
  __syncthreads();
  if (tid() == 0) {
    unsigned* bar = b.bar;
    __builtin_amdgcn_s_waitcnt(0);
    unsigned nloc = b.st[0], nx = b.st[1];
    if (nloc == 0u) { xcd_barrier_complete(bar, b.x, nloc, nx); b.st[0] = nloc; b.st[1] = nx; }
    const unsigned old = xb_add(&bar[XB_XSUB(b.x)], 1u);
    const unsigned gen = old / nloc;
    if (old + 1u == (gen + 1u) * nloc) {
      __builtin_amdgcn_fence(__ATOMIC_RELEASE, "agent");
      asm volatile("s_waitcnt vmcnt(0)" ::: "memory");
      const unsigned og = xb_add(&bar[XB_TOP], 1u);
      const unsigned tg = og / nx;
      if (og + 1u == (tg + 1u) * nx) xb_add(&bar[XB_TOPGEN], 1u);
      else XB_SPIN(xb_ld(&bar[XB_TOPGEN]) == tg, bar);
      __builtin_amdgcn_fence(__ATOMIC_ACQUIRE, "agent");
      xb_add(&bar[XB_XGEN(b.x)], 1u);
      asm volatile("s_waitcnt vmcnt(0)" ::: "memory");
    } else {
      XB_SPIN(xb_ld(&bar[XB_XGEN(b.x)]) == gen, bar);
      __builtin_amdgcn_fence(__ATOMIC_ACQUIRE, "agent");
      asm volatile("s_waitcnt vmcnt(0)" ::: "memory");
    }
  }
  __syncthreads();
}

template <bool COOP>
__global__ void __launch_bounds__(256, 2) mega(Params p) {
  __shared__ __attribute__((aligned(16))) char lds[LDS_BYTES];
  XcdBarrier xb{};
  if (COOP) {
    volatile LAS unsigned* st = (volatile LAS unsigned*)(lds + 67584);
    if (tid() == 0) { st[0] = 0u; st[1] = 0u; }
    __syncthreads();
    xb = xcd_barrier_post((unsigned*)p.counters + 64, st);
  }
  for (int ph = p.ph_lo; ph < p.ph_hi; ++ph) {
#ifdef ONLY_PHASE
    if (ph != ONLY_PHASE) continue;
#endif
    switch (ph) {
      case 0: phase0(p, lds); break;
      case 1: phase1(p, lds); break;
      case 2: phase2(p, lds); break;
      case 3: phase3(p, lds); break;
      case 4: phase4(p, lds, 0); break;
      case 5: phase5(p, lds); break;
      case 6: phase6(p, lds); break;
      case 7: phase7(p, lds); break;
      case 8: phase8(p, lds); break;
      default: phase9(p); break;
    }
#ifdef DOUBLE_PHASE
    if (ph == DOUBLE_PHASE) {
      __syncthreads();
      switch (ph) { case 0: phase0(p, lds); break; case 1: phase1(p, lds); break; case 2: phase2(p, lds); break; case 3: phase3(p, lds); break; case 4: phase4(p, lds, 1); break;
                    case 5: phase5(p, lds); break; case 6: phase6(p, lds); break; case 7: phase7(p, lds); break; default: break; }
    }
#endif
    if (COOP) { if (ph + 1 < p.ph_hi) { if (ph == 0) cg::this_grid().sync(); else xcd_barrier(xb); } }
  }
}

static size_t al256(size_t x) { return (x + 255) & ~(size_t)255; }

extern "C" void kernel_launch(void* const* d_in, const int* in_sizes, int n_in, void* d_out, int out_size, void* d_ws, size_t ws_size, hipStream_t stream) {
  Params p{};
  for (int i = 0; i < 28; ++i) p.in[i] = (const float*)d_in[i];
  p.out = (float*)d_out;
  char* base = (char*)d_ws; size_t off = 0;
  auto take = [&](size_t bytes) { char* q = base + off; off = al256(off + bytes); return q; };
  p.WinT = (bf16_t*)take((size_t)1664 * 1024 * 2);
  p.WqT = (bf16_t*)take((size_t)768 * 768 * 2);
  p.WkT = (bf16_t*)take((size_t)512 * 256 * 2);
  p.WvT = (bf16_t*)take((size_t)512 * 256 * 2);
  p.WgT = (bf16_t*)take((size_t)512 * 512 * 2);
  p.WoT = (bf16_t*)take((size_t)1024 * 1024 * 2);
  p.WuT = (bf16_t*)take((size_t)4096 * 1024 * 2);
  p.WdT = (bf16_t*)take((size_t)1024 * 4096 * 2);
  p.BbT = (bf16_t*)take((size_t)32 * 128 * 16 * 2);
  p.CcT = (bf16_t*)take((size_t)32 * 16 * 128 * 2);
  p.lam = (float2*)take(2048 * 8);
  p.lam64 = (float2*)take(2048 * 8);
  p.rope = (float2*)take((size_t)8192 * 16 * 8);
  p.rstd_x = (float*)take((size_t)NT * 4);
  p.cq_part = (float*)take((size_t)NT * 12 * 4);
  p.ckv_part = (float*)take((size_t)NT * 4 * 4);
  p.attn_part = (float*)take((size_t)NT * 8 * 4);
  p.ssm_part = (float*)take((size_t)NT * 8 * 4);
  p.h_part = (float*)take((size_t)NT * 16 * 4);
  p.out_part = (float*)take((size_t)NT * 16 * 4);
  p.counters = (int*)take(16384);
  p.E = (float2*)take((size_t)8 * 128 * 32 * 64 * 8);
  p.S = (float2*)take((size_t)8 * 128 * 32 * 64 * 8);
  const size_t a0 = off;
  p.Kn = (bf16_t*)take((size_t)NK * 512 * 2);
  const size_t aVt = off;
  p.Vt = (bf16_t*)take((size_t)NK * 512 * 2);
  p.Q = (bf16_t*)take((size_t)NT * 768 * 2);
  p.latb = (bf16_t*)take((size_t)NK * 256 * 2);
  p.krb = (bf16_t*)take((size_t)NK * 32 * 2);
  p.ub = (bf16_t*)take((size_t)NT * 512 * 2);
  const size_t aSsmY = off;
  p.ssm_y = (bf16_t*)take((size_t)NT * 512 * 2);
  p.mix = (bf16_t*)take((size_t)NT * 1024 * 2);
  const size_t total = off;
  p.xb = (bf16_t*)(base + a0);
  p.cq = (bf16_t*)(base + aVt);
  p.ckv_raw = (float*)(base + aVt + al256((size_t)NT * 768 * 2));
  p.act = (bf16_t*)(base + a0);
  const size_t aHb = a0 + al256((size_t)NT * 4096 * 2);
  p.hb = (bf16_t*)(base + aHb);
  if (aHb + (size_t)NT * 1024 * 2 > aSsmY || total > ws_size) { fprintf(stderr, "workspace layout error: total %zu ws %zu\n", total, ws_size); return; }

  const int MULTI = 0;
  hipMemsetAsync(p.counters, 0, 16384, stream);
  if (MULTI) {
    for (int ph = 0; ph < NPHASE; ++ph) {
      p.ph_lo = ph; p.ph_hi = ph + 1;
      hipLaunchKernelGGL(mega<false>, dim3(512), dim3(256), 0, stream, p);
    }
  } else {
    static int grid_blocks = 0;
    if (!grid_blocks) {
      int dev = 0, cus = 0, per_cu = 0;
      hipGetDevice(&dev);
      hipDeviceGetAttribute(&cus, hipDeviceAttributeMultiprocessorCount, dev);
      hipOccupancyMaxActiveBlocksPerMultiprocessor(&per_cu, mega<true>, 256, 0);
      grid_blocks = cus * per_cu;
    }
    p.ph_lo = 0; p.ph_hi = NPHASE;
    void* args[] = {&p};
    hipError_t e = hipLaunchCooperativeKernel((void*)mega<true>, dim3(grid_blocks), dim3(256), args, 0, stream);
    if (e != hipSuccess) fprintf(stderr, "cooperative launch failed: %s (grid %d)\n", hipGetErrorString(e), grid_blocks);
  }
}
```

```cpp
#include <hip/hip_runtime.h>
#include <hip/hip_cooperative_groups.h>
#include <stdint.h>
#include <cstdio>
namespace cg = cooperative_groups;
#define DI __device__ __forceinline__

typedef unsigned short bf16_t;
typedef short bf16x8 __attribute__((ext_vector_type(8)));
typedef float f32x16 __attribute__((ext_vector_type(16)));
typedef float f32x4 __attribute__((ext_vector_type(4)));
typedef unsigned u32x4 __attribute__((ext_vector_type(4)));
typedef unsigned u32x2 __attribute__((ext_vector_type(2)));

constexpr int NTP = 65536, NTS = 2048, NT = NTP + NTS, NK = NTP + 32 * 4160;
constexpr int SKS = 4160;
constexpr size_t OFF_Y = 0;
constexpr size_t OFF_LATP = (size_t)NT * 1024;
constexpr size_t OFF_KRP = OFF_LATP + (size_t)NTP * 256;
constexpr size_t OFF_HRP = OFF_KRP + (size_t)NTP * 32;
constexpr size_t OFF_HIP = OFF_HRP + 8 * 32 * 64;
constexpr size_t OFF_LATS = OFF_HIP + 8 * 32 * 64;
constexpr size_t OFF_KRS = OFF_LATS + (size_t)NTS * 256;
constexpr size_t OFF_HRS = OFF_KRS + (size_t)NTS * 32;
constexpr size_t OFF_HIS = OFF_HRS + 32 * 32 * 64;
constexpr size_t VT_S_OFF = (size_t)8 * 512 * 8192;
constexpr float EPS = 1e-6f;
constexpr int LDS_BYTES = 67600;
constexpr int NPHASE = 10;
constexpr int AQT = 1, NQQ = 128 / (4 / (64 / (32 * AQT)));

struct Params {
  const float* in[28];
  float* out;
  bf16_t *WinT, *WqT, *WkT, *WvT, *WgT, *WoT, *WuT, *WdT, *BbT, *CcT;
  float2 *lam, *lam64, *rope;
  float *rstd_x, *cq_part, *ckv_part, *attn_part, *ssm_part, *h_part, *out_part;
  int* counters;
  float2 *E, *S;
  bf16_t *Kn, *Vt, *Q, *latb, *krb, *ub, *ssm_y, *mix, *xb, *cq, *hb, *act;
  float* ckv_raw;
  int ph_lo, ph_hi;
};

DI int tid() { int t = __builtin_amdgcn_workitem_id_x(); asm volatile("" : "+v"(t)); return t; }
typedef __bf16 nbf16x2 __attribute__((ext_vector_type(2)));
typedef float f32x2 __attribute__((ext_vector_type(2)));
DI unsigned pk_bf16(float lo, float hi) { f32x2 v = {lo, hi}; return __builtin_bit_cast(unsigned, __builtin_convertvector(v, nbf16x2)); }
DI bf16_t f2bf(float x) { return (bf16_t)(pk_bf16(x, 0.f) & 0xffffu); }
DI float bf2f(bf16_t v) { return __uint_as_float(((unsigned)v) << 16); }
DI int crow(int i, int hh) { return (i & 3) + 8 * (i >> 2) + 4 * hh; }
DI const float* xrow(const Params& p, int row) { return row < NTP ? p.in[0] + (size_t)row * 1024 : p.in[1] + (size_t)(row - NTP) * 1024; }
DI int pos_of(int row) { return row < NTP ? (row & 8191) : 4096 + ((row - NTP) & 63); }
DI int kr_of(int row) { return row < NTP ? row : NTP + ((row - NTP) >> 6) * SKS + 4096 + ((row - NTP) & 63); }
#define MFMA32(a, b, c) __builtin_amdgcn_mfma_f32_32x32x16_bf16((a), (b), (c), 0, 0, 0)
#define MFMA16(a, b, c) __builtin_amdgcn_mfma_f32_16x16x32_bf16((a), (b), (c), 0, 0, 0)

DI void sincos_d(double x, double& s4, double& c4) {
  double k = rint(x * 0.15915494309189535);
  double rr = fma(-k, 6.283185307179586, x);
  rr = fma(-k, 2.4492935982947064e-16, rr);
  double y = rr * 0.25, y2 = y * y;
  double s = y * (1 - y2 / 6 * (1 - y2 / 20 * (1 - y2 / 42 * (1 - y2 / 72 * (1 - y2 / 110 * (1 - y2 / 156 * (1 - y2 / 210)))))));
  double c = 1 - y2 / 2 * (1 - y2 / 12 * (1 - y2 / 30 * (1 - y2 / 56 * (1 - y2 / 90 * (1 - y2 / 132 * (1 - y2 / 182))))));
  double s2 = 2 * s * c, c2 = 1 - 2 * s * s;
  s4 = 2 * s2 * c2; c4 = 1 - 2 * s2 * s2;
}

DI void gemm_core(const bf16_t* __restrict__ A, int lda, const bf16_t* __restrict__ B, int ldb, int nk,
                  int m0, int n0, char* lds, f32x16 (&acc)[2][2], int midk, const float* ratio) {
  const int t = tid(), lane = t & 63, wid = t >> 6, wm = wid >> 1, wn = wid & 1;
  const int r = lane & 31, hh = lane >> 5;
  const int lc = t & 7, lr = t >> 3;
  const unsigned woff = lr * 128 + ((lc ^ ((lr >> 1) & 7)) << 4);
  const bf16_t* ga = A + (size_t)(m0 + lr) * lda + lc * 8;
  const bf16_t* gb = B + (size_t)(n0 + lr) * ldb + lc * 8;
  char* sA = lds; char* sB = lds + 32768;
  u32x4 ra[4], rb[4];
#pragma unroll
  for (int i = 0; i < 4; ++i) { ra[i] = *(const u32x4*)(ga + (size_t)(32 * i) * lda); rb[i] = *(const u32x4*)(gb + (size_t)(32 * i) * ldb); }
#pragma unroll
  for (int i = 0; i < 4; ++i) { *(u32x4*)(sA + woff + i * 4096) = ra[i]; *(u32x4*)(sB + woff + i * 4096) = rb[i]; }
#pragma unroll
  for (int a = 0; a < 2; ++a)
#pragma unroll
    for (int b = 0; b < 2; ++b)
#pragma unroll
      for (int i = 0; i < 16; ++i) acc[a][b][i] = 0.f;
  __syncthreads();
  const int rsw = (r >> 1) & 7;
  const unsigned aoff = (wm * 64 + r) * 128, boff = (wn * 64 + r) * 128;
  for (int kt = 0; kt < nk; ++kt) {
    const int cur = kt & 1;
    const bool more = (kt + 1 < nk);
    if (more) {
      const bf16_t* ga2 = ga + (kt + 1) * 64; const bf16_t* gb2 = gb + (kt + 1) * 64;
#pragma unroll
      for (int i = 0; i < 4; ++i) { ra[i] = *(const u32x4*)(ga2 + (size_t)(32 * i) * lda); rb[i] = *(const u32x4*)(gb2 + (size_t)(32 * i) * ldb); }
    }
    if (midk && kt == midk) {
#pragma unroll
      for (int mt = 0; mt < 2; ++mt)
      { const float f = ratio[wm * 64 + mt * 32 + r];
#pragma unroll
        for (int i = 0; i < 16; ++i) { acc[mt][0][i] *= f; acc[mt][1][i] *= f; } }
    }
    const char* cA = sA + cur * 16384; const char* cB = sB + cur * 16384;
#pragma unroll
    for (int ks = 0; ks < 4; ++ks) {
      const unsigned co = (((ks * 2 + hh) ^ rsw) << 4);
      const bf16x8 a0 = *(const bf16x8*)(cA + aoff + co), a1 = *(const bf16x8*)(cA + aoff + 4096 + co);
      const bf16x8 b0 = *(const bf16x8*)(cB + boff + co), b1 = *(const bf16x8*)(cB + boff + 4096 + co);
      acc[0][0] = MFMA32(b0, a0, acc[0][0]); acc[0][1] = MFMA32(b1, a0, acc[0][1]);
      acc[1][0] = MFMA32(b0, a1, acc[1][0]); acc[1][1] = MFMA32(b1, a1, acc[1][1]);
    }
    if (more) {
      char* nA = sA + (cur ^ 1) * 16384; char* nB = sB + (cur ^ 1) * 16384;
#pragma unroll
      for (int i = 0; i < 4; ++i) { *(u32x4*)(nA + woff + i * 4096) = ra[i]; *(u32x4*)(nB + woff + i * 4096) = rb[i]; }
    }
    __syncthreads();
  }
}

DI void rowscale_load(float* rs, const float* src, int np, float inv_dim, int m0) {
  const int t = tid();
  if (t < 128) {
    const int row = m0 + t;
    if (np == 0) rs[t] = src[row];
    else { float s = 0.f; for (int j = 0; j < np; ++j) s += src[(size_t)row * np + j]; rs[t] = rsqrtf(s * inv_dim + EPS); }
  }
}

template <bool BLKA = false, class TileFn, class RsFn, class EpiFn>
DI void gemm_stream(const bf16_t* __restrict__ A, int lda, const bf16_t* __restrict__ B, int ldb, int nk, char* lds, int midk,
                    TileFn tile_fn, RsFn rs_fn, EpiFn epi) {
  int m0, n0;
  if (!tile_fn(0, m0, n0)) return;
  const int t = tid(), lane = t & 63, wid = t >> 6, wm = wid >> 1, wn = wid & 1;
  const int r = lane & 31, hh = lane >> 5;
  const int lc = t & 7, lr = t >> 3;
  const unsigned woff = lr * 128 + ((lc ^ ((lr >> 1) & 7)) << 4);
  char* sA = lds; char* sB = lds + 32768;
  float* rsbuf = (float*)(lds + 65536);
  const int rsw = (r >> 1) & 7;
  const unsigned aoff = (wm * 64 + r) * 128, boff = (wn * 64 + r) * 128;
  int lj = 0, lkt = 0, lm0 = m0, ln0 = n0; bool lvalid = true;
  u32x4 ra0[4], rb0[4], ra1[4], rb1[4];
#define GS_LOAD(RA, RB) do {   \
        \
      const bf16_t* ga_ = BLKA ? A + ((size_t)(lm0 >> 7) * nk + lkt) * 8192 + lr * 64 + lc * 8 : A + (size_t)(lm0 + lr) * lda + lc * 8 + lkt * 64; const bf16_t* gb_ = B + (size_t)(ln0 + lr) * ldb + lc * 8 + lkt * 64; \
      _Pragma("unroll") for (int i = 0; i < 4; ++i) { RA[i] = *(const u32x4*)(ga_ + (size_t)(32 * i) * (BLKA ? 64 : lda)); RB[i] = *(const u32x4*)(gb_ + (size_t)(32 * i) * ldb); } \
      if (++lkt == nk) { lkt = 0; if (lvalid) { ++lj; lvalid = tile_fn(lj, lm0, ln0); } } } while (0)
  GS_LOAD(ra0, rb0);
  GS_LOAD(ra1, rb1);
  {
    float2 rv = make_float2(0.f, 0.f);
    if (t < 128) rv = rs_fn(m0, t);
    __syncthreads();
#pragma unroll
    for (int i = 0; i < 4; ++i) { *(u32x4*)(sA + woff + i * 4096) = ra0[i]; *(u32x4*)(sB + woff + i * 4096) = rb0[i]; }
    if (t < 128) { rsbuf[t] = rv.x; rsbuf[128 + t] = rv.y; }
    __syncthreads();
  }
  int cur = 0;
  for (int j = 0;; ++j) {
    int m1 = 0, n1 = 0;
    const bool has_next = tile_fn(j + 1, m1, n1);
    const float* rs = rsbuf + (j & 1) * 256;
    f32x16 acc[2][2];
#pragma unroll
    for (int a = 0; a < 2; ++a)
#pragma unroll
      for (int b = 0; b < 2; ++b)
#pragma unroll
        for (int i = 0; i < 16; ++i) acc[a][b][i] = 0.f;
#define GS_STEP(RL_A, RL_B, RW_A, RW_B, KT) do { \
      const bool last_ = ((KT) + 1 == nk); const bool wr_ = !last_ || has_next; \
      float2 rv_ = make_float2(0.f, 0.f); \
      if (last_ && has_next) { if (t < 128) rv_ = rs_fn(m1, t); asm volatile("" : "+v"(rv_.x), "+v"(rv_.y)); }   \
      GS_LOAD(RL_A, RL_B); \
      if (midk && (KT) == midk) { _Pragma("unroll") for (int mt = 0; mt < 2; ++mt) { const float f = rs[128 + wm * 64 + mt * 32 + r]; \
          _Pragma("unroll") for (int i = 0; i < 16; ++i) { acc[mt][0][i] *= f; acc[mt][1][i] *= f; } } } \
      const char* cA = sA + cur * 16384; const char* cB = sB + cur * 16384; \
      __builtin_amdgcn_iglp_opt(0); \
      _Pragma("unroll") for (int ks = 0; ks < 4; ++ks) { \
        const unsigned co = (((ks * 2 + hh) ^ rsw) << 4); \
        const bf16x8 a0 = *(const bf16x8*)(cA + aoff + co), a1 = *(const bf16x8*)(cA + aoff + 4096 + co); \
        const bf16x8 b0 = *(const bf16x8*)(cB + boff + co), b1 = *(const bf16x8*)(cB + boff + 4096 + co); \
        acc[0][0] = MFMA32(b0, a0, acc[0][0]); acc[0][1] = MFMA32(b1, a0, acc[0][1]); \
        acc[1][0] = MFMA32(b0, a1, acc[1][0]); acc[1][1] = MFMA32(b1, a1, acc[1][1]); } \
      if (wr_) { char* nA = sA + (cur ^ 1) * 16384; char* nB = sB + (cur ^ 1) * 16384; \
        _Pragma("unroll") for (int i = 0; i < 4; ++i) { *(u32x4*)(nA + woff + i * 4096) = RW_A[i]; *(u32x4*)(nB + woff + i * 4096) = RW_B[i]; } \
        if (last_ && t < 128) { float* rn = rsbuf + ((j + 1) & 1) * 256; rn[t] = rv_.x; rn[128 + t] = rv_.y; } } \
      __syncthreads(); cur ^= 1; } while (0)
    for (int kt = 0; kt < nk; kt += 2) {
      GS_STEP(ra0, rb0, ra1, rb1, kt);
      GS_STEP(ra1, rb1, ra0, rb0, kt + 1);
    }
    epi(acc, m0, n0, rs, cur ^ 1);
    if (!has_next) break;
    m0 = m1; n0 = n1;
  }
#undef GS_STEP
#undef GS_LOAD
  __syncthreads();
}

DI float half_reduce(float s) {
  s += __shfl_xor(s, 1); s += __shfl_xor(s, 2); s += __shfl_xor(s, 4); s += __shfl_xor(s, 8); s += __shfl_xor(s, 16); return s;
}

#define EPI_IDS int t = tid(); asm volatile("" : "+v"(t)); const int lane = t & 63, wid = t >> 6, wm = wid >> 1, wn = wid & 1, r = lane & 31, hh = lane >> 5; (void)lane; (void)wid; (void)wm; (void)wn; (void)r; (void)hh;
#define GEMM_IDS const int t = tid(), lane = t & 63, wid = t >> 6, wm = wid >> 1, wn = wid & 1, r = lane & 31, hh = lane >> 5; (void)t; (void)wm; (void)wn; (void)r; (void)hh;

DI char* wave_stage(char* lds, int fstage, int wid) { return lds + (wid < 2 ? 0 : 32768) + fstage * 16384 + (wid & 1) * 8192; }
DI void wave_store64(char* stg, const u32x2 (&w)[2][2][4], bf16_t* gdst, size_t row_stride, int lane, int r, int hh) {
#pragma unroll
  for (int mt = 0; mt < 2; ++mt)
#pragma unroll
    for (int nt = 0; nt < 2; ++nt)
#pragma unroll
      for (int i4 = 0; i4 < 4; ++i4) { const int rloc = mt * 32 + r; *(u32x2*)(stg + rloc * 128 + (((nt * 4 + i4) ^ (rloc & 7)) << 4) + hh * 8) = w[mt][nt][i4]; }
  asm volatile("s_waitcnt lgkmcnt(0)" ::: "memory");
  __builtin_amdgcn_wave_barrier();
#pragma unroll
  for (int s8 = 0; s8 < 8; ++s8) {
    const int rloc = s8 * 8 + (lane >> 3), c = lane & 7;
    const u32x4 q = *(const u32x4*)(stg + rloc * 128 + ((c ^ (rloc & 7)) << 4));
    *(u32x4*)(gdst + (size_t)rloc * row_stride + c * 8) = q;
  }
}

DI void wave_load64(char* stg, u32x2 (&w)[2][2][4], const bf16_t* gsrc, size_t row_stride, int lane, int r, int hh) {
  u32x4 q[8];
#pragma unroll
  for (int s8 = 0; s8 < 8; ++s8) { const int rloc = s8 * 8 + (lane >> 3), c = lane & 7; q[s8] = *(const u32x4*)(gsrc + (size_t)rloc * row_stride + c * 8); }
#pragma unroll
  for (int s8 = 0; s8 < 8; ++s8) { const int rloc = s8 * 8 + (lane >> 3), c = lane & 7; *(u32x4*)(stg + rloc * 128 + ((c ^ (rloc & 7)) << 4)) = q[s8]; }
  asm volatile("s_waitcnt lgkmcnt(0)" ::: "memory");
  __builtin_amdgcn_wave_barrier();
#pragma unroll
  for (int mt = 0; mt < 2; ++mt)
#pragma unroll
    for (int nt = 0; nt < 2; ++nt)
#pragma unroll
      for (int i4 = 0; i4 < 4; ++i4) { const int rloc = mt * 32 + r; w[mt][nt][i4] = *(const u32x2*)(stg + rloc * 128 + (((nt * 4 + i4) ^ (rloc & 7)) << 4) + hh * 8); }
  asm volatile("s_waitcnt lgkmcnt(0)" ::: "memory");
  __builtin_amdgcn_wave_barrier();
}
DI void wave_add64_f32(char* stg, f32x16 (&a)[2][2], const float* gsrc, size_t row_stride, int lane, int r, int hh) {
#pragma unroll
  for (int mt = 0; mt < 2; ++mt) {
    f32x4 q[8];
#pragma unroll
    for (int s8 = 0; s8 < 8; ++s8) { const int row = s8 * 4 + (lane >> 4), c = lane & 15; q[s8] = *(const f32x4*)(gsrc + (size_t)(mt * 32 + row) * row_stride + c * 4); }
#pragma unroll
    for (int s8 = 0; s8 < 8; ++s8) { const int row = s8 * 4 + (lane >> 4), c = lane & 15; *(f32x4*)(stg + row * 256 + ((c ^ (row & 15)) << 4)) = q[s8]; }
    asm volatile("s_waitcnt lgkmcnt(0)" ::: "memory");
    __builtin_amdgcn_wave_barrier();
#pragma unroll
    for (int nt = 0; nt < 2; ++nt)
#pragma unroll
      for (int i4 = 0; i4 < 4; ++i4) {
        const f32x4 xv = *(const f32x4*)(stg + r * 256 + (((nt * 8 + 2 * i4 + hh) ^ (r & 15)) << 4));
#pragma unroll
        for (int jj = 0; jj < 4; ++jj) a[mt][nt][4 * i4 + jj] += xv[jj];
      }
    asm volatile("s_waitcnt lgkmcnt(0)" ::: "memory");
    __builtin_amdgcn_wave_barrier();
  }
}
DI void wave_store64_f32(char* stg, const f32x16 (&a)[2][2], float* gdst, size_t row_stride, int lane, int r, int hh) {
#pragma unroll
  for (int mt = 0; mt < 2; ++mt) {
#pragma unroll
    for (int nt = 0; nt < 2; ++nt)
#pragma unroll
      for (int i4 = 0; i4 < 4; ++i4) {
        const f32x4 v = {a[mt][nt][4 * i4], a[mt][nt][4 * i4 + 1], a[mt][nt][4 * i4 + 2], a[mt][nt][4 * i4 + 3]};
        *(f32x4*)(stg + r * 256 + (((nt * 8 + 2 * i4 + hh) ^ (r & 15)) << 4)) = v;
      }
    asm volatile("s_waitcnt lgkmcnt(0)" ::: "memory");
    __builtin_amdgcn_wave_barrier();
#pragma unroll
    for (int s8 = 0; s8 < 8; ++s8) {
      const int row = s8 * 4 + (lane >> 4), c = lane & 15;
      const f32x4 q = *(const f32x4*)(stg + row * 256 + ((c ^ (row & 15)) << 4));
      *(f32x4*)(gdst + (size_t)(mt * 32 + row) * row_stride + c * 4) = q;
    }
    asm volatile("s_waitcnt lgkmcnt(0)" ::: "memory");
    __builtin_amdgcn_wave_barrier();
  }
}

DI void transpose_tile(const float* __restrict__ src, int ld, int K, int kt, int nt, int job, const float* g0, const float* g1, bf16_t* __restrict__ dst, char* lds) {
  bf16_t* tile = (bf16_t*)lds;
  const int t = tid(), nl = t & 63, kq = t >> 6;
  const int n = nt * 64 + nl;
  int c = n;
  if (job == 0) { c = n < 1024 ? n : (n < 1536 ? 1056 + (n - 1024) : (n < 1568 ? 1024 + (n - 1536) : -1)); }
  else if (job == 2) c = (n >> 6) * 128 + (n & 63);
  else if (job == 3) c = (n >> 6) * 128 + 64 + (n & 63);
#pragma unroll 4
  for (int pass = 0; pass < 16; ++pass) {
    const int kl = pass * 4 + kq, k = kt * 64 + kl;
    float v = 0.f;
    if (c >= 0) {
      v = src[(size_t)k * ld + c];
      if (g0) { const float g = (g1 && k >= 512) ? g1[k - 512] : g0[k]; v *= g; }
    }
    tile[nl * 66 + kl] = f2bf(v);
  }
  __syncthreads();
  const int kl = t & 63;
#pragma unroll 4
  for (int pass = 0; pass < 16; ++pass) { const int nl2 = pass * 4 + kq; dst[(size_t)(nt * 64 + nl2) * K + kt * 64 + kl] = tile[nl2 * 66 + kl]; }
  __syncthreads();
}

DI void phase0(const Params& p, char* lds) {
  const int t = tid(), nb = gridDim.x, bid = blockIdx.x, lane = t & 63, wid = t >> 6;
  for (int ti = bid; ti < 2992; ti += nb) {
    int job, base, nNt, ld, K; const float* src; const float* g0 = nullptr; const float* g1 = nullptr; bf16_t* dst;
    if (ti < 416) { job = 0; base = 0; nNt = 26; ld = 1568; K = 1024; src = p.in[7]; g0 = p.in[6]; dst = p.WinT; }
    else if (ti < 560) { job = 1; base = 416; nNt = 12; ld = 768; K = 768; src = p.in[9]; g0 = p.in[8]; dst = p.WqT; }
    else if (ti < 592) { job = 2; base = 560; nNt = 8; ld = 1024; K = 256; src = p.in[11]; dst = p.WkT; }
    else if (ti < 624) { job = 3; base = 592; nNt = 8; ld = 1024; K = 256; src = p.in[11]; dst = p.WvT; }
    else if (ti < 688) { job = 4; base = 624; nNt = 8; ld = 512; K = 512; src = p.in[20]; dst = p.WgT; }
    else if (ti < 944) { job = 5; base = 688; nNt = 16; ld = 1024; K = 1024; src = p.in[23]; g0 = p.in[21]; g1 = p.in[22]; dst = p.WoT; }
    else if (ti < 1968) { job = 6; base = 944; nNt = 64; ld = 4096; K = 1024; src = p.in[25]; g0 = p.in[24]; dst = p.WuT; }
    else { job = 7; base = 1968; nNt = 16; ld = 1024; K = 4096; src = p.in[26]; dst = p.WdT; }
    const int tile = ti - base;
    transpose_tile(src, ld, K, tile / nNt, tile % nNt, job, g0, g1, dst, lds);
  }
  for (int row = bid * 4 + wid; row < NT; row += nb * 4) {
    const float* x = xrow(p, row);
    f32x4 v[4]; float ss = 0.f;
#pragma unroll
    for (int j = 0; j < 4; ++j) { v[j] = *(const f32x4*)(x + lane * 4 + 256 * j); ss += v[j][0] * v[j][0] + v[j][1] * v[j][1] + v[j][2] * v[j][2] + v[j][3] * v[j][3]; }
    ss += __shfl_xor(ss, 32); ss = half_reduce(ss);
#pragma unroll
    for (int j = 0; j < 4; ++j) { u32x2 w; w.x = pk_bf16(v[j][0], v[j][1]); w.y = pk_bf16(v[j][2], v[j][3]); *(u32x2*)(p.xb + (size_t)row * 1024 + lane * 4 + 256 * j) = w; }
    if (lane == 0) p.rstd_x[row] = rsqrtf(ss * (1.f / 1024.f) + EPS);
  }
  const int gt = bid * 256 + t, ngt = nb * 256;
  for (int v = gt; v < 32 * 4096 * 32; v += ngt) {
    const size_t e0 = (size_t)v * 8; const int b = (int)(e0 >> 20), rem = (int)(e0 & 1048575), tt = rem >> 8, c = rem & 255;
    const f32x4 a = *(const f32x4*)(p.in[2] + e0), bq = *(const f32x4*)(p.in[2] + e0 + 4);
    u32x4 w; w.x = pk_bf16(a[0], a[1]); w.y = pk_bf16(a[2], a[3]); w.z = pk_bf16(bq[0], bq[1]); w.w = pk_bf16(bq[2], bq[3]);
    *(u32x4*)(p.latb + (size_t)(NTP + b * SKS + tt) * 256 + c) = w;
  }
  for (int v = gt; v < 32 * 4096 * 4; v += ngt) {
    const size_t e0 = (size_t)v * 8; const int b = (int)(e0 >> 17), rem = (int)(e0 & 131071), tt = rem >> 5, c = rem & 31;
    const f32x4 a = *(const f32x4*)(p.in[3] + e0), bq = *(const f32x4*)(p.in[3] + e0 + 4);
    u32x4 w; w.x = pk_bf16(a[0], a[1]); w.y = pk_bf16(a[2], a[3]); w.z = pk_bf16(bq[0], bq[1]); w.w = pk_bf16(bq[2], bq[3]);
    *(u32x4*)(p.krb + (size_t)(NTP + b * SKS + tt) * 32 + c) = w;
  }
  if (gt < 2048) {
    const int g = gt >> 6, n = gt & 63;
    const double dt = (double)expf(p.in[14][g]);
    const double lr = p.in[12][gt], li = p.in[13][gt];
    const double mag = (double)expf((float)(lr * dt)); double s, c; sincos_d(li * dt, s, c);
    const double lbr = mag * c, lbi = mag * s;
    const double nr = lbr - 1.0, ni = lbi, den = lr * lr + li * li;
    const double cr = (nr * lr + ni * li) / den, ci = (ni * lr - nr * li) / den;
    p.lam[gt] = make_float2((float)lbr, (float)lbi);
    const double mag64 = (double)expf((float)(64.0 * lr * dt)); sincos_d(64.0 * li * dt, s, c);
    p.lam64[gt] = make_float2((float)(mag64 * c), (float)(mag64 * s));
    for (int q = 0; q < 16; ++q) {
      const double br = p.in[15][(size_t)gt * 16 + q], bi = p.in[16][(size_t)gt * 16 + q];
      p.BbT[(size_t)(g * 128 + n) * 16 + q] = f2bf((float)(cr * br - ci * bi));
      p.BbT[(size_t)(g * 128 + 64 + n) * 16 + q] = f2bf((float)(cr * bi + ci * br));
      p.CcT[(size_t)(g * 16 + q) * 128 + n] = f2bf(p.in[17][(size_t)(g * 16 + q) * 64 + n]);
      p.CcT[(size_t)(g * 16 + q) * 128 + 64 + n] = f2bf(-p.in[18][(size_t)(g * 16 + q) * 64 + n]);
    }
  }
  for (int e = gt; e < 8192 * 16; e += ngt) {
    const int pos = e >> 4, i = e & 15;
    const float inv = expf(-(float)i * (9.210340371976184f / 16.0f));
    const float ang = (float)pos * inv;
    double s, c; sincos_d((double)ang, s, c);
    p.rope[e] = make_float2((float)c, (float)s);
  }
}

DI void phase1(const Params& p, char* lds) {
  float* rs = (float*)(lds + 65536);
  const int ntiles = 528 * 13;
  {
    auto tile_fn = [&](int j, int& m0, int& n0) -> bool { const int li = (int)(blockIdx.x >> 3) + j * (int)(gridDim.x >> 3); const int ti_ = li / 13, tj_ = li - ti_ * 13; const int tbig = ti_ * 8 + (int)(blockIdx.x & 7); if (tbig >= 528) return false; m0 = tbig * 128; n0 = tj_ * 128; return true; };
    auto rs_fn = [&](int m0, int t) -> float2 { return make_float2(p.rstd_x[m0 + t], 0.f); };
    auto epi = [&](f32x16 (&acc)[2][2], int m0, int n0, const float* rs, int fstage) { (void)fstage;
    const int tn = n0 >> 7; (void)tn;
    { EPI_IDS
    u32x2 wq[2][2][4];
    if (tn < 8) {
#pragma unroll
      for (int mt = 0; mt < 2; ++mt) {
        const int rl = wm * 64 + mt * 32 + r, row = m0 + rl;
        const float sc = rs[rl];
        float ss = 0.f;
#pragma unroll
        for (int nt = 0; nt < 2; ++nt)
#pragma unroll
          for (int i4 = 0; i4 < 4; ++i4) {
            const float v0 = acc[mt][nt][4 * i4] * sc, v1 = acc[mt][nt][4 * i4 + 1] * sc, v2 = acc[mt][nt][4 * i4 + 2] * sc, v3 = acc[mt][nt][4 * i4 + 3] * sc;
            ss += v0 * v0 + v1 * v1 + v2 * v2 + v3 * v3;
            const int col = n0 + wn * 64 + nt * 32 + 8 * i4 + 4 * hh;
            if (tn < 6) { wq[mt][nt][i4].x = pk_bf16(v0, v1); wq[mt][nt][i4].y = pk_bf16(v2, v3); }
            else { f32x4 w = {v0, v1, v2, v3}; *(f32x4*)(p.ckv_raw + (size_t)row * 256 + (col - 768)) = w; }
          }
        ss += __shfl_xor(ss, 32);
        if (hh == 0) { if (tn < 6) p.cq_part[(size_t)row * 12 + tn * 2 + wn] = ss; else p.ckv_part[(size_t)row * 4 + (tn - 6) * 2 + wn] = ss; }
      }
      if (tn < 6) wave_store64(wave_stage(lds, fstage, wid), wq, p.cq + (size_t)(m0 + wm * 64) * 768 + n0 + wn * 64, 768, lane, r, hh);
    } else if (tn < 12) {
#pragma unroll
      for (int mt = 0; mt < 2; ++mt) {
        const int rl = wm * 64 + mt * 32 + r, row = m0 + rl;
        const float sc = rs[rl];
#pragma unroll
        for (int nt = 0; nt < 2; ++nt)
#pragma unroll
          for (int i4 = 0; i4 < 4; ++i4) {
            wq[mt][nt][i4].x = pk_bf16(acc[mt][nt][4 * i4] * sc, acc[mt][nt][4 * i4 + 1] * sc); wq[mt][nt][i4].y = pk_bf16(acc[mt][nt][4 * i4 + 2] * sc, acc[mt][nt][4 * i4 + 3] * sc);
          }
      }
      wave_store64(wave_stage(lds, fstage, wid), wq, p.ub + (size_t)(m0 + wm * 64) * 512 + (n0 - 1024) + wn * 64, 512, lane, r, hh);
    } else if (wn == 0) {
#pragma unroll
      for (int mt = 0; mt < 2; ++mt) {
        const int rl = wm * 64 + mt * 32 + r, row = m0 + rl;
        const float sc = rs[rl];
        float* dst = row < NTP ? p.out + OFF_KRP + (size_t)row * 32 : p.out + OFF_KRS + (size_t)(row - NTP) * 32;
        bf16_t* dkb = p.krb + (size_t)kr_of(row) * 32;
        const float* rp = (const float*)(p.rope + pos_of(row) * 16);
#pragma unroll
        for (int ih = 0; ih < 2; ++ih) {
          const int j0 = 8 * ih + 4 * hh;
          const f32x4 c01 = *(const f32x4*)(rp + 2 * j0), c23 = *(const f32x4*)(rp + 2 * j0 + 4);
          const float cc[4] = {c01[0], c01[2], c23[0], c23[2]}, sn[4] = {c01[1], c01[3], c23[1], c23[3]};
          f32x4 o1, o2;
#pragma unroll
          for (int jj = 0; jj < 4; ++jj) {
            const float x1 = acc[mt][0][4 * ih + jj] * sc, x2 = acc[mt][0][8 + 4 * ih + jj] * sc;
            o1[jj] = x1 * cc[jj] - x2 * sn[jj]; o2[jj] = x1 * sn[jj] + x2 * cc[jj];
          }
          *(f32x4*)(dst + j0) = o1; *(f32x4*)(dst + 16 + j0) = o2;
          u32x2 w1, w2; w1.x = pk_bf16(o1[0], o1[1]); w1.y = pk_bf16(o1[2], o1[3]); w2.x = pk_bf16(o2[0], o2[1]); w2.y = pk_bf16(o2[2], o2[3]);
          *(u32x2*)(dkb + j0) = w1; *(u32x2*)(dkb + 16 + j0) = w2;
        }
      }
    }
    }
    __syncthreads();
    };
    gemm_stream(p.xb, 1024, p.WinT, 1024, 16, lds, 0, tile_fn, rs_fn, epi);
  }
}

DI void ssm_chunk(const Params& p, int row0, int g, float& hr, float& hi, bool write_y, char* lds_w) {
  const int lane = tid() & 63, r = lane & 31, hh = lane >> 5;
  const float2 lm = p.lam[g * 64 + lane];
  bf16x8 bfr[4];
#pragma unroll
  for (int nt = 0; nt < 4; ++nt) bfr[nt] = *(const bf16x8*)(p.BbT + (size_t)(g * 128 + nt * 32 + r) * 16 + hh * 8);
  const int fr = lane & 15, fq = lane >> 4;
  bf16x8 cfr[4];
#pragma unroll
  for (int ks = 0; ks < 4; ++ks) cfr[ks] = *(const bf16x8*)(p.CcT + (size_t)(g * 16 + fr) * 128 + ks * 32 + fq * 8);
  const float dsk = p.in[19][g * 16 + fr];
#pragma unroll 1
  for (int sub = 0; sub < 2; ++sub) {
    const int rb = row0 + sub * 32;
    const bf16x8 uf = *(const bf16x8*)(p.ub + (size_t)(rb + r) * 512 + g * 16 + hh * 8);
    f32x16 z; for (int i = 0; i < 16; ++i) z[i] = 0.f;
    const f32x16 x0 = MFMA32(uf, bfr[0], z), x1 = MFMA32(uf, bfr[1], z), x2 = MFMA32(uf, bfr[2], z), x3 = MFMA32(uf, bfr[3], z);
    float xr0[16], xr1[16], xi0[16], xi1[16];
#pragma unroll
    for (int i = 0; i < 16; ++i) {
      const auto re = __builtin_amdgcn_permlane32_swap(__float_as_uint(x0[i]), __float_as_uint(x1[i]), false, false);
      const auto im = __builtin_amdgcn_permlane32_swap(__float_as_uint(x2[i]), __float_as_uint(x3[i]), false, false);
      xr0[i] = __uint_as_float(re[0]); xr1[i] = __uint_as_float(re[1]);
      xi0[i] = __uint_as_float(im[0]); xi1[i] = __uint_as_float(im[1]);
    }
    bf16_t* Hs = (bf16_t*)lds_w;
#pragma unroll
    for (int m = 0; m < 4; ++m) {
#pragma unroll
      for (int half = 0; half < 2; ++half) {
#pragma unroll
        for (int jj = 0; jj < 4; ++jj) {
          const int i = 4 * m + jj, tt = 8 * m + 4 * half + jj;
          const float xr = half ? xr1[i] : xr0[i], xi = half ? xi1[i] : xi0[i];
          const float nr = lm.x * hr - lm.y * hi + xr;
          const float ni = lm.x * hi + lm.y * hr + xi;
          hr = nr; hi = ni;
          if (write_y) { Hs[tt * 136 + lane] = f2bf(hr); Hs[tt * 136 + 64 + lane] = f2bf(hi); }
        }
      }
    }
    if (write_y) {
      asm volatile("s_waitcnt lgkmcnt(0)" ::: "memory");
      __builtin_amdgcn_wave_barrier();
#pragma unroll
      for (int mt = 0; mt < 2; ++mt) {
        f32x4 y = {0.f, 0.f, 0.f, 0.f};
#pragma unroll
        for (int ks = 0; ks < 4; ++ks) {
          const bf16x8 hf = *(const bf16x8*)(Hs + (mt * 16 + fr) * 136 + ks * 32 + fq * 8);
          y = MFMA16(hf, cfr[ks], y);
        }
#pragma unroll
        for (int j = 0; j < 4; ++j) {
          const int row = rb + mt * 16 + fq * 4 + j;
          const float u = bf2f(p.ub[(size_t)row * 512 + g * 16 + fr]);
          const float v = y[j] + dsk * u;
          const float zz = 0.7978845608028654f * (v + 0.044715f * v * v * v);
          const float th = 1.f - 2.f / (__expf(2.f * zz) + 1.f);
          p.ssm_y[(size_t)row * 512 + g * 16 + fr] = f2bf(0.5f * v * (1.f + th));
        }
      }
      asm volatile("s_waitcnt lgkmcnt(0)" ::: "memory");
      __builtin_amdgcn_wave_barrier();
    }
  }
}

DI void phase2(const Params& p, char* lds) {
  const int lane = tid() & 63, wid = tid() >> 6;
  const int nb = gridDim.x, bid = blockIdx.x;
  for (int row = bid * 4 + wid; row < NT; row += nb * 4) {
    const f32x4 v = *(const f32x4*)(p.ckv_raw + (size_t)row * 256 + lane * 4);
    const f32x4 pp = *(const f32x4*)(p.ckv_part + (size_t)row * 4);
    const float rstd = rsqrtf((pp[0] + pp[1] + pp[2] + pp[3]) * (1.f / 256.f) + EPS);
    const f32x4 g = *(const f32x4*)(p.in[10] + lane * 4);
    f32x4 o; o[0] = v[0] * rstd * g[0]; o[1] = v[1] * rstd * g[1]; o[2] = v[2] * rstd * g[2]; o[3] = v[3] * rstd * g[3];
    float* dst = row < NTP ? p.out + OFF_LATP + (size_t)row * 256 : p.out + OFF_LATS + (size_t)(row - NTP) * 256;
    *(f32x4*)(dst + lane * 4) = o;
    u32x2 w; w.x = pk_bf16(o[0], o[1]); w.y = pk_bf16(o[2], o[3]);
    *(u32x2*)(p.latb + (size_t)kr_of(row) * 256 + lane * 4) = w;
  }
  for (int it = bid * 4 + wid; it < 8 * 128 * 32; it += nb * 4) {
    const int g = it & 31, c = (it >> 5) & 127, b = it >> 12;
    float hr = 0.f, hi = 0.f;
    ssm_chunk(p, b * 8192 + c * 64, g, hr, hi, false, lds + wid * 8704);
    p.E[(size_t)it * 64 + lane] = make_float2(hr, hi);
  }
  float* rs = (float*)(lds + 65536);
  {
    auto tile_fn = [&](int j, int& m0, int& n0) -> bool { const int li = (int)(blockIdx.x >> 3) + j * (int)(gridDim.x >> 3); const int ti_ = li / 6, tj_ = li - ti_ * 6; const int tbig = ti_ * 8 + (int)(blockIdx.x & 7); if (tbig >= 528) return false; m0 = tbig * 128; n0 = tj_ * 128; return true; };
    auto rs_fn = [&](int m0, int t) -> float2 { float sm = 0.f; for (int q = 0; q < 3; ++q) { const f32x4 v = *(const f32x4*)(p.cq_part + (size_t)(m0 + t) * 12 + 4 * q); sm += (v[0] + v[1]) + (v[2] + v[3]); } return make_float2(rsqrtf(sm * (1.f / 768.f) + EPS), 0.f); };
    auto epi = [&](f32x16 (&acc)[2][2], int m0, int n0, const float* rs, int fstage) { (void)fstage;
    const int tn = n0 >> 7; (void)tn;
    EPI_IDS
    const float qs = 0.10206207261596577f * 1.4426950408889634f;
    u32x2 wq[2][2][4];
#pragma unroll
    for (int mt = 0; mt < 2; ++mt) {
      const int rl = wm * 64 + mt * 32 + r, row = m0 + rl;
      const float sc = rs[rl] * qs;
      const float* rp = (const float*)(p.rope + pos_of(row) * 16);
#pragma unroll
      for (int nt = 0; nt < 2; ++nt) {
        const int cb = n0 + wn * 64 + nt * 32;
        if ((cb % 96) == 64) {
#pragma unroll
          for (int ih = 0; ih < 2; ++ih) {
            const int j0 = 8 * ih + 4 * hh;
            const f32x4 c01 = *(const f32x4*)(rp + 2 * j0), c23 = *(const f32x4*)(rp + 2 * j0 + 4);
            const float cc[4] = {c01[0], c01[2], c23[0], c23[2]}, sn[4] = {c01[1], c01[3], c23[1], c23[3]};
            float o1[4], o2[4];
#pragma unroll
            for (int jj = 0; jj < 4; ++jj) {
              const float x1 = acc[mt][nt][4 * ih + jj] * sc, x2 = acc[mt][nt][8 + 4 * ih + jj] * sc;
              o1[jj] = x1 * cc[jj] - x2 * sn[jj]; o2[jj] = x1 * sn[jj] + x2 * cc[jj];
            }
            wq[mt][nt][ih].x = pk_bf16(o1[0], o1[1]); wq[mt][nt][ih].y = pk_bf16(o1[2], o1[3]); wq[mt][nt][ih + 2].x = pk_bf16(o2[0], o2[1]); wq[mt][nt][ih + 2].y = pk_bf16(o2[2], o2[3]);
          }
        } else {
#pragma unroll
          for (int i4 = 0; i4 < 4; ++i4) {
            wq[mt][nt][i4].x = pk_bf16(acc[mt][nt][4 * i4] * sc, acc[mt][nt][4 * i4 + 1] * sc); wq[mt][nt][i4].y = pk_bf16(acc[mt][nt][4 * i4 + 2] * sc, acc[mt][nt][4 * i4 + 3] * sc);
          }
        }
      }
    }

    wave_store64(wave_stage(lds, fstage, wid), wq, p.Q + (size_t)(m0 + wm * 64) * 768 + n0 + wn * 64, 768, lane, r, hh);
    __syncthreads();
    };
    gemm_stream(p.cq, 768, p.WqT, 768, 12, lds, 0, tile_fn, rs_fn, epi);
  }
}

DI void phase3(const Params& p, char* lds) {
  const int lane = tid() & 63, wid = tid() >> 6;
  const int nb = gridDim.x, bid = blockIdx.x;
  for (int it = bid * 4 + wid; it < 256; it += nb * 4) {
    const int b = it >> 5, g = it & 31;
    const float2 l64 = p.lam64[g * 64 + lane];
    float sr = 0.f, si = 0.f;
    const size_t base = ((size_t)(b * 128) * 32 + g) * 64 + lane;
    for (int c0 = 0; c0 < 128; c0 += 16) {
      float2 e[16];
#pragma unroll
      for (int j = 0; j < 16; ++j) e[j] = p.E[base + (size_t)(c0 + j) * 2048];
#pragma unroll
      for (int j = 0; j < 16; ++j) {
        p.S[base + (size_t)(c0 + j) * 2048] = make_float2(sr, si);
        const float nr = l64.x * sr - l64.y * si + e[j].x, ni = l64.x * si + l64.y * sr + e[j].y;
        sr = nr; si = ni;
      }
    }
  }
  {
    auto tile_fn = [&](int j, int& m0, int& n0) -> bool { const int li = (int)(blockIdx.x >> 3) + j * (int)(gridDim.x >> 3); const int ti_ = li / 4, tj_ = li - ti_ * 4; const int tbig = ti_ * 8 + (int)(blockIdx.x & 7); if (tbig >= 1552) return false; m0 = tbig * 128; n0 = tj_ * 128; return true; };
    auto rs_fn = [&](int m0, int t) -> float2 { return make_float2(0.f, 0.f); };
    auto epi = [&](f32x16 (&acc)[2][2], int m0, int n0, const float* rs, int fstage) { (void)fstage;
    const int tn = n0 >> 7; (void)tn;
    EPI_IDS
    u32x2 w[2][2][4];
#pragma unroll
    for (int mt = 0; mt < 2; ++mt)
#pragma unroll
      for (int nt = 0; nt < 2; ++nt)
#pragma unroll
        for (int i4 = 0; i4 < 4; ++i4) { w[mt][nt][i4].x = pk_bf16(acc[mt][nt][4 * i4], acc[mt][nt][4 * i4 + 1]); w[mt][nt][i4].y = pk_bf16(acc[mt][nt][4 * i4 + 2], acc[mt][nt][4 * i4 + 3]); }
    wave_store64(wave_stage(lds, fstage, wid), w, p.Kn + (size_t)(m0 + wm * 64) * 512 + n0 + wn * 64, 512, lane, r, hh);
    __syncthreads();
    };
    gemm_stream(p.latb, 256, p.WkT, 256, 4, lds, 0, tile_fn, rs_fn, epi);
  }
  {
    auto tile_fn = [&](int j, int& m0, int& n0) -> bool { const int li = (int)(blockIdx.x >> 3) + j * (int)(gridDim.x >> 3); const int ti_ = li / 4, tj_ = li - ti_ * 4; const int tbig = ti_ * 8 + (int)(blockIdx.x & 7); if (tbig >= 1552) return false; n0 = tbig * 128; m0 = tj_ * 128; return true; };
    auto rs_fn = [&](int m0, int t) -> float2 { return make_float2(0.f, 0.f); };
    auto epi = [&](f32x16 (&acc)[2][2], int m0, int n0, const float* rs, int fstage) { (void)fstage;
    const int tn = n0 >> 7; (void)tn;
    EPI_IDS
    u32x2 w[2][2][4];
#pragma unroll
    for (int mt = 0; mt < 2; ++mt)
#pragma unroll
      for (int nt = 0; nt < 2; ++nt)
#pragma unroll
        for (int i4 = 0; i4 < 4; ++i4) { w[mt][nt][i4].x = pk_bf16(acc[mt][nt][4 * i4], acc[mt][nt][4 * i4 + 1]); w[mt][nt][i4].y = pk_bf16(acc[mt][nt][4 * i4 + 2], acc[mt][nt][4 * i4 + 3]); }
    const int kr0 = n0 + wn * 64;
    size_t cbase; int S;
    if (kr0 < NTP) { cbase = (size_t)(kr0 >> 13) * 512 * 8192 + (kr0 & 8191); S = 8192; }
    else { const int k2 = kr0 - NTP, b = k2 / SKS, tt = k2 - b * SKS; cbase = VT_S_OFF + (size_t)b * 512 * SKS + tt; S = SKS; }
    wave_store64(wave_stage(lds, fstage, wid), w, p.Vt + cbase + (size_t)(m0 + wm * 64) * S, (size_t)S, lane, r, hh);
    __syncthreads();
    };
    gemm_stream(p.WvT, 256, p.latb, 256, 4, lds, 0, tile_fn, rs_fn, epi);
  }
}

template <int QT, bool HALF>
DI void attn_item(const Params& p, int kind, int b, int h, int qq, char* lds) {
  const int t = tid(), lane = t & 63, wid = t >> 6, r = lane & 31, hh = lane >> 5;
  int qrow0, nkb_w, nkb_max, S; size_t kr0; const bf16_t* vt_base;
  constexpr int RW = 32 * QT, WPC = 64 / RW, CPB = 4 / WPC;
  if (kind == 0) {
    const int c = qq * CPB + wid / WPC; qrow0 = b * 8192 + c * 64 + (wid % WPC) * RW; nkb_w = c + 1; nkb_max = qq * CPB + CPB; kr0 = (size_t)b * 8192; S = 8192;
    vt_base = p.Vt + (size_t)(b * 8 + h) * 64 * 8192;
  } else {
    qrow0 = NTP + b * 64 + (wid % WPC) * RW; nkb_w = (wid < WPC) ? 65 : 0; nkb_max = 65; kr0 = (size_t)NTP + (size_t)b * SKS; S = SKS;
    vt_base = p.Vt + VT_S_OFF + (size_t)(b * 8 + h) * 64 * SKS;
  }
  bf16x8 qf[QT][6];
#pragma unroll
  for (int qt = 0; qt < QT; ++qt)
#pragma unroll
    for (int ks = 0; ks < 6; ++ks) qf[qt][ks] = *(const bf16x8*)(p.Q + (size_t)(qrow0 + qt * 32 + r) * 768 + h * 96 + ks * 16 + hh * 8);
  f32x16 o[2][QT];
  float mrun[QT], lrun[QT];
#pragma unroll
  for (int qt = 0; qt < QT; ++qt) { mrun[qt] = -1e30f; lrun[qt] = 0.f;
#pragma unroll
    for (int dt = 0; dt < 2; ++dt)
#pragma unroll
      for (int i = 0; i < 16; ++i) o[dt][qt][i] = 0.f; }
  const int kkey = t >> 3, kc = t & 7;
  const int rkey = t >> 2, rc = t & 3;
  const int vd = t >> 3, vc = t & 7;
  const bf16_t* gk = p.Kn + (kr0 + kkey) * 512 + h * 64 + kc * 8;
  const bf16_t* gr = p.krb + (kr0 + rkey) * 32 + rc * 8;
  const bf16_t* gv = vt_base + (size_t)vd * S + vc * 8;
  const unsigned kw0 = kkey * 208 + kc * 16, kw1 = kw0 + 32 * 208, rw = rkey * 208 + 128 + rc * 16;
  const unsigned vlo = vd * 144 + (vc >> 1) * 32 + (vc & 1) * 8, vhi = vlo + 16;
  constexpr int KB = 13312, VB = 9216, BUF = KB + VB;
  u32x4 k0r, k1r, rr, v0r, v1r;
  k0r = *(const u32x4*)gk; k1r = *(const u32x4*)(gk + 32 * 512); rr = *(const u32x4*)gr;
  v0r = *(const u32x4*)gv; v1r = *(const u32x4*)(gv + (size_t)32 * S);
  __syncthreads();
  {
    char* kb_ = lds; char* vb_ = lds + KB;
    *(u32x4*)(kb_ + kw0) = k0r; *(u32x4*)(kb_ + kw1) = k1r; *(u32x4*)(kb_ + rw) = rr;
    *(u32x2*)(vb_ + vlo) = (u32x2){v0r.x, v0r.y}; *(u32x2*)(vb_ + vhi) = (u32x2){v0r.z, v0r.w};
    *(u32x2*)(vb_ + vlo + 32 * 144) = (u32x2){v1r.x, v1r.y}; *(u32x2*)(vb_ + vhi + 32 * 144) = (u32x2){v1r.z, v1r.w};
  }
  __syncthreads();
  for (int kb = 0; kb < nkb_max; ++kb) {
    const int cur = kb & 1;
    const bool more = kb + 1 < nkb_max;
    if (more) {
      const size_t ko = (size_t)(kb + 1) * 64;
      k0r = *(const u32x4*)(gk + ko * 512); k1r = *(const u32x4*)(gk + (ko + 32) * 512); rr = *(const u32x4*)(gr + ko * 32);
      v0r = *(const u32x4*)(gv + ko); v1r = *(const u32x4*)(gv + (size_t)32 * S + ko);
    }
    if (HALF && kb < nkb_w) {
      const char* kt_ = lds + cur * BUF; const char* vt_ = kt_ + KB;
#pragma unroll
      for (int kt = 0; kt < 2; ++kt) {
        __builtin_amdgcn_iglp_opt(0);
        f32x16 sh[QT];
#pragma unroll
        for (int qt = 0; qt < QT; ++qt)
#pragma unroll
          for (int i = 0; i < 16; ++i) sh[qt][i] = 0.f;
#pragma unroll
        for (int ks = 0; ks < 6; ++ks) {
          const bf16x8 kf = *(const bf16x8*)(kt_ + (kt * 32 + r) * 208 + ks * 32 + hh * 16);
#pragma unroll
          for (int qt = 0; qt < QT; ++qt) sh[qt] = MFMA32(kf, qf[qt][ks], sh[qt]);
        }
        bf16x8 ph[QT][2];
#pragma unroll
        for (int qt = 0; qt < QT; ++qt) {
          float mx = sh[qt][0];
#pragma unroll
          for (int i = 1; i < 16; ++i) mx = fmaxf(mx, sh[qt][i]);
          mx = fmaxf(mx, __shfl_xor(mx, 32));
          const bool need = mx > mrun[qt] + 8.f;
          if (__any(need)) {
            const float mnew = need ? mx : mrun[qt];
            const float alpha = __builtin_amdgcn_exp2f(mrun[qt] - mnew);
            mrun[qt] = mnew; lrun[qt] *= alpha;
#pragma unroll
            for (int dt = 0; dt < 2; ++dt)
#pragma unroll
              for (int i = 0; i < 16; ++i) o[dt][qt][i] *= alpha;
          }
          float ls = 0.f;
#pragma unroll
          for (int i = 0; i < 16; ++i) { const float pv = __builtin_amdgcn_exp2f(sh[qt][i] - mrun[qt]); ls += pv; sh[qt][i] = pv; }
          lrun[qt] += ls;
#pragma unroll
          for (int s2 = 0; s2 < 2; ++s2) {
            u32x4 w;
            w.x = pk_bf16(sh[qt][8 * s2 + 0], sh[qt][8 * s2 + 1]); w.y = pk_bf16(sh[qt][8 * s2 + 2], sh[qt][8 * s2 + 3]);
            w.z = pk_bf16(sh[qt][8 * s2 + 4], sh[qt][8 * s2 + 5]); w.w = pk_bf16(sh[qt][8 * s2 + 6], sh[qt][8 * s2 + 7]);
            ph[qt][s2] = __builtin_bit_cast(bf16x8, w);
          }
        }
#pragma unroll
        for (int dt = 0; dt < 2; ++dt)
#pragma unroll
          for (int s2 = 0; s2 < 2; ++s2) {
            const bf16x8 vf = *(const bf16x8*)(vt_ + (dt * 32 + r) * 144 + (kt * 2 + s2) * 32 + hh * 16);
#pragma unroll
            for (int qt = 0; qt < QT; ++qt) o[dt][qt] = MFMA32(vf, ph[qt][s2], o[dt][qt]);
          }
      }
    }
    if (!HALF && kb < nkb_w) {
      const char* kt_ = lds + cur * BUF; const char* vt_ = kt_ + KB;
      f32x16 st[2][QT];
#pragma unroll
      for (int kt = 0; kt < 2; ++kt)
#pragma unroll
        for (int qt = 0; qt < QT; ++qt)
#pragma unroll
          for (int i = 0; i < 16; ++i) st[kt][qt][i] = 0.f;
#pragma unroll
      for (int ks = 0; ks < 6; ++ks)
#pragma unroll
        for (int kt = 0; kt < 2; ++kt) {
          const bf16x8 kf = *(const bf16x8*)(kt_ + (kt * 32 + r) * 208 + ks * 32 + hh * 16);
#pragma unroll
          for (int qt = 0; qt < QT; ++qt) st[kt][qt] = MFMA32(kf, qf[qt][ks], st[kt][qt]);
        }
      bf16x8 pb[2][QT][2];
#pragma unroll
      for (int qt = 0; qt < QT; ++qt) {
        float mx = mrun[qt];
#pragma unroll
        for (int kt = 0; kt < 2; ++kt)
#pragma unroll
          for (int i = 0; i < 16; ++i) mx = fmaxf(mx, st[kt][qt][i]);
        mx = fmaxf(mx, __shfl_xor(mx, 32));
        const float alpha = __builtin_amdgcn_exp2f(mrun[qt] - mx);
        mrun[qt] = mx;
        float ls = 0.f;
#pragma unroll
        for (int kt = 0; kt < 2; ++kt) {
#pragma unroll
          for (int i = 0; i < 16; ++i) { const float pv = __builtin_amdgcn_exp2f(st[kt][qt][i] - mx); ls += pv; st[kt][qt][i] = pv; }
#pragma unroll
          for (int s2 = 0; s2 < 2; ++s2) {
            u32x4 w;
            w.x = pk_bf16(st[kt][qt][8 * s2 + 0], st[kt][qt][8 * s2 + 1]); w.y = pk_bf16(st[kt][qt][8 * s2 + 2], st[kt][qt][8 * s2 + 3]);
            w.z = pk_bf16(st[kt][qt][8 * s2 + 4], st[kt][qt][8 * s2 + 5]); w.w = pk_bf16(st[kt][qt][8 * s2 + 6], st[kt][qt][8 * s2 + 7]);
            pb[kt][qt][s2] = __builtin_bit_cast(bf16x8, w);
          }
        }
        lrun[qt] = lrun[qt] * alpha + ls;
#pragma unroll
        for (int dt = 0; dt < 2; ++dt)
#pragma unroll
          for (int i = 0; i < 16; ++i) o[dt][qt][i] *= alpha;
      }
#pragma unroll
      for (int dt = 0; dt < 2; ++dt)
#pragma unroll
        for (int kt = 0; kt < 2; ++kt)
#pragma unroll
          for (int s2 = 0; s2 < 2; ++s2) {
            const bf16x8 vf = *(const bf16x8*)(vt_ + (dt * 32 + r) * 144 + (kt * 2 + s2) * 32 + hh * 16);
#pragma unroll
            for (int qt = 0; qt < QT; ++qt) o[dt][qt] = MFMA32(vf, pb[kt][qt][s2], o[dt][qt]);
          }
    }
    if (more) {
      char* kb_ = lds + (cur ^ 1) * BUF; char* vb_ = kb_ + KB;
      *(u32x4*)(kb_ + kw0) = k0r; *(u32x4*)(kb_ + kw1) = k1r; *(u32x4*)(kb_ + rw) = rr;
      *(u32x2*)(vb_ + vlo) = (u32x2){v0r.x, v0r.y}; *(u32x2*)(vb_ + vhi) = (u32x2){v0r.z, v0r.w};
      *(u32x2*)(vb_ + vlo + 32 * 144) = (u32x2){v1r.x, v1r.y}; *(u32x2*)(vb_ + vhi + 32 * 144) = (u32x2){v1r.z, v1r.w};
    }
    __syncthreads();
  }
  if (nkb_w > 0) {
    u32x2 wo[2][2][4];
#pragma unroll
    for (int qt = 0; qt < QT; ++qt) {
      const float lt = lrun[qt] + __shfl_xor(lrun[qt], 32);
      const float inv = 1.f / lt;
      const int row = qrow0 + qt * 32 + r;
      float ss = 0.f;
#pragma unroll
      for (int dt = 0; dt < 2; ++dt)
#pragma unroll
        for (int i4 = 0; i4 < 4; ++i4) {
          const float a0 = o[dt][qt][4 * i4] * inv, a1 = o[dt][qt][4 * i4 + 1] * inv, a2 = o[dt][qt][4 * i4 + 2] * inv, a3 = o[dt][qt][4 * i4 + 3] * inv;
          ss += a0 * a0 + a1 * a1 + a2 * a2 + a3 * a3;
          u32x2 w; w.x = pk_bf16(a0, a1); w.y = pk_bf16(a2, a3);
          if (QT == 2) wo[qt][dt][i4] = w;
          else *(u32x2*)(p.mix + (size_t)row * 1024 + h * 64 + dt * 32 + 8 * i4 + 4 * hh) = w;
        }
      ss += __shfl_xor(ss, 32);
      if (hh == 0) p.attn_part[(size_t)row * 8 + h] = ss;
    }
    if (QT == 2) wave_store64(lds + wid * 8192, wo, p.mix + (size_t)qrow0 * 1024 + h * 64, 1024, lane, r, hh);
  }
}

DI void phase4(const Params& p, char* lds, int qidx) {
  const int t = tid(), lane = t & 63, wid = t >> 6;
  const int nb = gridDim.x, bid = blockIdx.x;
  int* nxt = (int*)(lds + 65536);
  for (;;) {
    __syncthreads();
    if (t == 0) *nxt = atomicAdd(p.counters + qidx, 1);
    __syncthreads();
    const int it = *nxt;
    if (it >= 256 + 64 * 32) break;
    if (it < 256) attn_item<1, false>(p, 1, it >> 3, it & 7, 0, lds);
    else { const int j = it - 256; const int qq = 31 - (j >> 6), bh = j & 63; attn_item<2, true>(p, 0, bh >> 3, bh & 7, qq, lds); }
  }
  __syncthreads();
  for (int it = bid * 4 + wid; it < 8 * 128 * 32 + 1024; it += nb * 4) {
    if (it < 8 * 128 * 32) {
      const int g = it & 31, c = (it >> 5) & 127, b = it >> 12;
      const float2 s0 = p.S[(size_t)it * 64 + lane];
      float hr = s0.x, hi = s0.y;
      ssm_chunk(p, b * 8192 + c * 64, g, hr, hi, true, lds + wid * 8704);
      if (c == 127) { p.out[OFF_HRP + (size_t)(b * 32 + g) * 64 + lane] = hr; p.out[OFF_HIP + (size_t)(b * 32 + g) * 64 + lane] = hi; }
    } else {
      const int j = it - 8 * 128 * 32, g = j & 31, b = j >> 5;
      float hr = p.in[4][(size_t)(b * 32 + g) * 64 + lane], hi = p.in[5][(size_t)(b * 32 + g) * 64 + lane];
      ssm_chunk(p, NTP + b * 64, g, hr, hi, true, lds + wid * 8704);
      p.out[OFF_HRS + (size_t)(b * 32 + g) * 64 + lane] = hr; p.out[OFF_HIS + (size_t)(b * 32 + g) * 64 + lane] = hi;
    }
  }
}

DI void phase5(const Params& p, char* lds) {
  {
    auto tile_fn = [&](int j, int& m0, int& n0) -> bool { const int li = (int)(blockIdx.x >> 3) + j * (int)(gridDim.x >> 3); const int ti_ = li / 4, tj_ = li - ti_ * 4; const int tbig = ti_ * 8 + (int)(blockIdx.x & 7); if (tbig >= 528) return false; m0 = tbig * 128; n0 = tj_ * 128; return true; };
    auto rs_fn = [&](int m0, int t) -> float2 { return make_float2(0.f, 0.f); };
    auto epi = [&](f32x16 (&acc)[2][2], int m0, int n0, const float* rs, int fstage) { (void)fstage;
    const int tn = n0 >> 7; (void)tn;
    { EPI_IDS
    u32x2 wq[2][2][4];
#pragma unroll
    for (int mt = 0; mt < 2; ++mt) {
      const int row = m0 + wm * 64 + mt * 32 + r;
      float ss = 0.f;
#pragma unroll
      for (int nt = 0; nt < 2; ++nt)
#pragma unroll
        for (int i4 = 0; i4 < 4; ++i4) {
          const int col = n0 + wn * 64 + nt * 32 + 8 * i4 + 4 * hh;
          const u32x2 yv = *(const u32x2*)(p.ssm_y + (size_t)row * 512 + col);
          const float y0 = __uint_as_float(yv.x << 16), y1 = __uint_as_float(yv.x & 0xffff0000u), y2 = __uint_as_float(yv.y << 16), y3 = __uint_as_float(yv.y & 0xffff0000u);
          const float o0 = y0 / (1.f + __expf(-acc[mt][nt][4 * i4])), o1 = y1 / (1.f + __expf(-acc[mt][nt][4 * i4 + 1]));
          const float o2 = y2 / (1.f + __expf(-acc[mt][nt][4 * i4 + 2])), o3 = y3 / (1.f + __expf(-acc[mt][nt][4 * i4 + 3]));
          ss += o0 * o0 + o1 * o1 + o2 * o2 + o3 * o3;
          wq[mt][nt][i4].x = pk_bf16(o0, o1); wq[mt][nt][i4].y = pk_bf16(o2, o3);
        }
      ss += __shfl_xor(ss, 32);
      if (hh == 0) p.ssm_part[(size_t)row * 8 + tn * 2 + wn] = ss;
    }
    wave_store64(wave_stage(lds, fstage, wid), wq, p.mix + (size_t)(m0 + wm * 64) * 1024 + 512 + n0 + wn * 64, 1024, lane, r, hh);
    }
    __syncthreads();
    };
    gemm_stream(p.ssm_y, 512, p.WgT, 512, 8, lds, 0, tile_fn, rs_fn, epi);
  }
}

DI void phase6(const Params& p, char* lds) {
  const int xb_ = blockIdx.x & 7, xl_ = blockIdx.x >> 3, nbx_ = gridDim.x >> 3;
  {
    auto tile_fn = [&](int j, int& m0, int& n0) -> bool { const int li6 = xl_ + j * nbx_, tm = (li6 >> 3) * 8 + xb_; if (tm >= 528) return false; m0 = tm * 128; n0 = (li6 & 7) * 128; return true; };
    auto rs_fn = [&](int m0, int t) -> float2 {
      const f32x4 a0 = *(const f32x4*)(p.attn_part + (size_t)(m0 + t) * 8), a1 = *(const f32x4*)(p.attn_part + (size_t)(m0 + t) * 8 + 4);
      const float sa = (a0[0] + a0[1]) + (a0[2] + a0[3]) + (a1[0] + a1[1]) + (a1[2] + a1[3]);
      const f32x4 b0 = *(const f32x4*)(p.ssm_part + (size_t)(m0 + t) * 8), b1 = *(const f32x4*)(p.ssm_part + (size_t)(m0 + t) * 8 + 4);
      const float sb = (b0[0] + b0[1]) + (b0[2] + b0[3]) + (b1[0] + b1[1]) + (b1[2] + b1[3]);
      const float ra = rsqrtf(sa * (1.f / 512.f) + EPS), rb = rsqrtf(sb * (1.f / 512.f) + EPS);
      return make_float2(rb, ra / rb); };
    auto epi = [&](f32x16 (&acc)[2][2], int m0, int n0, const float* rs, int fstage) { (void)fstage;
    const int tn = n0 >> 7;
    { EPI_IDS
    char* stg = wave_stage(lds, fstage, wid);
#pragma unroll
    for (int mt = 0; mt < 2; ++mt) {
      const float sc = rs[wm * 64 + mt * 32 + r];
#pragma unroll
      for (int nt = 0; nt < 2; ++nt)
#pragma unroll
        for (int i = 0; i < 16; ++i) acc[mt][nt][i] *= sc;
    }
    wave_add64_f32(stg, acc, xrow(p, m0 + wm * 64) + n0 + wn * 64, 1024, lane, r, hh);
    u32x2 w[2][2][4];
#pragma unroll
    for (int mt = 0; mt < 2; ++mt) {
      const int row = m0 + wm * 64 + mt * 32 + r;
      float ss = 0.f;
#pragma unroll
      for (int nt = 0; nt < 2; ++nt)
#pragma unroll
        for (int i4 = 0; i4 < 4; ++i4) {
#pragma unroll
          for (int jj = 0; jj < 4; ++jj) ss += acc[mt][nt][4 * i4 + jj] * acc[mt][nt][4 * i4 + jj];
          w[mt][nt][i4].x = pk_bf16(acc[mt][nt][4 * i4], acc[mt][nt][4 * i4 + 1]); w[mt][nt][i4].y = pk_bf16(acc[mt][nt][4 * i4 + 2], acc[mt][nt][4 * i4 + 3]);
        }
      ss += __shfl_xor(ss, 32);
      if (hh == 0) p.h_part[(size_t)row * 16 + tn * 2 + wn] = ss;
    }
    wave_store64(stg, w, p.hb + (size_t)(m0 + wm * 64) * 1024 + n0 + wn * 64, 1024, lane, r, hh);
    }
    __syncthreads();
    };
    gemm_stream(p.mix, 1024, p.WoT, 1024, 16, lds, 8, tile_fn, rs_fn, epi);
  }
}

DI void phase7(const Params& p, char* lds) {
  float* rs = (float*)(lds + 65536);
  const int xb_ = blockIdx.x & 7, xl_ = blockIdx.x >> 3, nbx_ = gridDim.x >> 3;
  {
    auto tile_fn = [&](int j, int& m0, int& n0) -> bool { const int tm = j * (nbx_ >> 2) + (xl_ >> 2); if (tm >= 528) return false; m0 = tm * 128; n0 = (xb_ * 4 + (xl_ & 3)) * 128; return true; };
    auto rs_fn = [&](int m0, int t) -> float2 { float sm = 0.f; for (int q = 0; q < 4; ++q) { const f32x4 v = *(const f32x4*)(p.h_part + (size_t)(m0 + t) * 16 + 4 * q); sm += (v[0] + v[1]) + (v[2] + v[3]); } return make_float2(rsqrtf(sm * (1.f / 1024.f) + EPS), 0.f); };
    auto epi = [&](f32x16 (&acc)[2][2], int m0, int n0, const float* rs, int fstage) { (void)fstage;
    const int tn = n0 >> 7; (void)tn;
    { EPI_IDS
    char* stg = lds + (wid < 2 ? 0 : 32768) + fstage * 16384 + (wid & 1) * 8192;
#pragma unroll
    for (int mt = 0; mt < 2; ++mt) {
      const int rloc = mt * 32 + r;
      const float sc = rs[wm * 64 + rloc];
#pragma unroll
      for (int nt = 0; nt < 2; ++nt)
#pragma unroll
        for (int i4 = 0; i4 < 4; ++i4) {
          float v[4];
#pragma unroll
          for (int jj = 0; jj < 4; ++jj) { const float a_ = fmaxf(acc[mt][nt][4 * i4 + jj] * sc, 0.f); v[jj] = a_ * a_; }
          u32x2 w; w.x = pk_bf16(v[0], v[1]); w.y = pk_bf16(v[2], v[3]);
          *(u32x2*)(stg + rloc * 128 + (((nt * 4 + i4) ^ (rloc & 7)) << 4) + hh * 8) = w;
        }
    }
    asm volatile("s_waitcnt lgkmcnt(0)" ::: "memory");
    __builtin_amdgcn_wave_barrier();
    bf16_t* gdst = p.act + ((((size_t)(m0 >> 7) * 64 + (n0 >> 6) + wn) * 128 + wm * 64) * 64);
#pragma unroll
    for (int s8 = 0; s8 < 8; ++s8) {
      const int rloc = s8 * 8 + (lane >> 3), c = lane & 7;
      const u32x4 q = *(const u32x4*)(stg + rloc * 128 + ((c ^ (rloc & 7)) << 4));
      *(u32x4*)(gdst + rloc * 64 + c * 8) = q;
    }
    }
    __syncthreads();
    };
    gemm_stream(p.hb, 1024, p.WuT, 1024, 16, lds, 0, tile_fn, rs_fn, epi);
  }
}

DI void phase8(const Params& p, char* lds) {
  const int xb_ = blockIdx.x & 7, xl_ = blockIdx.x >> 3, nbx_ = gridDim.x >> 3;
  {
    auto tile_fn = [&](int j, int& m0, int& n0) -> bool { const int li = (int)(blockIdx.x >> 3) + j * (int)(gridDim.x >> 3); const int ti_ = li / 8, tj_ = li - ti_ * 8; const int tbig = ti_ * 8 + (int)(blockIdx.x & 7); if (tbig >= 528) return false; m0 = tbig * 128; n0 = tj_ * 128; return true; };
    auto rs_fn = [&](int m0, int t) -> float2 { return make_float2(0.f, 0.f); };
    auto epi = [&](f32x16 (&acc)[2][2], int m0, int n0, const float* rs, int fstage) { (void)fstage;
    const int tn = n0 >> 7; (void)tn;
    { EPI_IDS
    char* stg = wave_stage(lds, fstage, wid);
    u32x2 hw[2][2][4];
    wave_load64(stg, hw, p.hb + (size_t)(m0 + wm * 64) * 1024 + n0 + wn * 64, 1024, lane, r, hh);
#pragma unroll
    for (int mt = 0; mt < 2; ++mt) {
      const int row = m0 + wm * 64 + mt * 32 + r;
      float ss = 0.f;
#pragma unroll
      for (int nt = 0; nt < 2; ++nt)
#pragma unroll
        for (int i4 = 0; i4 < 4; ++i4) {
          const u32x2 hq = hw[mt][nt][i4];
          const float h0 = __uint_as_float(hq.x << 16), h1 = __uint_as_float(hq.x & 0xffff0000u), h2 = __uint_as_float(hq.y << 16), h3 = __uint_as_float(hq.y & 0xffff0000u);
          acc[mt][nt][4 * i4] += h0; acc[mt][nt][4 * i4 + 1] += h1; acc[mt][nt][4 * i4 + 2] += h2; acc[mt][nt][4 * i4 + 3] += h3;
#pragma unroll
          for (int jj = 0; jj < 4; ++jj) ss += acc[mt][nt][4 * i4 + jj] * acc[mt][nt][4 * i4 + jj];
        }
      ss += __shfl_xor(ss, 32);
      if (hh == 0) p.out_part[(size_t)row * 16 + tn * 2 + wn] = ss;
    }
    wave_store64_f32(stg, acc, p.out + OFF_Y + (size_t)(m0 + wm * 64) * 1024 + n0 + wn * 64, 1024, lane, r, hh);
    }
    __syncthreads();
    };
    gemm_stream<true>(p.act, 4096, p.WdT, 4096, 64, lds, 0, tile_fn, rs_fn, epi);
  }
}

DI void phase9(const Params& p) {
  const int t = tid(), lane = t & 63, wid = t >> 6;
  for (int row = blockIdx.x * 4 + wid; row < NT; row += gridDim.x * 4) {
    float s = 0.f;
    for (int j = 0; j < 16; ++j) s += p.out_part[(size_t)row * 16 + j];
    const float rstd = rsqrtf(s * (1.f / 1024.f) + EPS);
    float* y = p.out + OFF_Y + (size_t)row * 1024;
#pragma unroll
    for (int j = 0; j < 4; ++j) {
      f32x4 v = *(const f32x4*)(y + lane * 4 + 256 * j);
      const f32x4 g = *(const f32x4*)(p.in[27] + lane * 4 + 256 * j);
      v[0] *= rstd * g[0]; v[1] *= rstd * g[1]; v[2] *= rstd * g[2]; v[3] *= rstd * g[3];
      *(f32x4*)(y + lane * 4 + 256 * j) = v;
    }
  }
}

DI void grid_barrier(unsigned* cnt, unsigned target) {
  asm volatile("s_waitcnt vmcnt(0)" ::: "memory");
  __syncthreads();
  if (tid() == 0) {
    __builtin_amdgcn_fence(__ATOMIC_RELEASE, "agent");
    asm volatile("s_waitcnt vmcnt(0)" ::: "memory");
    __hip_atomic_fetch_add(cnt, 1u, __ATOMIC_RELAXED, __HIP_MEMORY_SCOPE_AGENT);
    while (__hip_atomic_load(cnt, __ATOMIC_RELAXED, __HIP_MEMORY_SCOPE_AGENT) < target) __builtin_amdgcn_s_sleep(2);
  }
  __syncthreads();
  __builtin_amdgcn_fence(__ATOMIC_ACQUIRE, "agent");
  asm volatile("s_waitcnt vmcnt(0)" ::: "memory");
}

#define XB_TMO      128
#define XB_XCNT(j)  (256  + 64 * (j))
#define XB_XSUB(j)  (1280 + 64 * (j))
#define XB_XGEN(j)  (2304 + 64 * (j))
#define XB_TOP      3328
#define XB_TOPGEN   3392
#define XCD_BAR_WORDS 3456
#define XB_SPIN_CAP (1u << 22)
#define LAS __attribute__((address_space(3)))
DI unsigned xb_ld(unsigned* p)              { return __hip_atomic_load(p, __ATOMIC_RELAXED, __HIP_MEMORY_SCOPE_AGENT); }
DI unsigned xb_add(unsigned* p, unsigned v) { return __hip_atomic_fetch_add(p, v, __ATOMIC_RELAXED, __HIP_MEMORY_SCOPE_AGENT); }
DI unsigned xb_xcc_id() { return (unsigned)__builtin_amdgcn_s_getreg((3 << 11) | 20) & 0xFu; }
#define XB_SPIN(cond, bar) do { unsigned _sp = 0; while (cond) { __builtin_amdgcn_s_sleep(1); \
    if ((++_sp & 255u) == 0u) { if (xb_ld(&(bar)[XB_TMO])) break; if (_sp > XB_SPIN_CAP) { atomicAdd(&(bar)[XB_TMO], 1u); break; } } } } while (0)
struct XcdBarrier { unsigned* bar; unsigned x; volatile LAS unsigned* st; };
DI XcdBarrier xcd_barrier_post(unsigned* bar, volatile LAS unsigned* st) {
  XcdBarrier b; b.bar = bar; b.x = xb_xcc_id(); b.st = st;
  if (tid() == 0) (void)xb_add(&bar[XB_XCNT(b.x)], 1u);
  return b;
}
DI void xcd_barrier_complete(unsigned* bar, unsigned x, unsigned& nloc, unsigned& nx) {
  const unsigned G = gridDim.x * gridDim.y * gridDim.z;
  unsigned sum, cnt, mine, sp = 0u;
  for (;;) {
    sum = 0u; cnt = 0u; mine = 0u;
#pragma unroll
    for (unsigned j = 0; j < 16; ++j) { const unsigned c = xb_ld(&bar[XB_XCNT(j)]); sum += c; cnt += (c > 0u) ? 1u : 0u; mine = (j == x) ? c : mine; }
    if (sum == G) break;
    __builtin_amdgcn_s_sleep(1);
    if ((++sp & 255u) == 0u) { if (xb_ld(&bar[XB_TMO])) break; if (sp > XB_SPIN_CAP) { atomicAdd(&bar[XB_TMO], 1u); break; } }
  }
  nloc = mine > 0u ? mine : 1u; nx = cnt > 0u ? cnt : 1u;
}
DI void xcd_barrier(const XcdBarrier& b) {
  asm volatile("s_waitcnt vmcnt(0)" ::: "memory");
  __syncthreads();
  if (tid() == 0) {
    unsigned* bar = b.bar;
    __builtin_amdgcn_s_waitcnt(0);
    unsigned nloc = b.st[0], nx = b.st[1];
    if (nloc == 0u) { xcd_barrier_complete(bar, b.x, nloc, nx); b.st[0] = nloc; b.st[1] = nx; }
    const unsigned old = xb_add(&bar[XB_XSUB(b.x)], 1u);
    const unsigned gen = old / nloc;
    if (old + 1u == (gen + 1u) * nloc) {
      __builtin_amdgcn_fence(__ATOMIC_RELEASE, "agent");
      asm volatile("s_waitcnt vmcnt(0)" ::: "memory");
      const unsigned og = xb_add(&bar[XB_TOP], 1u);
      const unsigned tg = og / nx;
      if (og + 1u == (tg + 1u) * nx) xb_add(&bar[XB_TOPGEN], 1u);
      else XB_SPIN(xb_ld(&bar[XB_TOPGEN]) == tg, bar);
      __builtin_amdgcn_fence(__ATOMIC_ACQUIRE, "agent");
      xb_add(&bar[XB_XGEN(b.x)], 1u);
      asm volatile("s_waitcnt vmcnt(0)" ::: "memory");
    } else {
      XB_SPIN(xb_ld(&bar[XB_XGEN(b.x)]) == gen, bar);
      __builtin_amdgcn_fence(__ATOMIC_ACQUIRE, "agent");
      asm volatile("s_waitcnt vmcnt(0)" ::: "memory");
    }
  }
  __syncthreads();
}

template <bool COOP>
__global__ void __launch_bounds__(256, 2) mega(Params p) {
  __shared__ __attribute__((aligned(16))) char lds[LDS_BYTES];
  XcdBarrier xb{};
  if (COOP) {
    volatile LAS unsigned* st = (volatile LAS unsigned*)(lds + 67584);
    if (tid() == 0) { st[0] = 0u; st[1] = 0u; }
    __syncthreads();
    xb = xcd_barrier_post((unsigned*)p.counters + 64, st);
  }
  for (int ph = p.ph_lo; ph < p.ph_hi; ++ph) {
#ifdef ONLY_PHASE
    if (ph != ONLY_PHASE) continue;
#endif
    switch (ph) {
      case 0: phase0(p, lds); break;
      case 1: phase1(p, lds); break;
      case 2: phase2(p, lds); break;
      case 3: phase3(p, lds); break;
      case 4: phase4(p, lds, 0); break;
      case 5: phase5(p, lds); break;
      case 6: phase6(p, lds); break;
      case 7: phase7(p, lds); break;
      case 8: phase8(p, lds); break;
      default: phase9(p); break;
    }
#ifdef DOUBLE_PHASE
    if (ph == DOUBLE_PHASE) {
      __syncthreads();
      switch (ph) { case 0: phase0(p, lds); break; case 1: phase1(p, lds); break; case 2: phase2(p, lds); break; case 3: phase3(p, lds); break; case 4: phase4(p, lds, 1); break;
                    case 5: phase5(p, lds); break; case 6: phase6(p, lds); break; case 7: phase7(p, lds); break; default: break; }
    }
#endif
    if (COOP) { if (ph + 1 < p.ph_hi) { if (ph == 0) cg::this_grid().sync(); else xcd_barrier(xb); } }
  }
}

static size_t al256(size_t x) { return (x + 255) & ~(size_t)255; }

extern "C" void kernel_launch(void* const* d_in, const int* in_sizes, int n_in, void* d_out, int out_size, void* d_ws, size_t ws_size, hipStream_t stream) {
  Params p{};
  for (int i = 0; i < 28; ++i) p.in[i] = (const float*)d_in[i];
  p.out = (float*)d_out;
  char* base = (char*)d_ws; size_t off = 0;
  auto take = [&](size_t bytes) { char* q = base + off; off = al256(off + bytes); return q; };
  p.WinT = (bf16_t*)take((size_t)1664 * 1024 * 2);
  p.WqT = (bf16_t*)take((size_t)768 * 768 * 2);
  p.WkT = (bf16_t*)take((size_t)512 * 256 * 2);
  p.WvT = (bf16_t*)take((size_t)512 * 256 * 2);
  p.WgT = (bf16_t*)take((size_t)512 * 512 * 2);
  p.WoT = (bf16_t*)take((size_t)1024 * 1024 * 2);
  p.WuT = (bf16_t*)take((size_t)4096 * 1024 * 2);
  p.WdT = (bf16_t*)take((size_t)1024 * 4096 * 2);
  p.BbT = (bf16_t*)take((size_t)32 * 128 * 16 * 2);
  p.CcT = (bf16_t*)take((size_t)32 * 16 * 128 * 2);
  p.lam = (float2*)take(2048 * 8);
  p.lam64 = (float2*)take(2048 * 8);
  p.rope = (float2*)take((size_t)8192 * 16 * 8);
  p.rstd_x = (float*)take((size_t)NT * 4);
  p.cq_part = (float*)take((size_t)NT * 12 * 4);
  p.ckv_part = (float*)take((size_t)NT * 4 * 4);
  p.attn_part = (float*)take((size_t)NT * 8 * 4);
  p.ssm_part = (float*)take((size_t)NT * 8 * 4);
  p.h_part = (float*)take((size_t)NT * 16 * 4);
  p.out_part = (float*)take((size_t)NT * 16 * 4);
  p.counters = (int*)take(16384);
  p.E = (float2*)take((size_t)8 * 128 * 32 * 64 * 8);
  p.S = (float2*)take((size_t)8 * 128 * 32 * 64 * 8);
  const size_t a0 = off;
  p.Kn = (bf16_t*)take((size_t)NK * 512 * 2);
  const size_t aVt = off;
  p.Vt = (bf16_t*)take((size_t)NK * 512 * 2);
  p.Q = (bf16_t*)take((size_t)NT * 768 * 2);
  p.latb = (bf16_t*)take((size_t)NK * 256 * 2);
  p.krb = (bf16_t*)take((size_t)NK * 32 * 2);
  p.ub = (bf16_t*)take((size_t)NT * 512 * 2);
  const size_t aSsmY = off;
  p.ssm_y = (bf16_t*)take((size_t)NT * 512 * 2);
  p.mix = (bf16_t*)take((size_t)NT * 1024 * 2);
  const size_t total = off;
  p.xb = (bf16_t*)(base + a0);
  p.cq = (bf16_t*)(base + aVt);
  p.ckv_raw = (float*)(base + aVt + al256((size_t)NT * 768 * 2));
  p.act = (bf16_t*)(base + a0);
  const size_t aHb = a0 + al256((size_t)NT * 4096 * 2);
  p.hb = (bf16_t*)(base + aHb);
  if (aHb + (size_t)NT * 1024 * 2 > aSsmY || total > ws_size) { fprintf(stderr, "workspace layout error: total %zu ws %zu\n", total, ws_size); return; }

  const int MULTI = 0;
  hipMemsetAsync(p.counters, 0, 16384, stream);
  if (MULTI) {
    for (int ph = 0; ph < NPHASE; ++ph) {
      p.ph_lo = ph; p.ph_hi = ph + 1;
      hipLaunchKernelGGL(mega<false>, dim3(512), dim3(256), 0, stream, p);
    }
  } else {
    static int grid_blocks = 0;
    if (!grid_blocks) {
      int dev = 0, cus = 0, per_cu = 0;
      hipGetDevice(&dev);
      hipDeviceGetAttribute(&cus, hipDeviceAttributeMultiprocessorCount, dev);
      hipOccupancyMaxActiveBlocksPerMultiprocessor(&per_cu, mega<true>, 256, 0);
      grid_blocks = cus * per_cu;
    }
    p.ph_lo = 0; p.ph_hi = NPHASE;
    void* args[] = {&p};
    hipError_t e = hipLaunchCooperativeKernel((void*)mega<true>, dim3(grid_blocks), dim3(256), args, 0, stream);
    if (e != hipSuccess) fprintf(stderr, "cooperative launch failed: %s (grid %d)\n", hipGetErrorString(e), grid_blocks);
  }
}
```

```cpp
#include <hip/hip_runtime.h>
#include <hip/hip_cooperative_groups.h>
#include <stdint.h>
#include <cstdio>
namespace cg = cooperative_groups;
#define DI __device__ __forceinline__

typedef unsigned short bf16_t;
typedef short bf16x8 __attribute__((ext_vector_type(8)));
typedef float f32x16 __attribute__((ext_vector_type(16)));
typedef float f32x4 __attribute__((ext_vector_type(4)));
typedef unsigned u32x4 __attribute__((ext_vector_type(4)));
typedef unsigned u32x2 __attribute__((ext_vector_type(2)));

constexpr int NTP = 65536, NTS = 2048, NT = NTP + NTS, NK = NTP + 32 * 4160;
constexpr int SKS = 4160;
constexpr size_t OFF_Y = 0;
constexpr size_t OFF_LATP = (size_t)NT * 1024;
constexpr size_t OFF_KRP = OFF_LATP + (size_t)NTP * 256;
constexpr size_t OFF_HRP = OFF_KRP + (size_t)NTP * 32;
constexpr size_t OFF_HIP = OFF_HRP + 8 * 32 * 64;
constexpr size_t OFF_LATS = OFF_HIP + 8 * 32 * 64;
constexpr size_t OFF_KRS = OFF_LATS + (size_t)NTS * 256;
constexpr size_t OFF_HRS = OFF_KRS + (size_t)NTS * 32;
constexpr size_t OFF_HIS = OFF_HRS + 32 * 32 * 64;
constexpr size_t VT_S_OFF = (size_t)8 * 512 * 8192;
constexpr float EPS = 1e-6f;
constexpr int LDS_BYTES = 67600;
constexpr int NPHASE = 10;
constexpr int AQT = 1, NQQ = 128 / (4 / (64 / (32 * AQT)));

struct Params {
  const float* in[28];
  float* out;
  bf16_t *WinT, *WqT, *WkT, *WvT, *WgT, *WoT, *WuT, *WdT, *BbT, *CcT;
  float2 *lam, *lam64, *rope;
  float *rstd_x, *cq_part, *ckv_part, *attn_part, *ssm_part, *h_part, *out_part;
  int* counters;
  float2 *E, *S;
  bf16_t *Kn, *Vt, *Q, *latb, *krb, *ub, *ssm_y, *mix, *xb, *cq, *hb, *act;
  float* ckv_raw;
  int ph_lo, ph_hi;
};

DI int tid() { int t = __builtin_amdgcn_workitem_id_x(); asm volatile("" : "+v"(t)); return t; }
typedef __bf16 nbf16x2 __attribute__((ext_vector_type(2)));
typedef float f32x2 __attribute__((ext_vector_type(2)));
DI unsigned pk_bf16(float lo, float hi) { f32x2 v = {lo, hi}; return __builtin_bit_cast(unsigned, __builtin_convertvector(v, nbf16x2)); }
DI bf16_t f2bf(float x) { return (bf16_t)(pk_bf16(x, 0.f) & 0xffffu); }
DI float bf2f(bf16_t v) { return __uint_as_float(((unsigned)v) << 16); }
DI int crow(int i, int hh) { return (i & 3) + 8 * (i >> 2) + 4 * hh; }
DI const float* xrow(const Params& p, int row) { return row < NTP ? p.in[0] + (size_t)row * 1024 : p.in[1] + (size_t)(row - NTP) * 1024; }
DI int pos_of(int row) { return row < NTP ? (row & 8191) : 4096 + ((row - NTP) & 63); }
DI int kr_of(int row) { return row < NTP ? row : NTP + ((row - NTP) >> 6) * SKS + 4096 + ((row - NTP) & 63); }
#define MFMA32(a, b, c) __builtin_amdgcn_mfma_f32_32x32x16_bf16((a), (b), (c), 0, 0, 0)
#define MFMA16(a, b, c) __builtin_amdgcn_mfma_f32_16x16x32_bf16((a), (b), (c), 0, 0, 0)

DI void sincos_d(double x, double& s4, double& c4) {
  double k = rint(x * 0.15915494309189535);
  double rr = fma(-k, 6.283185307179586, x);
  rr = fma(-k, 2.4492935982947064e-16, rr);
  double y = rr * 0.25, y2 = y * y;
  double s = y * (1 - y2 / 6 * (1 - y2 / 20 * (1 - y2 / 42 * (1 - y2 / 72 * (1 - y2 / 110 * (1 - y2 / 156 * (1 - y2 / 210)))))));
  double c = 1 - y2 / 2 * (1 - y2 / 12 * (1 - y2 / 30 * (1 - y2 / 56 * (1 - y2 / 90 * (1 - y2 / 132 * (1 - y2 / 182))))));
  double s2 = 2 * s * c, c2 = 1 - 2 * s * s;
  s4 = 2 * s2 * c2; c4 = 1 - 2 * s2 * s2;
}

DI void gemm_core(const bf16_t* __restrict__ A, int lda, const bf16_t* __restrict__ B, int ldb, int nk,
                  int m0, int n0, char* lds, f32x16 (&acc)[2][2], int midk, const float* ratio) {
  const int t = tid(), lane = t & 63, wid = t >> 6, wm = wid >> 1, wn = wid & 1;
  const int r = lane & 31, hh = lane >> 5;
  const int lc = t & 7, lr = t >> 3;
  const unsigned woff = lr * 128 + ((lc ^ ((lr >> 1) & 7)) << 4);
  const bf16_t* ga = A + (size_t)(m0 + lr) * lda + lc * 8;
  const bf16_t* gb = B + (size_t)(n0 + lr) * ldb + lc * 8;
  char* sA = lds; char* sB = lds + 32768;
  u32x4 ra[4], rb[4];
#pragma unroll
  for (int i = 0; i < 4; ++i) { ra[i] = *(const u32x4*)(ga + (size_t)(32 * i) * lda); rb[i] = *(const u32x4*)(gb + (size_t)(32 * i) * ldb); }
#pragma unroll
  for (int i = 0; i < 4; ++i) { *(u32x4*)(sA + woff + i * 4096) = ra[i]; *(u32x4*)(sB + woff + i * 4096) = rb[i]; }
#pragma unroll
  for (int a = 0; a < 2; ++a)
#pragma unroll
    for (int b = 0; b < 2; ++b)
#pragma unroll
      for (int i = 0; i < 16; ++i) acc[a][b][i] = 0.f;
  __syncthreads();
  const int rsw = (r >> 1) & 7;
  const unsigned aoff = (wm * 64 + r) * 128, boff = (wn * 64 + r) * 128;
  for (int kt = 0; kt < nk; ++kt) {
    const int cur = kt & 1;
    const bool more = (kt + 1 < nk);
    if (more) {
      const bf16_t* ga2 = ga + (kt + 1) * 64; const bf16_t* gb2 = gb + (kt + 1) * 64;
#pragma unroll
      for (int i = 0; i < 4; ++i) { ra[i] = *(const u32x4*)(ga2 + (size_t)(32 * i) * lda); rb[i] = *(const u32x4*)(gb2 + (size_t)(32 * i) * ldb); }
    }
    if (midk && kt == midk) {
#pragma unroll
      for (int mt = 0; mt < 2; ++mt)
      { const float f = ratio[wm * 64 + mt * 32 + r];
#pragma unroll
        for (int i = 0; i < 16; ++i) { acc[mt][0][i] *= f; acc[mt][1][i] *= f; } }
    }
    const char* cA = sA + cur * 16384; const char* cB = sB + cur * 16384;
#pragma unroll
    for (int ks = 0; ks < 4; ++ks) {
      const unsigned co = (((ks * 2 + hh) ^ rsw) << 4);
      const bf16x8 a0 = *(const bf16x8*)(cA + aoff + co), a1 = *(const bf16x8*)(cA + aoff + 4096 + co);
      const bf16x8 b0 = *(const bf16x8*)(cB + boff + co), b1 = *(const bf16x8*)(cB + boff + 4096 + co);
      acc[0][0] = MFMA32(b0, a0, acc[0][0]); acc[0][1] = MFMA32(b1, a0, acc[0][1]);
      acc[1][0] = MFMA32(b0, a1, acc[1][0]); acc[1][1] = MFMA32(b1, a1, acc[1][1]);
    }
    if (more) {
      char* nA = sA + (cur ^ 1) * 16384; char* nB = sB + (cur ^ 1) * 16384;
#pragma unroll
      for (int i = 0; i < 4; ++i) { *(u32x4*)(nA + woff + i * 4096) = ra[i]; *(u32x4*)(nB + woff + i * 4096) = rb[i]; }
    }
    __syncthreads();
  }
}

DI void rowscale_load(float* rs, const float* src, int np, float inv_dim, int m0) {
  const int t = tid();
  if (t < 128) {
    const int row = m0 + t;
    if (np == 0) rs[t] = src[row];
    else { float s = 0.f; for (int j = 0; j < np; ++j) s += src[(size_t)row * np + j]; rs[t] = rsqrtf(s * inv_dim + EPS); }
  }
}

template <bool BLKA = false, class TileFn, class RsFn, class EpiFn>
DI void gemm_stream(const bf16_t* __restrict__ A, int lda, const bf16_t* __restrict__ B, int ldb, int nk, char* lds, int midk,
                    TileFn tile_fn, RsFn rs_fn, EpiFn epi) {
  int m0, n0;
  if (!tile_fn(0, m0, n0)) return;
  const int t = tid(), lane = t & 63, wid = t >> 6, wm = wid >> 1, wn = wid & 1;
  const int r = lane & 31, hh = lane >> 5;
  const int lc = t & 7, lr = t >> 3;
  const unsigned woff = lr * 128 + ((lc ^ ((lr >> 1) & 7)) << 4);
  char* sA = lds; char* sB = lds + 32768;
  float* rsbuf = (float*)(lds + 65536);
  const int rsw = (r >> 1) & 7;
  const unsigned aoff = (wm * 64 + r) * 128, boff = (wn * 64 + r) * 128;
  int lj = 0, lkt = 0, lm0 = m0, ln0 = n0; bool lvalid = true;
  u32x4 ra0[4], rb0[4], ra1[4], rb1[4];
#define GS_LOAD(RA, RB) do {   \
        \
      const bf16_t* ga_ = BLKA ? A + ((size_t)(lm0 >> 7) * nk + lkt) * 8192 + lr * 64 + lc * 8 : A + (size_t)(lm0 + lr) * lda + lc * 8 + lkt * 64; const bf16_t* gb_ = B + (size_t)(ln0 + lr) * ldb + lc * 8 + lkt * 64; \
      _Pragma("unroll") for (int i = 0; i < 4; ++i) { RA[i] = *(const u32x4*)(ga_ + (size_t)(32 * i) * (BLKA ? 64 : lda)); RB[i] = *(const u32x4*)(gb_ + (size_t)(32 * i) * ldb); } \
      if (++lkt == nk) { lkt = 0; if (lvalid) { ++lj; lvalid = tile_fn(lj, lm0, ln0); } } } while (0)
  GS_LOAD(ra0, rb0);
  GS_LOAD(ra1, rb1);
  {
    float2 rv = make_float2(0.f, 0.f);
    if (t < 128) rv = rs_fn(m0, t);
    __syncthreads();
#pragma unroll
    for (int i = 0; i < 4; ++i) { *(u32x4*)(sA + woff + i * 4096) = ra0[i]; *(u32x4*)(sB + woff + i * 4096) = rb0[i]; }
    if (t < 128) { rsbuf[t] = rv.x; rsbuf[128 + t] = rv.y; }
    __syncthreads();
  }
  int cur = 0;
  for (int j = 0;; ++j) {
    int m1 = 0, n1 = 0;
    const bool has_next = tile_fn(j + 1, m1, n1);
    const float* rs = rsbuf + (j & 1) * 256;
    f32x16 acc[2][2];
#pragma unroll
    for (int a = 0; a < 2; ++a)
#pragma unroll
      for (int b = 0; b < 2; ++b)
#pragma unroll
        for (int i = 0; i < 16; ++i) acc[a][b][i] = 0.f;
#define GS_STEP(RL_A, RL_B, RW_A, RW_B, KT) do { \
      const bool last_ = ((KT) + 1 == nk); const bool wr_ = !last_ || has_next; \
      float2 rv_ = make_float2(0.f, 0.f); \
      if (last_ && has_next) { if (t < 128) rv_ = rs_fn(m1, t); asm volatile("" : "+v"(rv_.x), "+v"(rv_.y)); }   \
      GS_LOAD(RL_A, RL_B); \
      if (midk && (KT) == midk) { _Pragma("unroll") for (int mt = 0; mt < 2; ++mt) { const float f = rs[128 + wm * 64 + mt * 32 + r]; \
          _Pragma("unroll") for (int i = 0; i < 16; ++i) { acc[mt][0][i] *= f; acc[mt][1][i] *= f; } } } \
      const char* cA = sA + cur * 16384; const char* cB = sB + cur * 16384; \
      __builtin_amdgcn_iglp_opt(0); \
      _Pragma("unroll") for (int ks = 0; ks < 4; ++ks) { \
        const unsigned co = (((ks * 2 + hh) ^ rsw) << 4); \
        const bf16x8 a0 = *(const bf16x8*)(cA + aoff + co), a1 = *(const bf16x8*)(cA + aoff + 4096 + co); \
        const bf16x8 b0 = *(const bf16x8*)(cB + boff + co), b1 = *(const bf16x8*)(cB + boff + 4096 + co); \
        acc[0][0] = MFMA32(b0, a0, acc[0][0]); acc[0][1] = MFMA32(b1, a0, acc[0][1]); \
        acc[1][0] = MFMA32(b0, a1, acc[1][0]); acc[1][1] = MFMA32(b1, a1, acc[1][1]); } \
      if (wr_) { char* nA = sA + (cur ^ 1) * 16384; char* nB = sB + (cur ^ 1) * 16384; \
        _Pragma("unroll") for (int i = 0; i < 4; ++i) { *(u32x4*)(nA + woff + i * 4096) = RW_A[i]; *(u32x4*)(nB + woff + i * 4096) = RW_B[i]; } \
        if (last_ && t < 128) { float* rn = rsbuf + ((j + 1) & 1) * 256; rn[t] = rv_.x; rn[128 + t] = rv_.y; } } \
      __syncthreads(); cur ^= 1; } while (0)
    for (int kt = 0; kt < nk; kt += 2) {
      GS_STEP(ra0, rb0, ra1, rb1, kt);
      GS_STEP(ra1, rb1, ra0, rb0, kt + 1);
    }
    epi(acc, m0, n0, rs, cur ^ 1);
    if (!has_next) break;
    m0 = m1; n0 = n1;
  }
#undef GS_STEP
#undef GS_LOAD
  __syncthreads();
}

DI float half_reduce(float s) {
  s += __shfl_xor(s, 1); s += __shfl_xor(s, 2); s += __shfl_xor(s, 4); s += __shfl_xor(s, 8); s += __shfl_xor(s, 16); return s;
}

#define EPI_IDS int t = tid(); asm volatile("" : "+v"(t)); const int lane = t & 63, wid = t >> 6, wm = wid >> 1, wn = wid & 1, r = lane & 31, hh = lane >> 5; (void)lane; (void)wid; (void)wm; (void)wn; (void)r; (void)hh;
#define GEMM_IDS const int t = tid(), lane = t & 63, wid = t >> 6, wm = wid >> 1, wn = wid & 1, r = lane & 31, hh = lane >> 5; (void)t; (void)wm; (void)wn; (void)r; (void)hh;

DI char* wave_stage(char* lds, int fstage, int wid) { return lds + (wid < 2 ? 0 : 32768) + fstage * 16384 + (wid & 1) * 8192; }
DI void wave_store64(char* stg, const u32x2 (&w)[2][2][4], bf16_t* gdst, size_t row_stride, int lane, int r, int hh) {
#pragma unroll
  for (int mt = 0; mt < 2; ++mt)
#pragma unroll
    for (int nt = 0; nt < 2; ++nt)
#pragma unroll
      for (int i4 = 0; i4 < 4; ++i4) { const int rloc = mt * 32 + r; *(u32x2*)(stg + rloc * 128 + (((nt * 4 + i4) ^ (rloc & 7)) << 4) + hh * 8) = w[mt][nt][i4]; }
  asm volatile("s_waitcnt lgkmcnt(0)" ::: "memory");
  __builtin_amdgcn_wave_barrier();
#pragma unroll
  for (int s8 = 0; s8 < 8; ++s8) {
    const int rloc = s8 * 8 + (lane >> 3), c = lane & 7;
    const u32x4 q = *(const u32x4*)(stg + rloc * 128 + ((c ^ (rloc & 7)) << 4));
    *(u32x4*)(gdst + (size_t)rloc * row_stride + c * 8) = q;
  }
}

DI void wave_load64(char* stg, u32x2 (&w)[2][2][4], const bf16_t* gsrc, size_t row_stride, int lane, int r, int hh) {
  u32x4 q[8];
#pragma unroll
  for (int s8 = 0; s8 < 8; ++s8) { const int rloc = s8 * 8 + (lane >> 3), c = lane & 7; q[s8] = *(const u32x4*)(gsrc + (size_t)rloc * row_stride + c * 8); }
#pragma unroll
  for (int s8 = 0; s8 < 8; ++s8) { const int rloc = s8 * 8 + (lane >> 3), c = lane & 7; *(u32x4*)(stg + rloc * 128 + ((c ^ (rloc & 7)) << 4)) = q[s8]; }
  asm volatile("s_waitcnt lgkmcnt(0)" ::: "memory");
  __builtin_amdgcn_wave_barrier();
#pragma unroll
  for (int mt = 0; mt < 2; ++mt)
#pragma unroll
    for (int nt = 0; nt < 2; ++nt)
#pragma unroll
      for (int i4 = 0; i4 < 4; ++i4) { const int rloc = mt * 32 + r; w[mt][nt][i4] = *(const u32x2*)(stg + rloc * 128 + (((nt * 4 + i4) ^ (rloc & 7)) << 4) + hh * 8); }
  asm volatile("s_waitcnt lgkmcnt(0)" ::: "memory");
  __builtin_amdgcn_wave_barrier();
}
DI void wave_add64_f32(char* stg, f32x16 (&a)[2][2], const float* gsrc, size_t row_stride, int lane, int r, int hh) {
#pragma unroll
  for (int mt = 0; mt < 2; ++mt) {
    f32x4 q[8];
#pragma unroll
    for (int s8 = 0; s8 < 8; ++s8) { const int row = s8 * 4 + (lane >> 4), c = lane & 15; q[s8] = *(const f32x4*)(gsrc + (size_t)(mt * 32 + row) * row_stride + c * 4); }
#pragma unroll
    for (int s8 = 0; s8 < 8; ++s8) { const int row = s8 * 4 + (lane >> 4), c = lane & 15; *(f32x4*)(stg + row * 256 + ((c ^ (row & 15)) << 4)) = q[s8]; }
    asm volatile("s_waitcnt lgkmcnt(0)" ::: "memory");
    __builtin_amdgcn_wave_barrier();
#pragma unroll
    for (int nt = 0; nt < 2; ++nt)
#pragma unroll
      for (int i4 = 0; i4 < 4; ++i4) {
        const f32x4 xv = *(const f32x4*)(stg + r * 256 + (((nt * 8 + 2 * i4 + hh) ^ (r & 15)) << 4));
#pragma unroll
        for (int jj = 0; jj < 4; ++jj) a[mt][nt][4 * i4 + jj] += xv[jj];
      }
    asm volatile("s_waitcnt lgkmcnt(0)" ::: "memory");
    __builtin_amdgcn_wave_barrier();
  }
}
DI void wave_store64_f32(char* stg, const f32x16 (&a)[2][2], float* gdst, size_t row_stride, int lane, int r, int hh) {
#pragma unroll
  for (int mt = 0; mt < 2; ++mt) {
#pragma unroll
    for (int nt = 0; nt < 2; ++nt)
#pragma unroll
      for (int i4 = 0; i4 < 4; ++i4) {
        const f32x4 v = {a[mt][nt][4 * i4], a[mt][nt][4 * i4 + 1], a[mt][nt][4 * i4 + 2], a[mt][nt][4 * i4 + 3]};
        *(f32x4*)(stg + r * 256 + (((nt * 8 + 2 * i4 + hh) ^ (r & 15)) << 4)) = v;
      }
    asm volatile("s_waitcnt lgkmcnt(0)" ::: "memory");
    __builtin_amdgcn_wave_barrier();
#pragma unroll
    for (int s8 = 0; s8 < 8; ++s8) {
      const int row = s8 * 4 + (lane >> 4), c = lane & 15;
      const f32x4 q = *(const f32x4*)(stg + row * 256 + ((c ^ (row & 15)) << 4));
      *(f32x4*)(gdst + (size_t)(mt * 32 + row) * row_stride + c * 4) = q;
    }
    asm volatile("s_waitcnt lgkmcnt(0)" ::: "memory");
    __builtin_amdgcn_wave_barrier();
  }
}

DI void transpose_tile(const float* __restrict__ src, int ld, int K, int kt, int nt, int job, const float* g0, const float* g1, bf16_t* __restrict__ dst, char* lds) {
  bf16_t* tile = (bf16_t*)lds;
  const int t = tid(), nl = t & 63, kq = t >> 6;
  const int n = nt * 64 + nl;
  int c = n;
  if (job == 0) { c = n < 1024 ? n : (n < 1536 ? 1056 + (n - 1024) : (n < 1568 ? 1024 + (n - 1536) : -1)); }
  else if (job == 2) c = (n >> 6) * 128 + (n & 63);
  else if (job == 3) c = (n >> 6) * 128 + 64 + (n & 63);
#pragma unroll 4
  for (int pass = 0; pass < 16; ++pass) {
    const int kl = pass * 4 + kq, k = kt * 64 + kl;
    float v = 0.f;
    if (c >= 0) {
      v = src[(size_t)k * ld + c];
      if (g0) { const float g = (g1 && k >= 512) ? g1[k - 512] : g0[k]; v *= g; }
    }
    tile[nl * 66 + kl] = f2bf(v);
  }
  __syncthreads();
  const int kl = t & 63;
#pragma unroll 4
  for (int pass = 0; pass < 16; ++pass) { const int nl2 = pass * 4 + kq; dst[(size_t)(nt * 64 + nl2) * K + kt * 64 + kl] = tile[nl2 * 66 + kl]; }
  __syncthreads();
}

DI void phase0(const Params& p, char* lds) {
  const int t = tid(), nb = gridDim.x, bid = blockIdx.x, lane = t & 63, wid = t >> 6;
  for (int ti = bid; ti < 2992; ti += nb) {
    int job, base, nNt, ld, K; const float* src; const float* g0 = nullptr; const float* g1 = nullptr; bf16_t* dst;
    if (ti < 416) { job = 0; base = 0; nNt = 26; ld = 1568; K = 1024; src = p.in[7]; g0 = p.in[6]; dst = p.WinT; }
    else if (ti < 560) { job = 1; base = 416; nNt = 12; ld = 768; K = 768; src = p.in[9]; g0 = p.in[8]; dst = p.WqT; }
    else if (ti < 592) { job = 2; base = 560; nNt = 8; ld = 1024; K = 256; src = p.in[11]; dst = p.WkT; }
    else if (ti < 624) { job = 3; base = 592; nNt = 8; ld = 1024; K = 256; src = p.in[11]; dst = p.WvT; }
    else if (ti < 688) { job = 4; base = 624; nNt = 8; ld = 512; K = 512; src = p.in[20]; dst = p.WgT; }
    else if (ti < 944) { job = 5; base = 688; nNt = 16; ld = 1024; K = 1024; src = p.in[23]; g0 = p.in[21]; g1 = p.in[22]; dst = p.WoT; }
    else if (ti < 1968) { job = 6; base = 944; nNt = 64; ld = 4096; K = 1024; src = p.in[25]; g0 = p.in[24]; dst = p.WuT; }
    else { job = 7; base = 1968; nNt = 16; ld = 1024; K = 4096; src = p.in[26]; dst = p.WdT; }
    const int tile = ti - base;
    transpose_tile(src, ld, K, tile / nNt, tile % nNt, job, g0, g1, dst, lds);
  }
  for (int row = bid * 4 + wid; row < NT; row += nb * 4) {
    const float* x = xrow(p, row);
    f32x4 v[4]; float ss = 0.f;
#pragma unroll
    for (int j = 0; j < 4; ++j) { v[j] = *(const f32x4*)(x + lane * 4 + 256 * j); ss += v[j][0] * v[j][0] + v[j][1] * v[j][1] + v[j][2] * v[j][2] + v[j][3] * v[j][3]; }
    ss += __shfl_xor(ss, 32); ss = half_reduce(ss);
#pragma unroll
    for (int j = 0; j < 4; ++j) { u32x2 w; w.x = pk_bf16(v[j][0], v[j][1]); w.y = pk_bf16(v[j][2], v[j][3]); *(u32x2*)(p.xb + (size_t)row * 1024 + lane * 4 + 256 * j) = w; }
    if (lane == 0) p.rstd_x[row] = rsqrtf(ss * (1.f / 1024.f) + EPS);
  }
  const int gt = bid * 256 + t, ngt = nb * 256;
  for (int v = gt; v < 32 * 4096 * 32; v += ngt) {
    const size_t e0 = (size_t)v * 8; const int b = (int)(e0 >> 20), rem = (int)(e0 & 1048575), tt = rem >> 8, c = rem & 255;
    const f32x4 a = *(const f32x4*)(p.in[2] + e0), bq = *(const f32x4*)(p.in[2] + e0 + 4);
    u32x4 w; w.x = pk_bf16(a[0], a[1]); w.y = pk_bf16(a[2], a[3]); w.z = pk_bf16(bq[0], bq[1]); w.w = pk_bf16(bq[2], bq[3]);
    *(u32x4*)(p.latb + (size_t)(NTP + b * SKS + tt) * 256 + c) = w;
  }
  for (int v = gt; v < 32 * 4096 * 4; v += ngt) {
    const size_t e0 = (size_t)v * 8; const int b = (int)(e0 >> 17), rem = (int)(e0 & 131071), tt = rem >> 5, c = rem & 31;
    const f32x4 a = *(const f32x4*)(p.in[3] + e0), bq = *(const f32x4*)(p.in[3] + e0 + 4);
    u32x4 w; w.x = pk_bf16(a[0], a[1]); w.y = pk_bf16(a[2], a[3]); w.z = pk_bf16(bq[0], bq[1]); w.w = pk_bf16(bq[2], bq[3]);
    *(u32x4*)(p.krb + (size_t)(NTP + b * SKS + tt) * 32 + c) = w;
  }
  if (gt < 2048) {
    const int g = gt >> 6, n = gt & 63;
    const double dt = (double)expf(p.in[14][g]);
    const double lr = p.in[12][gt], li = p.in[13][gt];
    const double mag = (double)expf((float)(lr * dt)); double s, c; sincos_d(li * dt, s, c);
    const double lbr = mag * c, lbi = mag * s;
    const double nr = lbr - 1.0, ni = lbi, den = lr * lr + li * li;
    const double cr = (nr * lr + ni * li) / den, ci = (ni * lr - nr * li) / den;
    p.lam[gt] = make_float2((float)lbr, (float)lbi);
    const double mag64 = (double)expf((float)(64.0 * lr * dt)); sincos_d(64.0 * li * dt, s, c);
    p.lam64[gt] = make_float2((float)(mag64 * c), (float)(mag64 * s));
    for (int q = 0; q < 16; ++q) {
      const double br = p.in[15][(size_t)gt * 16 + q], bi = p.in[16][(size_t)gt * 16 + q];
      p.BbT[(size_t)(g * 128 + n) * 16 + q] = f2bf((float)(cr * br - ci * bi));
      p.BbT[(size_t)(g * 128 + 64 + n) * 16 + q] = f2bf((float)(cr * bi + ci * br));
      p.CcT[(size_t)(g * 16 + q) * 128 + n] = f2bf(p.in[17][(size_t)(g * 16 + q) * 64 + n]);
      p.CcT[(size_t)(g * 16 + q) * 128 + 64 + n] = f2bf(-p.in[18][(size_t)(g * 16 + q) * 64 + n]);
    }
  }
  for (int e = gt; e < 8192 * 16; e += ngt) {
    const int pos = e >> 4, i = e & 15;
    const float inv = expf(-(float)i * (9.210340371976184f / 16.0f));
    const float ang = (float)pos * inv;
    double s, c; sincos_d((double)ang, s, c);
    p.rope[e] = make_float2((float)c, (float)s);
  }
}

DI void phase1(const Params& p, char* lds) {
  float* rs = (float*)(lds + 65536);
  const int ntiles = 528 * 13;
  {
    auto tile_fn = [&](int j, int& m0, int& n0) -> bool { const int li = (int)(blockIdx.x >> 3) + j * (int)(gridDim.x >> 3); const int ti_ = li / 13, tj_ = li - ti_ * 13; const int tbig = ti_ * 8 + (int)(blockIdx.x & 7); if (tbig >= 528) return false; m0 = tbig * 128; n0 = tj_ * 128; return true; };
    auto rs_fn = [&](int m0, int t) -> float2 { return make_float2(p.rstd_x[m0 + t], 0.f); };
    auto epi = [&](f32x16 (&acc)[2][2], int m0, int n0, const float* rs, int fstage) { (void)fstage;
    const int tn = n0 >> 7; (void)tn;
    { EPI_IDS
    u32x2 wq[2][2][4];
    if (tn < 8) {
#pragma unroll
      for (int mt = 0; mt < 2; ++mt) {
        const int rl = wm * 64 + mt * 32 + r, row = m0 + rl;
        const float sc = rs[rl];
        float ss = 0.f;
#pragma unroll
        for (int nt = 0; nt < 2; ++nt)
#pragma unroll
          for (int i4 = 0; i4 < 4; ++i4) {
            const float v0 = acc[mt][nt][4 * i4] * sc, v1 = acc[mt][nt][4 * i4 + 1] * sc, v2 = acc[mt][nt][4 * i4 + 2] * sc, v3 = acc[mt][nt][4 * i4 + 3] * sc;
            ss += v0 * v0 + v1 * v1 + v2 * v2 + v3 * v3;
            const int col = n0 + wn * 64 + nt * 32 + 8 * i4 + 4 * hh;
            if (tn < 6) { wq[mt][nt][i4].x = pk_bf16(v0, v1); wq[mt][nt][i4].y = pk_bf16(v2, v3); }
            else { acc[mt][nt][4 * i4] = v0; acc[mt][nt][4 * i4 + 1] = v1; acc[mt][nt][4 * i4 + 2] = v2; acc[mt][nt][4 * i4 + 3] = v3; }
          }
        ss += __shfl_xor(ss, 32);
        if (hh == 0) { if (tn < 6) p.cq_part[(size_t)row * 12 + tn * 2 + wn] = ss; else p.ckv_part[(size_t)row * 4 + (tn - 6) * 2 + wn] = ss; }
      }
      if (tn < 6) wave_store64(wave_stage(lds, fstage, wid), wq, p.cq + (size_t)(m0 + wm * 64) * 768 + n0 + wn * 64, 768, lane, r, hh);
      else wave_store64_f32(wave_stage(lds, fstage, wid), acc, p.ckv_raw + (size_t)(m0 + wm * 64) * 256 + (n0 - 768) + wn * 64, 256, lane, r, hh);
    } else if (tn < 12) {
#pragma unroll
      for (int mt = 0; mt < 2; ++mt) {
        const int rl = wm * 64 + mt * 32 + r, row = m0 + rl;
        const float sc = rs[rl];
#pragma unroll
        for (int nt = 0; nt < 2; ++nt)
#pragma unroll
          for (int i4 = 0; i4 < 4; ++i4) {
            wq[mt][nt][i4].x = pk_bf16(acc[mt][nt][4 * i4] * sc, acc[mt][nt][4 * i4 + 1] * sc); wq[mt][nt][i4].y = pk_bf16(acc[mt][nt][4 * i4 + 2] * sc, acc[mt][nt][4 * i4 + 3] * sc);
          }
      }
      wave_store64(wave_stage(lds, fstage, wid), wq, p.ub + (size_t)(m0 + wm * 64) * 512 + (n0 - 1024) + wn * 64, 512, lane, r, hh);
    } else if (wn == 0) {
#pragma unroll
      for (int mt = 0; mt < 2; ++mt) {
        const int rl = wm * 64 + mt * 32 + r, row = m0 + rl;
        const float sc = rs[rl];
        float* dst = row < NTP ? p.out + OFF_KRP + (size_t)row * 32 : p.out + OFF_KRS + (size_t)(row - NTP) * 32;
        bf16_t* dkb = p.krb + (size_t)kr_of(row) * 32;
        const float* rp = (const float*)(p.rope + pos_of(row) * 16);
#pragma unroll
        for (int ih = 0; ih < 2; ++ih) {
          const int j0 = 8 * ih + 4 * hh;
          const f32x4 c01 = *(const f32x4*)(rp + 2 * j0), c23 = *(const f32x4*)(rp + 2 * j0 + 4);
          const float cc[4] = {c01[0], c01[2], c23[0], c23[2]}, sn[4] = {c01[1], c01[3], c23[1], c23[3]};
          f32x4 o1, o2;
#pragma unroll
          for (int jj = 0; jj < 4; ++jj) {
            const float x1 = acc[mt][0][4 * ih + jj] * sc, x2 = acc[mt][0][8 + 4 * ih + jj] * sc;
            o1[jj] = x1 * cc[jj] - x2 * sn[jj]; o2[jj] = x1 * sn[jj] + x2 * cc[jj];
          }
          *(f32x4*)(dst + j0) = o1; *(f32x4*)(dst + 16 + j0) = o2;
          u32x2 w1, w2; w1.x = pk_bf16(o1[0], o1[1]); w1.y = pk_bf16(o1[2], o1[3]); w2.x = pk_bf16(o2[0], o2[1]); w2.y = pk_bf16(o2[2], o2[3]);
          *(u32x2*)(dkb + j0) = w1; *(u32x2*)(dkb + 16 + j0) = w2;
        }
      }
    }
    }
    __syncthreads();
    };
    gemm_stream(p.xb, 1024, p.WinT, 1024, 16, lds, 0, tile_fn, rs_fn, epi);
  }
}

DI void ssm_chunk(const Params& p, int row0, int g, float& hr, float& hi, bool write_y, char* lds_w) {
  const int lane = tid() & 63, r = lane & 31, hh = lane >> 5;
  const float2 lm = p.lam[g * 64 + lane];
  bf16x8 bfr[4];
#pragma unroll
  for (int nt = 0; nt < 4; ++nt) bfr[nt] = *(const bf16x8*)(p.BbT + (size_t)(g * 128 + nt * 32 + r) * 16 + hh * 8);
  const int fr = lane & 15, fq = lane >> 4;
  bf16x8 cfr[4];
#pragma unroll
  for (int ks = 0; ks < 4; ++ks) cfr[ks] = *(const bf16x8*)(p.CcT + (size_t)(g * 16 + fr) * 128 + ks * 32 + fq * 8);
  const float dsk = p.in[19][g * 16 + fr];
#pragma unroll 1
  for (int sub = 0; sub < 2; ++sub) {
    const int rb = row0 + sub * 32;
    const bf16x8 uf = *(const bf16x8*)(p.ub + (size_t)(rb + r) * 512 + g * 16 + hh * 8);
    f32x16 z; for (int i = 0; i < 16; ++i) z[i] = 0.f;
    const f32x16 x0 = MFMA32(uf, bfr[0], z), x1 = MFMA32(uf, bfr[1], z), x2 = MFMA32(uf, bfr[2], z), x3 = MFMA32(uf, bfr[3], z);
    float xr0[16], xr1[16], xi0[16], xi1[16];
#pragma unroll
    for (int i = 0; i < 16; ++i) {
      const auto re = __builtin_amdgcn_permlane32_swap(__float_as_uint(x0[i]), __float_as_uint(x1[i]), false, false);
      const auto im = __builtin_amdgcn_permlane32_swap(__float_as_uint(x2[i]), __float_as_uint(x3[i]), false, false);
      xr0[i] = __uint_as_float(re[0]); xr1[i] = __uint_as_float(re[1]);
      xi0[i] = __uint_as_float(im[0]); xi1[i] = __uint_as_float(im[1]);
    }
    bf16_t* Hs = (bf16_t*)lds_w;
#pragma unroll
    for (int m = 0; m < 4; ++m) {
#pragma unroll
      for (int half = 0; half < 2; ++half) {
#pragma unroll
        for (int jj = 0; jj < 4; ++jj) {
          const int i = 4 * m + jj, tt = 8 * m + 4 * half + jj;
          const float xr = half ? xr1[i] : xr0[i], xi = half ? xi1[i] : xi0[i];
          const float nr = lm.x * hr - lm.y * hi + xr;
          const float ni = lm.x * hi + lm.y * hr + xi;
          hr = nr; hi = ni;
          if (write_y) { Hs[tt * 136 + lane] = f2bf(hr); Hs[tt * 136 + 64 + lane] = f2bf(hi); }
        }
      }
    }
    if (write_y) {
      asm volatile("s_waitcnt lgkmcnt(0)" ::: "memory");
      __builtin_amdgcn_wave_barrier();
#pragma unroll
      for (int mt = 0; mt < 2; ++mt) {
        f32x4 y = {0.f, 0.f, 0.f, 0.f};
#pragma unroll
        for (int ks = 0; ks < 4; ++ks) {
          const bf16x8 hf = *(const bf16x8*)(Hs + (mt * 16 + fr) * 136 + ks * 32 + fq * 8);
          y = MFMA16(hf, cfr[ks], y);
        }
#pragma unroll
        for (int j = 0; j < 4; ++j) {
          const int row = rb + mt * 16 + fq * 4 + j;
          const float u = bf2f(p.ub[(size_t)row * 512 + g * 16 + fr]);
          const float v = y[j] + dsk * u;
          const float zz = 0.7978845608028654f * (v + 0.044715f * v * v * v);
          const float th = 1.f - 2.f / (__expf(2.f * zz) + 1.f);
          p.ssm_y[(size_t)row * 512 + g * 16 + fr] = f2bf(0.5f * v * (1.f + th));
        }
      }
      asm volatile("s_waitcnt lgkmcnt(0)" ::: "memory");
      __builtin_amdgcn_wave_barrier();
    }
  }
}

DI void phase2(const Params& p, char* lds) {
  const int lane = tid() & 63, wid = tid() >> 6;
  const int nb = gridDim.x, bid = blockIdx.x;
  for (int row = bid * 4 + wid; row < NT; row += nb * 4) {
    const f32x4 v = *(const f32x4*)(p.ckv_raw + (size_t)row * 256 + lane * 4);
    const f32x4 pp = *(const f32x4*)(p.ckv_part + (size_t)row * 4);
    const float rstd = rsqrtf((pp[0] + pp[1] + pp[2] + pp[3]) * (1.f / 256.f) + EPS);
    const f32x4 g = *(const f32x4*)(p.in[10] + lane * 4);
    f32x4 o; o[0] = v[0] * rstd * g[0]; o[1] = v[1] * rstd * g[1]; o[2] = v[2] * rstd * g[2]; o[3] = v[3] * rstd * g[3];
    float* dst = row < NTP ? p.out + OFF_LATP + (size_t)row * 256 : p.out + OFF_LATS + (size_t)(row - NTP) * 256;
    *(f32x4*)(dst + lane * 4) = o;
    u32x2 w; w.x = pk_bf16(o[0], o[1]); w.y = pk_bf16(o[2], o[3]);
    *(u32x2*)(p.latb + (size_t)kr_of(row) * 256 + lane * 4) = w;
  }
  for (int it = bid * 4 + wid; it < 8 * 128 * 32; it += nb * 4) {
    const int g = it & 31, c = (it >> 5) & 127, b = it >> 12;
    float hr = 0.f, hi = 0.f;
    ssm_chunk(p, b * 8192 + c * 64, g, hr, hi, false, lds + wid * 8704);
    p.E[(size_t)it * 64 + lane] = make_float2(hr, hi);
  }
  float* rs = (float*)(lds + 65536);
  {
    auto tile_fn = [&](int j, int& m0, int& n0) -> bool { const int li = (int)(blockIdx.x >> 3) + j * (int)(gridDim.x >> 3); const int ti_ = li / 6, tj_ = li - ti_ * 6; const int tbig = ti_ * 8 + (int)(blockIdx.x & 7); if (tbig >= 528) return false; m0 = tbig * 128; n0 = tj_ * 128; return true; };
    auto rs_fn = [&](int m0, int t) -> float2 { float sm = 0.f; for (int q = 0; q < 3; ++q) { const f32x4 v = *(const f32x4*)(p.cq_part + (size_t)(m0 + t) * 12 + 4 * q); sm += (v[0] + v[1]) + (v[2] + v[3]); } return make_float2(rsqrtf(sm * (1.f / 768.f) + EPS), 0.f); };
    auto epi = [&](f32x16 (&acc)[2][2], int m0, int n0, const float* rs, int fstage) { (void)fstage;
    const int tn = n0 >> 7; (void)tn;
    EPI_IDS
    const float qs = 0.10206207261596577f * 1.4426950408889634f;
    u32x2 wq[2][2][4];
#pragma unroll
    for (int mt = 0; mt < 2; ++mt) {
      const int rl = wm * 64 + mt * 32 + r, row = m0 + rl;
      const float sc = rs[rl] * qs;
      const float* rp = (const float*)(p.rope + pos_of(row) * 16);
#pragma unroll
      for (int nt = 0; nt < 2; ++nt) {
        const int cb = n0 + wn * 64 + nt * 32;
        if ((cb % 96) == 64) {
#pragma unroll
          for (int ih = 0; ih < 2; ++ih) {
            const int j0 = 8 * ih + 4 * hh;
            const f32x4 c01 = *(const f32x4*)(rp + 2 * j0), c23 = *(const f32x4*)(rp + 2 * j0 + 4);
            const float cc[4] = {c01[0], c01[2], c23[0], c23[2]}, sn[4] = {c01[1], c01[3], c23[1], c23[3]};
            float o1[4], o2[4];
#pragma unroll
            for (int jj = 0; jj < 4; ++jj) {
              const float x1 = acc[mt][nt][4 * ih + jj] * sc, x2 = acc[mt][nt][8 + 4 * ih + jj] * sc;
              o1[jj] = x1 * cc[jj] - x2 * sn[jj]; o2[jj] = x1 * sn[jj] + x2 * cc[jj];
            }
            wq[mt][nt][ih].x = pk_bf16(o1[0], o1[1]); wq[mt][nt][ih].y = pk_bf16(o1[2], o1[3]); wq[mt][nt][ih + 2].x = pk_bf16(o2[0], o2[1]); wq[mt][nt][ih + 2].y = pk_bf16(o2[2], o2[3]);
          }
        } else {
#pragma unroll
          for (int i4 = 0; i4 < 4; ++i4) {
            wq[mt][nt][i4].x = pk_bf16(acc[mt][nt][4 * i4] * sc, acc[mt][nt][4 * i4 + 1] * sc); wq[mt][nt][i4].y = pk_bf16(acc[mt][nt][4 * i4 + 2] * sc, acc[mt][nt][4 * i4 + 3] * sc);
          }
        }
      }
    }

    wave_store64(wave_stage(lds, fstage, wid), wq, p.Q + (size_t)(m0 + wm * 64) * 768 + n0 + wn * 64, 768, lane, r, hh);
    __syncthreads();
    };
    gemm_stream(p.cq, 768, p.WqT, 768, 12, lds, 0, tile_fn, rs_fn, epi);
  }
}

DI void phase3(const Params& p, char* lds) {
  const int lane = tid() & 63, wid = tid() >> 6;
  const int nb = gridDim.x, bid = blockIdx.x;
  for (int it = bid * 4 + wid; it < 256; it += nb * 4) {
    const int b = it >> 5, g = it & 31;
    const float2 l64 = p.lam64[g * 64 + lane];
    float sr = 0.f, si = 0.f;
    const size_t base = ((size_t)(b * 128) * 32 + g) * 64 + lane;
    for (int c0 = 0; c0 < 128; c0 += 16) {
      float2 e[16];
#pragma unroll
      for (int j = 0; j < 16; ++j) e[j] = p.E[base + (size_t)(c0 + j) * 2048];
#pragma unroll
      for (int j = 0; j < 16; ++j) {
        p.S[base + (size_t)(c0 + j) * 2048] = make_float2(sr, si);
        const float nr = l64.x * sr - l64.y * si + e[j].x, ni = l64.x * si + l64.y * sr + e[j].y;
        sr = nr; si = ni;
      }
    }
  }
  {
    auto tile_fn = [&](int j, int& m0, int& n0) -> bool { const int li = (int)(blockIdx.x >> 3) + j * (int)(gridDim.x >> 3); const int ti_ = li / 4, tj_ = li - ti_ * 4; const int tbig = ti_ * 8 + (int)(blockIdx.x & 7); if (tbig >= 1552) return false; m0 = tbig * 128; n0 = tj_ * 128; return true; };
    auto rs_fn = [&](int m0, int t) -> float2 { return make_float2(0.f, 0.f); };
    auto epi = [&](f32x16 (&acc)[2][2], int m0, int n0, const float* rs, int fstage) { (void)fstage;
    const int tn = n0 >> 7; (void)tn;
    EPI_IDS
    u32x2 w[2][2][4];
#pragma unroll
    for (int mt = 0; mt < 2; ++mt)
#pragma unroll
      for (int nt = 0; nt < 2; ++nt)
#pragma unroll
        for (int i4 = 0; i4 < 4; ++i4) { w[mt][nt][i4].x = pk_bf16(acc[mt][nt][4 * i4], acc[mt][nt][4 * i4 + 1]); w[mt][nt][i4].y = pk_bf16(acc[mt][nt][4 * i4 + 2], acc[mt][nt][4 * i4 + 3]); }
    wave_store64(wave_stage(lds, fstage, wid), w, p.Kn + (size_t)(m0 + wm * 64) * 512 + n0 + wn * 64, 512, lane, r, hh);
    __syncthreads();
    };
    gemm_stream(p.latb, 256, p.WkT, 256, 4, lds, 0, tile_fn, rs_fn, epi);
  }
  {
    auto tile_fn = [&](int j, int& m0, int& n0) -> bool { const int li = (int)(blockIdx.x >> 3) + j * (int)(gridDim.x >> 3); const int ti_ = li / 4, tj_ = li - ti_ * 4; const int tbig = ti_ * 8 + (int)(blockIdx.x & 7); if (tbig >= 1552) return false; n0 = tbig * 128; m0 = tj_ * 128; return true; };
    auto rs_fn = [&](int m0, int t) -> float2 { return make_float2(0.f, 0.f); };
    auto epi = [&](f32x16 (&acc)[2][2], int m0, int n0, const float* rs, int fstage) { (void)fstage;
    const int tn = n0 >> 7; (void)tn;
    EPI_IDS
    u32x2 w[2][2][4];
#pragma unroll
    for (int mt = 0; mt < 2; ++mt)
#pragma unroll
      for (int nt = 0; nt < 2; ++nt)
#pragma unroll
        for (int i4 = 0; i4 < 4; ++i4) { w[mt][nt][i4].x = pk_bf16(acc[mt][nt][4 * i4], acc[mt][nt][4 * i4 + 1]); w[mt][nt][i4].y = pk_bf16(acc[mt][nt][4 * i4 + 2], acc[mt][nt][4 * i4 + 3]); }
    const int kr0 = n0 + wn * 64;
    size_t cbase; int S;
    if (kr0 < NTP) { cbase = (size_t)(kr0 >> 13) * 512 * 8192 + (kr0 & 8191); S = 8192; }
    else { const int k2 = kr0 - NTP, b = k2 / SKS, tt = k2 - b * SKS; cbase = VT_S_OFF + (size_t)b * 512 * SKS + tt; S = SKS; }
    wave_store64(wave_stage(lds, fstage, wid), w, p.Vt + cbase + (size_t)(m0 + wm * 64) * S, (size_t)S, lane, r, hh);
    __syncthreads();
    };
    gemm_stream(p.WvT, 256, p.latb, 256, 4, lds, 0, tile_fn, rs_fn, epi);
  }
}

template <int QT, bool HALF>
DI void attn_item(const Params& p, int kind, int b, int h, int qq, char* lds) {
  const int t = tid(), lane = t & 63, wid = t >> 6, r = lane & 31, hh = lane >> 5;
  int qrow0, nkb_w, nkb_max, S; size_t kr0; const bf16_t* vt_base;
  constexpr int RW = 32 * QT, WPC = 64 / RW, CPB = 4 / WPC;
  if (kind == 0) {
    const int c = qq * CPB + wid / WPC; qrow0 = b * 8192 + c * 64 + (wid % WPC) * RW; nkb_w = c + 1; nkb_max = qq * CPB + CPB; kr0 = (size_t)b * 8192; S = 8192;
    vt_base = p.Vt + (size_t)(b * 8 + h) * 64 * 8192;
  } else {
    qrow0 = NTP + b * 64 + (wid % WPC) * RW; nkb_w = (wid < WPC) ? 65 : 0; nkb_max = 65; kr0 = (size_t)NTP + (size_t)b * SKS; S = SKS;
    vt_base = p.Vt + VT_S_OFF + (size_t)(b * 8 + h) * 64 * SKS;
  }
  bf16x8 qf[QT][6];
#pragma unroll
  for (int qt = 0; qt < QT; ++qt)
#pragma unroll
    for (int ks = 0; ks < 6; ++ks) qf[qt][ks] = *(const bf16x8*)(p.Q + (size_t)(qrow0 + qt * 32 + r) * 768 + h * 96 + ks * 16 + hh * 8);
  f32x16 o[2][QT];
  float mrun[QT], lrun[QT];
#pragma unroll
  for (int qt = 0; qt < QT; ++qt) { mrun[qt] = -1e30f; lrun[qt] = 0.f;
#pragma unroll
    for (int dt = 0; dt < 2; ++dt)
#pragma unroll
      for (int i = 0; i < 16; ++i) o[dt][qt][i] = 0.f; }
  const int kkey = t >> 3, kc = t & 7;
  const int rkey = t >> 2, rc = t & 3;
  const int vd = t >> 3, vc = t & 7;
  const bf16_t* gk = p.Kn + (kr0 + kkey) * 512 + h * 64 + kc * 8;
  const bf16_t* gr = p.krb + (kr0 + rkey) * 32 + rc * 8;
  const bf16_t* gv = vt_base + (size_t)vd * S + vc * 8;
  const unsigned kw0 = kkey * 208 + kc * 16, kw1 = kw0 + 32 * 208, rw = rkey * 208 + 128 + rc * 16;
  const unsigned vlo = vd * 144 + (vc >> 1) * 32 + (vc & 1) * 8, vhi = vlo + 16;
  constexpr int KB = 13312, VB = 9216, BUF = KB + VB;
  u32x4 k0r, k1r, rr, v0r, v1r;
  k0r = *(const u32x4*)gk; k1r = *(const u32x4*)(gk + 32 * 512); rr = *(const u32x4*)gr;
  v0r = *(const u32x4*)gv; v1r = *(const u32x4*)(gv + (size_t)32 * S);
  __syncthreads();
  {
    char* kb_ = lds; char* vb_ = lds + KB;
    *(u32x4*)(kb_ + kw0) = k0r; *(u32x4*)(kb_ + kw1) = k1r; *(u32x4*)(kb_ + rw) = rr;
    *(u32x2*)(vb_ + vlo) = (u32x2){v0r.x, v0r.y}; *(u32x2*)(vb_ + vhi) = (u32x2){v0r.z, v0r.w};
    *(u32x2*)(vb_ + vlo + 32 * 144) = (u32x2){v1r.x, v1r.y}; *(u32x2*)(vb_ + vhi + 32 * 144) = (u32x2){v1r.z, v1r.w};
  }
  __syncthreads();
  for (int kb = 0; kb < nkb_max; ++kb) {
    const int cur = kb & 1;
    const bool more = kb + 1 < nkb_max;
    if (more) {
      const size_t ko = (size_t)(kb + 1) * 64;
      k0r = *(const u32x4*)(gk + ko * 512); k1r = *(const u32x4*)(gk + (ko + 32) * 512); rr = *(const u32x4*)(gr + ko * 32);
      v0r = *(const u32x4*)(gv + ko); v1r = *(const u32x4*)(gv + (size_t)32 * S + ko);
    }
    if (HALF && kb < nkb_w) {
      const char* kt_ = lds + cur * BUF; const char* vt_ = kt_ + KB;
#pragma unroll
      for (int kt = 0; kt < 2; ++kt) {
        __builtin_amdgcn_iglp_opt(0);
        f32x16 sh[QT];
#pragma unroll
        for (int qt = 0; qt < QT; ++qt)
#pragma unroll
          for (int i = 0; i < 16; ++i) sh[qt][i] = 0.f;
#pragma unroll
        for (int ks = 0; ks < 6; ++ks) {
          const bf16x8 kf = *(const bf16x8*)(kt_ + (kt * 32 + r) * 208 + ks * 32 + hh * 16);
#pragma unroll
          for (int qt = 0; qt < QT; ++qt) sh[qt] = MFMA32(kf, qf[qt][ks], sh[qt]);
        }
        bf16x8 ph[QT][2];
#pragma unroll
        for (int qt = 0; qt < QT; ++qt) {
          float mx = sh[qt][0];
#pragma unroll
          for (int i = 1; i < 16; ++i) mx = fmaxf(mx, sh[qt][i]);
          mx = fmaxf(mx, __shfl_xor(mx, 32));
          const bool need = mx > mrun[qt] + 8.f;
          if (__any(need)) {
            const float mnew = need ? mx : mrun[qt];
            const float alpha = __builtin_amdgcn_exp2f(mrun[qt] - mnew);
            mrun[qt] = mnew; lrun[qt] *= alpha;
#pragma unroll
            for (int dt = 0; dt < 2; ++dt)
#pragma unroll
              for (int i = 0; i < 16; ++i) o[dt][qt][i] *= alpha;
          }
          float ls = 0.f;
#pragma unroll
          for (int i = 0; i < 16; ++i) { const float pv = __builtin_amdgcn_exp2f(sh[qt][i] - mrun[qt]); ls += pv; sh[qt][i] = pv; }
          lrun[qt] += ls;
#pragma unroll
          for (int s2 = 0; s2 < 2; ++s2) {
            u32x4 w;
            w.x = pk_bf16(sh[qt][8 * s2 + 0], sh[qt][8 * s2 + 1]); w.y = pk_bf16(sh[qt][8 * s2 + 2], sh[qt][8 * s2 + 3]);
            w.z = pk_bf16(sh[qt][8 * s2 + 4], sh[qt][8 * s2 + 5]); w.w = pk_bf16(sh[qt][8 * s2 + 6], sh[qt][8 * s2 + 7]);
            ph[qt][s2] = __builtin_bit_cast(bf16x8, w);
          }
        }
#pragma unroll
        for (int dt = 0; dt < 2; ++dt)
#pragma unroll
          for (int s2 = 0; s2 < 2; ++s2) {
            const bf16x8 vf = *(const bf16x8*)(vt_ + (dt * 32 + r) * 144 + (kt * 2 + s2) * 32 + hh * 16);
#pragma unroll
            for (int qt = 0; qt < QT; ++qt) o[dt][qt] = MFMA32(vf, ph[qt][s2], o[dt][qt]);
          }
      }
    }
    if (!HALF && kb < nkb_w) {
      const char* kt_ = lds + cur * BUF; const char* vt_ = kt_ + KB;
      f32x16 st[2][QT];
#pragma unroll
      for (int kt = 0; kt < 2; ++kt)
#pragma unroll
        for (int qt = 0; qt < QT; ++qt)
#pragma unroll
          for (int i = 0; i < 16; ++i) st[kt][qt][i] = 0.f;
#pragma unroll
      for (int ks = 0; ks < 6; ++ks)
#pragma unroll
        for (int kt = 0; kt < 2; ++kt) {
          const bf16x8 kf = *(const bf16x8*)(kt_ + (kt * 32 + r) * 208 + ks * 32 + hh * 16);
#pragma unroll
          for (int qt = 0; qt < QT; ++qt) st[kt][qt] = MFMA32(kf, qf[qt][ks], st[kt][qt]);
        }
      bf16x8 pb[2][QT][2];
#pragma unroll
      for (int qt = 0; qt < QT; ++qt) {
        float mx = mrun[qt];
#pragma unroll
        for (int kt = 0; kt < 2; ++kt)
#pragma unroll
          for (int i = 0; i < 16; ++i) mx = fmaxf(mx, st[kt][qt][i]);
        mx = fmaxf(mx, __shfl_xor(mx, 32));
        const float alpha = __builtin_amdgcn_exp2f(mrun[qt] - mx);
        mrun[qt] = mx;
        float ls = 0.f;
#pragma unroll
        for (int kt = 0; kt < 2; ++kt) {
#pragma unroll
          for (int i = 0; i < 16; ++i) { const float pv = __builtin_amdgcn_exp2f(st[kt][qt][i] - mx); ls += pv; st[kt][qt][i] = pv; }
#pragma unroll
          for (int s2 = 0; s2 < 2; ++s2) {
            u32x4 w;
            w.x = pk_bf16(st[kt][qt][8 * s2 + 0], st[kt][qt][8 * s2 + 1]); w.y = pk_bf16(st[kt][qt][8 * s2 + 2], st[kt][qt][8 * s2 + 3]);
            w.z = pk_bf16(st[kt][qt][8 * s2 + 4], st[kt][qt][8 * s2 + 5]); w.w = pk_bf16(st[kt][qt][8 * s2 + 6], st[kt][qt][8 * s2 + 7]);
            pb[kt][qt][s2] = __builtin_bit_cast(bf16x8, w);
          }
        }
        lrun[qt] = lrun[qt] * alpha + ls;
#pragma unroll
        for (int dt = 0; dt < 2; ++dt)
#pragma unroll
          for (int i = 0; i < 16; ++i) o[dt][qt][i] *= alpha;
      }
#pragma unroll
      for (int dt = 0; dt < 2; ++dt)
#pragma unroll
        for (int kt = 0; kt < 2; ++kt)
#pragma unroll
          for (int s2 = 0; s2 < 2; ++s2) {
            const bf16x8 vf = *(const bf16x8*)(vt_ + (dt * 32 + r) * 144 + (kt * 2 + s2) * 32 + hh * 16);
#pragma unroll
            for (int qt = 0; qt < QT; ++qt) o[dt][qt] = MFMA32(vf, pb[kt][qt][s2], o[dt][qt]);
          }
    }
    if (more) {
      char* kb_ = lds + (cur ^ 1) * BUF; char* vb_ = kb_ + KB;
      *(u32x4*)(kb_ + kw0) = k0r; *(u32x4*)(kb_ + kw1) = k1r; *(u32x4*)(kb_ + rw) = rr;
      *(u32x2*)(vb_ + vlo) = (u32x2){v0r.x, v0r.y}; *(u32x2*)(vb_ + vhi) = (u32x2){v0r.z, v0r.w};
      *(u32x2*)(vb_ + vlo + 32 * 144) = (u32x2){v1r.x, v1r.y}; *(u32x2*)(vb_ + vhi + 32 * 144) = (u32x2){v1r.z, v1r.w};
    }
    __syncthreads();
  }
  if (nkb_w > 0) {
    u32x2 wo[2][2][4];
#pragma unroll
    for (int qt = 0; qt < QT; ++qt) {
      const float lt = lrun[qt] + __shfl_xor(lrun[qt], 32);
      const float inv = 1.f / lt;
      const int row = qrow0 + qt * 32 + r;
      float ss = 0.f;
#pragma unroll
      for (int dt = 0; dt < 2; ++dt)
#pragma unroll
        for (int i4 = 0; i4 < 4; ++i4) {
          const float a0 = o[dt][qt][4 * i4] * inv, a1 = o[dt][qt][4 * i4 + 1] * inv, a2 = o[dt][qt][4 * i4 + 2] * inv, a3 = o[dt][qt][4 * i4 + 3] * inv;
          ss += a0 * a0 + a1 * a1 + a2 * a2 + a3 * a3;
          u32x2 w; w.x = pk_bf16(a0, a1); w.y = pk_bf16(a2, a3);
          if (QT == 2) wo[qt][dt][i4] = w;
          else *(u32x2*)(p.mix + (size_t)row * 1024 + h * 64 + dt * 32 + 8 * i4 + 4 * hh) = w;
        }
      ss += __shfl_xor(ss, 32);
      if (hh == 0) p.attn_part[(size_t)row * 8 + h] = ss;
    }
    if (QT == 2) wave_store64(lds + wid * 8192, wo, p.mix + (size_t)qrow0 * 1024 + h * 64, 1024, lane, r, hh);
  }
}

DI void phase4(const Params& p, char* lds, int qidx) {
  const int t = tid(), lane = t & 63, wid = t >> 6;
  const int nb = gridDim.x, bid = blockIdx.x;
  int* nxt = (int*)(lds + 65536);
  for (;;) {
    __syncthreads();
    if (t == 0) *nxt = atomicAdd(p.counters + qidx, 1);
    __syncthreads();
    const int it = *nxt;
    if (it >= 256 + 64 * 32) break;
    if (it < 256) attn_item<1, false>(p, 1, it >> 3, it & 7, 0, lds);
    else { const int j = it - 256; const int qq = 31 - (j >> 6), bh = j & 63; attn_item<2, true>(p, 0, bh >> 3, bh & 7, qq, lds); }
  }
  __syncthreads();
  for (int it = bid * 4 + wid; it < 8 * 128 * 32 + 1024; it += nb * 4) {
    if (it < 8 * 128 * 32) {
      const int g = it & 31, c = (it >> 5) & 127, b = it >> 12;
      const float2 s0 = p.S[(size_t)it * 64 + lane];
      float hr = s0.x, hi = s0.y;
      ssm_chunk(p, b * 8192 + c * 64, g, hr, hi, true, lds + wid * 8704);
      if (c == 127) { p.out[OFF_HRP + (size_t)(b * 32 + g) * 64 + lane] = hr; p.out[OFF_HIP + (size_t)(b * 32 + g) * 64 + lane] = hi; }
    } else {
      const int j = it - 8 * 128 * 32, g = j & 31, b = j >> 5;
      float hr = p.in[4][(size_t)(b * 32 + g) * 64 + lane], hi = p.in[5][(size_t)(b * 32 + g) * 64 + lane];
      ssm_chunk(p, NTP + b * 64, g, hr, hi, true, lds + wid * 8704);
      p.out[OFF_HRS + (size_t)(b * 32 + g) * 64 + lane] = hr; p.out[OFF_HIS + (size_t)(b * 32 + g) * 64 + lane] = hi;
    }
  }
}

DI void phase5(const Params& p, char* lds) {
  {
    auto tile_fn = [&](int j, int& m0, int& n0) -> bool { const int li = (int)(blockIdx.x >> 3) + j * (int)(gridDim.x >> 3); const int ti_ = li / 4, tj_ = li - ti_ * 4; const int tbig = ti_ * 8 + (int)(blockIdx.x & 7); if (tbig >= 528) return false; m0 = tbig * 128; n0 = tj_ * 128; return true; };
    auto rs_fn = [&](int m0, int t) -> float2 { return make_float2(0.f, 0.f); };
    auto epi = [&](f32x16 (&acc)[2][2], int m0, int n0, const float* rs, int fstage) { (void)fstage;
    const int tn = n0 >> 7; (void)tn;
    { EPI_IDS
    u32x2 wq[2][2][4], yw[2][2][4];
    wave_load64(wave_stage(lds, fstage, wid), yw, p.ssm_y + (size_t)(m0 + wm * 64) * 512 + n0 + wn * 64, 512, lane, r, hh);
#pragma unroll
    for (int mt = 0; mt < 2; ++mt) {
      const int row = m0 + wm * 64 + mt * 32 + r;
      float ss = 0.f;
#pragma unroll
      for (int nt = 0; nt < 2; ++nt)
#pragma unroll
        for (int i4 = 0; i4 < 4; ++i4) {
          const int col = n0 + wn * 64 + nt * 32 + 8 * i4 + 4 * hh;
          const u32x2 yv = yw[mt][nt][i4];
          const float y0 = __uint_as_float(yv.x << 16), y1 = __uint_as_float(yv.x & 0xffff0000u), y2 = __uint_as_float(yv.y << 16), y3 = __uint_as_float(yv.y & 0xffff0000u);
          const float o0 = y0 / (1.f + __expf(-acc[mt][nt][4 * i4])), o1 = y1 / (1.f + __expf(-acc[mt][nt][4 * i4 + 1]));
          const float o2 = y2 / (1.f + __expf(-acc[mt][nt][4 * i4 + 2])), o3 = y3 / (1.f + __expf(-acc[mt][nt][4 * i4 + 3]));
          ss += o0 * o0 + o1 * o1 + o2 * o2 + o3 * o3;
          wq[mt][nt][i4].x = pk_bf16(o0, o1); wq[mt][nt][i4].y = pk_bf16(o2, o3);
        }
      ss += __shfl_xor(ss, 32);
      if (hh == 0) p.ssm_part[(size_t)row * 8 + tn * 2 + wn] = ss;
    }
    wave_store64(wave_stage(lds, fstage, wid), wq, p.mix + (size_t)(m0 + wm * 64) * 1024 + 512 + n0 + wn * 64, 1024, lane, r, hh);
    }
    __syncthreads();
    };
    gemm_stream(p.ssm_y, 512, p.WgT, 512, 8, lds, 0, tile_fn, rs_fn, epi);
  }
}

DI void phase6(const Params& p, char* lds) {
  const int xb_ = blockIdx.x & 7, xl_ = blockIdx.x >> 3, nbx_ = gridDim.x >> 3;
  {
    auto tile_fn = [&](int j, int& m0, int& n0) -> bool { const int li6 = xl_ + j * nbx_, tm = (li6 >> 3) * 8 + xb_; if (tm >= 528) return false; m0 = tm * 128; n0 = (li6 & 7) * 128; return true; };
    auto rs_fn = [&](int m0, int t) -> float2 {
      const f32x4 a0 = *(const f32x4*)(p.attn_part + (size_t)(m0 + t) * 8), a1 = *(const f32x4*)(p.attn_part + (size_t)(m0 + t) * 8 + 4);
      const float sa = (a0[0] + a0[1]) + (a0[2] + a0[3]) + (a1[0] + a1[1]) + (a1[2] + a1[3]);
      const f32x4 b0 = *(const f32x4*)(p.ssm_part + (size_t)(m0 + t) * 8), b1 = *(const f32x4*)(p.ssm_part + (size_t)(m0 + t) * 8 + 4);
      const float sb = (b0[0] + b0[1]) + (b0[2] + b0[3]) + (b1[0] + b1[1]) + (b1[2] + b1[3]);
      const float ra = rsqrtf(sa * (1.f / 512.f) + EPS), rb = rsqrtf(sb * (1.f / 512.f) + EPS);
      return make_float2(rb, ra / rb); };
    auto epi = [&](f32x16 (&acc)[2][2], int m0, int n0, const float* rs, int fstage) { (void)fstage;
    const int tn = n0 >> 7;
    { EPI_IDS
    char* stg = wave_stage(lds, fstage, wid);
#pragma unroll
    for (int mt = 0; mt < 2; ++mt) {
      const float sc = rs[wm * 64 + mt * 32 + r];
#pragma unroll
      for (int nt = 0; nt < 2; ++nt)
#pragma unroll
        for (int i = 0; i < 16; ++i) acc[mt][nt][i] *= sc;
    }
    wave_add64_f32(stg, acc, xrow(p, m0 + wm * 64) + n0 + wn * 64, 1024, lane, r, hh);
    u32x2 w[2][2][4];
#pragma unroll
    for (int mt = 0; mt < 2; ++mt) {
      const int row = m0 + wm * 64 + mt * 32 + r;
      float ss = 0.f;
#pragma unroll
      for (int nt = 0; nt < 2; ++nt)
#pragma unroll
        for (int i4 = 0; i4 < 4; ++i4) {
#pragma unroll
          for (int jj = 0; jj < 4; ++jj) ss += acc[mt][nt][4 * i4 + jj] * acc[mt][nt][4 * i4 + jj];
          w[mt][nt][i4].x = pk_bf16(acc[mt][nt][4 * i4], acc[mt][nt][4 * i4 + 1]); w[mt][nt][i4].y = pk_bf16(acc[mt][nt][4 * i4 + 2], acc[mt][nt][4 * i4 + 3]);
        }
      ss += __shfl_xor(ss, 32);
      if (hh == 0) p.h_part[(size_t)row * 16 + tn * 2 + wn] = ss;
    }
    wave_store64(stg, w, p.hb + (size_t)(m0 + wm * 64) * 1024 + n0 + wn * 64, 1024, lane, r, hh);
    }
    __syncthreads();
    };
    gemm_stream(p.mix, 1024, p.WoT, 1024, 16, lds, 8, tile_fn, rs_fn, epi);
  }
}

DI void phase7(const Params& p, char* lds) {
  float* rs = (float*)(lds + 65536);
  const int xb_ = blockIdx.x & 7, xl_ = blockIdx.x >> 3, nbx_ = gridDim.x >> 3;
  {
    auto tile_fn = [&](int j, int& m0, int& n0) -> bool { const int tm = j * (nbx_ >> 2) + (xl_ >> 2); if (tm >= 528) return false; m0 = tm * 128; n0 = (xb_ * 4 + (xl_ & 3)) * 128; return true; };
    auto rs_fn = [&](int m0, int t) -> float2 { float sm = 0.f; for (int q = 0; q < 4; ++q) { const f32x4 v = *(const f32x4*)(p.h_part + (size_t)(m0 + t) * 16 + 4 * q); sm += (v[0] + v[1]) + (v[2] + v[3]); } return make_float2(rsqrtf(sm * (1.f / 1024.f) + EPS), 0.f); };
    auto epi = [&](f32x16 (&acc)[2][2], int m0, int n0, const float* rs, int fstage) { (void)fstage;
    const int tn = n0 >> 7; (void)tn;
    { EPI_IDS
    char* stg = lds + (wid < 2 ? 0 : 32768) + fstage * 16384 + (wid & 1) * 8192;
#pragma unroll
    for (int mt = 0; mt < 2; ++mt) {
      const int rloc = mt * 32 + r;
      const float sc = rs[wm * 64 + rloc];
#pragma unroll
      for (int nt = 0; nt < 2; ++nt)
#pragma unroll
        for (int i4 = 0; i4 < 4; ++i4) {
          float v[4];
#pragma unroll
          for (int jj = 0; jj < 4; ++jj) { const float a_ = fmaxf(acc[mt][nt][4 * i4 + jj] * sc, 0.f); v[jj] = a_ * a_; }
          u32x2 w; w.x = pk_bf16(v[0], v[1]); w.y = pk_bf16(v[2], v[3]);
          *(u32x2*)(stg + rloc * 128 + (((nt * 4 + i4) ^ (rloc & 7)) << 4) + hh * 8) = w;
        }
    }
    asm volatile("s_waitcnt lgkmcnt(0)" ::: "memory");
    __builtin_amdgcn_wave_barrier();
    bf16_t* gdst = p.act + ((((size_t)(m0 >> 7) * 64 + (n0 >> 6) + wn) * 128 + wm * 64) * 64);
#pragma unroll
    for (int s8 = 0; s8 < 8; ++s8) {
      const int rloc = s8 * 8 + (lane >> 3), c = lane & 7;
      const u32x4 q = *(const u32x4*)(stg + rloc * 128 + ((c ^ (rloc & 7)) << 4));
      *(u32x4*)(gdst + rloc * 64 + c * 8) = q;
    }
    }
    __syncthreads();
    };
    gemm_stream(p.hb, 1024, p.WuT, 1024, 16, lds, 0, tile_fn, rs_fn, epi);
  }
}

DI void phase8(const Params& p, char* lds) {
  const int xb_ = blockIdx.x & 7, xl_ = blockIdx.x >> 3, nbx_ = gridDim.x >> 3;
  {
    auto tile_fn = [&](int j, int& m0, int& n0) -> bool { const int li = (int)(blockIdx.x >> 3) + j * (int)(gridDim.x >> 3); const int ti_ = li / 8, tj_ = li - ti_ * 8; const int tbig = ti_ * 8 + (int)(blockIdx.x & 7); if (tbig >= 528) return false; m0 = tbig * 128; n0 = tj_ * 128; return true; };
    auto rs_fn = [&](int m0, int t) -> float2 { return make_float2(0.f, 0.f); };
    auto epi = [&](f32x16 (&acc)[2][2], int m0, int n0, const float* rs, int fstage) { (void)fstage;
    const int tn = n0 >> 7; (void)tn;
    { EPI_IDS
    char* stg = wave_stage(lds, fstage, wid);
    u32x2 hw[2][2][4];
    wave_load64(stg, hw, p.hb + (size_t)(m0 + wm * 64) * 1024 + n0 + wn * 64, 1024, lane, r, hh);
#pragma unroll
    for (int mt = 0; mt < 2; ++mt) {
      const int row = m0 + wm * 64 + mt * 32 + r;
      float ss = 0.f;
#pragma unroll
      for (int nt = 0; nt < 2; ++nt)
#pragma unroll
        for (int i4 = 0; i4 < 4; ++i4) {
          const u32x2 hq = hw[mt][nt][i4];
          const float h0 = __uint_as_float(hq.x << 16), h1 = __uint_as_float(hq.x & 0xffff0000u), h2 = __uint_as_float(hq.y << 16), h3 = __uint_as_float(hq.y & 0xffff0000u);
          acc[mt][nt][4 * i4] += h0; acc[mt][nt][4 * i4 + 1] += h1; acc[mt][nt][4 * i4 + 2] += h2; acc[mt][nt][4 * i4 + 3] += h3;
#pragma unroll
          for (int jj = 0; jj < 4; ++jj) ss += acc[mt][nt][4 * i4 + jj] * acc[mt][nt][4 * i4 + jj];
        }
      ss += __shfl_xor(ss, 32);
      if (hh == 0) p.out_part[(size_t)row * 16 + tn * 2 + wn] = ss;
    }
    wave_store64_f32(stg, acc, p.out + OFF_Y + (size_t)(m0 + wm * 64) * 1024 + n0 + wn * 64, 1024, lane, r, hh);
    }
    __syncthreads();
    };
    gemm_stream<true>(p.act, 4096, p.WdT, 4096, 64, lds, 0, tile_fn, rs_fn, epi);
  }
}

DI void phase9(const Params& p) {
  const int t = tid(), lane = t & 63, wid = t >> 6;
  for (int row = blockIdx.x * 4 + wid; row < NT; row += gridDim.x * 4) {
    float s = 0.f;
    for (int j = 0; j < 16; ++j) s += p.out_part[(size_t)row * 16 + j];
    const float rstd = rsqrtf(s * (1.f / 1024.f) + EPS);
    float* y = p.out + OFF_Y + (size_t)row * 1024;
#pragma unroll
    for (int j = 0; j < 4; ++j) {
      f32x4 v = *(const f32x4*)(y + lane * 4 + 256 * j);
      const f32x4 g = *(const f32x4*)(p.in[27] + lane * 4 + 256 * j);
      v[0] *= rstd * g[0]; v[1] *= rstd * g[1]; v[2] *= rstd * g[2]; v[3] *= rstd * g[3];
      *(f32x4*)(y + lane * 4 + 256 * j) = v;
    }
  }
}

DI void grid_barrier(unsigned* cnt, unsigned target) {
  asm volatile("s_waitcnt vmcnt(0)" ::: "memory");
  __syncthreads();
  if (tid() == 0) {
    __builtin_amdgcn_fence(__ATOMIC_RELEASE, "agent");
    asm volatile("s_waitcnt vmcnt(0)" ::: "memory");
    __hip_atomic_fetch_add(cnt, 1u, __ATOMIC_RELAXED, __HIP_MEMORY_SCOPE_AGENT);
    while (__hip_atomic_load(cnt, __ATOMIC_RELAXED, __HIP_MEMORY_SCOPE_AGENT) < target) __builtin_amdgcn_s_sleep(2);
  }
  __syncthreads();
  __builtin_amdgcn_fence(__ATOMIC_ACQUIRE, "agent");
  asm volatile("s_waitcnt vmcnt(0)" ::: "memory");
}

#define XB_TMO      128
#define XB_XCNT(j)  (256  + 64 * (j))
#define XB_XSUB(j)  (1280 + 64 * (j))
#define XB_XGEN(j)  (2304 + 64 * (j))
#define XB_TOP      3328
#define XB_TOPGEN   3392
#define XCD_BAR_WORDS 3456
#define XB_SPIN_CAP (1u << 22)
#define LAS __attribute__((address_space(3)))
DI unsigned xb_ld(unsigned* p)              { return __hip_atomic_load(p, __ATOMIC_RELAXED, __HIP_MEMORY_SCOPE_AGENT); }
DI unsigned xb_add(unsigned* p, unsigned v) { return __hip_atomic_fetch_add(p, v, __ATOMIC_RELAXED, __HIP_MEMORY_SCOPE_AGENT); }
DI unsigned xb_xcc_id() { return (unsigned)__builtin_amdgcn_s_getreg((3 << 11) | 20) & 0xFu; }
#define XB_SPIN(cond, bar) do { unsigned _sp = 0; while (cond) { __builtin_amdgcn_s_sleep(1); \
    if ((++_sp & 255u) == 0u) { if (xb_ld(&(bar)[XB_TMO])) break; if (_sp > XB_SPIN_CAP) { atomicAdd(&(bar)[XB_TMO], 1u); break; } } } } while (0)
struct XcdBarrier { unsigned* bar; unsigned x; volatile LAS unsigned* st; };
DI XcdBarrier xcd_barrier_post(unsigned* bar, volatile LAS unsigned* st) {
  XcdBarrier b; b.bar = bar; b.x = xb_xcc_id(); b.st = st;
  if (tid() == 0) (void)xb_add(&bar[XB_XCNT(b.x)], 1u);
  return b;
}
DI void xcd_barrier_complete(unsigned* bar, unsigned x, unsigned& nloc, unsigned& nx) {
  const unsigned G = gridDim.x * gridDim.y * gridDim.z;
  unsigned sum, cnt, mine, sp = 0u;
  for (;;) {
    sum = 0u; cnt = 0u; mine = 0u;
#pragma unroll
    for (unsigned j = 0; j < 16; ++j) { const unsigned c = xb_ld(&bar[XB_XCNT(j)]); sum += c; cnt += (c > 0u) ? 1u : 0u; mine = (j == x) ? c : mine; }
    if (sum == G) break;
    __builtin_amdgcn_s_sleep(1);
    if ((++sp & 255u) == 0u) { if (xb_ld(&bar[XB_TMO])) break; if (sp > XB_SPIN_CAP) { atomicAdd(&bar[XB_TMO], 1u); break; } }
  }
  nloc = mine > 0u ? mine : 1u; nx = cnt > 0u ? cnt : 1u;
}
DI void xcd_barrier(const XcdBarrier& b) {
  asm volatile("s_waitcnt vmcnt(0)" ::: "memory");
  __syncthreads();
  if (tid() == 0) {
    unsigned* bar = b.bar;
    __builtin_amdgcn_s_waitcnt(0);
    unsigned nloc = b.st[0], nx = b.st[1];
    if (nloc == 0u) { xcd_barrier_complete(bar, b.x, nloc, nx); b.st[0] = nloc; b.st[1] = nx; }
    const unsigned old = xb_add(&bar[XB_XSUB(b.x)], 1u);
    const unsigned gen = old / nloc;
    if (old + 1u == (gen + 1u) * nloc) {
      __builtin_amdgcn_fence(__ATOMIC_RELEASE, "agent");
      asm volatile("s_waitcnt vmcnt(0)" ::: "memory");
      const unsigned og = xb_add(&bar[XB_TOP], 1u);
      const unsigned tg = og / nx;
      if (og + 1u == (tg + 1u) * nx) xb_add(&bar[XB_TOPGEN], 1u);
      else XB_SPIN(xb_ld(&bar[XB_TOPGEN]) == tg, bar);
      __builtin_amdgcn_fence(__ATOMIC_ACQUIRE, "agent");
      xb_add(&bar[XB_XGEN(b.x)], 1u);
      asm volatile("s_waitcnt vmcnt(0)" ::: "memory");
    } else {
      XB_SPIN(xb_ld(&bar[XB_XGEN(b.x)]) == gen, bar);
      __builtin_amdgcn_fence(__ATOMIC_ACQUIRE, "agent");
      asm volatile("s_waitcnt vmcnt(0)" ::: "memory");
    }
  }
  __syncthreads();
}

template <bool COOP>
__global__ void __launch_bounds__(256, 2) mega(Params p) {
  __shared__ __attribute__((aligned(16))) char lds[LDS_BYTES];
  XcdBarrier xb{};
  if (COOP) {
    volatile LAS unsigned* st = (volatile LAS unsigned*)(lds + 67584);
    if (tid() == 0) { st[0] = 0u; st[1] = 0u; }
    __syncthreads();
    xb = xcd_barrier_post((unsigned*)p.counters + 64, st);
  }
  for (int ph = p.ph_lo; ph < p.ph_hi; ++ph) {
#ifdef ONLY_PHASE
    if (ph != ONLY_PHASE) continue;
#endif
    switch (ph) {
      case 0: phase0(p, lds); break;
      case 1: phase1(p, lds); break;
      case 2: phase2(p, lds); break;
      case 3: phase3(p, lds); break;
      case 4: phase4(p, lds, 0); break;
      case 5: phase5(p, lds); break;
      case 6: phase6(p, lds); break;
      case 7: phase7(p, lds); break;
      case 8: phase8(p, lds); break;
      default: phase9(p); break;
    }
#ifdef DOUBLE_PHASE
    if (ph == DOUBLE_PHASE) {
      __syncthreads();
      switch (ph) { case 0: phase0(p, lds); break; case 1: phase1(p, lds); break; case 2: phase2(p, lds); break; case 3: phase3(p, lds); break; case 4: phase4(p, lds, 1); break;
                    case 5: phase5(p, lds); break; case 6: phase6(p, lds); break; case 7: phase7(p, lds); break; default: break; }
    }
#endif
    if (COOP) { if (ph + 1 < p.ph_hi) { if (ph == 0) cg::this_grid().sync(); else xcd_barrier(xb); } }
  }
}

static size_t al256(size_t x) { return (x + 255) & ~(size_t)255; }

extern "C" void kernel_launch(void* const* d_in, const int* in_sizes, int n_in, void* d_out, int out_size, void* d_ws, size_t ws_size, hipStream_t stream) {
  Params p{};
  for (int i = 0; i < 28; ++i) p.in[i] = (const float*)d_in[i];
  p.out = (float*)d_out;
  char* base = (char*)d_ws; size_t off = 0;
  auto take = [&](size_t bytes) { char* q = base + off; off = al256(off + bytes); return q; };
  p.WinT = (bf16_t*)take((size_t)1664 * 1024 * 2);
  p.WqT = (bf16_t*)take((size_t)768 * 768 * 2);
  p.WkT = (bf16_t*)take((size_t)512 * 256 * 2);
  p.WvT = (bf16_t*)take((size_t)512 * 256 * 2);
  p.WgT = (bf16_t*)take((size_t)512 * 512 * 2);
  p.WoT = (bf16_t*)take((size_t)1024 * 1024 * 2);
  p.WuT = (bf16_t*)take((size_t)4096 * 1024 * 2);
  p.WdT = (bf16_t*)take((size_t)1024 * 4096 * 2);
  p.BbT = (bf16_t*)take((size_t)32 * 128 * 16 * 2);
  p.CcT = (bf16_t*)take((size_t)32 * 16 * 128 * 2);
  p.lam = (float2*)take(2048 * 8);
  p.lam64 = (float2*)take(2048 * 8);
  p.rope = (float2*)take((size_t)8192 * 16 * 8);
  p.rstd_x = (float*)take((size_t)NT * 4);
  p.cq_part = (float*)take((size_t)NT * 12 * 4);
  p.ckv_part = (float*)take((size_t)NT * 4 * 4);
  p.attn_part = (float*)take((size_t)NT * 8 * 4);
  p.ssm_part = (float*)take((size_t)NT * 8 * 4);
  p.h_part = (float*)take((size_t)NT * 16 * 4);
  p.out_part = (float*)take((size_t)NT * 16 * 4);
  p.counters = (int*)take(16384);
  p.E = (float2*)take((size_t)8 * 128 * 32 * 64 * 8);
  p.S = (float2*)take((size_t)8 * 128 * 32 * 64 * 8);
  const size_t a0 = off;
  p.Kn = (bf16_t*)take((size_t)NK * 512 * 2);
  const size_t aVt = off;
  p.Vt = (bf16_t*)take((size_t)NK * 512 * 2);
  p.Q = (bf16_t*)take((size_t)NT * 768 * 2);
  p.latb = (bf16_t*)take((size_t)NK * 256 * 2);
  p.krb = (bf16_t*)take((size_t)NK * 32 * 2);
  p.ub = (bf16_t*)take((size_t)NT * 512 * 2);
  const size_t aSsmY = off;
  p.ssm_y = (bf16_t*)take((size_t)NT * 512 * 2);
  p.mix = (bf16_t*)take((size_t)NT * 1024 * 2);
  const size_t total = off;
  p.xb = (bf16_t*)(base + a0);
  p.cq = (bf16_t*)(base + aVt);
  p.ckv_raw = (float*)(base + aVt + al256((size_t)NT * 768 * 2));
  p.act = (bf16_t*)(base + a0);
  const size_t aHb = a0 + al256((size_t)NT * 4096 * 2);
  p.hb = (bf16_t*)(base + aHb);
  if (aHb + (size_t)NT * 1024 * 2 > aSsmY || total > ws_size) { fprintf(stderr, "workspace layout error: total %zu ws %zu\n", total, ws_size); return; }

  const int MULTI = 0;
  hipMemsetAsync(p.counters, 0, 16384, stream);
  if (MULTI) {
    for (int ph = 0; ph < NPHASE; ++ph) {
      p.ph_lo = ph; p.ph_hi = ph + 1;
      hipLaunchKernelGGL(mega<false>, dim3(512), dim3(256), 0, stream, p);
    }
  } else {
    static int grid_blocks = 0;
    if (!grid_blocks) {
      int dev = 0, cus = 0, per_cu = 0;
      hipGetDevice(&dev);
      hipDeviceGetAttribute(&cus, hipDeviceAttributeMultiprocessorCount, dev);
      hipOccupancyMaxActiveBlocksPerMultiprocessor(&per_cu, mega<true>, 256, 0);
      grid_blocks = cus * per_cu;
    }
    p.ph_lo = 0; p.ph_hi = NPHASE;
    void* args[] = {&p};
    hipError_t e = hipLaunchCooperativeKernel((void*)mega<true>, dim3(grid_blocks), dim3(256), args, 0, stream);
    if (e != hipSuccess) fprintf(stderr, "cooperative launch failed: %s (grid %d)\n", hipGetErrorString(e), grid_blocks);
  }
}
```

```cpp
#include <hip/hip_runtime.h>
#include <hip/hip_cooperative_groups.h>
#include <stdint.h>
#include <cstdio>
namespace cg = cooperative_groups;
#define DI __device__ __forceinline__

typedef unsigned short bf16_t;
typedef short bf16x8 __attribute__((ext_vector_type(8)));
typedef float f32x16 __attribute__((ext_vector_type(16)));
typedef float f32x4 __attribute__((ext_vector_type(4)));
typedef unsigned u32x4 __attribute__((ext_vector_type(4)));
typedef unsigned u32x2 __attribute__((ext_vector_type(2)));

constexpr int NTP = 65536, NTS = 2048, NT = NTP + NTS, NK = NTP + 32 * 4160;
constexpr int SKS = 4160;
constexpr size_t OFF_Y = 0;
constexpr size_t OFF_LATP = (size_t)NT * 1024;
constexpr size_t OFF_KRP = OFF_LATP + (size_t)NTP * 256;
constexpr size_t OFF_HRP = OFF_KRP + (size_t)NTP * 32;
constexpr size_t OFF_HIP = OFF_HRP + 8 * 32 * 64;
constexpr size_t OFF_LATS = OFF_HIP + 8 * 32 * 64;
constexpr size_t OFF_KRS = OFF_LATS + (size_t)NTS * 256;
constexpr size_t OFF_HRS = OFF_KRS + (size_t)NTS * 32;
constexpr size_t OFF_HIS = OFF_HRS + 32 * 32 * 64;
constexpr size_t VT_S_OFF = (size_t)8 * 512 * 8192;
constexpr float EPS = 1e-6f;
constexpr int LDS_BYTES = 67600;
constexpr int NPHASE = 10;
constexpr int AQT = 1, NQQ = 128 / (4 / (64 / (32 * AQT)));

struct Params {
  const float* in[28];
  float* out;
  bf16_t *WinT, *WqT, *WkT, *WvT, *WgT, *WoT, *WuT, *WdT, *BbT, *CcT;
  float2 *lam, *lam64, *rope;
  float *rstd_x, *cq_part, *ckv_part, *attn_part, *ssm_part, *h_part, *out_part;
  int* counters;
  float2 *E, *S;
  bf16_t *Kn, *Vt, *Q, *latb, *krb, *ub, *ssm_y, *mix, *xb, *cq, *hb, *act;
  float* ckv_raw;
  int ph_lo, ph_hi;
};

DI int tid() { int t = __builtin_amdgcn_workitem_id_x(); asm volatile("" : "+v"(t)); return t; }
typedef __bf16 nbf16x2 __attribute__((ext_vector_type(2)));
typedef float f32x2 __attribute__((ext_vector_type(2)));
DI unsigned pk_bf16(float lo, float hi) { f32x2 v = {lo, hi}; return __builtin_bit_cast(unsigned, __builtin_convertvector(v, nbf16x2)); }
DI bf16_t f2bf(float x) { return (bf16_t)(pk_bf16(x, 0.f) & 0xffffu); }
DI float bf2f(bf16_t v) { return __uint_as_float(((unsigned)v) << 16); }
DI int crow(int i, int hh) { return (i & 3) + 8 * (i >> 2) + 4 * hh; }
DI const float* xrow(const Params& p, int row) { return row < NTP ? p.in[0] + (size_t)row * 1024 : p.in[1] + (size_t)(row - NTP) * 1024; }
DI int pos_of(int row) { return row < NTP ? (row & 8191) : 4096 + ((row - NTP) & 63); }
DI int kr_of(int row) { return row < NTP ? row : NTP + ((row - NTP) >> 6) * SKS + 4096 + ((row - NTP) & 63); }
#define MFMA32(a, b, c) __builtin_amdgcn_mfma_f32_32x32x16_bf16((a), (b), (c), 0, 0, 0)
#define MFMA16(a, b, c) __builtin_amdgcn_mfma_f32_16x16x32_bf16((a), (b), (c), 0, 0, 0)

DI void sincos_d(double x, double& s4, double& c4) {
  double k = rint(x * 0.15915494309189535);
  double rr = fma(-k, 6.283185307179586, x);
  rr = fma(-k, 2.4492935982947064e-16, rr);
  double y = rr * 0.25, y2 = y * y;
  double s = y * (1 - y2 / 6 * (1 - y2 / 20 * (1 - y2 / 42 * (1 - y2 / 72 * (1 - y2 / 110 * (1 - y2 / 156 * (1 - y2 / 210)))))));
  double c = 1 - y2 / 2 * (1 - y2 / 12 * (1 - y2 / 30 * (1 - y2 / 56 * (1 - y2 / 90 * (1 - y2 / 132 * (1 - y2 / 182))))));
  double s2 = 2 * s * c, c2 = 1 - 2 * s * s;
  s4 = 2 * s2 * c2; c4 = 1 - 2 * s2 * s2;
}

DI void gemm_core(const bf16_t* __restrict__ A, int lda, const bf16_t* __restrict__ B, int ldb, int nk,
                  int m0, int n0, char* lds, f32x16 (&acc)[2][2], int midk, const float* ratio) {
  const int t = tid(), lane = t & 63, wid = t >> 6, wm = wid >> 1, wn = wid & 1;
  const int r = lane & 31, hh = lane >> 5;
  const int lc = t & 7, lr = t >> 3;
  const unsigned woff = lr * 128 + ((lc ^ ((lr >> 1) & 7)) << 4);
  const bf16_t* ga = A + (size_t)(m0 + lr) * lda + lc * 8;
  const bf16_t* gb = B + (size_t)(n0 + lr) * ldb + lc * 8;
  char* sA = lds; char* sB = lds + 32768;
  u32x4 ra[4], rb[4];
#pragma unroll
  for (int i = 0; i < 4; ++i) { ra[i] = *(const u32x4*)(ga + (size_t)(32 * i) * lda); rb[i] = *(const u32x4*)(gb + (size_t)(32 * i) * ldb); }
#pragma unroll
  for (int i = 0; i < 4; ++i) { *(u32x4*)(sA + woff + i * 4096) = ra[i]; *(u32x4*)(sB + woff + i * 4096) = rb[i]; }
#pragma unroll
  for (int a = 0; a < 2; ++a)
#pragma unroll
    for (int b = 0; b < 2; ++b)
#pragma unroll
      for (int i = 0; i < 16; ++i) acc[a][b][i] = 0.f;
  __syncthreads();
  const int rsw = (r >> 1) & 7;
  const unsigned aoff = (wm * 64 + r) * 128, boff = (wn * 64 + r) * 128;
  for (int kt = 0; kt < nk; ++kt) {
    const int cur = kt & 1;
    const bool more = (kt + 1 < nk);
    if (more) {
      const bf16_t* ga2 = ga + (kt + 1) * 64; const bf16_t* gb2 = gb + (kt + 1) * 64;
#pragma unroll
      for (int i = 0; i < 4; ++i) { ra[i] = *(const u32x4*)(ga2 + (size_t)(32 * i) * lda); rb[i] = *(const u32x4*)(gb2 + (size_t)(32 * i) * ldb); }
    }
    if (midk && kt == midk) {
#pragma unroll
      for (int mt = 0; mt < 2; ++mt)
      { const float f = ratio[wm * 64 + mt * 32 + r];
#pragma unroll
        for (int i = 0; i < 16; ++i) { acc[mt][0][i] *= f; acc[mt][1][i] *= f; } }
    }
    const char* cA = sA + cur * 16384; const char* cB = sB + cur * 16384;
#pragma unroll
    for (int ks = 0; ks < 4; ++ks) {
      const unsigned co = (((ks * 2 + hh) ^ rsw) << 4);
      const bf16x8 a0 = *(const bf16x8*)(cA + aoff + co), a1 = *(const bf16x8*)(cA + aoff + 4096 + co);
      const bf16x8 b0 = *(const bf16x8*)(cB + boff + co), b1 = *(const bf16x8*)(cB + boff + 4096 + co);
      acc[0][0] = MFMA32(b0, a0, acc[0][0]); acc[0][1] = MFMA32(b1, a0, acc[0][1]);
      acc[1][0] = MFMA32(b0, a1, acc[1][0]); acc[1][1] = MFMA32(b1, a1, acc[1][1]);
    }
    if (more) {
      char* nA = sA + (cur ^ 1) * 16384; char* nB = sB + (cur ^ 1) * 16384;
#pragma unroll
      for (int i = 0; i < 4; ++i) { *(u32x4*)(nA + woff + i * 4096) = ra[i]; *(u32x4*)(nB + woff + i * 4096) = rb[i]; }
    }
    __syncthreads();
  }
}

DI void rowscale_load(float* rs, const float* src, int np, float inv_dim, int m0) {
  const int t = tid();
  if (t < 128) {
    const int row = m0 + t;
    if (np == 0) rs[t] = src[row];
    else { float s = 0.f; for (int j = 0; j < np; ++j) s += src[(size_t)row * np + j]; rs[t] = rsqrtf(s * inv_dim + EPS); }
  }
}

template <bool BLKA = false, class TileFn, class RsFn, class EpiFn>
DI void gemm_stream(const bf16_t* __restrict__ A, int lda, const bf16_t* __restrict__ B, int ldb, int nk, char* lds, int midk,
                    TileFn tile_fn, RsFn rs_fn, EpiFn epi) {
  int m0, n0;
  if (!tile_fn(0, m0, n0)) return;
  const int t = tid(), lane = t & 63, wid = t >> 6, wm = wid >> 1, wn = wid & 1;
  const int r = lane & 31, hh = lane >> 5;
  const int lc = t & 7, lr = t >> 3;
  const unsigned woff = lr * 128 + ((lc ^ ((lr >> 1) & 7)) << 4);
  char* sA = lds; char* sB = lds + 32768;
  float* rsbuf = (float*)(lds + 65536);
  const int rsw = (r >> 1) & 7;
  const unsigned aoff = (wm * 64 + r) * 128, boff = (wn * 64 + r) * 128;
  int lj = 0, lkt = 0, lm0 = m0, ln0 = n0; bool lvalid = true;
  u32x4 ra0[4], rb0[4], ra1[4], rb1[4];
#define GS_LOAD(RA, RB) do {   \
        \
      const bf16_t* ga_ = BLKA ? A + ((size_t)(lm0 >> 7) * nk + lkt) * 8192 + lr * 64 + lc * 8 : A + (size_t)(lm0 + lr) * lda + lc * 8 + lkt * 64; const bf16_t* gb_ = B + (size_t)(ln0 + lr) * ldb + lc * 8 + lkt * 64; \
      _Pragma("unroll") for (int i = 0; i < 4; ++i) { RA[i] = *(const u32x4*)(ga_ + (size_t)(32 * i) * (BLKA ? 64 : lda)); RB[i] = *(const u32x4*)(gb_ + (size_t)(32 * i) * ldb); } \
      if (++lkt == nk) { lkt = 0; if (lvalid) { ++lj; lvalid = tile_fn(lj, lm0, ln0); } } } while (0)
  GS_LOAD(ra0, rb0);
  GS_LOAD(ra1, rb1);
  {
    float2 rv = make_float2(0.f, 0.f);
    if (t < 128) rv = rs_fn(m0, t);
    __syncthreads();
#pragma unroll
    for (int i = 0; i < 4; ++i) { *(u32x4*)(sA + woff + i * 4096) = ra0[i]; *(u32x4*)(sB + woff + i * 4096) = rb0[i]; }
    if (t < 128) { rsbuf[t] = rv.x; rsbuf[128 + t] = rv.y; }
    __syncthreads();
  }
  int cur = 0;
  for (int j = 0;; ++j) {
    int m1 = 0, n1 = 0;
    const bool has_next = tile_fn(j + 1, m1, n1);
    const float* rs = rsbuf + (j & 1) * 256;
    f32x16 acc[2][2];
#pragma unroll
    for (int a = 0; a < 2; ++a)
#pragma unroll
      for (int b = 0; b < 2; ++b)
#pragma unroll
        for (int i = 0; i < 16; ++i) acc[a][b][i] = 0.f;
#define GS_STEP(RL_A, RL_B, RW_A, RW_B, KT) do { \
      const bool last_ = ((KT) + 1 == nk); const bool wr_ = !last_ || has_next; \
      float2 rv_ = make_float2(0.f, 0.f); \
      if (last_ && has_next) { if (t < 128) rv_ = rs_fn(m1, t); asm volatile("" : "+v"(rv_.x), "+v"(rv_.y)); }   \
      GS_LOAD(RL_A, RL_B); \
      if (midk && (KT) == midk) { _Pragma("unroll") for (int mt = 0; mt < 2; ++mt) { const float f = rs[128 + wm * 64 + mt * 32 + r]; \
          _Pragma("unroll") for (int i = 0; i < 16; ++i) { acc[mt][0][i] *= f; acc[mt][1][i] *= f; } } } \
      const char* cA = sA + cur * 16384; const char* cB = sB + cur * 16384; \
      __builtin_amdgcn_iglp_opt(0); \
      _Pragma("unroll") for (int ks = 0; ks < 4; ++ks) { \
        const unsigned co = (((ks * 2 + hh) ^ rsw) << 4); \
        const bf16x8 a0 = *(const bf16x8*)(cA + aoff + co), a1 = *(const bf16x8*)(cA + aoff + 4096 + co); \
        const bf16x8 b0 = *(const bf16x8*)(cB + boff + co), b1 = *(const bf16x8*)(cB + boff + 4096 + co); \
        acc[0][0] = MFMA32(b0, a0, acc[0][0]); acc[0][1] = MFMA32(b1, a0, acc[0][1]); \
        acc[1][0] = MFMA32(b0, a1, acc[1][0]); acc[1][1] = MFMA32(b1, a1, acc[1][1]); } \
      if (wr_) { char* nA = sA + (cur ^ 1) * 16384; char* nB = sB + (cur ^ 1) * 16384; \
        _Pragma("unroll") for (int i = 0; i < 4; ++i) { *(u32x4*)(nA + woff + i * 4096) = RW_A[i]; *(u32x4*)(nB + woff + i * 4096) = RW_B[i]; } \
        if (last_ && t < 128) { float* rn = rsbuf + ((j + 1) & 1) * 256; rn[t] = rv_.x; rn[128 + t] = rv_.y; } } \
      __syncthreads(); cur ^= 1; } while (0)
    for (int kt = 0; kt < nk; kt += 2) {
      GS_STEP(ra0, rb0, ra1, rb1, kt);
      GS_STEP(ra1, rb1, ra0, rb0, kt + 1);
    }
    epi(acc, m0, n0, rs, cur ^ 1);
    if (!has_next) break;
    m0 = m1; n0 = n1;
  }
#undef GS_STEP
#undef GS_LOAD
  __syncthreads();
}

DI float half_reduce(float s) {
  s += __shfl_xor(s, 1); s += __shfl_xor(s, 2); s += __shfl_xor(s, 4); s += __shfl_xor(s, 8); s += __shfl_xor(s, 16); return s;
}

#define EPI_IDS int t = tid(); asm volatile("" : "+v"(t)); const int lane = t & 63, wid = t >> 6, wm = wid >> 1, wn = wid & 1, r = lane & 31, hh = lane >> 5; (void)lane; (void)wid; (void)wm; (void)wn; (void)r; (void)hh;
#define GEMM_IDS const int t = tid(), lane = t & 63, wid = t >> 6, wm = wid >> 1, wn = wid & 1, r = lane & 31, hh = lane >> 5; (void)t; (void)wm; (void)wn; (void)r; (void)hh;

DI char* wave_stage(char* lds, int fstage, int wid) { return lds + (wid < 2 ? 0 : 32768) + fstage * 16384 + (wid & 1) * 8192; }
DI void wave_store64(char* stg, const u32x2 (&w)[2][2][4], bf16_t* gdst, size_t row_stride, int lane, int r, int hh) {
#pragma unroll
  for (int mt = 0; mt < 2; ++mt)
#pragma unroll
    for (int nt = 0; nt < 2; ++nt)
#pragma unroll
      for (int i4 = 0; i4 < 4; ++i4) { const int rloc = mt * 32 + r; *(u32x2*)(stg + rloc * 128 + (((nt * 4 + i4) ^ (rloc & 7)) << 4) + hh * 8) = w[mt][nt][i4]; }
  asm volatile("s_waitcnt lgkmcnt(0)" ::: "memory");
  __builtin_amdgcn_wave_barrier();
#pragma unroll
  for (int s8 = 0; s8 < 8; ++s8) {
    const int rloc = s8 * 8 + (lane >> 3), c = lane & 7;
    const u32x4 q = *(const u32x4*)(stg + rloc * 128 + ((c ^ (rloc & 7)) << 4));
    *(u32x4*)(gdst + (size_t)rloc * row_stride + c * 8) = q;
  }
}

DI void wave_load64(char* stg, u32x2 (&w)[2][2][4], const bf16_t* gsrc, size_t row_stride, int lane, int r, int hh) {
  u32x4 q[8];
#pragma unroll
  for (int s8 = 0; s8 < 8; ++s8) { const int rloc = s8 * 8 + (lane >> 3), c = lane & 7; q[s8] = *(const u32x4*)(gsrc + (size_t)rloc * row_stride + c * 8); }
#pragma unroll
  for (int s8 = 0; s8 < 8; ++s8) { const int rloc = s8 * 8 + (lane >> 3), c = lane & 7; *(u32x4*)(stg + rloc * 128 + ((c ^ (rloc & 7)) << 4)) = q[s8]; }
  asm volatile("s_waitcnt lgkmcnt(0)" ::: "memory");
  __builtin_amdgcn_wave_barrier();
#pragma unroll
  for (int mt = 0; mt < 2; ++mt)
#pragma unroll
    for (int nt = 0; nt < 2; ++nt)
#pragma unroll
      for (int i4 = 0; i4 < 4; ++i4) { const int rloc = mt * 32 + r; w[mt][nt][i4] = *(const u32x2*)(stg + rloc * 128 + (((nt * 4 + i4) ^ (rloc & 7)) << 4) + hh * 8); }
  asm volatile("s_waitcnt lgkmcnt(0)" ::: "memory");
  __builtin_amdgcn_wave_barrier();
}
DI void wave_add64_f32(char* stg, f32x16 (&a)[2][2], const float* gsrc, size_t row_stride, int lane, int r, int hh) {
#pragma unroll
  for (int mt = 0; mt < 2; ++mt) {
    f32x4 q[8];
#pragma unroll
    for (int s8 = 0; s8 < 8; ++s8) { const int row = s8 * 4 + (lane >> 4), c = lane & 15; q[s8] = *(const f32x4*)(gsrc + (size_t)(mt * 32 + row) * row_stride + c * 4); }
#pragma unroll
    for (int s8 = 0; s8 < 8; ++s8) { const int row = s8 * 4 + (lane >> 4), c = lane & 15; *(f32x4*)(stg + row * 256 + ((c ^ (row & 15)) << 4)) = q[s8]; }
    asm volatile("s_waitcnt lgkmcnt(0)" ::: "memory");
    __builtin_amdgcn_wave_barrier();
#pragma unroll
    for (int nt = 0; nt < 2; ++nt)
#pragma unroll
      for (int i4 = 0; i4 < 4; ++i4) {
        const f32x4 xv = *(const f32x4*)(stg + r * 256 + (((nt * 8 + 2 * i4 + hh) ^ (r & 15)) << 4));
#pragma unroll
        for (int jj = 0; jj < 4; ++jj) a[mt][nt][4 * i4 + jj] += xv[jj];
      }
    asm volatile("s_waitcnt lgkmcnt(0)" ::: "memory");
    __builtin_amdgcn_wave_barrier();
  }
}
DI void wave_store64_f32(char* stg, const f32x16 (&a)[2][2], float* gdst, size_t row_stride, int lane, int r, int hh) {
#pragma unroll
  for (int mt = 0; mt < 2; ++mt) {
#pragma unroll
    for (int nt = 0; nt < 2; ++nt)
#pragma unroll
      for (int i4 = 0; i4 < 4; ++i4) {
        const f32x4 v = {a[mt][nt][4 * i4], a[mt][nt][4 * i4 + 1], a[mt][nt][4 * i4 + 2], a[mt][nt][4 * i4 + 3]};
        *(f32x4*)(stg + r * 256 + (((nt * 8 + 2 * i4 + hh) ^ (r & 15)) << 4)) = v;
      }
    asm volatile("s_waitcnt lgkmcnt(0)" ::: "memory");
    __builtin_amdgcn_wave_barrier();
#pragma unroll
    for (int s8 = 0; s8 < 8; ++s8) {
      const int row = s8 * 4 + (lane >> 4), c = lane & 15;
      const f32x4 q = *(const f32x4*)(stg + row * 256 + ((c ^ (row & 15)) << 4));
      *(f32x4*)(gdst + (size_t)(mt * 32 + row) * row_stride + c * 4) = q;
    }
    asm volatile("s_waitcnt lgkmcnt(0)" ::: "memory");
    __builtin_amdgcn_wave_barrier();
  }
}

DI size_t blk_off(int row, int col, int KB) { return (((size_t)(row >> 7) * KB + (col >> 6)) * 128 + (row & 127)) * 64 + (col & 63); }

DI void transpose_tile(const float* __restrict__ src, int ld, int K, int kt, int nt, int job, const float* g0, const float* g1, bf16_t* __restrict__ dst, char* lds) {
  bf16_t* tile = (bf16_t*)lds;
  const int t = tid(), nl = t & 63, kq = t >> 6;
  const int n = nt * 64 + nl;
  int c = n;
  if (job == 0) { c = n < 1024 ? n : (n < 1536 ? 1056 + (n - 1024) : (n < 1568 ? 1024 + (n - 1536) : -1)); }
  else if (job == 2) c = (n >> 6) * 128 + (n & 63);
  else if (job == 3) c = (n >> 6) * 128 + 64 + (n & 63);
#pragma unroll 4
  for (int pass = 0; pass < 16; ++pass) {
    const int kl = pass * 4 + kq, k = kt * 64 + kl;
    float v = 0.f;
    if (c >= 0) {
      v = src[(size_t)k * ld + c];
      if (g0) { const float g = (g1 && k >= 512) ? g1[k - 512] : g0[k]; v *= g; }
    }
    tile[nl * 66 + kl] = f2bf(v);
  }
  __syncthreads();
  const int kl = t & 63;
#pragma unroll 4
  for (int pass = 0; pass < 16; ++pass) { const int nl2 = pass * 4 + kq; dst[(size_t)(nt * 64 + nl2) * K + kt * 64 + kl] = tile[nl2 * 66 + kl]; }
  __syncthreads();
}

DI void phase0(const Params& p, char* lds) {
  const int t = tid(), nb = gridDim.x, bid = blockIdx.x, lane = t & 63, wid = t >> 6;
  for (int ti = bid; ti < 2992; ti += nb) {
    int job, base, nNt, ld, K; const float* src; const float* g0 = nullptr; const float* g1 = nullptr; bf16_t* dst;
    if (ti < 416) { job = 0; base = 0; nNt = 26; ld = 1568; K = 1024; src = p.in[7]; g0 = p.in[6]; dst = p.WinT; }
    else if (ti < 560) { job = 1; base = 416; nNt = 12; ld = 768; K = 768; src = p.in[9]; g0 = p.in[8]; dst = p.WqT; }
    else if (ti < 592) { job = 2; base = 560; nNt = 8; ld = 1024; K = 256; src = p.in[11]; dst = p.WkT; }
    else if (ti < 624) { job = 3; base = 592; nNt = 8; ld = 1024; K = 256; src = p.in[11]; dst = p.WvT; }
    else if (ti < 688) { job = 4; base = 624; nNt = 8; ld = 512; K = 512; src = p.in[20]; dst = p.WgT; }
    else if (ti < 944) { job = 5; base = 688; nNt = 16; ld = 1024; K = 1024; src = p.in[23]; g0 = p.in[21]; g1 = p.in[22]; dst = p.WoT; }
    else if (ti < 1968) { job = 6; base = 944; nNt = 64; ld = 4096; K = 1024; src = p.in[25]; g0 = p.in[24]; dst = p.WuT; }
    else { job = 7; base = 1968; nNt = 16; ld = 1024; K = 4096; src = p.in[26]; dst = p.WdT; }
    const int tile = ti - base;
    transpose_tile(src, ld, K, tile / nNt, tile % nNt, job, g0, g1, dst, lds);
  }
  for (int row = bid * 4 + wid; row < NT; row += nb * 4) {
    const float* x = xrow(p, row);
    f32x4 v[4]; float ss = 0.f;
#pragma unroll
    for (int j = 0; j < 4; ++j) { v[j] = *(const f32x4*)(x + lane * 4 + 256 * j); ss += v[j][0] * v[j][0] + v[j][1] * v[j][1] + v[j][2] * v[j][2] + v[j][3] * v[j][3]; }
    ss += __shfl_xor(ss, 32); ss = half_reduce(ss);
#pragma unroll
    for (int j = 0; j < 4; ++j) { u32x2 w; w.x = pk_bf16(v[j][0], v[j][1]); w.y = pk_bf16(v[j][2], v[j][3]); *(u32x2*)(p.xb + blk_off(row, lane * 4 + 256 * j, 16)) = w; }
    if (lane == 0) p.rstd_x[row] = rsqrtf(ss * (1.f / 1024.f) + EPS);
  }
  const int gt = bid * 256 + t, ngt = nb * 256;
  for (int v = gt; v < 32 * 4096 * 32; v += ngt) {
    const size_t e0 = (size_t)v * 8; const int b = (int)(e0 >> 20), rem = (int)(e0 & 1048575), tt = rem >> 8, c = rem & 255;
    const f32x4 a = *(const f32x4*)(p.in[2] + e0), bq = *(const f32x4*)(p.in[2] + e0 + 4);
    u32x4 w; w.x = pk_bf16(a[0], a[1]); w.y = pk_bf16(a[2], a[3]); w.z = pk_bf16(bq[0], bq[1]); w.w = pk_bf16(bq[2], bq[3]);
    *(u32x4*)(p.latb + (size_t)(NTP + b * SKS + tt) * 256 + c) = w;
  }
  for (int v = gt; v < 32 * 4096 * 4; v += ngt) {
    const size_t e0 = (size_t)v * 8; const int b = (int)(e0 >> 17), rem = (int)(e0 & 131071), tt = rem >> 5, c = rem & 31;
    const f32x4 a = *(const f32x4*)(p.in[3] + e0), bq = *(const f32x4*)(p.in[3] + e0 + 4);
    u32x4 w; w.x = pk_bf16(a[0], a[1]); w.y = pk_bf16(a[2], a[3]); w.z = pk_bf16(bq[0], bq[1]); w.w = pk_bf16(bq[2], bq[3]);
    *(u32x4*)(p.krb + (size_t)(NTP + b * SKS + tt) * 32 + c) = w;
  }
  if (gt < 2048) {
    const int g = gt >> 6, n = gt & 63;
    const double dt = (double)expf(p.in[14][g]);
    const double lr = p.in[12][gt], li = p.in[13][gt];
    const double mag = (double)expf((float)(lr * dt)); double s, c; sincos_d(li * dt, s, c);
    const double lbr = mag * c, lbi = mag * s;
    const double nr = lbr - 1.0, ni = lbi, den = lr * lr + li * li;
    const double cr = (nr * lr + ni * li) / den, ci = (ni * lr - nr * li) / den;
    p.lam[gt] = make_float2((float)lbr, (float)lbi);
    const double mag64 = (double)expf((float)(64.0 * lr * dt)); sincos_d(64.0 * li * dt, s, c);
    p.lam64[gt] = make_float2((float)(mag64 * c), (float)(mag64 * s));
    for (int q = 0; q < 16; ++q) {
      const double br = p.in[15][(size_t)gt * 16 + q], bi = p.in[16][(size_t)gt * 16 + q];
      p.BbT[(size_t)(g * 128 + n) * 16 + q] = f2bf((float)(cr * br - ci * bi));
      p.BbT[(size_t)(g * 128 + 64 + n) * 16 + q] = f2bf((float)(cr * bi + ci * br));
      p.CcT[(size_t)(g * 16 + q) * 128 + n] = f2bf(p.in[17][(size_t)(g * 16 + q) * 64 + n]);
      p.CcT[(size_t)(g * 16 + q) * 128 + 64 + n] = f2bf(-p.in[18][(size_t)(g * 16 + q) * 64 + n]);
    }
  }
  for (int e = gt; e < 8192 * 16; e += ngt) {
    const int pos = e >> 4, i = e & 15;
    const float inv = expf(-(float)i * (9.210340371976184f / 16.0f));
    const float ang = (float)pos * inv;
    double s, c; sincos_d((double)ang, s, c);
    p.rope[e] = make_float2((float)c, (float)s);
  }
}

DI void phase1(const Params& p, char* lds) {
  float* rs = (float*)(lds + 65536);
  const int ntiles = 528 * 13;
  {
    auto tile_fn = [&](int j, int& m0, int& n0) -> bool { const int li = (int)(blockIdx.x >> 3) + j * (int)(gridDim.x >> 3); const int ti_ = li / 13, tj_ = li - ti_ * 13; const int tbig = ti_ * 8 + (int)(blockIdx.x & 7); if (tbig >= 528) return false; m0 = tbig * 128; n0 = tj_ * 128; return true; };
    auto rs_fn = [&](int m0, int t) -> float2 { return make_float2(p.rstd_x[m0 + t], 0.f); };
    auto epi = [&](f32x16 (&acc)[2][2], int m0, int n0, const float* rs, int fstage) { (void)fstage;
    const int tn = n0 >> 7; (void)tn;
    { EPI_IDS
    u32x2 wq[2][2][4];
    if (tn < 8) {
#pragma unroll
      for (int mt = 0; mt < 2; ++mt) {
        const int rl = wm * 64 + mt * 32 + r, row = m0 + rl;
        const float sc = rs[rl];
        float ss = 0.f;
#pragma unroll
        for (int nt = 0; nt < 2; ++nt)
#pragma unroll
          for (int i4 = 0; i4 < 4; ++i4) {
            const float v0 = acc[mt][nt][4 * i4] * sc, v1 = acc[mt][nt][4 * i4 + 1] * sc, v2 = acc[mt][nt][4 * i4 + 2] * sc, v3 = acc[mt][nt][4 * i4 + 3] * sc;
            ss += v0 * v0 + v1 * v1 + v2 * v2 + v3 * v3;
            const int col = n0 + wn * 64 + nt * 32 + 8 * i4 + 4 * hh;
            if (tn < 6) { wq[mt][nt][i4].x = pk_bf16(v0, v1); wq[mt][nt][i4].y = pk_bf16(v2, v3); }
            else { acc[mt][nt][4 * i4] = v0; acc[mt][nt][4 * i4 + 1] = v1; acc[mt][nt][4 * i4 + 2] = v2; acc[mt][nt][4 * i4 + 3] = v3; }
          }
        ss += __shfl_xor(ss, 32);
        if (hh == 0) { if (tn < 6) p.cq_part[(size_t)row * 12 + tn * 2 + wn] = ss; else p.ckv_part[(size_t)row * 4 + (tn - 6) * 2 + wn] = ss; }
      }
      if (tn < 6) wave_store64(wave_stage(lds, fstage, wid), wq, p.cq + blk_off(m0 + wm * 64, n0 + wn * 64, 12), 64, lane, r, hh);
      else wave_store64_f32(wave_stage(lds, fstage, wid), acc, p.ckv_raw + (size_t)(m0 + wm * 64) * 256 + (n0 - 768) + wn * 64, 256, lane, r, hh);
    } else if (tn < 12) {
#pragma unroll
      for (int mt = 0; mt < 2; ++mt) {
        const int rl = wm * 64 + mt * 32 + r, row = m0 + rl;
        const float sc = rs[rl];
#pragma unroll
        for (int nt = 0; nt < 2; ++nt)
#pragma unroll
          for (int i4 = 0; i4 < 4; ++i4) {
            wq[mt][nt][i4].x = pk_bf16(acc[mt][nt][4 * i4] * sc, acc[mt][nt][4 * i4 + 1] * sc); wq[mt][nt][i4].y = pk_bf16(acc[mt][nt][4 * i4 + 2] * sc, acc[mt][nt][4 * i4 + 3] * sc);
          }
      }
      wave_store64(wave_stage(lds, fstage, wid), wq, p.ub + (size_t)(m0 + wm * 64) * 512 + (n0 - 1024) + wn * 64, 512, lane, r, hh);
    } else if (wn == 0) {
#pragma unroll
      for (int mt = 0; mt < 2; ++mt) {
        const int rl = wm * 64 + mt * 32 + r, row = m0 + rl;
        const float sc = rs[rl];
        float* dst = row < NTP ? p.out + OFF_KRP + (size_t)row * 32 : p.out + OFF_KRS + (size_t)(row - NTP) * 32;
        bf16_t* dkb = p.krb + (size_t)kr_of(row) * 32;
        const float* rp = (const float*)(p.rope + pos_of(row) * 16);
#pragma unroll
        for (int ih = 0; ih < 2; ++ih) {
          const int j0 = 8 * ih + 4 * hh;
          const f32x4 c01 = *(const f32x4*)(rp + 2 * j0), c23 = *(const f32x4*)(rp + 2 * j0 + 4);
          const float cc[4] = {c01[0], c01[2], c23[0], c23[2]}, sn[4] = {c01[1], c01[3], c23[1], c23[3]};
          f32x4 o1, o2;
#pragma unroll
          for (int jj = 0; jj < 4; ++jj) {
            const float x1 = acc[mt][0][4 * ih + jj] * sc, x2 = acc[mt][0][8 + 4 * ih + jj] * sc;
            o1[jj] = x1 * cc[jj] - x2 * sn[jj]; o2[jj] = x1 * sn[jj] + x2 * cc[jj];
          }
          *(f32x4*)(dst + j0) = o1; *(f32x4*)(dst + 16 + j0) = o2;
          u32x2 w1, w2; w1.x = pk_bf16(o1[0], o1[1]); w1.y = pk_bf16(o1[2], o1[3]); w2.x = pk_bf16(o2[0], o2[1]); w2.y = pk_bf16(o2[2], o2[3]);
          *(u32x2*)(dkb + j0) = w1; *(u32x2*)(dkb + 16 + j0) = w2;
        }
      }
    }
    }
    __syncthreads();
    };
    gemm_stream<true>(p.xb, 1024, p.WinT, 1024, 16, lds, 0, tile_fn, rs_fn, epi);
  }
}

DI void ssm_chunk(const Params& p, int row0, int g, float& hr, float& hi, bool write_y, char* lds_w) {
  const int lane = tid() & 63, r = lane & 31, hh = lane >> 5;
  const float2 lm = p.lam[g * 64 + lane];
  bf16x8 bfr[4];
#pragma unroll
  for (int nt = 0; nt < 4; ++nt) bfr[nt] = *(const bf16x8*)(p.BbT + (size_t)(g * 128 + nt * 32 + r) * 16 + hh * 8);
  const int fr = lane & 15, fq = lane >> 4;
  bf16x8 cfr[4];
#pragma unroll
  for (int ks = 0; ks < 4; ++ks) cfr[ks] = *(const bf16x8*)(p.CcT + (size_t)(g * 16 + fr) * 128 + ks * 32 + fq * 8);
  const float dsk = p.in[19][g * 16 + fr];
#pragma unroll 1
  for (int sub = 0; sub < 2; ++sub) {
    const int rb = row0 + sub * 32;
    const bf16x8 uf = *(const bf16x8*)(p.ub + (size_t)(rb + r) * 512 + g * 16 + hh * 8);
    f32x16 z; for (int i = 0; i < 16; ++i) z[i] = 0.f;
    const f32x16 x0 = MFMA32(uf, bfr[0], z), x1 = MFMA32(uf, bfr[1], z), x2 = MFMA32(uf, bfr[2], z), x3 = MFMA32(uf, bfr[3], z);
    float xr0[16], xr1[16], xi0[16], xi1[16];
#pragma unroll
    for (int i = 0; i < 16; ++i) {
      const auto re = __builtin_amdgcn_permlane32_swap(__float_as_uint(x0[i]), __float_as_uint(x1[i]), false, false);
      const auto im = __builtin_amdgcn_permlane32_swap(__float_as_uint(x2[i]), __float_as_uint(x3[i]), false, false);
      xr0[i] = __uint_as_float(re[0]); xr1[i] = __uint_as_float(re[1]);
      xi0[i] = __uint_as_float(im[0]); xi1[i] = __uint_as_float(im[1]);
    }
    bf16_t* Hs = (bf16_t*)lds_w;
#pragma unroll
    for (int m = 0; m < 4; ++m) {
#pragma unroll
      for (int half = 0; half < 2; ++half) {
#pragma unroll
        for (int jj = 0; jj < 4; ++jj) {
          const int i = 4 * m + jj, tt = 8 * m + 4 * half + jj;
          const float xr = half ? xr1[i] : xr0[i], xi = half ? xi1[i] : xi0[i];
          const float nr = lm.x * hr - lm.y * hi + xr;
          const float ni = lm.x * hi + lm.y * hr + xi;
          hr = nr; hi = ni;
          if (write_y) { Hs[tt * 136 + lane] = f2bf(hr); Hs[tt * 136 + 64 + lane] = f2bf(hi); }
        }
      }
    }
    if (write_y) {
      asm volatile("s_waitcnt lgkmcnt(0)" ::: "memory");
      __builtin_amdgcn_wave_barrier();
#pragma unroll
      for (int mt = 0; mt < 2; ++mt) {
        f32x4 y = {0.f, 0.f, 0.f, 0.f};
#pragma unroll
        for (int ks = 0; ks < 4; ++ks) {
          const bf16x8 hf = *(const bf16x8*)(Hs + (mt * 16 + fr) * 136 + ks * 32 + fq * 8);
          y = MFMA16(hf, cfr[ks], y);
        }
#pragma unroll
        for (int j = 0; j < 4; ++j) {
          const int row = rb + mt * 16 + fq * 4 + j;
          const float u = bf2f(p.ub[(size_t)row * 512 + g * 16 + fr]);
          const float v = y[j] + dsk * u;
          const float zz = 0.7978845608028654f * (v + 0.044715f * v * v * v);
          const float th = 1.f - 2.f / (__expf(2.f * zz) + 1.f);
          p.ssm_y[(size_t)row * 512 + g * 16 + fr] = f2bf(0.5f * v * (1.f + th));
        }
      }
      asm volatile("s_waitcnt lgkmcnt(0)" ::: "memory");
      __builtin_amdgcn_wave_barrier();
    }
  }
}

DI void phase2(const Params& p, char* lds) {
  const int lane = tid() & 63, wid = tid() >> 6;
  const int nb = gridDim.x, bid = blockIdx.x;
  for (int row = bid * 4 + wid; row < NT; row += nb * 4) {
    const f32x4 v = *(const f32x4*)(p.ckv_raw + (size_t)row * 256 + lane * 4);
    const f32x4 pp = *(const f32x4*)(p.ckv_part + (size_t)row * 4);
    const float rstd = rsqrtf((pp[0] + pp[1] + pp[2] + pp[3]) * (1.f / 256.f) + EPS);
    const f32x4 g = *(const f32x4*)(p.in[10] + lane * 4);
    f32x4 o; o[0] = v[0] * rstd * g[0]; o[1] = v[1] * rstd * g[1]; o[2] = v[2] * rstd * g[2]; o[3] = v[3] * rstd * g[3];
    float* dst = row < NTP ? p.out + OFF_LATP + (size_t)row * 256 : p.out + OFF_LATS + (size_t)(row - NTP) * 256;
    *(f32x4*)(dst + lane * 4) = o;
    u32x2 w; w.x = pk_bf16(o[0], o[1]); w.y = pk_bf16(o[2], o[3]);
    *(u32x2*)(p.latb + (size_t)kr_of(row) * 256 + lane * 4) = w;
  }
  for (int it = bid * 4 + wid; it < 8 * 128 * 32; it += nb * 4) {
    const int g = it & 31, c = (it >> 5) & 127, b = it >> 12;
    float hr = 0.f, hi = 0.f;
    ssm_chunk(p, b * 8192 + c * 64, g, hr, hi, false, lds + wid * 8704);
    p.E[(size_t)it * 64 + lane] = make_float2(hr, hi);
  }
  float* rs = (float*)(lds + 65536);
  {
    auto tile_fn = [&](int j, int& m0, int& n0) -> bool { const int li = (int)(blockIdx.x >> 3) + j * (int)(gridDim.x >> 3); const int ti_ = li / 6, tj_ = li - ti_ * 6; const int tbig = ti_ * 8 + (int)(blockIdx.x & 7); if (tbig >= 528) return false; m0 = tbig * 128; n0 = tj_ * 128; return true; };
    auto rs_fn = [&](int m0, int t) -> float2 { float sm = 0.f; for (int q = 0; q < 3; ++q) { const f32x4 v = *(const f32x4*)(p.cq_part + (size_t)(m0 + t) * 12 + 4 * q); sm += (v[0] + v[1]) + (v[2] + v[3]); } return make_float2(rsqrtf(sm * (1.f / 768.f) + EPS), 0.f); };
    auto epi = [&](f32x16 (&acc)[2][2], int m0, int n0, const float* rs, int fstage) { (void)fstage;
    const int tn = n0 >> 7; (void)tn;
    EPI_IDS
    const float qs = 0.10206207261596577f * 1.4426950408889634f;
    u32x2 wq[2][2][4];
#pragma unroll
    for (int mt = 0; mt < 2; ++mt) {
      const int rl = wm * 64 + mt * 32 + r, row = m0 + rl;
      const float sc = rs[rl] * qs;
      const float* rp = (const float*)(p.rope + pos_of(row) * 16);
#pragma unroll
      for (int nt = 0; nt < 2; ++nt) {
        const int cb = n0 + wn * 64 + nt * 32;
        if ((cb % 96) == 64) {
#pragma unroll
          for (int ih = 0; ih < 2; ++ih) {
            const int j0 = 8 * ih + 4 * hh;
            const f32x4 c01 = *(const f32x4*)(rp + 2 * j0), c23 = *(const f32x4*)(rp + 2 * j0 + 4);
            const float cc[4] = {c01[0], c01[2], c23[0], c23[2]}, sn[4] = {c01[1], c01[3], c23[1], c23[3]};
            float o1[4], o2[4];
#pragma unroll
            for (int jj = 0; jj < 4; ++jj) {
              const float x1 = acc[mt][nt][4 * ih + jj] * sc, x2 = acc[mt][nt][8 + 4 * ih + jj] * sc;
              o1[jj] = x1 * cc[jj] - x2 * sn[jj]; o2[jj] = x1 * sn[jj] + x2 * cc[jj];
            }
            wq[mt][nt][ih].x = pk_bf16(o1[0], o1[1]); wq[mt][nt][ih].y = pk_bf16(o1[2], o1[3]); wq[mt][nt][ih + 2].x = pk_bf16(o2[0], o2[1]); wq[mt][nt][ih + 2].y = pk_bf16(o2[2], o2[3]);
          }
        } else {
#pragma unroll
          for (int i4 = 0; i4 < 4; ++i4) {
            wq[mt][nt][i4].x = pk_bf16(acc[mt][nt][4 * i4] * sc, acc[mt][nt][4 * i4 + 1] * sc); wq[mt][nt][i4].y = pk_bf16(acc[mt][nt][4 * i4 + 2] * sc, acc[mt][nt][4 * i4 + 3] * sc);
          }
        }
      }
    }

    wave_store64(wave_stage(lds, fstage, wid), wq, p.Q + (size_t)(m0 + wm * 64) * 768 + n0 + wn * 64, 768, lane, r, hh);
    __syncthreads();
    };
    gemm_stream<true>(p.cq, 768, p.WqT, 768, 12, lds, 0, tile_fn, rs_fn, epi);
  }
}

DI void phase3(const Params& p, char* lds) {
  const int lane = tid() & 63, wid = tid() >> 6;
  const int nb = gridDim.x, bid = blockIdx.x;
  for (int it = bid * 4 + wid; it < 256; it += nb * 4) {
    const int b = it >> 5, g = it & 31;
    const float2 l64 = p.lam64[g * 64 + lane];
    float sr = 0.f, si = 0.f;
    const size_t base = ((size_t)(b * 128) * 32 + g) * 64 + lane;
    for (int c0 = 0; c0 < 128; c0 += 16) {
      float2 e[16];
#pragma unroll
      for (int j = 0; j < 16; ++j) e[j] = p.E[base + (size_t)(c0 + j) * 2048];
#pragma unroll
      for (int j = 0; j < 16; ++j) {
        p.S[base + (size_t)(c0 + j) * 2048] = make_float2(sr, si);
        const float nr = l64.x * sr - l64.y * si + e[j].x, ni = l64.x * si + l64.y * sr + e[j].y;
        sr = nr; si = ni;
      }
    }
  }
  {
    auto tile_fn = [&](int j, int& m0, int& n0) -> bool { const int li = (int)(blockIdx.x >> 3) + j * (int)(gridDim.x >> 3); const int ti_ = li / 4, tj_ = li - ti_ * 4; const int tbig = ti_ * 8 + (int)(blockIdx.x & 7); if (tbig >= 1552) return false; m0 = tbig * 128; n0 = tj_ * 128; return true; };
    auto rs_fn = [&](int m0, int t) -> float2 { return make_float2(0.f, 0.f); };
    auto epi = [&](f32x16 (&acc)[2][2], int m0, int n0, const float* rs, int fstage) { (void)fstage;
    const int tn = n0 >> 7; (void)tn;
    EPI_IDS
    u32x2 w[2][2][4];
#pragma unroll
    for (int mt = 0; mt < 2; ++mt)
#pragma unroll
      for (int nt = 0; nt < 2; ++nt)
#pragma unroll
        for (int i4 = 0; i4 < 4; ++i4) { w[mt][nt][i4].x = pk_bf16(acc[mt][nt][4 * i4], acc[mt][nt][4 * i4 + 1]); w[mt][nt][i4].y = pk_bf16(acc[mt][nt][4 * i4 + 2], acc[mt][nt][4 * i4 + 3]); }
    wave_store64(wave_stage(lds, fstage, wid), w, p.Kn + (size_t)(m0 + wm * 64) * 512 + n0 + wn * 64, 512, lane, r, hh);
    __syncthreads();
    };
    gemm_stream(p.latb, 256, p.WkT, 256, 4, lds, 0, tile_fn, rs_fn, epi);
  }
  {
    auto tile_fn = [&](int j, int& m0, int& n0) -> bool { const int li = (int)(blockIdx.x >> 3) + j * (int)(gridDim.x >> 3); const int ti_ = li / 4, tj_ = li - ti_ * 4; const int tbig = ti_ * 8 + (int)(blockIdx.x & 7); if (tbig >= 1552) return false; n0 = tbig * 128; m0 = tj_ * 128; return true; };
    auto rs_fn = [&](int m0, int t) -> float2 { return make_float2(0.f, 0.f); };
    auto epi = [&](f32x16 (&acc)[2][2], int m0, int n0, const float* rs, int fstage) { (void)fstage;
    const int tn = n0 >> 7; (void)tn;
    EPI_IDS
    u32x2 w[2][2][4];
#pragma unroll
    for (int mt = 0; mt < 2; ++mt)
#pragma unroll
      for (int nt = 0; nt < 2; ++nt)
#pragma unroll
        for (int i4 = 0; i4 < 4; ++i4) { w[mt][nt][i4].x = pk_bf16(acc[mt][nt][4 * i4], acc[mt][nt][4 * i4 + 1]); w[mt][nt][i4].y = pk_bf16(acc[mt][nt][4 * i4 + 2], acc[mt][nt][4 * i4 + 3]); }
    const int kr0 = n0 + wn * 64;
    size_t cbase; int S;
    if (kr0 < NTP) { cbase = (size_t)(kr0 >> 13) * 512 * 8192 + (kr0 & 8191); S = 8192; }
    else { const int k2 = kr0 - NTP, b = k2 / SKS, tt = k2 - b * SKS; cbase = VT_S_OFF + (size_t)b * 512 * SKS + tt; S = SKS; }
    wave_store64(wave_stage(lds, fstage, wid), w, p.Vt + cbase + (size_t)(m0 + wm * 64) * S, (size_t)S, lane, r, hh);
    __syncthreads();
    };
    gemm_stream(p.WvT, 256, p.latb, 256, 4, lds, 0, tile_fn, rs_fn, epi);
  }
}

template <int QT, bool HALF>
DI void attn_item(const Params& p, int kind, int b, int h, int qq, char* lds) {
  const int t = tid(), lane = t & 63, wid = t >> 6, r = lane & 31, hh = lane >> 5;
  int qrow0, nkb_w, nkb_max, S; size_t kr0; const bf16_t* vt_base;
  constexpr int RW = 32 * QT, WPC = 64 / RW, CPB = 4 / WPC;
  if (kind == 0) {
    const int c = qq * CPB + wid / WPC; qrow0 = b * 8192 + c * 64 + (wid % WPC) * RW; nkb_w = c + 1; nkb_max = qq * CPB + CPB; kr0 = (size_t)b * 8192; S = 8192;
    vt_base = p.Vt + (size_t)(b * 8 + h) * 64 * 8192;
  } else {
    qrow0 = NTP + b * 64 + (wid % WPC) * RW; nkb_w = (wid < WPC) ? 65 : 0; nkb_max = 65; kr0 = (size_t)NTP + (size_t)b * SKS; S = SKS;
    vt_base = p.Vt + VT_S_OFF + (size_t)(b * 8 + h) * 64 * SKS;
  }
  bf16x8 qf[QT][6];
#pragma unroll
  for (int qt = 0; qt < QT; ++qt)
#pragma unroll
    for (int ks = 0; ks < 6; ++ks) qf[qt][ks] = *(const bf16x8*)(p.Q + (size_t)(qrow0 + qt * 32 + r) * 768 + h * 96 + ks * 16 + hh * 8);
  f32x16 o[2][QT];
  float mrun[QT], lrun[QT];
#pragma unroll
  for (int qt = 0; qt < QT; ++qt) { mrun[qt] = -1e30f; lrun[qt] = 0.f;
#pragma unroll
    for (int dt = 0; dt < 2; ++dt)
#pragma unroll
      for (int i = 0; i < 16; ++i) o[dt][qt][i] = 0.f; }
  const int kkey = t >> 3, kc = t & 7;
  const int rkey = t >> 2, rc = t & 3;
  const int vd = t >> 3, vc = t & 7;
  const bf16_t* gk = p.Kn + (kr0 + kkey) * 512 + h * 64 + kc * 8;
  const bf16_t* gr = p.krb + (kr0 + rkey) * 32 + rc * 8;
  const bf16_t* gv = vt_base + (size_t)vd * S + vc * 8;
  const unsigned kw0 = kkey * 208 + kc * 16, kw1 = kw0 + 32 * 208, rw = rkey * 208 + 128 + rc * 16;
  const unsigned vlo = vd * 144 + (vc >> 1) * 32 + (vc & 1) * 8, vhi = vlo + 16;
  constexpr int KB = 13312, VB = 9216, BUF = KB + VB;
  u32x4 k0r, k1r, rr, v0r, v1r;
  k0r = *(const u32x4*)gk; k1r = *(const u32x4*)(gk + 32 * 512); rr = *(const u32x4*)gr;
  v0r = *(const u32x4*)gv; v1r = *(const u32x4*)(gv + (size_t)32 * S);
  __syncthreads();
  {
    char* kb_ = lds; char* vb_ = lds + KB;
    *(u32x4*)(kb_ + kw0) = k0r; *(u32x4*)(kb_ + kw1) = k1r; *(u32x4*)(kb_ + rw) = rr;
    *(u32x2*)(vb_ + vlo) = (u32x2){v0r.x, v0r.y}; *(u32x2*)(vb_ + vhi) = (u32x2){v0r.z, v0r.w};
    *(u32x2*)(vb_ + vlo + 32 * 144) = (u32x2){v1r.x, v1r.y}; *(u32x2*)(vb_ + vhi + 32 * 144) = (u32x2){v1r.z, v1r.w};
  }
  __syncthreads();
  for (int kb = 0; kb < nkb_max; ++kb) {
    const int cur = kb & 1;
    const bool more = kb + 1 < nkb_max;
    if (more) {
      const size_t ko = (size_t)(kb + 1) * 64;
      k0r = *(const u32x4*)(gk + ko * 512); k1r = *(const u32x4*)(gk + (ko + 32) * 512); rr = *(const u32x4*)(gr + ko * 32);
      v0r = *(const u32x4*)(gv + ko); v1r = *(const u32x4*)(gv + (size_t)32 * S + ko);
    }
    if (HALF && kb < nkb_w) {
      const char* kt_ = lds + cur * BUF; const char* vt_ = kt_ + KB;
#pragma unroll
      for (int kt = 0; kt < 2; ++kt) {
        __builtin_amdgcn_iglp_opt(0);
        f32x16 sh[QT];
#pragma unroll
        for (int qt = 0; qt < QT; ++qt)
#pragma unroll
          for (int i = 0; i < 16; ++i) sh[qt][i] = 0.f;
#pragma unroll
        for (int ks = 0; ks < 6; ++ks) {
          const bf16x8 kf = *(const bf16x8*)(kt_ + (kt * 32 + r) * 208 + ks * 32 + hh * 16);
#pragma unroll
          for (int qt = 0; qt < QT; ++qt) sh[qt] = MFMA32(kf, qf[qt][ks], sh[qt]);
        }
        bf16x8 ph[QT][2];
#pragma unroll
        for (int qt = 0; qt < QT; ++qt) {
          float mx = sh[qt][0];
#pragma unroll
          for (int i = 1; i < 16; ++i) mx = fmaxf(mx, sh[qt][i]);
          mx = fmaxf(mx, __shfl_xor(mx, 32));
          const bool need = mx > mrun[qt] + 8.f;
          if (__any(need)) {
            const float mnew = need ? mx : mrun[qt];
            const float alpha = __builtin_amdgcn_exp2f(mrun[qt] - mnew);
            mrun[qt] = mnew; lrun[qt] *= alpha;
#pragma unroll
            for (int dt = 0; dt < 2; ++dt)
#pragma unroll
              for (int i = 0; i < 16; ++i) o[dt][qt][i] *= alpha;
          }
          float ls = 0.f;
#pragma unroll
          for (int i = 0; i < 16; ++i) { const float pv = __builtin_amdgcn_exp2f(sh[qt][i] - mrun[qt]); ls += pv; sh[qt][i] = pv; }
          lrun[qt] += ls;
#pragma unroll
          for (int s2 = 0; s2 < 2; ++s2) {
            u32x4 w;
            w.x = pk_bf16(sh[qt][8 * s2 + 0], sh[qt][8 * s2 + 1]); w.y = pk_bf16(sh[qt][8 * s2 + 2], sh[qt][8 * s2 + 3]);
            w.z = pk_bf16(sh[qt][8 * s2 + 4], sh[qt][8 * s2 + 5]); w.w = pk_bf16(sh[qt][8 * s2 + 6], sh[qt][8 * s2 + 7]);
            ph[qt][s2] = __builtin_bit_cast(bf16x8, w);
          }
        }
#pragma unroll
        for (int dt = 0; dt < 2; ++dt)
#pragma unroll
          for (int s2 = 0; s2 < 2; ++s2) {
            const bf16x8 vf = *(const bf16x8*)(vt_ + (dt * 32 + r) * 144 + (kt * 2 + s2) * 32 + hh * 16);
#pragma unroll
            for (int qt = 0; qt < QT; ++qt) o[dt][qt] = MFMA32(vf, ph[qt][s2], o[dt][qt]);
          }
      }
    }
    if (!HALF && kb < nkb_w) {
      const char* kt_ = lds + cur * BUF; const char* vt_ = kt_ + KB;
      f32x16 st[2][QT];
#pragma unroll
      for (int kt = 0; kt < 2; ++kt)
#pragma unroll
        for (int qt = 0; qt < QT; ++qt)
#pragma unroll
          for (int i = 0; i < 16; ++i) st[kt][qt][i] = 0.f;
#pragma unroll
      for (int ks = 0; ks < 6; ++ks)
#pragma unroll
        for (int kt = 0; kt < 2; ++kt) {
          const bf16x8 kf = *(const bf16x8*)(kt_ + (kt * 32 + r) * 208 + ks * 32 + hh * 16);
#pragma unroll
          for (int qt = 0; qt < QT; ++qt) st[kt][qt] = MFMA32(kf, qf[qt][ks], st[kt][qt]);
        }
      bf16x8 pb[2][QT][2];
#pragma unroll
      for (int qt = 0; qt < QT; ++qt) {
        float mx = mrun[qt];
#pragma unroll
        for (int kt = 0; kt < 2; ++kt)
#pragma unroll
          for (int i = 0; i < 16; ++i) mx = fmaxf(mx, st[kt][qt][i]);
        mx = fmaxf(mx, __shfl_xor(mx, 32));
        const float alpha = __builtin_amdgcn_exp2f(mrun[qt] - mx);
        mrun[qt] = mx;
        float ls = 0.f;
#pragma unroll
        for (int kt = 0; kt < 2; ++kt) {
#pragma unroll
          for (int i = 0; i < 16; ++i) { const float pv = __builtin_amdgcn_exp2f(st[kt][qt][i] - mx); ls += pv; st[kt][qt][i] = pv; }
#pragma unroll
          for (int s2 = 0; s2 < 2; ++s2) {
            u32x4 w;
            w.x = pk_bf16(st[kt][qt][8 * s2 + 0], st[kt][qt][8 * s2 + 1]); w.y = pk_bf16(st[kt][qt][8 * s2 + 2], st[kt][qt][8 * s2 + 3]);
            w.z = pk_bf16(st[kt][qt][8 * s2 + 4], st[kt][qt][8 * s2 + 5]); w.w = pk_bf16(st[kt][qt][8 * s2 + 6], st[kt][qt][8 * s2 + 7]);
            pb[kt][qt][s2] = __builtin_bit_cast(bf16x8, w);
          }
        }
        lrun[qt] = lrun[qt] * alpha + ls;
#pragma unroll
        for (int dt = 0; dt < 2; ++dt)
#pragma unroll
          for (int i = 0; i < 16; ++i) o[dt][qt][i] *= alpha;
      }
#pragma unroll
      for (int dt = 0; dt < 2; ++dt)
#pragma unroll
        for (int kt = 0; kt < 2; ++kt)
#pragma unroll
          for (int s2 = 0; s2 < 2; ++s2) {
            const bf16x8 vf = *(const bf16x8*)(vt_ + (dt * 32 + r) * 144 + (kt * 2 + s2) * 32 + hh * 16);
#pragma unroll
            for (int qt = 0; qt < QT; ++qt) o[dt][qt] = MFMA32(vf, pb[kt][qt][s2], o[dt][qt]);
          }
    }
    if (more) {
      char* kb_ = lds + (cur ^ 1) * BUF; char* vb_ = kb_ + KB;
      *(u32x4*)(kb_ + kw0) = k0r; *(u32x4*)(kb_ + kw1) = k1r; *(u32x4*)(kb_ + rw) = rr;
      *(u32x2*)(vb_ + vlo) = (u32x2){v0r.x, v0r.y}; *(u32x2*)(vb_ + vhi) = (u32x2){v0r.z, v0r.w};
      *(u32x2*)(vb_ + vlo + 32 * 144) = (u32x2){v1r.x, v1r.y}; *(u32x2*)(vb_ + vhi + 32 * 144) = (u32x2){v1r.z, v1r.w};
    }
    __syncthreads();
  }
  if (nkb_w > 0) {
    u32x2 wo[2][2][4];
#pragma unroll
    for (int qt = 0; qt < QT; ++qt) {
      const float lt = lrun[qt] + __shfl_xor(lrun[qt], 32);
      const float inv = 1.f / lt;
      const int row = qrow0 + qt * 32 + r;
      float ss = 0.f;
#pragma unroll
      for (int dt = 0; dt < 2; ++dt)
#pragma unroll
        for (int i4 = 0; i4 < 4; ++i4) {
          const float a0 = o[dt][qt][4 * i4] * inv, a1 = o[dt][qt][4 * i4 + 1] * inv, a2 = o[dt][qt][4 * i4 + 2] * inv, a3 = o[dt][qt][4 * i4 + 3] * inv;
          ss += a0 * a0 + a1 * a1 + a2 * a2 + a3 * a3;
          u32x2 w; w.x = pk_bf16(a0, a1); w.y = pk_bf16(a2, a3);
          if (QT == 2) wo[qt][dt][i4] = w;
          else *(u32x2*)(p.mix + blk_off(row, h * 64 + dt * 32 + 8 * i4 + 4 * hh, 16)) = w;
        }
      ss += __shfl_xor(ss, 32);
      if (hh == 0) p.attn_part[(size_t)row * 8 + h] = ss;
    }
    if (QT == 2) wave_store64(lds + wid * 8192, wo, p.mix + blk_off(qrow0, h * 64, 16), 64, lane, r, hh);
  }
}

DI void phase4(const Params& p, char* lds, int qidx) {
  const int t = tid(), lane = t & 63, wid = t >> 6;
  const int nb = gridDim.x, bid = blockIdx.x;
  int* nxt = (int*)(lds + 65536);
  for (;;) {
    __syncthreads();
    if (t == 0) *nxt = atomicAdd(p.counters + qidx, 1);
    __syncthreads();
    const int it = *nxt;
    if (it >= 256 + 64 * 32) break;
    if (it < 256) attn_item<1, false>(p, 1, it >> 3, it & 7, 0, lds);
    else { const int j = it - 256; const int qq = 31 - (j >> 6), bh = j & 63; attn_item<2, true>(p, 0, bh >> 3, bh & 7, qq, lds); }
  }
  __syncthreads();
  for (int it = bid * 4 + wid; it < 8 * 128 * 32 + 1024; it += nb * 4) {
    if (it < 8 * 128 * 32) {
      const int g = it & 31, c = (it >> 5) & 127, b = it >> 12;
      const float2 s0 = p.S[(size_t)it * 64 + lane];
      float hr = s0.x, hi = s0.y;
      ssm_chunk(p, b * 8192 + c * 64, g, hr, hi, true, lds + wid * 8704);
      if (c == 127) { p.out[OFF_HRP + (size_t)(b * 32 + g) * 64 + lane] = hr; p.out[OFF_HIP + (size_t)(b * 32 + g) * 64 + lane] = hi; }
    } else {
      const int j = it - 8 * 128 * 32, g = j & 31, b = j >> 5;
      float hr = p.in[4][(size_t)(b * 32 + g) * 64 + lane], hi = p.in[5][(size_t)(b * 32 + g) * 64 + lane];
      ssm_chunk(p, NTP + b * 64, g, hr, hi, true, lds + wid * 8704);
      p.out[OFF_HRS + (size_t)(b * 32 + g) * 64 + lane] = hr; p.out[OFF_HIS + (size_t)(b * 32 + g) * 64 + lane] = hi;
    }
  }
}

DI void phase5(const Params& p, char* lds) {
  {
    auto tile_fn = [&](int j, int& m0, int& n0) -> bool { const int li = (int)(blockIdx.x >> 3) + j * (int)(gridDim.x >> 3); const int ti_ = li / 4, tj_ = li - ti_ * 4; const int tbig = ti_ * 8 + (int)(blockIdx.x & 7); if (tbig >= 528) return false; m0 = tbig * 128; n0 = tj_ * 128; return true; };
    auto rs_fn = [&](int m0, int t) -> float2 { return make_float2(0.f, 0.f); };
    auto epi = [&](f32x16 (&acc)[2][2], int m0, int n0, const float* rs, int fstage) { (void)fstage;
    const int tn = n0 >> 7; (void)tn;
    { EPI_IDS
    u32x2 wq[2][2][4], yw[2][2][4];
    wave_load64(wave_stage(lds, fstage, wid), yw, p.ssm_y + (size_t)(m0 + wm * 64) * 512 + n0 + wn * 64, 512, lane, r, hh);
#pragma unroll
    for (int mt = 0; mt < 2; ++mt) {
      const int row = m0 + wm * 64 + mt * 32 + r;
      float ss = 0.f;
#pragma unroll
      for (int nt = 0; nt < 2; ++nt)
#pragma unroll
        for (int i4 = 0; i4 < 4; ++i4) {
          const int col = n0 + wn * 64 + nt * 32 + 8 * i4 + 4 * hh;
          const u32x2 yv = yw[mt][nt][i4];
          const float y0 = __uint_as_float(yv.x << 16), y1 = __uint_as_float(yv.x & 0xffff0000u), y2 = __uint_as_float(yv.y << 16), y3 = __uint_as_float(yv.y & 0xffff0000u);
          const float o0 = y0 / (1.f + __expf(-acc[mt][nt][4 * i4])), o1 = y1 / (1.f + __expf(-acc[mt][nt][4 * i4 + 1]));
          const float o2 = y2 / (1.f + __expf(-acc[mt][nt][4 * i4 + 2])), o3 = y3 / (1.f + __expf(-acc[mt][nt][4 * i4 + 3]));
          ss += o0 * o0 + o1 * o1 + o2 * o2 + o3 * o3;
          wq[mt][nt][i4].x = pk_bf16(o0, o1); wq[mt][nt][i4].y = pk_bf16(o2, o3);
        }
      ss += __shfl_xor(ss, 32);
      if (hh == 0) p.ssm_part[(size_t)row * 8 + tn * 2 + wn] = ss;
    }
    wave_store64(wave_stage(lds, fstage, wid), wq, p.mix + blk_off(m0 + wm * 64, 512 + n0 + wn * 64, 16), 64, lane, r, hh);
    }
    __syncthreads();
    };
    gemm_stream(p.ssm_y, 512, p.WgT, 512, 8, lds, 0, tile_fn, rs_fn, epi);
  }
}

DI void phase6(const Params& p, char* lds) {
  const int xb_ = blockIdx.x & 7, xl_ = blockIdx.x >> 3, nbx_ = gridDim.x >> 3;
  {
    auto tile_fn = [&](int j, int& m0, int& n0) -> bool { const int li6 = xl_ + j * nbx_, tm = (li6 >> 3) * 8 + xb_; if (tm >= 528) return false; m0 = tm * 128; n0 = (li6 & 7) * 128; return true; };
    auto rs_fn = [&](int m0, int t) -> float2 {
      const f32x4 a0 = *(const f32x4*)(p.attn_part + (size_t)(m0 + t) * 8), a1 = *(const f32x4*)(p.attn_part + (size_t)(m0 + t) * 8 + 4);
      const float sa = (a0[0] + a0[1]) + (a0[2] + a0[3]) + (a1[0] + a1[1]) + (a1[2] + a1[3]);
      const f32x4 b0 = *(const f32x4*)(p.ssm_part + (size_t)(m0 + t) * 8), b1 = *(const f32x4*)(p.ssm_part + (size_t)(m0 + t) * 8 + 4);
      const float sb = (b0[0] + b0[1]) + (b0[2] + b0[3]) + (b1[0] + b1[1]) + (b1[2] + b1[3]);
      const float ra = rsqrtf(sa * (1.f / 512.f) + EPS), rb = rsqrtf(sb * (1.f / 512.f) + EPS);
      return make_float2(rb, ra / rb); };
    auto epi = [&](f32x16 (&acc)[2][2], int m0, int n0, const float* rs, int fstage) { (void)fstage;
    const int tn = n0 >> 7;
    { EPI_IDS
    char* stg = wave_stage(lds, fstage, wid);
#pragma unroll
    for (int mt = 0; mt < 2; ++mt) {
      const float sc = rs[wm * 64 + mt * 32 + r];
#pragma unroll
      for (int nt = 0; nt < 2; ++nt)
#pragma unroll
        for (int i = 0; i < 16; ++i) acc[mt][nt][i] *= sc;
    }
    wave_add64_f32(stg, acc, xrow(p, m0 + wm * 64) + n0 + wn * 64, 1024, lane, r, hh);
    u32x2 w[2][2][4];
#pragma unroll
    for (int mt = 0; mt < 2; ++mt) {
      const int row = m0 + wm * 64 + mt * 32 + r;
      float ss = 0.f;
#pragma unroll
      for (int nt = 0; nt < 2; ++nt)
#pragma unroll
        for (int i4 = 0; i4 < 4; ++i4) {
#pragma unroll
          for (int jj = 0; jj < 4; ++jj) ss += acc[mt][nt][4 * i4 + jj] * acc[mt][nt][4 * i4 + jj];
          w[mt][nt][i4].x = pk_bf16(acc[mt][nt][4 * i4], acc[mt][nt][4 * i4 + 1]); w[mt][nt][i4].y = pk_bf16(acc[mt][nt][4 * i4 + 2], acc[mt][nt][4 * i4 + 3]);
        }
      ss += __shfl_xor(ss, 32);
      if (hh == 0) p.h_part[(size_t)row * 16 + tn * 2 + wn] = ss;
    }
    wave_store64(stg, w, p.hb + blk_off(m0 + wm * 64, n0 + wn * 64, 16), 64, lane, r, hh);
    }
    __syncthreads();
    };
    gemm_stream<true>(p.mix, 1024, p.WoT, 1024, 16, lds, 8, tile_fn, rs_fn, epi);
  }
}

DI void phase7(const Params& p, char* lds) {
  float* rs = (float*)(lds + 65536);
  const int xb_ = blockIdx.x & 7, xl_ = blockIdx.x >> 3, nbx_ = gridDim.x >> 3;
  {
    auto tile_fn = [&](int j, int& m0, int& n0) -> bool { const int tm = j * (nbx_ >> 2) + (xl_ >> 2); if (tm >= 528) return false; m0 = tm * 128; n0 = (xb_ * 4 + (xl_ & 3)) * 128; return true; };
    auto rs_fn = [&](int m0, int t) -> float2 { float sm = 0.f; for (int q = 0; q < 4; ++q) { const f32x4 v = *(const f32x4*)(p.h_part + (size_t)(m0 + t) * 16 + 4 * q); sm += (v[0] + v[1]) + (v[2] + v[3]); } return make_float2(rsqrtf(sm * (1.f / 1024.f) + EPS), 0.f); };
    auto epi = [&](f32x16 (&acc)[2][2], int m0, int n0, const float* rs, int fstage) { (void)fstage;
    const int tn = n0 >> 7; (void)tn;
    { EPI_IDS
    char* stg = lds + (wid < 2 ? 0 : 32768) + fstage * 16384 + (wid & 1) * 8192;
#pragma unroll
    for (int mt = 0; mt < 2; ++mt) {
      const int rloc = mt * 32 + r;
      const float sc = rs[wm * 64 + rloc];
#pragma unroll
      for (int nt = 0; nt < 2; ++nt)
#pragma unroll
        for (int i4 = 0; i4 < 4; ++i4) {
          float v[4];
#pragma unroll
          for (int jj = 0; jj < 4; ++jj) { const float a_ = fmaxf(acc[mt][nt][4 * i4 + jj] * sc, 0.f); v[jj] = a_ * a_; }
          u32x2 w; w.x = pk_bf16(v[0], v[1]); w.y = pk_bf16(v[2], v[3]);
          *(u32x2*)(stg + rloc * 128 + (((nt * 4 + i4) ^ (rloc & 7)) << 4) + hh * 8) = w;
        }
    }
    asm volatile("s_waitcnt lgkmcnt(0)" ::: "memory");
    __builtin_amdgcn_wave_barrier();
    bf16_t* gdst = p.act + ((((size_t)(m0 >> 7) * 64 + (n0 >> 6) + wn) * 128 + wm * 64) * 64);
#pragma unroll
    for (int s8 = 0; s8 < 8; ++s8) {
      const int rloc = s8 * 8 + (lane >> 3), c = lane & 7;
      const u32x4 q = *(const u32x4*)(stg + rloc * 128 + ((c ^ (rloc & 7)) << 4));
      *(u32x4*)(gdst + rloc * 64 + c * 8) = q;
    }
    }
    __syncthreads();
    };
    gemm_stream<true>(p.hb, 1024, p.WuT, 1024, 16, lds, 0, tile_fn, rs_fn, epi);
  }
}

DI void phase8(const Params& p, char* lds) {
  const int xb_ = blockIdx.x & 7, xl_ = blockIdx.x >> 3, nbx_ = gridDim.x >> 3;
  {
    auto tile_fn = [&](int j, int& m0, int& n0) -> bool { const int li = (int)(blockIdx.x >> 3) + j * (int)(gridDim.x >> 3); const int ti_ = li / 8, tj_ = li - ti_ * 8; const int tbig = ti_ * 8 + (int)(blockIdx.x & 7); if (tbig >= 528) return false; m0 = tbig * 128; n0 = tj_ * 128; return true; };
    auto rs_fn = [&](int m0, int t) -> float2 { return make_float2(0.f, 0.f); };
    auto epi = [&](f32x16 (&acc)[2][2], int m0, int n0, const float* rs, int fstage) { (void)fstage;
    const int tn = n0 >> 7; (void)tn;
    { EPI_IDS
    char* stg = wave_stage(lds, fstage, wid);
    u32x2 hw[2][2][4];
    wave_load64(stg, hw, p.hb + blk_off(m0 + wm * 64, n0 + wn * 64, 16), 64, lane, r, hh);
#pragma unroll
    for (int mt = 0; mt < 2; ++mt) {
      const int row = m0 + wm * 64 + mt * 32 + r;
      float ss = 0.f;
#pragma unroll
      for (int nt = 0; nt < 2; ++nt)
#pragma unroll
        for (int i4 = 0; i4 < 4; ++i4) {
          const u32x2 hq = hw[mt][nt][i4];
          const float h0 = __uint_as_float(hq.x << 16), h1 = __uint_as_float(hq.x & 0xffff0000u), h2 = __uint_as_float(hq.y << 16), h3 = __uint_as_float(hq.y & 0xffff0000u);
          acc[mt][nt][4 * i4] += h0; acc[mt][nt][4 * i4 + 1] += h1; acc[mt][nt][4 * i4 + 2] += h2; acc[mt][nt][4 * i4 + 3] += h3;
#pragma unroll
          for (int jj = 0; jj < 4; ++jj) ss += acc[mt][nt][4 * i4 + jj] * acc[mt][nt][4 * i4 + jj];
        }
      ss += __shfl_xor(ss, 32);
      if (hh == 0) p.out_part[(size_t)row * 16 + tn * 2 + wn] = ss;
    }
    wave_store64_f32(stg, acc, p.out + OFF_Y + (size_t)(m0 + wm * 64) * 1024 + n0 + wn * 64, 1024, lane, r, hh);
    }
    __syncthreads();
    };
    gemm_stream<true>(p.act, 4096, p.WdT, 4096, 64, lds, 0, tile_fn, rs_fn, epi);
  }
}

DI void phase9(const Params& p) {
  const int t = tid(), lane = t & 63, wid = t >> 6;
  for (int row = blockIdx.x * 4 + wid; row < NT; row += gridDim.x * 4) {
    float s = 0.f;
    for (int j = 0; j < 16; ++j) s += p.out_part[(size_t)row * 16 + j];
    const float rstd = rsqrtf(s * (1.f / 1024.f) + EPS);
    float* y = p.out + OFF_Y + (size_t)row * 1024;
#pragma unroll
    for (int j = 0; j < 4; ++j) {
      f32x4 v = *(const f32x4*)(y + lane * 4 + 256 * j);
      const f32x4 g = *(const f32x4*)(p.in[27] + lane * 4 + 256 * j);
      v[0] *= rstd * g[0]; v[1] *= rstd * g[1]; v[2] *= rstd * g[2]; v[3] *= rstd * g[3];
      *(f32x4*)(y + lane * 4 + 256 * j) = v;
    }
  }
}

DI void grid_barrier(unsigned* cnt, unsigned target) {
  asm volatile("s_waitcnt vmcnt(0)" ::: "memory");
  __syncthreads();
  if (tid() == 0) {
    __builtin_amdgcn_fence(__ATOMIC_RELEASE, "agent");
    asm volatile("s_waitcnt vmcnt(0)" ::: "memory");
    __hip_atomic_fetch_add(cnt, 1u, __ATOMIC_RELAXED, __HIP_MEMORY_SCOPE_AGENT);
    while (__hip_atomic_load(cnt, __ATOMIC_RELAXED, __HIP_MEMORY_SCOPE_AGENT) < target) __builtin_amdgcn_s_sleep(2);
  }
  __syncthreads();
  __builtin_amdgcn_fence(__ATOMIC_ACQUIRE, "agent");
  asm volatile("s_waitcnt vmcnt(0)" ::: "memory");
}

#define XB_TMO      128
#define XB_XCNT(j)  (256  + 64 * (j))
#define XB_XSUB(j)  (1280 + 64 * (j))
#define XB_XGEN(j)  (2304 + 64 * (j))
#define XB_TOP      3328
#define XB_TOPGEN   3392
#define XCD_BAR_WORDS 3456
#define XB_SPIN_CAP (1u << 22)
#define LAS __attribute__((address_space(3)))
DI unsigned xb_ld(unsigned* p)              { return __hip_atomic_load(p, __ATOMIC_RELAXED, __HIP_MEMORY_SCOPE_AGENT); }
DI unsigned xb_add(unsigned* p, unsigned v) { return __hip_atomic_fetch_add(p, v, __ATOMIC_RELAXED, __HIP_MEMORY_SCOPE_AGENT); }
DI unsigned xb_xcc_id() { return (unsigned)__builtin_amdgcn_s_getreg((3 << 11) | 20) & 0xFu; }
#define XB_SPIN(cond, bar) do { unsigned _sp = 0; while (cond) { __builtin_amdgcn_s_sleep(1); \
    if ((++_sp & 255u) == 0u) { if (xb_ld(&(bar)[XB_TMO])) break; if (_sp > XB_SPIN_CAP) { atomicAdd(&(bar)[XB_TMO], 1u); break; } } } } while (0)
struct XcdBarrier { unsigned* bar; unsigned x; volatile LAS unsigned* st; };
DI XcdBarrier xcd_barrier_post(unsigned* bar, volatile LAS unsigned* st) {
  XcdBarrier b; b.bar = bar; b.x = xb_xcc_id(); b.st = st;
  if (tid() == 0) (void)xb_add(&bar[XB_XCNT(b.x)], 1u);
  return b;
}
DI void xcd_barrier_complete(unsigned* bar, unsigned x, unsigned& nloc, unsigned& nx) {
  const unsigned G = gridDim.x * gridDim.y * gridDim.z;
  unsigned sum, cnt, mine, sp = 0u;
  for (;;) {
    sum = 0u; cnt = 0u; mine = 0u;
#pragma unroll
    for (unsigned j = 0; j < 16; ++j) { const unsigned c = xb_ld(&bar[XB_XCNT(j)]); sum += c; cnt += (c > 0u) ? 1u : 0u; mine = (j == x) ? c : mine; }
    if (sum == G) break;
    __builtin_amdgcn_s_sleep(1);
    if ((++sp & 255u) == 0u) { if (xb_ld(&bar[XB_TMO])) break; if (sp > XB_SPIN_CAP) { atomicAdd(&bar[XB_TMO], 1u); break; } }
  }
  nloc = mine > 0u ? mine : 1u; nx = cnt > 0u ? cnt : 1u;
}
DI void xcd_barrier(const XcdBarrier& b) {
  asm volatile("s_waitcnt vmcnt(0)" ::: "memory");
  __syncthreads();
  if (tid() == 0) {
    unsigned* bar = b.bar;
    __builtin_amdgcn_s_waitcnt(0);
    unsigned nloc = b.st[0], nx = b.st[1];
    if (nloc == 0u) { xcd_barrier_complete(bar, b.x, nloc, nx); b.st[0] = nloc; b.st[1] = nx; }
    const unsigned old = xb_add(&bar[XB_XSUB(b.x)], 1u);
    const unsigned gen = old / nloc;
    if (old + 1u == (gen + 1u) * nloc) {
      __builtin_amdgcn_fence(__ATOMIC_RELEASE, "agent");
      asm volatile("s_waitcnt vmcnt(0)" ::: "memory");
      const unsigned og = xb_add(&bar[XB_TOP], 1u);
      const unsigned tg = og / nx;
      if (og + 1u == (tg + 1u) * nx) xb_add(&bar[XB_TOPGEN], 1u);
      else XB_SPIN(xb_ld(&bar[XB_TOPGEN]) == tg, bar);
      __builtin_amdgcn_fence(__ATOMIC_ACQUIRE, "agent");
      xb_add(&bar[XB_XGEN(b.x)], 1u);
      asm volatile("s_waitcnt vmcnt(0)" ::: "memory");
    } else {
      XB_SPIN(xb_ld(&bar[XB_XGEN(b.x)]) == gen, bar);
      __builtin_amdgcn_fence(__ATOMIC_ACQUIRE, "agent");
      asm volatile("s_waitcnt vmcnt(0)" ::: "memory");
    }
  }
  __syncthreads();
}

template <bool COOP>
__global__ void __launch_bounds__(256, 2) mega(Params p) {
  __shared__ __attribute__((aligned(16))) char lds[LDS_BYTES];
  XcdBarrier xb{};
  if (COOP) {
    volatile LAS unsigned* st = (volatile LAS unsigned*)(lds + 67584);
    if (tid() == 0) { st[0] = 0u; st[1] = 0u; }
    __syncthreads();
    xb = xcd_barrier_post((unsigned*)p.counters + 64, st);
  }
  for (int ph = p.ph_lo; ph < p.ph_hi; ++ph) {
#ifdef ONLY_PHASE
    if (ph != ONLY_PHASE) continue;
#endif
    switch (ph) {
      case 0: phase0(p, lds); break;
      case 1: phase1(p, lds); break;
      case 2: phase2(p, lds); break;
      case 3: phase3(p, lds); break;
      case 4: phase4(p, lds, 0); break;
      case 5: phase5(p, lds); break;
      case 6: phase6(p, lds); break;
      case 7: phase7(p, lds); break;
      case 8: phase8(p, lds); break;
      default: phase9(p); break;
    }
#ifdef DOUBLE_PHASE
    if (ph == DOUBLE_PHASE) {
      __syncthreads();
      switch (ph) { case 0: phase0(p, lds); break; case 1: phase1(p, lds); break; case 2: phase2(p, lds); break; case 3: phase3(p, lds); break; case 4: phase4(p, lds, 1); break;
                    case 5: phase5(p, lds); break; case 6: phase6(p, lds); break; case 7: phase7(p, lds); break; default: break; }
    }
#endif
    if (COOP) { if (ph + 1 < p.ph_hi) { if (ph == 0) cg::this_grid().sync(); else xcd_barrier(xb); } }
  }
}

static size_t al256(size_t x) { return (x + 255) & ~(size_t)255; }

extern "C" void kernel_launch(void* const* d_in, const int* in_sizes, int n_in, void* d_out, int out_size, void* d_ws, size_t ws_size, hipStream_t stream) {
  Params p{};
  for (int i = 0; i < 28; ++i) p.in[i] = (const float*)d_in[i];
  p.out = (float*)d_out;
  char* base = (char*)d_ws; size_t off = 0;
  auto take = [&](size_t bytes) { char* q = base + off; off = al256(off + bytes); return q; };
  p.WinT = (bf16_t*)take((size_t)1664 * 1024 * 2);
  p.WqT = (bf16_t*)take((size_t)768 * 768 * 2);
  p.WkT = (bf16_t*)take((size_t)512 * 256 * 2);
  p.WvT = (bf16_t*)take((size_t)512 * 256 * 2);
  p.WgT = (bf16_t*)take((size_t)512 * 512 * 2);
  p.WoT = (bf16_t*)take((size_t)1024 * 1024 * 2);
  p.WuT = (bf16_t*)take((size_t)4096 * 1024 * 2);
  p.WdT = (bf16_t*)take((size_t)1024 * 4096 * 2);
  p.BbT = (bf16_t*)take((size_t)32 * 128 * 16 * 2);
  p.CcT = (bf16_t*)take((size_t)32 * 16 * 128 * 2);
  p.lam = (float2*)take(2048 * 8);
  p.lam64 = (float2*)take(2048 * 8);
  p.rope = (float2*)take((size_t)8192 * 16 * 8);
  p.rstd_x = (float*)take((size_t)NT * 4);
  p.cq_part = (float*)take((size_t)NT * 12 * 4);
  p.ckv_part = (float*)take((size_t)NT * 4 * 4);
  p.attn_part = (float*)take((size_t)NT * 8 * 4);
  p.ssm_part = (float*)take((size_t)NT * 8 * 4);
  p.h_part = (float*)take((size_t)NT * 16 * 4);
  p.out_part = (float*)take((size_t)NT * 16 * 4);
  p.counters = (int*)take(16384);
  p.E = (float2*)take((size_t)8 * 128 * 32 * 64 * 8);
  p.S = (float2*)take((size_t)8 * 128 * 32 * 64 * 8);
  const size_t a0 = off;
  p.Kn = (bf16_t*)take((size_t)NK * 512 * 2);
  const size_t aVt = off;
  p.Vt = (bf16_t*)take((size_t)NK * 512 * 2);
  p.Q = (bf16_t*)take((size_t)NT * 768 * 2);
  p.latb = (bf16_t*)take((size_t)NK * 256 * 2);
  p.krb = (bf16_t*)take((size_t)NK * 32 * 2);
  p.ub = (bf16_t*)take((size_t)NT * 512 * 2);
  const size_t aSsmY = off;
  p.ssm_y = (bf16_t*)take((size_t)NT * 512 * 2);
  p.mix = (bf16_t*)take((size_t)NT * 1024 * 2);
  const size_t total = off;
  p.xb = (bf16_t*)(base + a0);
  p.cq = (bf16_t*)(base + aVt);
  p.ckv_raw = (float*)(base + aVt + al256((size_t)NT * 768 * 2));
  p.act = (bf16_t*)(base + a0);
  const size_t aHb = a0 + al256((size_t)NT * 4096 * 2);
  p.hb = (bf16_t*)(base + aHb);
  if (aHb + (size_t)NT * 1024 * 2 > aSsmY || total > ws_size) { fprintf(stderr, "workspace layout error: total %zu ws %zu\n", total, ws_size); return; }

  const int MULTI = 0;
  hipMemsetAsync(p.counters, 0, 16384, stream);
  if (MULTI) {
    for (int ph = 0; ph < NPHASE; ++ph) {
      p.ph_lo = ph; p.ph_hi = ph + 1;
      hipLaunchKernelGGL(mega<false>, dim3(512), dim3(256), 0, stream, p);
    }
  } else {
    static int grid_blocks = 0;
    if (!grid_blocks) {
      int dev = 0, cus = 0, per_cu = 0;
      hipGetDevice(&dev);
      hipDeviceGetAttribute(&cus, hipDeviceAttributeMultiprocessorCount, dev);
      hipOccupancyMaxActiveBlocksPerMultiprocessor(&per_cu, mega<true>, 256, 0);
      grid_blocks = cus * per_cu;
    }
    p.ph_lo = 0; p.ph_hi = NPHASE;
    void* args[] = {&p};
    hipError_t e = hipLaunchCooperativeKernel((void*)mega<true>, dim3(grid_blocks), dim3(256), args, 0, stream);
    if (e != hipSuccess) fprintf(stderr, "cooperative launch failed: %s (grid %d)\n", hipGetErrorString(e), grid_blocks);
  }
}
```

```cpp
#include <hip/hip_runtime.h>
#include <hip/hip_cooperative_groups.h>
#include <stdint.h>
#include <cstdio>
namespace cg = cooperative_groups;
#define DI __device__ __forceinline__

typedef unsigned short bf16_t;
typedef short bf16x8 __attribute__((ext_vector_type(8)));
typedef float f32x16 __attribute__((ext_vector_type(16)));
typedef float f32x4 __attribute__((ext_vector_type(4)));
typedef unsigned u32x4 __attribute__((ext_vector_type(4)));
typedef unsigned u32x2 __attribute__((ext_vector_type(2)));

constexpr int NTP = 65536, NTS = 2048, NT = NTP + NTS, NK = NTP + 32 * 4160;
constexpr int SKS = 4160;
constexpr size_t OFF_Y = 0;
constexpr size_t OFF_LATP = (size_t)NT * 1024;
constexpr size_t OFF_KRP = OFF_LATP + (size_t)NTP * 256;
constexpr size_t OFF_HRP = OFF_KRP + (size_t)NTP * 32;
constexpr size_t OFF_HIP = OFF_HRP + 8 * 32 * 64;
constexpr size_t OFF_LATS = OFF_HIP + 8 * 32 * 64;
constexpr size_t OFF_KRS = OFF_LATS + (size_t)NTS * 256;
constexpr size_t OFF_HRS = OFF_KRS + (size_t)NTS * 32;
constexpr size_t OFF_HIS = OFF_HRS + 32 * 32 * 64;
constexpr size_t VT_S_OFF = (size_t)8 * 512 * 8192;
constexpr float EPS = 1e-6f;
constexpr int LDS_BYTES = 67600;
constexpr int NPHASE = 10;
constexpr int AQT = 1, NQQ = 128 / (4 / (64 / (32 * AQT)));

struct Params {
  const float* in[28];
  float* out;
  bf16_t *WinT, *WqT, *WkT, *WvT, *WgT, *WoT, *WuT, *WdT, *BbT, *CcT;
  float2 *lam, *lam64, *rope;
  float *rstd_x, *cq_part, *ckv_part, *attn_part, *ssm_part, *h_part, *out_part;
  int* counters;
  float2 *E, *S;
  bf16_t *Kn, *Vt, *Q, *latb, *krb, *ub, *ssm_y, *mix, *xb, *cq, *hb, *act;
  float* ckv_raw;
  int ph_lo, ph_hi;
};

DI int tid() { int t = __builtin_amdgcn_workitem_id_x(); asm volatile("" : "+v"(t)); return t; }
typedef __bf16 nbf16x2 __attribute__((ext_vector_type(2)));
typedef float f32x2 __attribute__((ext_vector_type(2)));
DI unsigned pk_bf16(float lo, float hi) { f32x2 v = {lo, hi}; return __builtin_bit_cast(unsigned, __builtin_convertvector(v, nbf16x2)); }
DI bf16_t f2bf(float x) { return (bf16_t)(pk_bf16(x, 0.f) & 0xffffu); }
DI float bf2f(bf16_t v) { return __uint_as_float(((unsigned)v) << 16); }
DI int crow(int i, int hh) { return (i & 3) + 8 * (i >> 2) + 4 * hh; }
DI const float* xrow(const Params& p, int row) { return row < NTP ? p.in[0] + (size_t)row * 1024 : p.in[1] + (size_t)(row - NTP) * 1024; }
DI int pos_of(int row) { return row < NTP ? (row & 8191) : 4096 + ((row - NTP) & 63); }
DI int kr_of(int row) { return row < NTP ? row : NTP + ((row - NTP) >> 6) * SKS + 4096 + ((row - NTP) & 63); }
#define MFMA32(a, b, c) __builtin_amdgcn_mfma_f32_32x32x16_bf16((a), (b), (c), 0, 0, 0)
#define MFMA16(a, b, c) __builtin_amdgcn_mfma_f32_16x16x32_bf16((a), (b), (c), 0, 0, 0)

DI void sincos_d(double x, double& s4, double& c4) {
  double k = rint(x * 0.15915494309189535);
  double rr = fma(-k, 6.283185307179586, x);
  rr = fma(-k, 2.4492935982947064e-16, rr);
  double y = rr * 0.25, y2 = y * y;
  double s = y * (1 - y2 / 6 * (1 - y2 / 20 * (1 - y2 / 42 * (1 - y2 / 72 * (1 - y2 / 110 * (1 - y2 / 156 * (1 - y2 / 210)))))));
  double c = 1 - y2 / 2 * (1 - y2 / 12 * (1 - y2 / 30 * (1 - y2 / 56 * (1 - y2 / 90 * (1 - y2 / 132 * (1 - y2 / 182))))));
  double s2 = 2 * s * c, c2 = 1 - 2 * s * s;
  s4 = 2 * s2 * c2; c4 = 1 - 2 * s2 * s2;
}

DI void gemm_core(const bf16_t* __restrict__ A, int lda, const bf16_t* __restrict__ B, int ldb, int nk,
                  int m0, int n0, char* lds, f32x16 (&acc)[2][2], int midk, const float* ratio) {
  const int t = tid(), lane = t & 63, wid = t >> 6, wm = wid >> 1, wn = wid & 1;
  const int r = lane & 31, hh = lane >> 5;
  const int lc = t & 7, lr = t >> 3;
  const unsigned woff = lr * 128 + ((lc ^ ((lr >> 1) & 7)) << 4);
  const bf16_t* ga = A + (size_t)(m0 + lr) * lda + lc * 8;
  const bf16_t* gb = B + (size_t)(n0 + lr) * ldb + lc * 8;
  char* sA = lds; char* sB = lds + 32768;
  u32x4 ra[4], rb[4];
#pragma unroll
  for (int i = 0; i < 4; ++i) { ra[i] = *(const u32x4*)(ga + (size_t)(32 * i) * lda); rb[i] = *(const u32x4*)(gb + (size_t)(32 * i) * ldb); }
#pragma unroll
  for (int i = 0; i < 4; ++i) { *(u32x4*)(sA + woff + i * 4096) = ra[i]; *(u32x4*)(sB + woff + i * 4096) = rb[i]; }
#pragma unroll
  for (int a = 0; a < 2; ++a)
#pragma unroll
    for (int b = 0; b < 2; ++b)
#pragma unroll
      for (int i = 0; i < 16; ++i) acc[a][b][i] = 0.f;
  __syncthreads();
  const int rsw = (r >> 1) & 7;
  const unsigned aoff = (wm * 64 + r) * 128, boff = (wn * 64 + r) * 128;
  for (int kt = 0; kt < nk; ++kt) {
    const int cur = kt & 1;
    const bool more = (kt + 1 < nk);
    if (more) {
      const bf16_t* ga2 = ga + (kt + 1) * 64; const bf16_t* gb2 = gb + (kt + 1) * 64;
#pragma unroll
      for (int i = 0; i < 4; ++i) { ra[i] = *(const u32x4*)(ga2 + (size_t)(32 * i) * lda); rb[i] = *(const u32x4*)(gb2 + (size_t)(32 * i) * ldb); }
    }
    if (midk && kt == midk) {
#pragma unroll
      for (int mt = 0; mt < 2; ++mt)
      { const float f = ratio[wm * 64 + mt * 32 + r];
#pragma unroll
        for (int i = 0; i < 16; ++i) { acc[mt][0][i] *= f; acc[mt][1][i] *= f; } }
    }
    const char* cA = sA + cur * 16384; const char* cB = sB + cur * 16384;
#pragma unroll
    for (int ks = 0; ks < 4; ++ks) {
      const unsigned co = (((ks * 2 + hh) ^ rsw) << 4);
      const bf16x8 a0 = *(const bf16x8*)(cA + aoff + co), a1 = *(const bf16x8*)(cA + aoff + 4096 + co);
      const bf16x8 b0 = *(const bf16x8*)(cB + boff + co), b1 = *(const bf16x8*)(cB + boff + 4096 + co);
      acc[0][0] = MFMA32(b0, a0, acc[0][0]); acc[0][1] = MFMA32(b1, a0, acc[0][1]);
      acc[1][0] = MFMA32(b0, a1, acc[1][0]); acc[1][1] = MFMA32(b1, a1, acc[1][1]);
    }
    if (more) {
      char* nA = sA + (cur ^ 1) * 16384; char* nB = sB + (cur ^ 1) * 16384;
#pragma unroll
      for (int i = 0; i < 4; ++i) { *(u32x4*)(nA + woff + i * 4096) = ra[i]; *(u32x4*)(nB + woff + i * 4096) = rb[i]; }
    }
    __syncthreads();
  }
}

DI void rowscale_load(float* rs, const float* src, int np, float inv_dim, int m0) {
  const int t = tid();
  if (t < 128) {
    const int row = m0 + t;
    if (np == 0) rs[t] = src[row];
    else { float s = 0.f; for (int j = 0; j < np; ++j) s += src[(size_t)row * np + j]; rs[t] = rsqrtf(s * inv_dim + EPS); }
  }
}

template <bool BLKA = false, class TileFn, class RsFn, class EpiFn>
DI void gemm_stream(const bf16_t* __restrict__ A, int lda, const bf16_t* __restrict__ B, int ldb, int nk, char* lds, int midk,
                    TileFn tile_fn, RsFn rs_fn, EpiFn epi) {
  int m0, n0;
  if (!tile_fn(0, m0, n0)) return;
  const int t = tid(), lane = t & 63, wid = t >> 6, wm = wid >> 1, wn = wid & 1;
  const int r = lane & 31, hh = lane >> 5;
  const int lc = t & 7, lr = t >> 3;
  const unsigned woff = lr * 128 + ((lc ^ ((lr >> 1) & 7)) << 4);
  char* sA = lds; char* sB = lds + 32768;
  float* rsbuf = (float*)(lds + 65536);
  const int rsw = (r >> 1) & 7;
  const unsigned aoff = (wm * 64 + r) * 128, boff = (wn * 64 + r) * 128;
  int lj = 0, lkt = 0, lm0 = m0, ln0 = n0; bool lvalid = true;
  u32x4 ra0[4], rb0[4], ra1[4], rb1[4];
#define GS_LOAD(RA, RB) do {   \
        \
      const bf16_t* ga_ = BLKA ? A + ((size_t)(lm0 >> 7) * nk + lkt) * 8192 + lr * 64 + lc * 8 : A + (size_t)(lm0 + lr) * lda + lc * 8 + lkt * 64; const bf16_t* gb_ = B + (size_t)(ln0 + lr) * ldb + lc * 8 + lkt * 64; \
      _Pragma("unroll") for (int i = 0; i < 4; ++i) { RA[i] = *(const u32x4*)(ga_ + (size_t)(32 * i) * (BLKA ? 64 : lda)); RB[i] = *(const u32x4*)(gb_ + (size_t)(32 * i) * ldb); } \
      if (++lkt == nk) { lkt = 0; if (lvalid) { ++lj; lvalid = tile_fn(lj, lm0, ln0); } } } while (0)
  GS_LOAD(ra0, rb0);
  GS_LOAD(ra1, rb1);
  {
    float2 rv = make_float2(0.f, 0.f);
    if (t < 128) rv = rs_fn(m0, t);
    __syncthreads();
#pragma unroll
    for (int i = 0; i < 4; ++i) { *(u32x4*)(sA + woff + i * 4096) = ra0[i]; *(u32x4*)(sB + woff + i * 4096) = rb0[i]; }
    if (t < 128) { rsbuf[t] = rv.x; rsbuf[128 + t] = rv.y; }
    __syncthreads();
  }
  int cur = 0;
  for (int j = 0;; ++j) {
    int m1 = 0, n1 = 0;
    const bool has_next = tile_fn(j + 1, m1, n1);
    const float* rs = rsbuf + (j & 1) * 256;
    f32x16 acc[2][2];
#pragma unroll
    for (int a = 0; a < 2; ++a)
#pragma unroll
      for (int b = 0; b < 2; ++b)
#pragma unroll
        for (int i = 0; i < 16; ++i) acc[a][b][i] = 0.f;
#define GS_STEP(RL_A, RL_B, RW_A, RW_B, KT) do { \
      const bool last_ = ((KT) + 1 == nk); const bool wr_ = !last_ || has_next; \
      float2 rv_ = make_float2(0.f, 0.f); \
      if (last_ && has_next) { if (t < 128) rv_ = rs_fn(m1, t); asm volatile("" : "+v"(rv_.x), "+v"(rv_.y)); }   \
      GS_LOAD(RL_A, RL_B); \
      if (midk && (KT) == midk) { _Pragma("unroll") for (int mt = 0; mt < 2; ++mt) { const float f = rs[128 + wm * 64 + mt * 32 + r]; \
          _Pragma("unroll") for (int i = 0; i < 16; ++i) { acc[mt][0][i] *= f; acc[mt][1][i] *= f; } } } \
      const char* cA = sA + cur * 16384; const char* cB = sB + cur * 16384; \
      __builtin_amdgcn_iglp_opt(0); \
      _Pragma("unroll") for (int ks = 0; ks < 4; ++ks) { \
        const unsigned co = (((ks * 2 + hh) ^ rsw) << 4); \
        const bf16x8 a0 = *(const bf16x8*)(cA + aoff + co), a1 = *(const bf16x8*)(cA + aoff + 4096 + co); \
        const bf16x8 b0 = *(const bf16x8*)(cB + boff + co), b1 = *(const bf16x8*)(cB + boff + 4096 + co); \
        acc[0][0] = MFMA32(b0, a0, acc[0][0]); acc[0][1] = MFMA32(b1, a0, acc[0][1]); \
        acc[1][0] = MFMA32(b0, a1, acc[1][0]); acc[1][1] = MFMA32(b1, a1, acc[1][1]); } \
      if (wr_) { char* nA = sA + (cur ^ 1) * 16384; char* nB = sB + (cur ^ 1) * 16384; \
        _Pragma("unroll") for (int i = 0; i < 4; ++i) { *(u32x4*)(nA + woff + i * 4096) = RW_A[i]; *(u32x4*)(nB + woff + i * 4096) = RW_B[i]; } \
        if (last_ && t < 128) { float* rn = rsbuf + ((j + 1) & 1) * 256; rn[t] = rv_.x; rn[128 + t] = rv_.y; } } \
      __syncthreads(); cur ^= 1; } while (0)
    for (int kt = 0; kt < nk; kt += 2) {
      GS_STEP(ra0, rb0, ra1, rb1, kt);
      GS_STEP(ra1, rb1, ra0, rb0, kt + 1);
    }
    epi(acc, m0, n0, rs, cur ^ 1);
    if (!has_next) break;
    m0 = m1; n0 = n1;
  }
#undef GS_STEP
#undef GS_LOAD
  __syncthreads();
}

DI float half_reduce(float s) {
  s += __shfl_xor(s, 1); s += __shfl_xor(s, 2); s += __shfl_xor(s, 4); s += __shfl_xor(s, 8); s += __shfl_xor(s, 16); return s;
}

#define EPI_IDS int t = tid(); asm volatile("" : "+v"(t)); const int lane = t & 63, wid = t >> 6, wm = wid >> 1, wn = wid & 1, r = lane & 31, hh = lane >> 5; (void)lane; (void)wid; (void)wm; (void)wn; (void)r; (void)hh;
#define GEMM_IDS const int t = tid(), lane = t & 63, wid = t >> 6, wm = wid >> 1, wn = wid & 1, r = lane & 31, hh = lane >> 5; (void)t; (void)wm; (void)wn; (void)r; (void)hh;

DI char* wave_stage(char* lds, int fstage, int wid) { return lds + (wid < 2 ? 0 : 32768) + fstage * 16384 + (wid & 1) * 8192; }
DI void wave_store64(char* stg, const u32x2 (&w)[2][2][4], bf16_t* gdst, size_t row_stride, int lane, int r, int hh) {
#pragma unroll
  for (int mt = 0; mt < 2; ++mt)
#pragma unroll
    for (int nt = 0; nt < 2; ++nt)
#pragma unroll
      for (int i4 = 0; i4 < 4; ++i4) { const int rloc = mt * 32 + r; *(u32x2*)(stg + rloc * 128 + (((nt * 4 + i4) ^ (rloc & 7)) << 4) + hh * 8) = w[mt][nt][i4]; }
  asm volatile("s_waitcnt lgkmcnt(0)" ::: "memory");
  __builtin_amdgcn_wave_barrier();
#pragma unroll
  for (int s8 = 0; s8 < 8; ++s8) {
    const int rloc = s8 * 8 + (lane >> 3), c = lane & 7;
    const u32x4 q = *(const u32x4*)(stg + rloc * 128 + ((c ^ (rloc & 7)) << 4));
    *(u32x4*)(gdst + (size_t)rloc * row_stride + c * 8) = q;
  }
}

DI void wave_load64(char* stg, u32x2 (&w)[2][2][4], const bf16_t* gsrc, size_t row_stride, int lane, int r, int hh) {
  u32x4 q[8];
#pragma unroll
  for (int s8 = 0; s8 < 8; ++s8) { const int rloc = s8 * 8 + (lane >> 3), c = lane & 7; q[s8] = *(const u32x4*)(gsrc + (size_t)rloc * row_stride + c * 8); }
#pragma unroll
  for (int s8 = 0; s8 < 8; ++s8) { const int rloc = s8 * 8 + (lane >> 3), c = lane & 7; *(u32x4*)(stg + rloc * 128 + ((c ^ (rloc & 7)) << 4)) = q[s8]; }
  asm volatile("s_waitcnt lgkmcnt(0)" ::: "memory");
  __builtin_amdgcn_wave_barrier();
#pragma unroll
  for (int mt = 0; mt < 2; ++mt)
#pragma unroll
    for (int nt = 0; nt < 2; ++nt)
#pragma unroll
      for (int i4 = 0; i4 < 4; ++i4) { const int rloc = mt * 32 + r; w[mt][nt][i4] = *(const u32x2*)(stg + rloc * 128 + (((nt * 4 + i4) ^ (rloc & 7)) << 4) + hh * 8); }
  asm volatile("s_waitcnt lgkmcnt(0)" ::: "memory");
  __builtin_amdgcn_wave_barrier();
}
DI void wave_add64_f32(char* stg, f32x16 (&a)[2][2], const float* gsrc, size_t row_stride, int lane, int r, int hh) {
#pragma unroll
  for (int mt = 0; mt < 2; ++mt) {
    f32x4 q[8];
#pragma unroll
    for (int s8 = 0; s8 < 8; ++s8) { const int row = s8 * 4 + (lane >> 4), c = lane & 15; q[s8] = *(const f32x4*)(gsrc + (size_t)(mt * 32 + row) * row_stride + c * 4); }
#pragma unroll
    for (int s8 = 0; s8 < 8; ++s8) { const int row = s8 * 4 + (lane >> 4), c = lane & 15; *(f32x4*)(stg + row * 256 + ((c ^ (row & 15)) << 4)) = q[s8]; }
    asm volatile("s_waitcnt lgkmcnt(0)" ::: "memory");
    __builtin_amdgcn_wave_barrier();
#pragma unroll
    for (int nt = 0; nt < 2; ++nt)
#pragma unroll
      for (int i4 = 0; i4 < 4; ++i4) {
        const f32x4 xv = *(const f32x4*)(stg + r * 256 + (((nt * 8 + 2 * i4 + hh) ^ (r & 15)) << 4));
#pragma unroll
        for (int jj = 0; jj < 4; ++jj) a[mt][nt][4 * i4 + jj] += xv[jj];
      }
    asm volatile("s_waitcnt lgkmcnt(0)" ::: "memory");
    __builtin_amdgcn_wave_barrier();
  }
}
DI void wave_store64_f32(char* stg, const f32x16 (&a)[2][2], float* gdst, size_t row_stride, int lane, int r, int hh) {
#pragma unroll
  for (int mt = 0; mt < 2; ++mt) {
#pragma unroll
    for (int nt = 0; nt < 2; ++nt)
#pragma unroll
      for (int i4 = 0; i4 < 4; ++i4) {
        const f32x4 v = {a[mt][nt][4 * i4], a[mt][nt][4 * i4 + 1], a[mt][nt][4 * i4 + 2], a[mt][nt][4 * i4 + 3]};
        *(f32x4*)(stg + r * 256 + (((nt * 8 + 2 * i4 + hh) ^ (r & 15)) << 4)) = v;
      }
    asm volatile("s_waitcnt lgkmcnt(0)" ::: "memory");
    __builtin_amdgcn_wave_barrier();
#pragma unroll
    for (int s8 = 0; s8 < 8; ++s8) {
      const int row = s8 * 4 + (lane >> 4), c = lane & 15;
      const f32x4 q = *(const f32x4*)(stg + row * 256 + ((c ^ (row & 15)) << 4));
      *(f32x4*)(gdst + (size_t)(mt * 32 + row) * row_stride + c * 4) = q;
    }
    asm volatile("s_waitcnt lgkmcnt(0)" ::: "memory");
    __builtin_amdgcn_wave_barrier();
  }
}

DI size_t blk_off(int row, int col, int KB) { return (((size_t)(row >> 7) * KB + (col >> 6)) * 128 + (row & 127)) * 64 + (col & 63); }

DI void transpose_tile(const float* __restrict__ src, int ld, int K, int kt, int nt, int job, const float* g0, const float* g1, bf16_t* __restrict__ dst, char* lds) {
  bf16_t* tile = (bf16_t*)lds;
  const int t = tid(), nl = t & 63, kq = t >> 6;
  const int n = nt * 64 + nl;
  int c = n;
  if (job == 0) { c = n < 1024 ? n : (n < 1536 ? 1056 + (n - 1024) : (n < 1568 ? 1024 + (n - 1536) : -1)); }
  else if (job == 2) c = (n >> 6) * 128 + (n & 63);
  else if (job == 3) c = (n >> 6) * 128 + 64 + (n & 63);
#pragma unroll 4
  for (int pass = 0; pass < 16; ++pass) {
    const int kl = pass * 4 + kq, k = kt * 64 + kl;
    float v = 0.f;
    if (c >= 0) {
      v = src[(size_t)k * ld + c];
      if (g0) { const float g = (g1 && k >= 512) ? g1[k - 512] : g0[k]; v *= g; }
    }
    tile[nl * 66 + kl] = f2bf(v);
  }
  __syncthreads();
  const int kl = t & 63;
#pragma unroll 4
  for (int pass = 0; pass < 16; ++pass) { const int nl2 = pass * 4 + kq; dst[(size_t)(nt * 64 + nl2) * K + kt * 64 + kl] = tile[nl2 * 66 + kl]; }
  __syncthreads();
}

DI void phase0(const Params& p, char* lds) {
  const int t = tid(), nb = gridDim.x, bid = blockIdx.x, lane = t & 63, wid = t >> 6;
  for (int ti = bid; ti < 2992; ti += nb) {
    int job, base, nNt, ld, K; const float* src; const float* g0 = nullptr; const float* g1 = nullptr; bf16_t* dst;
    if (ti < 416) { job = 0; base = 0; nNt = 26; ld = 1568; K = 1024; src = p.in[7]; g0 = p.in[6]; dst = p.WinT; }
    else if (ti < 560) { job = 1; base = 416; nNt = 12; ld = 768; K = 768; src = p.in[9]; g0 = p.in[8]; dst = p.WqT; }
    else if (ti < 592) { job = 2; base = 560; nNt = 8; ld = 1024; K = 256; src = p.in[11]; dst = p.WkT; }
    else if (ti < 624) { job = 3; base = 592; nNt = 8; ld = 1024; K = 256; src = p.in[11]; dst = p.WvT; }
    else if (ti < 688) { job = 4; base = 624; nNt = 8; ld = 512; K = 512; src = p.in[20]; dst = p.WgT; }
    else if (ti < 944) { job = 5; base = 688; nNt = 16; ld = 1024; K = 1024; src = p.in[23]; g0 = p.in[21]; g1 = p.in[22]; dst = p.WoT; }
    else if (ti < 1968) { job = 6; base = 944; nNt = 64; ld = 4096; K = 1024; src = p.in[25]; g0 = p.in[24]; dst = p.WuT; }
    else { job = 7; base = 1968; nNt = 16; ld = 1024; K = 4096; src = p.in[26]; dst = p.WdT; }
    const int tile = ti - base;
    transpose_tile(src, ld, K, tile / nNt, tile % nNt, job, g0, g1, dst, lds);
  }
  for (int row = bid * 4 + wid; row < NT; row += nb * 4) {
    const float* x = xrow(p, row);
    f32x4 v[4]; float ss = 0.f;
#pragma unroll
    for (int j = 0; j < 4; ++j) { v[j] = *(const f32x4*)(x + lane * 4 + 256 * j); ss += v[j][0] * v[j][0] + v[j][1] * v[j][1] + v[j][2] * v[j][2] + v[j][3] * v[j][3]; }
    ss += __shfl_xor(ss, 32); ss = half_reduce(ss);
#pragma unroll
    for (int j = 0; j < 4; ++j) { u32x2 w; w.x = pk_bf16(v[j][0], v[j][1]); w.y = pk_bf16(v[j][2], v[j][3]); *(u32x2*)(p.xb + blk_off(row, lane * 4 + 256 * j, 16)) = w; }
    if (lane == 0) p.rstd_x[row] = rsqrtf(ss * (1.f / 1024.f) + EPS);
  }
  const int gt = bid * 256 + t, ngt = nb * 256;
  for (int v = gt; v < 32 * 4096 * 32; v += ngt) {
    const size_t e0 = (size_t)v * 8; const int b = (int)(e0 >> 20), rem = (int)(e0 & 1048575), tt = rem >> 8, c = rem & 255;
    const f32x4 a = *(const f32x4*)(p.in[2] + e0), bq = *(const f32x4*)(p.in[2] + e0 + 4);
    u32x4 w; w.x = pk_bf16(a[0], a[1]); w.y = pk_bf16(a[2], a[3]); w.z = pk_bf16(bq[0], bq[1]); w.w = pk_bf16(bq[2], bq[3]);
    *(u32x4*)(p.latb + (size_t)(NTP + b * SKS + tt) * 256 + c) = w;
  }
  for (int v = gt; v < 32 * 4096 * 4; v += ngt) {
    const size_t e0 = (size_t)v * 8; const int b = (int)(e0 >> 17), rem = (int)(e0 & 131071), tt = rem >> 5, c = rem & 31;
    const f32x4 a = *(const f32x4*)(p.in[3] + e0), bq = *(const f32x4*)(p.in[3] + e0 + 4);
    u32x4 w; w.x = pk_bf16(a[0], a[1]); w.y = pk_bf16(a[2], a[3]); w.z = pk_bf16(bq[0], bq[1]); w.w = pk_bf16(bq[2], bq[3]);
    *(u32x4*)(p.krb + (size_t)(NTP + b * SKS + tt) * 32 + c) = w;
  }
  if (gt < 2048) {
    const int g = gt >> 6, n = gt & 63;
    const double dt = (double)expf(p.in[14][g]);
    const double lr = p.in[12][gt], li = p.in[13][gt];
    const double mag = (double)expf((float)(lr * dt)); double s, c; sincos_d(li * dt, s, c);
    const double lbr = mag * c, lbi = mag * s;
    const double nr = lbr - 1.0, ni = lbi, den = lr * lr + li * li;
    const double cr = (nr * lr + ni * li) / den, ci = (ni * lr - nr * li) / den;
    p.lam[gt] = make_float2((float)lbr, (float)lbi);
    const double mag64 = (double)expf((float)(64.0 * lr * dt)); sincos_d(64.0 * li * dt, s, c);
    p.lam64[gt] = make_float2((float)(mag64 * c), (float)(mag64 * s));
    for (int q = 0; q < 16; ++q) {
      const double br = p.in[15][(size_t)gt * 16 + q], bi = p.in[16][(size_t)gt * 16 + q];
      p.BbT[(size_t)(g * 128 + n) * 16 + q] = f2bf((float)(cr * br - ci * bi));
      p.BbT[(size_t)(g * 128 + 64 + n) * 16 + q] = f2bf((float)(cr * bi + ci * br));
      p.CcT[(size_t)(g * 16 + q) * 128 + n] = f2bf(p.in[17][(size_t)(g * 16 + q) * 64 + n]);
      p.CcT[(size_t)(g * 16 + q) * 128 + 64 + n] = f2bf(-p.in[18][(size_t)(g * 16 + q) * 64 + n]);
    }
  }
  for (int e = gt; e < 8192 * 16; e += ngt) {
    const int pos = e >> 4, i = e & 15;
    const float inv = expf(-(float)i * (9.210340371976184f / 16.0f));
    const float ang = (float)pos * inv;
    double s, c; sincos_d((double)ang, s, c);
    p.rope[e] = make_float2((float)c, (float)s);
  }
}

DI void phase1(const Params& p, char* lds) {
  float* rs = (float*)(lds + 65536);
  const int ntiles = 528 * 13;
  {
    auto tile_fn = [&](int j, int& m0, int& n0) -> bool { const int li = (int)(blockIdx.x >> 3) + j * (int)(gridDim.x >> 3); const int ti_ = li / 13, tj_ = li - ti_ * 13; const int tbig = ti_ * 8 + (int)(blockIdx.x & 7); if (tbig >= 528) return false; m0 = tbig * 128; n0 = tj_ * 128; return true; };
    auto rs_fn = [&](int m0, int t) -> float2 { return make_float2(p.rstd_x[m0 + t], 0.f); };
    auto epi = [&](f32x16 (&acc)[2][2], int m0, int n0, const float* rs, int fstage) { (void)fstage;
    const int tn = n0 >> 7; (void)tn;
    { EPI_IDS
    u32x2 wq[2][2][4];
    if (tn < 8) {
#pragma unroll
      for (int mt = 0; mt < 2; ++mt) {
        const int rl = wm * 64 + mt * 32 + r, row = m0 + rl;
        const float sc = rs[rl];
        float ss = 0.f;
#pragma unroll
        for (int nt = 0; nt < 2; ++nt)
#pragma unroll
          for (int i4 = 0; i4 < 4; ++i4) {
            const float v0 = acc[mt][nt][4 * i4] * sc, v1 = acc[mt][nt][4 * i4 + 1] * sc, v2 = acc[mt][nt][4 * i4 + 2] * sc, v3 = acc[mt][nt][4 * i4 + 3] * sc;
            ss += v0 * v0 + v1 * v1 + v2 * v2 + v3 * v3;
            const int col = n0 + wn * 64 + nt * 32 + 8 * i4 + 4 * hh;
            if (tn < 6) { wq[mt][nt][i4].x = pk_bf16(v0, v1); wq[mt][nt][i4].y = pk_bf16(v2, v3); }
            else { acc[mt][nt][4 * i4] = v0; acc[mt][nt][4 * i4 + 1] = v1; acc[mt][nt][4 * i4 + 2] = v2; acc[mt][nt][4 * i4 + 3] = v3; }
          }
        ss += __shfl_xor(ss, 32);
        if (hh == 0) { if (tn < 6) p.cq_part[(size_t)row * 12 + tn * 2 + wn] = ss; else p.ckv_part[(size_t)row * 4 + (tn - 6) * 2 + wn] = ss; }
      }
      if (tn < 6) wave_store64(wave_stage(lds, fstage, wid), wq, p.cq + blk_off(m0 + wm * 64, n0 + wn * 64, 12), 64, lane, r, hh);
      else wave_store64_f32(wave_stage(lds, fstage, wid), acc, p.ckv_raw + (size_t)(m0 + wm * 64) * 256 + (n0 - 768) + wn * 64, 256, lane, r, hh);
    } else if (tn < 12) {
#pragma unroll
      for (int mt = 0; mt < 2; ++mt) {
        const int rl = wm * 64 + mt * 32 + r, row = m0 + rl;
        const float sc = rs[rl];
#pragma unroll
        for (int nt = 0; nt < 2; ++nt)
#pragma unroll
          for (int i4 = 0; i4 < 4; ++i4) {
            wq[mt][nt][i4].x = pk_bf16(acc[mt][nt][4 * i4] * sc, acc[mt][nt][4 * i4 + 1] * sc); wq[mt][nt][i4].y = pk_bf16(acc[mt][nt][4 * i4 + 2] * sc, acc[mt][nt][4 * i4 + 3] * sc);
          }
      }
      wave_store64(wave_stage(lds, fstage, wid), wq, p.ub + (size_t)(m0 + wm * 64) * 512 + (n0 - 1024) + wn * 64, 512, lane, r, hh);
    } else if (wn == 0) {
#pragma unroll
      for (int mt = 0; mt < 2; ++mt) {
        const int rl = wm * 64 + mt * 32 + r, row = m0 + rl;
        const float sc = rs[rl];
        float* dst = row < NTP ? p.out + OFF_KRP + (size_t)row * 32 : p.out + OFF_KRS + (size_t)(row - NTP) * 32;
        bf16_t* dkb = p.krb + (size_t)kr_of(row) * 32;
        const float* rp = (const float*)(p.rope + pos_of(row) * 16);
#pragma unroll
        for (int ih = 0; ih < 2; ++ih) {
          const int j0 = 8 * ih + 4 * hh;
          const f32x4 c01 = *(const f32x4*)(rp + 2 * j0), c23 = *(const f32x4*)(rp + 2 * j0 + 4);
          const float cc[4] = {c01[0], c01[2], c23[0], c23[2]}, sn[4] = {c01[1], c01[3], c23[1], c23[3]};
          f32x4 o1, o2;
#pragma unroll
          for (int jj = 0; jj < 4; ++jj) {
            const float x1 = acc[mt][0][4 * ih + jj] * sc, x2 = acc[mt][0][8 + 4 * ih + jj] * sc;
            o1[jj] = x1 * cc[jj] - x2 * sn[jj]; o2[jj] = x1 * sn[jj] + x2 * cc[jj];
          }
          *(f32x4*)(dst + j0) = o1; *(f32x4*)(dst + 16 + j0) = o2;
          u32x2 w1, w2; w1.x = pk_bf16(o1[0], o1[1]); w1.y = pk_bf16(o1[2], o1[3]); w2.x = pk_bf16(o2[0], o2[1]); w2.y = pk_bf16(o2[2], o2[3]);
          *(u32x2*)(dkb + j0) = w1; *(u32x2*)(dkb + 16 + j0) = w2;
        }
      }
    }
    }
    __syncthreads();
    };
    gemm_stream<true>(p.xb, 1024, p.WinT, 1024, 16, lds, 0, tile_fn, rs_fn, epi);
  }
}

DI void ssm_chunk(const Params& p, int row0, int g, float& hr, float& hi, bool write_y, char* lds_w) {
  const int lane = tid() & 63, r = lane & 31, hh = lane >> 5;
  const float2 lm = p.lam[g * 64 + lane];
  bf16x8 bfr[4];
#pragma unroll
  for (int nt = 0; nt < 4; ++nt) bfr[nt] = *(const bf16x8*)(p.BbT + (size_t)(g * 128 + nt * 32 + r) * 16 + hh * 8);
  const int fr = lane & 15, fq = lane >> 4;
  bf16x8 cfr[4];
#pragma unroll
  for (int ks = 0; ks < 4; ++ks) cfr[ks] = *(const bf16x8*)(p.CcT + (size_t)(g * 16 + fr) * 128 + ks * 32 + fq * 8);
  const float dsk = p.in[19][g * 16 + fr];
#pragma unroll 1
  for (int sub = 0; sub < 2; ++sub) {
    const int rb = row0 + sub * 32;
    const bf16x8 uf = *(const bf16x8*)(p.ub + (size_t)(rb + r) * 512 + g * 16 + hh * 8);
    f32x16 z; for (int i = 0; i < 16; ++i) z[i] = 0.f;
    const f32x16 x0 = MFMA32(uf, bfr[0], z), x1 = MFMA32(uf, bfr[1], z), x2 = MFMA32(uf, bfr[2], z), x3 = MFMA32(uf, bfr[3], z);
    float xr0[16], xr1[16], xi0[16], xi1[16];
#pragma unroll
    for (int i = 0; i < 16; ++i) {
      const auto re = __builtin_amdgcn_permlane32_swap(__float_as_uint(x0[i]), __float_as_uint(x1[i]), false, false);
      const auto im = __builtin_amdgcn_permlane32_swap(__float_as_uint(x2[i]), __float_as_uint(x3[i]), false, false);
      xr0[i] = __uint_as_float(re[0]); xr1[i] = __uint_as_float(re[1]);
      xi0[i] = __uint_as_float(im[0]); xi1[i] = __uint_as_float(im[1]);
    }
    bf16_t* Hs = (bf16_t*)lds_w;
#pragma unroll
    for (int m = 0; m < 4; ++m) {
#pragma unroll
      for (int half = 0; half < 2; ++half) {
#pragma unroll
        for (int jj = 0; jj < 4; ++jj) {
          const int i = 4 * m + jj, tt = 8 * m + 4 * half + jj;
          const float xr = half ? xr1[i] : xr0[i], xi = half ? xi1[i] : xi0[i];
          const float nr = lm.x * hr - lm.y * hi + xr;
          const float ni = lm.x * hi + lm.y * hr + xi;
          hr = nr; hi = ni;
          if (write_y) { Hs[tt * 136 + lane] = f2bf(hr); Hs[tt * 136 + 64 + lane] = f2bf(hi); }
        }
      }
    }
    if (write_y) {
      asm volatile("s_waitcnt lgkmcnt(0)" ::: "memory");
      __builtin_amdgcn_wave_barrier();
#pragma unroll
      for (int mt = 0; mt < 2; ++mt) {
        f32x4 y = {0.f, 0.f, 0.f, 0.f};
#pragma unroll
        for (int ks = 0; ks < 4; ++ks) {
          const bf16x8 hf = *(const bf16x8*)(Hs + (mt * 16 + fr) * 136 + ks * 32 + fq * 8);
          y = MFMA16(hf, cfr[ks], y);
        }
#pragma unroll
        for (int j = 0; j < 4; ++j) {
          const int row = rb + mt * 16 + fq * 4 + j;
          const float u = bf2f(p.ub[(size_t)row * 512 + g * 16 + fr]);
          const float v = y[j] + dsk * u;
          const float zz = 0.7978845608028654f * (v + 0.044715f * v * v * v);
          const float th = 1.f - 2.f / (__expf(2.f * zz) + 1.f);
          p.ssm_y[(size_t)row * 512 + g * 16 + fr] = f2bf(0.5f * v * (1.f + th));
        }
      }
      asm volatile("s_waitcnt lgkmcnt(0)" ::: "memory");
      __builtin_amdgcn_wave_barrier();
    }
  }
}

DI void phase2(const Params& p, char* lds) {
  const int lane = tid() & 63, wid = tid() >> 6;
  const int nb = gridDim.x, bid = blockIdx.x;
  for (int row = bid * 4 + wid; row < NT; row += nb * 4) {
    const f32x4 v = *(const f32x4*)(p.ckv_raw + (size_t)row * 256 + lane * 4);
    const f32x4 pp = *(const f32x4*)(p.ckv_part + (size_t)row * 4);
    const float rstd = rsqrtf((pp[0] + pp[1] + pp[2] + pp[3]) * (1.f / 256.f) + EPS);
    const f32x4 g = *(const f32x4*)(p.in[10] + lane * 4);
    f32x4 o; o[0] = v[0] * rstd * g[0]; o[1] = v[1] * rstd * g[1]; o[2] = v[2] * rstd * g[2]; o[3] = v[3] * rstd * g[3];
    float* dst = row < NTP ? p.out + OFF_LATP + (size_t)row * 256 : p.out + OFF_LATS + (size_t)(row - NTP) * 256;
    *(f32x4*)(dst + lane * 4) = o;
    u32x2 w; w.x = pk_bf16(o[0], o[1]); w.y = pk_bf16(o[2], o[3]);
    *(u32x2*)(p.latb + (size_t)kr_of(row) * 256 + lane * 4) = w;
  }
  for (int it = bid * 4 + wid; it < 8 * 128 * 32; it += nb * 4) {
    const int g = it & 31, c = (it >> 5) & 127, b = it >> 12;
    float hr = 0.f, hi = 0.f;
    ssm_chunk(p, b * 8192 + c * 64, g, hr, hi, false, lds + wid * 8704);
    p.E[(size_t)it * 64 + lane] = make_float2(hr, hi);
  }
  float* rs = (float*)(lds + 65536);
  {
    auto tile_fn = [&](int j, int& m0, int& n0) -> bool { const int li = (int)(blockIdx.x >> 3) + j * (int)(gridDim.x >> 3); const int ti_ = li / 6, tj_ = li - ti_ * 6; const int tbig = ti_ * 8 + (int)(blockIdx.x & 7); if (tbig >= 528) return false; m0 = tbig * 128; n0 = tj_ * 128; return true; };
    auto rs_fn = [&](int m0, int t) -> float2 { float sm = 0.f; for (int q = 0; q < 3; ++q) { const f32x4 v = *(const f32x4*)(p.cq_part + (size_t)(m0 + t) * 12 + 4 * q); sm += (v[0] + v[1]) + (v[2] + v[3]); } return make_float2(rsqrtf(sm * (1.f / 768.f) + EPS), 0.f); };
    auto epi = [&](f32x16 (&acc)[2][2], int m0, int n0, const float* rs, int fstage) { (void)fstage;
    const int tn = n0 >> 7; (void)tn;
    EPI_IDS
    const float qs = 0.10206207261596577f * 1.4426950408889634f;
    u32x2 wq[2][2][4];
#pragma unroll
    for (int mt = 0; mt < 2; ++mt) {
      const int rl = wm * 64 + mt * 32 + r, row = m0 + rl;
      const float sc = rs[rl] * qs;
      const float* rp = (const float*)(p.rope + pos_of(row) * 16);
#pragma unroll
      for (int nt = 0; nt < 2; ++nt) {
        const int cb = n0 + wn * 64 + nt * 32;
        if ((cb % 96) == 64) {
#pragma unroll
          for (int ih = 0; ih < 2; ++ih) {
            const int j0 = 8 * ih + 4 * hh;
            const f32x4 c01 = *(const f32x4*)(rp + 2 * j0), c23 = *(const f32x4*)(rp + 2 * j0 + 4);
            const float cc[4] = {c01[0], c01[2], c23[0], c23[2]}, sn[4] = {c01[1], c01[3], c23[1], c23[3]};
            float o1[4], o2[4];
#pragma unroll
            for (int jj = 0; jj < 4; ++jj) {
              const float x1 = acc[mt][nt][4 * ih + jj] * sc, x2 = acc[mt][nt][8 + 4 * ih + jj] * sc;
              o1[jj] = x1 * cc[jj] - x2 * sn[jj]; o2[jj] = x1 * sn[jj] + x2 * cc[jj];
            }
            wq[mt][nt][ih].x = pk_bf16(o1[0], o1[1]); wq[mt][nt][ih].y = pk_bf16(o1[2], o1[3]); wq[mt][nt][ih + 2].x = pk_bf16(o2[0], o2[1]); wq[mt][nt][ih + 2].y = pk_bf16(o2[2], o2[3]);
          }
        } else {
#pragma unroll
          for (int i4 = 0; i4 < 4; ++i4) {
            wq[mt][nt][i4].x = pk_bf16(acc[mt][nt][4 * i4] * sc, acc[mt][nt][4 * i4 + 1] * sc); wq[mt][nt][i4].y = pk_bf16(acc[mt][nt][4 * i4 + 2] * sc, acc[mt][nt][4 * i4 + 3] * sc);
          }
        }
      }
    }

    wave_store64(wave_stage(lds, fstage, wid), wq, p.Q + (size_t)(m0 + wm * 64) * 768 + n0 + wn * 64, 768, lane, r, hh);
    __syncthreads();
    };
    gemm_stream<true>(p.cq, 768, p.WqT, 768, 12, lds, 0, tile_fn, rs_fn, epi);
  }
}

DI void phase3(const Params& p, char* lds) {
  const int lane = tid() & 63, wid = tid() >> 6;
  const int nb = gridDim.x, bid = blockIdx.x;
  for (int it = bid * 4 + wid; it < 256; it += nb * 4) {
    const int b = it >> 5, g = it & 31;
    const float2 l64 = p.lam64[g * 64 + lane];
    float sr = 0.f, si = 0.f;
    const size_t base = ((size_t)(b * 128) * 32 + g) * 64 + lane;
    for (int c0 = 0; c0 < 128; c0 += 16) {
      float2 e[16];
#pragma unroll
      for (int j = 0; j < 16; ++j) e[j] = p.E[base + (size_t)(c0 + j) * 2048];
#pragma unroll
      for (int j = 0; j < 16; ++j) {
        p.S[base + (size_t)(c0 + j) * 2048] = make_float2(sr, si);
        const float nr = l64.x * sr - l64.y * si + e[j].x, ni = l64.x * si + l64.y * sr + e[j].y;
        sr = nr; si = ni;
      }
    }
  }
  {
    auto tile_fn = [&](int j, int& m0, int& n0) -> bool { const int li = (int)(blockIdx.x >> 3) + j * (int)(gridDim.x >> 3); const int ti_ = li / 4, tj_ = li - ti_ * 4; const int tbig = ti_ * 8 + (int)(blockIdx.x & 7); if (tbig >= 1552) return false; m0 = tbig * 128; n0 = tj_ * 128; return true; };
    auto rs_fn = [&](int m0, int t) -> float2 { return make_float2(0.f, 0.f); };
    auto epi = [&](f32x16 (&acc)[2][2], int m0, int n0, const float* rs, int fstage) { (void)fstage;
    const int tn = n0 >> 7; (void)tn;
    EPI_IDS
    u32x2 w[2][2][4];
#pragma unroll
    for (int mt = 0; mt < 2; ++mt)
#pragma unroll
      for (int nt = 0; nt < 2; ++nt)
#pragma unroll
        for (int i4 = 0; i4 < 4; ++i4) { w[mt][nt][i4].x = pk_bf16(acc[mt][nt][4 * i4], acc[mt][nt][4 * i4 + 1]); w[mt][nt][i4].y = pk_bf16(acc[mt][nt][4 * i4 + 2], acc[mt][nt][4 * i4 + 3]); }
    wave_store64(wave_stage(lds, fstage, wid), w, p.Kn + (size_t)(m0 + wm * 64) * 512 + n0 + wn * 64, 512, lane, r, hh);
    __syncthreads();
    };
    gemm_stream(p.latb, 256, p.WkT, 256, 4, lds, 0, tile_fn, rs_fn, epi);
  }
  {
    auto tile_fn = [&](int j, int& m0, int& n0) -> bool { const int li = (int)(blockIdx.x >> 3) + j * (int)(gridDim.x >> 3); const int ti_ = li / 4, tj_ = li - ti_ * 4; const int tbig = ti_ * 8 + (int)(blockIdx.x & 7); if (tbig >= 1552) return false; n0 = tbig * 128; m0 = tj_ * 128; return true; };
    auto rs_fn = [&](int m0, int t) -> float2 { return make_float2(0.f, 0.f); };
    auto epi = [&](f32x16 (&acc)[2][2], int m0, int n0, const float* rs, int fstage) { (void)fstage;
    const int tn = n0 >> 7; (void)tn;
    EPI_IDS
    u32x2 w[2][2][4];
#pragma unroll
    for (int mt = 0; mt < 2; ++mt)
#pragma unroll
      for (int nt = 0; nt < 2; ++nt)
#pragma unroll
        for (int i4 = 0; i4 < 4; ++i4) { w[mt][nt][i4].x = pk_bf16(acc[mt][nt][4 * i4], acc[mt][nt][4 * i4 + 1]); w[mt][nt][i4].y = pk_bf16(acc[mt][nt][4 * i4 + 2], acc[mt][nt][4 * i4 + 3]); }
    const int kr0 = n0 + wn * 64;
    size_t cbase; int S;
    if (kr0 < NTP) { cbase = (size_t)(kr0 >> 13) * 512 * 8192 + (kr0 & 8191); S = 8192; }
    else { const int k2 = kr0 - NTP, b = k2 / SKS, tt = k2 - b * SKS; cbase = VT_S_OFF + (size_t)b * 512 * SKS + tt; S = SKS; }
    wave_store64(wave_stage(lds, fstage, wid), w, p.Vt + cbase + (size_t)(m0 + wm * 64) * S, (size_t)S, lane, r, hh);
    __syncthreads();
    };
    gemm_stream(p.WvT, 256, p.latb, 256, 4, lds, 0, tile_fn, rs_fn, epi);
  }
}

template <int QT, bool HALF>
DI void attn_item(const Params& p, int kind, int b, int h, int qq, char* lds) {
  const int t = tid(), lane = t & 63, wid = t >> 6, r = lane & 31, hh = lane >> 5;
  int qrow0, nkb_w, nkb_max, S; size_t kr0; const bf16_t* vt_base;
  constexpr int RW = 32 * QT, WPC = 64 / RW, CPB = 4 / WPC;
  if (kind == 0) {
    const int c = qq * CPB + wid / WPC; qrow0 = b * 8192 + c * 64 + (wid % WPC) * RW; nkb_w = c + 1; nkb_max = qq * CPB + CPB; kr0 = (size_t)b * 8192; S = 8192;
    vt_base = p.Vt + (size_t)(b * 8 + h) * 64 * 8192;
  } else {
    qrow0 = NTP + b * 64 + (wid % WPC) * RW; nkb_w = (wid < WPC) ? 65 : 0; nkb_max = 65; kr0 = (size_t)NTP + (size_t)b * SKS; S = SKS;
    vt_base = p.Vt + VT_S_OFF + (size_t)(b * 8 + h) * 64 * SKS;
  }
  bf16x8 qf[QT][6];
#pragma unroll
  for (int qt = 0; qt < QT; ++qt)
#pragma unroll
    for (int ks = 0; ks < 6; ++ks) qf[qt][ks] = *(const bf16x8*)(p.Q + (size_t)(qrow0 + qt * 32 + r) * 768 + h * 96 + ks * 16 + hh * 8);
  f32x16 o[2][QT];
  float mrun[QT], lrun[QT];
#pragma unroll
  for (int qt = 0; qt < QT; ++qt) { mrun[qt] = -1e30f; lrun[qt] = 0.f;
#pragma unroll
    for (int dt = 0; dt < 2; ++dt)
#pragma unroll
      for (int i = 0; i < 16; ++i) o[dt][qt][i] = 0.f; }
  const int kkey = t >> 3, kc = t & 7;
  const int rkey = t >> 2, rc = t & 3;
  const int vd = t >> 3, vc = t & 7;
  const bf16_t* gk = p.Kn + (kr0 + kkey) * 512 + h * 64 + kc * 8;
  const bf16_t* gr = p.krb + (kr0 + rkey) * 32 + rc * 8;
  const bf16_t* gv = vt_base + (size_t)vd * S + vc * 8;
  const unsigned kw0 = kkey * 208 + kc * 16, kw1 = kw0 + 32 * 208, rw = rkey * 208 + 128 + rc * 16;
  const unsigned vlo = vd * 144 + (vc >> 1) * 32 + (vc & 1) * 8, vhi = vlo + 16;
  constexpr int KB = 13312, VB = 9216, BUF = KB + VB;
  u32x4 k0r, k1r, rr, v0r, v1r;
  k0r = *(const u32x4*)gk; k1r = *(const u32x4*)(gk + 32 * 512); rr = *(const u32x4*)gr;
  v0r = *(const u32x4*)gv; v1r = *(const u32x4*)(gv + (size_t)32 * S);
  __syncthreads();
  {
    char* kb_ = lds; char* vb_ = lds + KB;
    *(u32x4*)(kb_ + kw0) = k0r; *(u32x4*)(kb_ + kw1) = k1r; *(u32x4*)(kb_ + rw) = rr;
    *(u32x2*)(vb_ + vlo) = (u32x2){v0r.x, v0r.y}; *(u32x2*)(vb_ + vhi) = (u32x2){v0r.z, v0r.w};
    *(u32x2*)(vb_ + vlo + 32 * 144) = (u32x2){v1r.x, v1r.y}; *(u32x2*)(vb_ + vhi + 32 * 144) = (u32x2){v1r.z, v1r.w};
  }
  __syncthreads();
  for (int kb = 0; kb < nkb_max; ++kb) {
    const int cur = kb & 1;
    const bool more = kb + 1 < nkb_max;
    if (more) {
      const size_t ko = (size_t)(kb + 1) * 64;
      k0r = *(const u32x4*)(gk + ko * 512); k1r = *(const u32x4*)(gk + (ko + 32) * 512); rr = *(const u32x4*)(gr + ko * 32);
      v0r = *(const u32x4*)(gv + ko); v1r = *(const u32x4*)(gv + (size_t)32 * S + ko);
    }
    if (HALF && kb < nkb_w) {
      const char* kt_ = lds + cur * BUF; const char* vt_ = kt_ + KB;
#pragma unroll
      for (int kt = 0; kt < 2; ++kt) {
        __builtin_amdgcn_iglp_opt(0);
        f32x16 sh[QT];
#pragma unroll
        for (int qt = 0; qt < QT; ++qt)
#pragma unroll
          for (int i = 0; i < 16; ++i) sh[qt][i] = 0.f;
#pragma unroll
        for (int ks = 0; ks < 6; ++ks) {
          const bf16x8 kf = *(const bf16x8*)(kt_ + (kt * 32 + r) * 208 + ks * 32 + hh * 16);
#pragma unroll
          for (int qt = 0; qt < QT; ++qt) sh[qt] = MFMA32(kf, qf[qt][ks], sh[qt]);
        }
        bf16x8 ph[QT][2];
#pragma unroll
        for (int qt = 0; qt < QT; ++qt) {
          float mx = sh[qt][0];
#pragma unroll
          for (int i = 1; i < 16; ++i) mx = fmaxf(mx, sh[qt][i]);
          mx = fmaxf(mx, __shfl_xor(mx, 32));
          const bool need = mx > mrun[qt] + 8.f;
          if (__any(need)) {
            const float mnew = need ? mx : mrun[qt];
            const float alpha = __builtin_amdgcn_exp2f(mrun[qt] - mnew);
            mrun[qt] = mnew; lrun[qt] *= alpha;
#pragma unroll
            for (int dt = 0; dt < 2; ++dt)
#pragma unroll
              for (int i = 0; i < 16; ++i) o[dt][qt][i] *= alpha;
          }
          float ls = 0.f;
#pragma unroll
          for (int i = 0; i < 16; ++i) { const float pv = __builtin_amdgcn_exp2f(sh[qt][i] - mrun[qt]); ls += pv; sh[qt][i] = pv; }
          lrun[qt] += ls;
#pragma unroll
          for (int s2 = 0; s2 < 2; ++s2) {
            u32x4 w;
            w.x = pk_bf16(sh[qt][8 * s2 + 0], sh[qt][8 * s2 + 1]); w.y = pk_bf16(sh[qt][8 * s2 + 2], sh[qt][8 * s2 + 3]);
            w.z = pk_bf16(sh[qt][8 * s2 + 4], sh[qt][8 * s2 + 5]); w.w = pk_bf16(sh[qt][8 * s2 + 6], sh[qt][8 * s2 + 7]);
            ph[qt][s2] = __builtin_bit_cast(bf16x8, w);
          }
        }
#pragma unroll
        for (int dt = 0; dt < 2; ++dt)
#pragma unroll
          for (int s2 = 0; s2 < 2; ++s2) {
            const bf16x8 vf = *(const bf16x8*)(vt_ + (dt * 32 + r) * 144 + (kt * 2 + s2) * 32 + hh * 16);
#pragma unroll
            for (int qt = 0; qt < QT; ++qt) o[dt][qt] = MFMA32(vf, ph[qt][s2], o[dt][qt]);
          }
      }
    }
    if (!HALF && kb < nkb_w) {
      const char* kt_ = lds + cur * BUF; const char* vt_ = kt_ + KB;
      f32x16 st[2][QT];
#pragma unroll
      for (int kt = 0; kt < 2; ++kt)
#pragma unroll
        for (int qt = 0; qt < QT; ++qt)
#pragma unroll
          for (int i = 0; i < 16; ++i) st[kt][qt][i] = 0.f;
#pragma unroll
      for (int ks = 0; ks < 6; ++ks)
#pragma unroll
        for (int kt = 0; kt < 2; ++kt) {
          const bf16x8 kf = *(const bf16x8*)(kt_ + (kt * 32 + r) * 208 + ks * 32 + hh * 16);
#pragma unroll
          for (int qt = 0; qt < QT; ++qt) st[kt][qt] = MFMA32(kf, qf[qt][ks], st[kt][qt]);
        }
      bf16x8 pb[2][QT][2];
#pragma unroll
      for (int qt = 0; qt < QT; ++qt) {
        float mx = mrun[qt];
#pragma unroll
        for (int kt = 0; kt < 2; ++kt)
#pragma unroll
          for (int i = 0; i < 16; ++i) mx = fmaxf(mx, st[kt][qt][i]);
        mx = fmaxf(mx, __shfl_xor(mx, 32));
        const float alpha = __builtin_amdgcn_exp2f(mrun[qt] - mx);
        mrun[qt] = mx;
        float ls = 0.f;
#pragma unroll
        for (int kt = 0; kt < 2; ++kt) {
#pragma unroll
          for (int i = 0; i < 16; ++i) { const float pv = __builtin_amdgcn_exp2f(st[kt][qt][i] - mx); ls += pv; st[kt][qt][i] = pv; }
#pragma unroll
          for (int s2 = 0; s2 < 2; ++s2) {
            u32x4 w;
            w.x = pk_bf16(st[kt][qt][8 * s2 + 0], st[kt][qt][8 * s2 + 1]); w.y = pk_bf16(st[kt][qt][8 * s2 + 2], st[kt][qt][8 * s2 + 3]);
            w.z = pk_bf16(st[kt][qt][8 * s2 + 4], st[kt][qt][8 * s2 + 5]); w.w = pk_bf16(st[kt][qt][8 * s2 + 6], st[kt][qt][8 * s2 + 7]);
            pb[kt][qt][s2] = __builtin_bit_cast(bf16x8, w);
          }
        }
        lrun[qt] = lrun[qt] * alpha + ls;
#pragma unroll
        for (int dt = 0; dt < 2; ++dt)
#pragma unroll
          for (int i = 0; i < 16; ++i) o[dt][qt][i] *= alpha;
      }
#pragma unroll
      for (int dt = 0; dt < 2; ++dt)
#pragma unroll
        for (int kt = 0; kt < 2; ++kt)
#pragma unroll
          for (int s2 = 0; s2 < 2; ++s2) {
            const bf16x8 vf = *(const bf16x8*)(vt_ + (dt * 32 + r) * 144 + (kt * 2 + s2) * 32 + hh * 16);
#pragma unroll
            for (int qt = 0; qt < QT; ++qt) o[dt][qt] = MFMA32(vf, pb[kt][qt][s2], o[dt][qt]);
          }
    }
    if (more) {
      char* kb_ = lds + (cur ^ 1) * BUF; char* vb_ = kb_ + KB;
      *(u32x4*)(kb_ + kw0) = k0r; *(u32x4*)(kb_ + kw1) = k1r; *(u32x4*)(kb_ + rw) = rr;
      *(u32x2*)(vb_ + vlo) = (u32x2){v0r.x, v0r.y}; *(u32x2*)(vb_ + vhi) = (u32x2){v0r.z, v0r.w};
      *(u32x2*)(vb_ + vlo + 32 * 144) = (u32x2){v1r.x, v1r.y}; *(u32x2*)(vb_ + vhi + 32 * 144) = (u32x2){v1r.z, v1r.w};
    }
    __syncthreads();
  }
  if (nkb_w > 0) {
    u32x2 wo[2][2][4];
#pragma unroll
    for (int qt = 0; qt < QT; ++qt) {
      const float lt = lrun[qt] + __shfl_xor(lrun[qt], 32);
      const float inv = 1.f / lt;
      const int row = qrow0 + qt * 32 + r;
      float ss = 0.f;
#pragma unroll
      for (int dt = 0; dt < 2; ++dt)
#pragma unroll
        for (int i4 = 0; i4 < 4; ++i4) {
          const float a0 = o[dt][qt][4 * i4] * inv, a1 = o[dt][qt][4 * i4 + 1] * inv, a2 = o[dt][qt][4 * i4 + 2] * inv, a3 = o[dt][qt][4 * i4 + 3] * inv;
          ss += a0 * a0 + a1 * a1 + a2 * a2 + a3 * a3;
          u32x2 w; w.x = pk_bf16(a0, a1); w.y = pk_bf16(a2, a3);
          if (QT == 2) wo[qt][dt][i4] = w;
          else *(u32x2*)(p.mix + blk_off(row, h * 64 + dt * 32 + 8 * i4 + 4 * hh, 16)) = w;
        }
      ss += __shfl_xor(ss, 32);
      if (hh == 0) p.attn_part[(size_t)row * 8 + h] = ss;
    }
    if (QT == 2) wave_store64(lds + wid * 8192, wo, p.mix + blk_off(qrow0, h * 64, 16), 64, lane, r, hh);
  }
}

DI void phase4(const Params& p, char* lds, int qidx) {
  const int t = tid(), lane = t & 63, wid = t >> 6;
  const int nb = gridDim.x, bid = blockIdx.x;
  int* nxt = (int*)(lds + 65536);
  for (;;) {
    __syncthreads();
    if (t == 0) *nxt = atomicAdd(p.counters + qidx, 1);
    __syncthreads();
    const int it = *nxt;
    if (it >= 256 + 64 * 32) break;
    if (it < 256) attn_item<1, false>(p, 1, it >> 3, it & 7, 0, lds);
    else { const int j = it - 256; const int qq = 31 - (j >> 6), bh = j & 63; attn_item<2, true>(p, 0, bh >> 3, bh & 7, qq, lds); }
  }
  __syncthreads();
  for (int it = bid * 4 + wid; it < 8 * 128 * 32 + 1024; it += nb * 4) {
    if (it < 8 * 128 * 32) {
      const int g = it & 31, c = (it >> 5) & 127, b = it >> 12;
      const float2 s0 = p.S[(size_t)it * 64 + lane];
      float hr = s0.x, hi = s0.y;
      ssm_chunk(p, b * 8192 + c * 64, g, hr, hi, true, lds + wid * 8704);
      if (c == 127) { p.out[OFF_HRP + (size_t)(b * 32 + g) * 64 + lane] = hr; p.out[OFF_HIP + (size_t)(b * 32 + g) * 64 + lane] = hi; }
    } else {
      const int j = it - 8 * 128 * 32, g = j & 31, b = j >> 5;
      float hr = p.in[4][(size_t)(b * 32 + g) * 64 + lane], hi = p.in[5][(size_t)(b * 32 + g) * 64 + lane];
      ssm_chunk(p, NTP + b * 64, g, hr, hi, true, lds + wid * 8704);
      p.out[OFF_HRS + (size_t)(b * 32 + g) * 64 + lane] = hr; p.out[OFF_HIS + (size_t)(b * 32 + g) * 64 + lane] = hi;
    }
  }
}

DI void phase5(const Params& p, char* lds) {
  {
    auto tile_fn = [&](int j, int& m0, int& n0) -> bool { const int li = (int)(blockIdx.x >> 3) + j * (int)(gridDim.x >> 3); const int ti_ = li / 4, tj_ = li - ti_ * 4; const int tbig = ti_ * 8 + (int)(blockIdx.x & 7); if (tbig >= 528) return false; m0 = tbig * 128; n0 = tj_ * 128; return true; };
    auto rs_fn = [&](int m0, int t) -> float2 { return make_float2(0.f, 0.f); };
    auto epi = [&](f32x16 (&acc)[2][2], int m0, int n0, const float* rs, int fstage) { (void)fstage;
    const int tn = n0 >> 7; (void)tn;
    { EPI_IDS
    u32x2 wq[2][2][4], yw[2][2][4];
    wave_load64(wave_stage(lds, fstage, wid), yw, p.ssm_y + (size_t)(m0 + wm * 64) * 512 + n0 + wn * 64, 512, lane, r, hh);
#pragma unroll
    for (int mt = 0; mt < 2; ++mt) {
      const int row = m0 + wm * 64 + mt * 32 + r;
      float ss = 0.f;
#pragma unroll
      for (int nt = 0; nt < 2; ++nt)
#pragma unroll
        for (int i4 = 0; i4 < 4; ++i4) {
          const int col = n0 + wn * 64 + nt * 32 + 8 * i4 + 4 * hh;
          const u32x2 yv = yw[mt][nt][i4];
          const float y0 = __uint_as_float(yv.x << 16), y1 = __uint_as_float(yv.x & 0xffff0000u), y2 = __uint_as_float(yv.y << 16), y3 = __uint_as_float(yv.y & 0xffff0000u);
          const float o0 = y0 / (1.f + __expf(-acc[mt][nt][4 * i4])), o1 = y1 / (1.f + __expf(-acc[mt][nt][4 * i4 + 1]));
          const float o2 = y2 / (1.f + __expf(-acc[mt][nt][4 * i4 + 2])), o3 = y3 / (1.f + __expf(-acc[mt][nt][4 * i4 + 3]));
          ss += o0 * o0 + o1 * o1 + o2 * o2 + o3 * o3;
          wq[mt][nt][i4].x = pk_bf16(o0, o1); wq[mt][nt][i4].y = pk_bf16(o2, o3);
        }
      ss += __shfl_xor(ss, 32);
      if (hh == 0) p.ssm_part[(size_t)row * 8 + tn * 2 + wn] = ss;
    }
    wave_store64(wave_stage(lds, fstage, wid), wq, p.mix + blk_off(m0 + wm * 64, 512 + n0 + wn * 64, 16), 64, lane, r, hh);
    }
    __syncthreads();
    };
    gemm_stream(p.ssm_y, 512, p.WgT, 512, 8, lds, 0, tile_fn, rs_fn, epi);
  }
}

DI void phase6(const Params& p, char* lds) {
  const int xb_ = blockIdx.x & 7, xl_ = blockIdx.x >> 3, nbx_ = gridDim.x >> 3;
  {
    auto tile_fn = [&](int j, int& m0, int& n0) -> bool { const int li6 = xl_ + j * nbx_, tm = (li6 >> 3) * 8 + xb_; if (tm >= 528) return false; m0 = tm * 128; n0 = (li6 & 7) * 128; return true; };
    auto rs_fn = [&](int m0, int t) -> float2 {
      const f32x4 a0 = *(const f32x4*)(p.attn_part + (size_t)(m0 + t) * 8), a1 = *(const f32x4*)(p.attn_part + (size_t)(m0 + t) * 8 + 4);
      const float sa = (a0[0] + a0[1]) + (a0[2] + a0[3]) + (a1[0] + a1[1]) + (a1[2] + a1[3]);
      const f32x4 b0 = *(const f32x4*)(p.ssm_part + (size_t)(m0 + t) * 8), b1 = *(const f32x4*)(p.ssm_part + (size_t)(m0 + t) * 8 + 4);
      const float sb = (b0[0] + b0[1]) + (b0[2] + b0[3]) + (b1[0] + b1[1]) + (b1[2] + b1[3]);
      const float ra = rsqrtf(sa * (1.f / 512.f) + EPS), rb = rsqrtf(sb * (1.f / 512.f) + EPS);
      return make_float2(rb, ra / rb); };
    auto epi = [&](f32x16 (&acc)[2][2], int m0, int n0, const float* rs, int fstage) { (void)fstage;
    const int tn = n0 >> 7;
    { EPI_IDS
    char* stg = wave_stage(lds, fstage, wid);
#pragma unroll
    for (int mt = 0; mt < 2; ++mt) {
      const float sc = rs[wm * 64 + mt * 32 + r];
#pragma unroll
      for (int nt = 0; nt < 2; ++nt)
#pragma unroll
        for (int i = 0; i < 16; ++i) acc[mt][nt][i] *= sc;
    }
    wave_add64_f32(stg, acc, xrow(p, m0 + wm * 64) + n0 + wn * 64, 1024, lane, r, hh);
    u32x2 w[2][2][4];
#pragma unroll
    for (int mt = 0; mt < 2; ++mt) {
      const int row = m0 + wm * 64 + mt * 32 + r;
      float ss = 0.f;
#pragma unroll
      for (int nt = 0; nt < 2; ++nt)
#pragma unroll
        for (int i4 = 0; i4 < 4; ++i4) {
#pragma unroll
          for (int jj = 0; jj < 4; ++jj) ss += acc[mt][nt][4 * i4 + jj] * acc[mt][nt][4 * i4 + jj];
          w[mt][nt][i4].x = pk_bf16(acc[mt][nt][4 * i4], acc[mt][nt][4 * i4 + 1]); w[mt][nt][i4].y = pk_bf16(acc[mt][nt][4 * i4 + 2], acc[mt][nt][4 * i4 + 3]);
        }
      ss += __shfl_xor(ss, 32);
      if (hh == 0) p.h_part[(size_t)row * 16 + tn * 2 + wn] = ss;
    }
    wave_store64(stg, w, p.hb + blk_off(m0 + wm * 64, n0 + wn * 64, 16), 64, lane, r, hh);
    }
    __syncthreads();
    };
    gemm_stream<true>(p.mix, 1024, p.WoT, 1024, 16, lds, 8, tile_fn, rs_fn, epi);
  }
}

DI void phase7(const Params& p, char* lds) {
  float* rs = (float*)(lds + 65536);
  const int xb_ = blockIdx.x & 7, xl_ = blockIdx.x >> 3, nbx_ = gridDim.x >> 3;
  {
    auto tile_fn = [&](int j, int& m0, int& n0) -> bool { const int tm = j * (nbx_ >> 2) + (xl_ >> 2); if (tm >= 528) return false; m0 = tm * 128; n0 = (xb_ * 4 + (xl_ & 3)) * 128; return true; };
    auto rs_fn = [&](int m0, int t) -> float2 { float sm = 0.f; for (int q = 0; q < 4; ++q) { const f32x4 v = *(const f32x4*)(p.h_part + (size_t)(m0 + t) * 16 + 4 * q); sm += (v[0] + v[1]) + (v[2] + v[3]); } return make_float2(rsqrtf(sm * (1.f / 1024.f) + EPS), 0.f); };
    auto epi = [&](f32x16 (&acc)[2][2], int m0, int n0, const float* rs, int fstage) { (void)fstage;
    const int tn = n0 >> 7; (void)tn;
    { EPI_IDS
    char* stg = lds + (wid < 2 ? 0 : 32768) + fstage * 16384 + (wid & 1) * 8192;
#pragma unroll
    for (int mt = 0; mt < 2; ++mt) {
      const int rloc = mt * 32 + r;
      const float sc = rs[wm * 64 + rloc];
#pragma unroll
      for (int nt = 0; nt < 2; ++nt)
#pragma unroll
        for (int i4 = 0; i4 < 4; ++i4) {
          float v[4];
#pragma unroll
          for (int jj = 0; jj < 4; ++jj) { const float a_ = fmaxf(acc[mt][nt][4 * i4 + jj] * sc, 0.f); v[jj] = a_ * a_; }
          u32x2 w; w.x = pk_bf16(v[0], v[1]); w.y = pk_bf16(v[2], v[3]);
          *(u32x2*)(stg + rloc * 128 + (((nt * 4 + i4) ^ (rloc & 7)) << 4) + hh * 8) = w;
        }
    }
    asm volatile("s_waitcnt lgkmcnt(0)" ::: "memory");
    __builtin_amdgcn_wave_barrier();
    bf16_t* gdst = p.act + ((((size_t)(m0 >> 7) * 64 + (n0 >> 6) + wn) * 128 + wm * 64) * 64);
#pragma unroll
    for (int s8 = 0; s8 < 8; ++s8) {
      const int rloc = s8 * 8 + (lane >> 3), c = lane & 7;
      const u32x4 q = *(const u32x4*)(stg + rloc * 128 + ((c ^ (rloc & 7)) << 4));
      *(u32x4*)(gdst + rloc * 64 + c * 8) = q;
    }
    }
    __syncthreads();
    };
    gemm_stream<true>(p.hb, 1024, p.WuT, 1024, 16, lds, 0, tile_fn, rs_fn, epi);
  }
}

DI void phase8(const Params& p, char* lds) {
  const int xb_ = blockIdx.x & 7, xl_ = blockIdx.x >> 3, nbx_ = gridDim.x >> 3;
  {
    auto tile_fn = [&](int j, int& m0, int& n0) -> bool { const int li = (int)(blockIdx.x >> 3) + j * (int)(gridDim.x >> 3); const int ti_ = li / 8, tj_ = li - ti_ * 8; const int tbig = ti_ * 8 + (int)(blockIdx.x & 7); if (tbig >= 528) return false; m0 = tbig * 128; n0 = tj_ * 128; return true; };
    auto rs_fn = [&](int m0, int t) -> float2 { return make_float2(0.f, 0.f); };
    auto epi = [&](f32x16 (&acc)[2][2], int m0, int n0, const float* rs, int fstage) { (void)fstage;
    const int tn = n0 >> 7; (void)tn;
    { EPI_IDS
    char* stg = wave_stage(lds, fstage, wid);
    u32x2 hw[2][2][4];
    wave_load64(stg, hw, p.hb + blk_off(m0 + wm * 64, n0 + wn * 64, 16), 64, lane, r, hh);
#pragma unroll
    for (int mt = 0; mt < 2; ++mt) {
      const int row = m0 + wm * 64 + mt * 32 + r;
      float ss = 0.f;
#pragma unroll
      for (int nt = 0; nt < 2; ++nt)
#pragma unroll
        for (int i4 = 0; i4 < 4; ++i4) {
          const u32x2 hq = hw[mt][nt][i4];
          const float h0 = __uint_as_float(hq.x << 16), h1 = __uint_as_float(hq.x & 0xffff0000u), h2 = __uint_as_float(hq.y << 16), h3 = __uint_as_float(hq.y & 0xffff0000u);
          acc[mt][nt][4 * i4] += h0; acc[mt][nt][4 * i4 + 1] += h1; acc[mt][nt][4 * i4 + 2] += h2; acc[mt][nt][4 * i4 + 3] += h3;
#pragma unroll
          for (int jj = 0; jj < 4; ++jj) ss += acc[mt][nt][4 * i4 + jj] * acc[mt][nt][4 * i4 + jj];
        }
      ss += __shfl_xor(ss, 32);
      if (hh == 0) p.out_part[(size_t)row * 16 + tn * 2 + wn] = ss;
    }
    wave_store64_f32(stg, acc, p.out + OFF_Y + (size_t)(m0 + wm * 64) * 1024 + n0 + wn * 64, 1024, lane, r, hh);
    }
    __syncthreads();
    };
    gemm_stream<true>(p.act, 4096, p.WdT, 4096, 64, lds, 0, tile_fn, rs_fn, epi);
  }
}

DI void phase9(const Params& p) {
  const int t = tid(), lane = t & 63, wid = t >> 6;
  for (int row = blockIdx.x * 4 + wid; row < NT; row += gridDim.x * 4) {
    float s = 0.f;
    for (int j = 0; j < 16; ++j) s += p.out_part[(size_t)row * 16 + j];
    const float rstd = rsqrtf(s * (1.f / 1024.f) + EPS);
    float* y = p.out + OFF_Y + (size_t)row * 1024;
#pragma unroll
    for (int j = 0; j < 4; ++j) {
      f32x4 v = *(const f32x4*)(y + lane * 4 + 256 * j);
      const f32x4 g = *(const f32x4*)(p.in[27] + lane * 4 + 256 * j);
      v[0] *= rstd * g[0]; v[1] *= rstd * g[1]; v[2] *= rstd * g[2]; v[3] *= rstd * g[3];
      *(f32x4*)(y + lane * 4 + 256 * j) = v;
    }
  }
}

DI void grid_barrier(unsigned* cnt, unsigned target) {
  asm volatile("s_waitcnt vmcnt(0)" ::: "memory");
  __syncthreads();
  if (tid() == 0) {
    __builtin_amdgcn_fence(__ATOMIC_RELEASE, "agent");
    asm volatile("s_waitcnt vmcnt(0)" ::: "memory");
    __hip_atomic_fetch_add(cnt, 1u, __ATOMIC_RELAXED, __HIP_MEMORY_SCOPE_AGENT);
    while (__hip_atomic_load(cnt, __ATOMIC_RELAXED, __HIP_MEMORY_SCOPE_AGENT) < target) __builtin_amdgcn_s_sleep(2);
  }
  __syncthreads();
  __builtin_amdgcn_fence(__ATOMIC_ACQUIRE, "agent");
  asm volatile("s_waitcnt vmcnt(0)" ::: "memory");
}

#define XB_TMO      128
#define XB_XCNT(j)  (256  + 64 * (j))
#define XB_XSUB(j)  (1280 + 64 * (j))
#define XB_XGEN(j)  (2304 + 64 * (j))
#define XB_TOP      3328
#define XB_TOPGEN   3392
#define XCD_BAR_WORDS 3456
#define XB_SPIN_CAP (1u << 22)
#define LAS __attribute__((address_space(3)))
DI unsigned xb_ld(unsigned* p)              { return __hip_atomic_load(p, __ATOMIC_RELAXED, __HIP_MEMORY_SCOPE_AGENT); }
DI unsigned xb_add(unsigned* p, unsigned v) { return __hip_atomic_fetch_add(p, v, __ATOMIC_RELAXED, __HIP_MEMORY_SCOPE_AGENT); }
DI unsigned xb_xcc_id() { return (unsigned)__builtin_amdgcn_s_getreg((3 << 11) | 20) & 0xFu; }
#define XB_SPIN(cond, bar) do { unsigned _sp = 0; while (cond) { __builtin_amdgcn_s_sleep(1); \
    if ((++_sp & 255u) == 0u) { if (xb_ld(&(bar)[XB_TMO])) break; if (_sp > XB_SPIN_CAP) { atomicAdd(&(bar)[XB_TMO], 1u); break; } } } } while (0)
struct XcdBarrier { unsigned* bar; unsigned x; volatile LAS unsigned* st; };
DI XcdBarrier xcd_barrier_post(unsigned* bar, volatile LAS unsigned* st) {
  XcdBarrier b; b.bar = bar; b.x = xb_xcc_id(); b.st = st;
  if (tid() == 0) (void)xb_add(&bar[XB_XCNT(b.x)], 1u);
  return b;
}
DI void xcd_barrier_complete(unsigned* bar, unsigned x, unsigned& nloc, unsigned& nx) {
  const unsigned G = gridDim.x * gridDim.y * gridDim.z;
  unsigned sum, cnt, mine, sp = 0u;
  for (;;) {
    sum = 0u; cnt = 0u; mine = 0u;
#pragma unroll
    for (unsigned j = 0; j < 16; ++j) { const unsigned c = xb_ld(&bar[XB_XCNT(j)]); sum += c; cnt += (c > 0u) ? 1u : 0u; mine = (j == x) ? c : mine; }
    if (sum == G) break;
    __builtin_amdgcn_s_sleep(1);
    if ((++sp & 255u) == 0u) { if (xb_ld(&bar[XB_TMO])) break; if (sp > XB_SPIN_CAP) { atomicAdd(&bar[XB_TMO], 1u); break; } }
  }
  nloc = mine > 0u ? mine : 1u; nx = cnt > 0u ? cnt : 1u;
}
DI void xcd_barrier(const XcdBarrier& b) {
  asm volatile("s_waitcnt vmcnt(0)" ::: "memory");
  __syncthreads();
  if (tid() == 0) {
    unsigned* bar = b.bar;
    __builtin_amdgcn_s_waitcnt(0);
    unsigned nloc = b.st[0], nx = b.st[1];
    if (nloc == 0u) { xcd_barrier_complete(bar, b.x, nloc, nx); b.st[0] = nloc; b.st[1] = nx; }
    const unsigned old = xb_add(&bar[XB_XSUB(b.x)], 1u);
    const unsigned gen = old / nloc;
    if (old + 1u == (gen + 1u) * nloc) {
      __builtin_amdgcn_fence(__ATOMIC_RELEASE, "agent");
      asm volatile("s_waitcnt vmcnt(0)" ::: "memory");
      const unsigned og = xb_add(&bar[XB_TOP], 1u);
      const unsigned tg = og / nx;
      if (og + 1u == (tg + 1u) * nx) xb_add(&bar[XB_TOPGEN], 1u);
      else XB_SPIN(xb_ld(&bar[XB_TOPGEN]) == tg, bar);
      __builtin_amdgcn_fence(__ATOMIC_ACQUIRE, "agent");
      xb_add(&bar[XB_XGEN(b.x)], 1u);
      asm volatile("s_waitcnt vmcnt(0)" ::: "memory");
    } else {
      XB_SPIN(xb_ld(&bar[XB_XGEN(b.x)]) == gen, bar);
      __builtin_amdgcn_fence(__ATOMIC_ACQUIRE, "agent");
      asm volatile("s_waitcnt vmcnt(0)" ::: "memory");
    }
  }
  __syncthreads();
}

template <bool COOP>
__global__ void __launch_bounds__(256, 2) mega(Params p) {
  __shared__ __attribute__((aligned(16))) char lds[LDS_BYTES];
  XcdBarrier xb{};
  if (COOP) {
    volatile LAS unsigned* st = (volatile LAS unsigned*)(lds + 67584);
    if (tid() == 0) { st[0] = 0u; st[1] = 0u; }
    __syncthreads();
    xb = xcd_barrier_post((unsigned*)p.counters + 64, st);
  }
  for (int ph = p.ph_lo; ph < p.ph_hi; ++ph) {
#ifdef ONLY_PHASE
    if (ph != ONLY_PHASE) continue;
#endif
    switch (ph) {
      case 0: phase0(p, lds); break;
      case 1: phase1(p, lds); break;
      case 2: phase2(p, lds); break;
      case 3: phase3(p, lds); break;
      case 4: phase4(p, lds, 0); break;
      case 5: phase5(p, lds); break;
      case 6: phase6(p, lds); break;
      case 7: phase7(p, lds); break;
      case 8: phase8(p, lds); break;
      default: phase9(p); break;
    }
#ifdef DOUBLE_PHASE
    if (ph == DOUBLE_PHASE) {
      __syncthreads();
      switch (ph) { case 0: phase0(p, lds); break; case 1: phase1(p, lds); break; case 2: phase2(p, lds); break; case 3: phase3(p, lds); break; case 4: phase4(p, lds, 1); break;
                    case 5: phase5(p, lds); break; case 6: phase6(p, lds); break; case 7: phase7(p, lds); break; default: break; }
    }
#endif
    if (COOP) { if (ph + 1 < p.ph_hi) { if (p.ph_hi > NPHASE) cg::this_grid().sync();   xcd_barrier(xb); } }
  }
}

static size_t al256(size_t x) { return (x + 255) & ~(size_t)255; }

extern "C" void kernel_launch(void* const* d_in, const int* in_sizes, int n_in, void* d_out, int out_size, void* d_ws, size_t ws_size, hipStream_t stream) {
  Params p{};
  for (int i = 0; i < 28; ++i) p.in[i] = (const float*)d_in[i];
  p.out = (float*)d_out;
  char* base = (char*)d_ws; size_t off = 0;
  auto take = [&](size_t bytes) { char* q = base + off; off = al256(off + bytes); return q; };
  p.WinT = (bf16_t*)take((size_t)1664 * 1024 * 2);
  p.WqT = (bf16_t*)take((size_t)768 * 768 * 2);
  p.WkT = (bf16_t*)take((size_t)512 * 256 * 2);
  p.WvT = (bf16_t*)take((size_t)512 * 256 * 2);
  p.WgT = (bf16_t*)take((size_t)512 * 512 * 2);
  p.WoT = (bf16_t*)take((size_t)1024 * 1024 * 2);
  p.WuT = (bf16_t*)take((size_t)4096 * 1024 * 2);
  p.WdT = (bf16_t*)take((size_t)1024 * 4096 * 2);
  p.BbT = (bf16_t*)take((size_t)32 * 128 * 16 * 2);
  p.CcT = (bf16_t*)take((size_t)32 * 16 * 128 * 2);
  p.lam = (float2*)take(2048 * 8);
  p.lam64 = (float2*)take(2048 * 8);
  p.rope = (float2*)take((size_t)8192 * 16 * 8);
  p.rstd_x = (float*)take((size_t)NT * 4);
  p.cq_part = (float*)take((size_t)NT * 12 * 4);
  p.ckv_part = (float*)take((size_t)NT * 4 * 4);
  p.attn_part = (float*)take((size_t)NT * 8 * 4);
  p.ssm_part = (float*)take((size_t)NT * 8 * 4);
  p.h_part = (float*)take((size_t)NT * 16 * 4);
  p.out_part = (float*)take((size_t)NT * 16 * 4);
  p.counters = (int*)take(16384);
  p.E = (float2*)take((size_t)8 * 128 * 32 * 64 * 8);
  p.S = (float2*)take((size_t)8 * 128 * 32 * 64 * 8);
  const size_t a0 = off;
  p.Kn = (bf16_t*)take((size_t)NK * 512 * 2);
  const size_t aVt = off;
  p.Vt = (bf16_t*)take((size_t)NK * 512 * 2);
  p.Q = (bf16_t*)take((size_t)NT * 768 * 2);
  p.latb = (bf16_t*)take((size_t)NK * 256 * 2);
  p.krb = (bf16_t*)take((size_t)NK * 32 * 2);
  p.ub = (bf16_t*)take((size_t)NT * 512 * 2);
  const size_t aSsmY = off;
  p.ssm_y = (bf16_t*)take((size_t)NT * 512 * 2);
  p.mix = (bf16_t*)take((size_t)NT * 1024 * 2);
  const size_t total = off;
  p.xb = (bf16_t*)(base + a0);
  p.cq = (bf16_t*)(base + aVt);
  p.ckv_raw = (float*)(base + aVt + al256((size_t)NT * 768 * 2));
  p.act = (bf16_t*)(base + a0);
  const size_t aHb = a0 + al256((size_t)NT * 4096 * 2);
  p.hb = (bf16_t*)(base + aHb);
  if (aHb + (size_t)NT * 1024 * 2 > aSsmY || total > ws_size) { fprintf(stderr, "workspace layout error: total %zu ws %zu\n", total, ws_size); return; }

  const int MULTI = 0;
  hipMemsetAsync(p.counters, 0, 16384, stream);
  if (MULTI) {
    for (int ph = 0; ph < NPHASE; ++ph) {
      p.ph_lo = ph; p.ph_hi = ph + 1;
      hipLaunchKernelGGL(mega<false>, dim3(512), dim3(256), 0, stream, p);
    }
  } else {
    static int grid_blocks = 0;
    if (!grid_blocks) {
      int dev = 0, cus = 0, per_cu = 0;
      hipGetDevice(&dev);
      hipDeviceGetAttribute(&cus, hipDeviceAttributeMultiprocessorCount, dev);
      hipOccupancyMaxActiveBlocksPerMultiprocessor(&per_cu, mega<true>, 256, 0);
      grid_blocks = cus * per_cu;
    }
    p.ph_lo = 0; p.ph_hi = NPHASE;
    void* args[] = {&p};
    hipError_t e = hipLaunchCooperativeKernel((void*)mega<true>, dim3(grid_blocks), dim3(256), args, 0, stream);
    if (e != hipSuccess) fprintf(stderr, "cooperative launch failed: %s (grid %d)\n", hipGetErrorString(e), grid_blocks);
  }
}
```

```cpp
#include <hip/hip_runtime.h>
#include <hip/hip_cooperative_groups.h>
#include <stdint.h>
#include <cstdio>
namespace cg = cooperative_groups;
#define DI __device__ __forceinline__

typedef unsigned short bf16_t;
typedef short bf16x8 __attribute__((ext_vector_type(8)));
typedef float f32x16 __attribute__((ext_vector_type(16)));
typedef float f32x4 __attribute__((ext_vector_type(4)));
typedef unsigned u32x4 __attribute__((ext_vector_type(4)));
typedef unsigned u32x2 __attribute__((ext_vector_type(2)));

constexpr int NTP = 65536, NTS = 2048, NT = NTP + NTS, NK = NTP + 32 * 4160;
constexpr int SKS = 4160;
constexpr size_t OFF_Y = 0;
constexpr size_t OFF_LATP = (size_t)NT * 1024;
constexpr size_t OFF_KRP = OFF_LATP + (size_t)NTP * 256;
constexpr size_t OFF_HRP = OFF_KRP + (size_t)NTP * 32;
constexpr size_t OFF_HIP = OFF_HRP + 8 * 32 * 64;
constexpr size_t OFF_LATS = OFF_HIP + 8 * 32 * 64;
constexpr size_t OFF_KRS = OFF_LATS + (size_t)NTS * 256;
constexpr size_t OFF_HRS = OFF_KRS + (size_t)NTS * 32;
constexpr size_t OFF_HIS = OFF_HRS + 32 * 32 * 64;
constexpr size_t VT_S_OFF = (size_t)8 * 512 * 8192;
constexpr float EPS = 1e-6f;
constexpr int LDS_BYTES = 67600;
constexpr int NPHASE = 10;
constexpr int AQT = 1, NQQ = 128 / (4 / (64 / (32 * AQT)));

struct Params {
  const float* in[28];
  float* out;
  bf16_t *WinT, *WqT, *WkT, *WvT, *WgT, *WoT, *WuT, *WdT, *BbT, *CcT;
  float2 *lam, *lam64, *rope;
  float *rstd_x, *cq_part, *ckv_part, *attn_part, *ssm_part, *h_part, *out_part;
  int* counters;
  float2 *E, *S;
  bf16_t *Kn, *Vt, *Q, *latb, *krb, *ub, *ssm_y, *mix, *xb, *cq, *hb, *act;
  float* ckv_raw;
  int ph_lo, ph_hi;
};

DI int tid() { int t = __builtin_amdgcn_workitem_id_x(); asm volatile("" : "+v"(t)); return t; }
typedef __bf16 nbf16x2 __attribute__((ext_vector_type(2)));
typedef float f32x2 __attribute__((ext_vector_type(2)));
DI unsigned pk_bf16(float lo, float hi) { f32x2 v = {lo, hi}; return __builtin_bit_cast(unsigned, __builtin_convertvector(v, nbf16x2)); }
DI bf16_t f2bf(float x) { return (bf16_t)(pk_bf16(x, 0.f) & 0xffffu); }
DI float bf2f(bf16_t v) { return __uint_as_float(((unsigned)v) << 16); }
DI int crow(int i, int hh) { return (i & 3) + 8 * (i >> 2) + 4 * hh; }
DI const float* xrow(const Params& p, int row) { return row < NTP ? p.in[0] + (size_t)row * 1024 : p.in[1] + (size_t)(row - NTP) * 1024; }
DI int pos_of(int row) { return row < NTP ? (row & 8191) : 4096 + ((row - NTP) & 63); }
DI int kr_of(int row) { return row < NTP ? row : NTP + ((row - NTP) >> 6) * SKS + 4096 + ((row - NTP) & 63); }
#define MFMA32(a, b, c) __builtin_amdgcn_mfma_f32_32x32x16_bf16((a), (b), (c), 0, 0, 0)
#define MFMA16(a, b, c) __builtin_amdgcn_mfma_f32_16x16x32_bf16((a), (b), (c), 0, 0, 0)

DI void sincos_d(double x, double& s4, double& c4) {
  double k = rint(x * 0.15915494309189535);
  double rr = fma(-k, 6.283185307179586, x);
  rr = fma(-k, 2.4492935982947064e-16, rr);
  double y = rr * 0.25, y2 = y * y;
  double s = y * (1 - y2 / 6 * (1 - y2 / 20 * (1 - y2 / 42 * (1 - y2 / 72 * (1 - y2 / 110 * (1 - y2 / 156 * (1 - y2 / 210)))))));
  double c = 1 - y2 / 2 * (1 - y2 / 12 * (1 - y2 / 30 * (1 - y2 / 56 * (1 - y2 / 90 * (1 - y2 / 132 * (1 - y2 / 182))))));
  double s2 = 2 * s * c, c2 = 1 - 2 * s * s;
  s4 = 2 * s2 * c2; c4 = 1 - 2 * s2 * s2;
}

DI void gemm_core(const bf16_t* __restrict__ A, int lda, const bf16_t* __restrict__ B, int ldb, int nk,
                  int m0, int n0, char* lds, f32x16 (&acc)[2][2], int midk, const float* ratio) {
  const int t = tid(), lane = t & 63, wid = t >> 6, wm = wid >> 1, wn = wid & 1;
  const int r = lane & 31, hh = lane >> 5;
  const int lc = t & 7, lr = t >> 3;
  const unsigned woff = lr * 128 + ((lc ^ ((lr >> 1) & 7)) << 4);
  const bf16_t* ga = A + (size_t)(m0 + lr) * lda + lc * 8;
  const bf16_t* gb = B + (size_t)(n0 + lr) * ldb + lc * 8;
  char* sA = lds; char* sB = lds + 32768;
  u32x4 ra[4], rb[4];
#pragma unroll
  for (int i = 0; i < 4; ++i) { ra[i] = *(const u32x4*)(ga + (size_t)(32 * i) * lda); rb[i] = *(const u32x4*)(gb + (size_t)(32 * i) * ldb); }
#pragma unroll
  for (int i = 0; i < 4; ++i) { *(u32x4*)(sA + woff + i * 4096) = ra[i]; *(u32x4*)(sB + woff + i * 4096) = rb[i]; }
#pragma unroll
  for (int a = 0; a < 2; ++a)
#pragma unroll
    for (int b = 0; b < 2; ++b)
#pragma unroll
      for (int i = 0; i < 16; ++i) acc[a][b][i] = 0.f;
  __syncthreads();
  const int rsw = (r >> 1) & 7;
  const unsigned aoff = (wm * 64 + r) * 128, boff = (wn * 64 + r) * 128;
  for (int kt = 0; kt < nk; ++kt) {
    const int cur = kt & 1;
    const bool more = (kt + 1 < nk);
    if (more) {
      const bf16_t* ga2 = ga + (kt + 1) * 64; const bf16_t* gb2 = gb + (kt + 1) * 64;
#pragma unroll
      for (int i = 0; i < 4; ++i) { ra[i] = *(const u32x4*)(ga2 + (size_t)(32 * i) * lda); rb[i] = *(const u32x4*)(gb2 + (size_t)(32 * i) * ldb); }
    }
    if (midk && kt == midk) {
#pragma unroll
      for (int mt = 0; mt < 2; ++mt)
      { const float f = ratio[wm * 64 + mt * 32 + r];
#pragma unroll
        for (int i = 0; i < 16; ++i) { acc[mt][0][i] *= f; acc[mt][1][i] *= f; } }
    }
    const char* cA = sA + cur * 16384; const char* cB = sB + cur * 16384;
#pragma unroll
    for (int ks = 0; ks < 4; ++ks) {
      const unsigned co = (((ks * 2 + hh) ^ rsw) << 4);
      const bf16x8 a0 = *(const bf16x8*)(cA + aoff + co), a1 = *(const bf16x8*)(cA + aoff + 4096 + co);
      const bf16x8 b0 = *(const bf16x8*)(cB + boff + co), b1 = *(const bf16x8*)(cB + boff + 4096 + co);
      acc[0][0] = MFMA32(b0, a0, acc[0][0]); acc[0][1] = MFMA32(b1, a0, acc[0][1]);
      acc[1][0] = MFMA32(b0, a1, acc[1][0]); acc[1][1] = MFMA32(b1, a1, acc[1][1]);
    }
    if (more) {
      char* nA = sA + (cur ^ 1) * 16384; char* nB = sB + (cur ^ 1) * 16384;
#pragma unroll
      for (int i = 0; i < 4; ++i) { *(u32x4*)(nA + woff + i * 4096) = ra[i]; *(u32x4*)(nB + woff + i * 4096) = rb[i]; }
    }
    __syncthreads();
  }
}

DI void rowscale_load(float* rs, const float* src, int np, float inv_dim, int m0) {
  const int t = tid();
  if (t < 128) {
    const int row = m0 + t;
    if (np == 0) rs[t] = src[row];
    else { float s = 0.f; for (int j = 0; j < np; ++j) s += src[(size_t)row * np + j]; rs[t] = rsqrtf(s * inv_dim + EPS); }
  }
}

template <bool BLKA = false, class TileFn, class RsFn, class EpiFn>
DI void gemm_stream(const bf16_t* __restrict__ A, int lda, const bf16_t* __restrict__ B, int ldb, int nk, char* lds, int midk,
                    TileFn tile_fn, RsFn rs_fn, EpiFn epi) {
  int m0, n0;
  if (!tile_fn(0, m0, n0)) return;
  const int t = tid(), lane = t & 63, wid = t >> 6, wm = wid >> 1, wn = wid & 1;
  const int r = lane & 31, hh = lane >> 5;
  const int lc = t & 7, lr = t >> 3;
  const unsigned woff = lr * 128 + ((lc ^ ((lr >> 1) & 7)) << 4);
  char* sA = lds; char* sB = lds + 32768;
  float* rsbuf = (float*)(lds + 65536);
  const int rsw = (r >> 1) & 7;
  const unsigned aoff = (wm * 64 + r) * 128, boff = (wn * 64 + r) * 128;
  int lj = 0, lkt = 0, lm0 = m0, ln0 = n0; bool lvalid = true;
  u32x4 ra0[4], rb0[4], ra1[4], rb1[4];
#define GS_LOAD(RA, RB) do {   \
        \
      const bf16_t* ga_ = BLKA ? A + ((size_t)(lm0 >> 7) * nk + lkt) * 8192 + lr * 64 + lc * 8 : A + (size_t)(lm0 + lr) * lda + lc * 8 + lkt * 64; const bf16_t* gb_ = B + (size_t)(ln0 + lr) * ldb + lc * 8 + lkt * 64; \
      _Pragma("unroll") for (int i = 0; i < 4; ++i) { RA[i] = *(const u32x4*)(ga_ + (size_t)(32 * i) * (BLKA ? 64 : lda)); RB[i] = *(const u32x4*)(gb_ + (size_t)(32 * i) * ldb); } \
      if (++lkt == nk) { lkt = 0; if (lvalid) { ++lj; lvalid = tile_fn(lj, lm0, ln0); } } } while (0)
  GS_LOAD(ra0, rb0);
  GS_LOAD(ra1, rb1);
  {
    float2 rv = make_float2(0.f, 0.f);
    if (t < 128) rv = rs_fn(m0, t);
    __syncthreads();
#pragma unroll
    for (int i = 0; i < 4; ++i) { *(u32x4*)(sA + woff + i * 4096) = ra0[i]; *(u32x4*)(sB + woff + i * 4096) = rb0[i]; }
    if (t < 128) { rsbuf[t] = rv.x; rsbuf[128 + t] = rv.y; }
    __syncthreads();
  }
  int cur = 0;
  for (int j = 0;; ++j) {
    int m1 = 0, n1 = 0;
    const bool has_next = tile_fn(j + 1, m1, n1);
    const float* rs = rsbuf + (j & 1) * 256;
    f32x16 acc[2][2];
#pragma unroll
    for (int a = 0; a < 2; ++a)
#pragma unroll
      for (int b = 0; b < 2; ++b)
#pragma unroll
        for (int i = 0; i < 16; ++i) acc[a][b][i] = 0.f;
#define GS_STEP(RL_A, RL_B, RW_A, RW_B, KT) do { \
      const bool last_ = ((KT) + 1 == nk); const bool wr_ = !last_ || has_next; \
      float2 rv_ = make_float2(0.f, 0.f); \
      if (last_ && has_next) { if (t < 128) rv_ = rs_fn(m1, t); asm volatile("" : "+v"(rv_.x), "+v"(rv_.y)); }   \
      GS_LOAD(RL_A, RL_B); \
      if (midk && (KT) == midk) { _Pragma("unroll") for (int mt = 0; mt < 2; ++mt) { const float f = rs[128 + wm * 64 + mt * 32 + r]; \
          _Pragma("unroll") for (int i = 0; i < 16; ++i) { acc[mt][0][i] *= f; acc[mt][1][i] *= f; } } } \
      const char* cA = sA + cur * 16384; const char* cB = sB + cur * 16384; \
      __builtin_amdgcn_iglp_opt(0); \
      _Pragma("unroll") for (int ks = 0; ks < 4; ++ks) { \
        const unsigned co = (((ks * 2 + hh) ^ rsw) << 4); \
        const bf16x8 a0 = *(const bf16x8*)(cA + aoff + co), a1 = *(const bf16x8*)(cA + aoff + 4096 + co); \
        const bf16x8 b0 = *(const bf16x8*)(cB + boff + co), b1 = *(const bf16x8*)(cB + boff + 4096 + co); \
        acc[0][0] = MFMA32(b0, a0, acc[0][0]); acc[0][1] = MFMA32(b1, a0, acc[0][1]); \
        acc[1][0] = MFMA32(b0, a1, acc[1][0]); acc[1][1] = MFMA32(b1, a1, acc[1][1]); } \
      if (wr_) { char* nA = sA + (cur ^ 1) * 16384; char* nB = sB + (cur ^ 1) * 16384; \
        _Pragma("unroll") for (int i = 0; i < 4; ++i) { *(u32x4*)(nA + woff + i * 4096) = RW_A[i]; *(u32x4*)(nB + woff + i * 4096) = RW_B[i]; } \
        if (last_ && t < 128) { float* rn = rsbuf + ((j + 1) & 1) * 256; rn[t] = rv_.x; rn[128 + t] = rv_.y; } } \
      __syncthreads(); cur ^= 1; } while (0)
    for (int kt = 0; kt < nk; kt += 2) {
      GS_STEP(ra0, rb0, ra1, rb1, kt);
      GS_STEP(ra1, rb1, ra0, rb0, kt + 1);
    }
    epi(acc, m0, n0, rs, cur ^ 1);
    if (!has_next) break;
    m0 = m1; n0 = n1;
  }
#undef GS_STEP
#undef GS_LOAD
  __syncthreads();
}

DI float half_reduce(float s) {
  s += __shfl_xor(s, 1); s += __shfl_xor(s, 2); s += __shfl_xor(s, 4); s += __shfl_xor(s, 8); s += __shfl_xor(s, 16); return s;
}

#define EPI_IDS int t = tid(); asm volatile("" : "+v"(t)); const int lane = t & 63, wid = t >> 6, wm = wid >> 1, wn = wid & 1, r = lane & 31, hh = lane >> 5; (void)lane; (void)wid; (void)wm; (void)wn; (void)r; (void)hh;
#define GEMM_IDS const int t = tid(), lane = t & 63, wid = t >> 6, wm = wid >> 1, wn = wid & 1, r = lane & 31, hh = lane >> 5; (void)t; (void)wm; (void)wn; (void)r; (void)hh;

DI char* wave_stage(char* lds, int fstage, int wid) { return lds + (wid < 2 ? 0 : 32768) + fstage * 16384 + (wid & 1) * 8192; }
DI void wave_store64(char* stg, const u32x2 (&w)[2][2][4], bf16_t* gdst, size_t row_stride, int lane, int r, int hh) {
#pragma unroll
  for (int mt = 0; mt < 2; ++mt)
#pragma unroll
    for (int nt = 0; nt < 2; ++nt)
#pragma unroll
      for (int i4 = 0; i4 < 4; ++i4) { const int rloc = mt * 32 + r; *(u32x2*)(stg + rloc * 128 + (((nt * 4 + i4) ^ (rloc & 7)) << 4) + hh * 8) = w[mt][nt][i4]; }
  asm volatile("s_waitcnt lgkmcnt(0)" ::: "memory");
  __builtin_amdgcn_wave_barrier();
#pragma unroll
  for (int s8 = 0; s8 < 8; ++s8) {
    const int rloc = s8 * 8 + (lane >> 3), c = lane & 7;
    const u32x4 q = *(const u32x4*)(stg + rloc * 128 + ((c ^ (rloc & 7)) << 4));
    *(u32x4*)(gdst + (size_t)rloc * row_stride + c * 8) = q;
  }
}

DI void wave_load64(char* stg, u32x2 (&w)[2][2][4], const bf16_t* gsrc, size_t row_stride, int lane, int r, int hh) {
  u32x4 q[8];
#pragma unroll
  for (int s8 = 0; s8 < 8; ++s8) { const int rloc = s8 * 8 + (lane >> 3), c = lane & 7; q[s8] = *(const u32x4*)(gsrc + (size_t)rloc * row_stride + c * 8); }
#pragma unroll
  for (int s8 = 0; s8 < 8; ++s8) { const int rloc = s8 * 8 + (lane >> 3), c = lane & 7; *(u32x4*)(stg + rloc * 128 + ((c ^ (rloc & 7)) << 4)) = q[s8]; }
  asm volatile("s_waitcnt lgkmcnt(0)" ::: "memory");
  __builtin_amdgcn_wave_barrier();
#pragma unroll
  for (int mt = 0; mt < 2; ++mt)
#pragma unroll
    for (int nt = 0; nt < 2; ++nt)
#pragma unroll
      for (int i4 = 0; i4 < 4; ++i4) { const int rloc = mt * 32 + r; w[mt][nt][i4] = *(const u32x2*)(stg + rloc * 128 + (((nt * 4 + i4) ^ (rloc & 7)) << 4) + hh * 8); }
  asm volatile("s_waitcnt lgkmcnt(0)" ::: "memory");
  __builtin_amdgcn_wave_barrier();
}
DI void wave_add64_f32(char* stg, f32x16 (&a)[2][2], const float* gsrc, size_t row_stride, int lane, int r, int hh) {
#pragma unroll
  for (int mt = 0; mt < 2; ++mt) {
    f32x4 q[8];
#pragma unroll
    for (int s8 = 0; s8 < 8; ++s8) { const int row = s8 * 4 + (lane >> 4), c = lane & 15; q[s8] = *(const f32x4*)(gsrc + (size_t)(mt * 32 + row) * row_stride + c * 4); }
#pragma unroll
    for (int s8 = 0; s8 < 8; ++s8) { const int row = s8 * 4 + (lane >> 4), c = lane & 15; *(f32x4*)(stg + row * 256 + ((c ^ (row & 15)) << 4)) = q[s8]; }
    asm volatile("s_waitcnt lgkmcnt(0)" ::: "memory");
    __builtin_amdgcn_wave_barrier();
#pragma unroll
    for (int nt = 0; nt < 2; ++nt)
#pragma unroll
      for (int i4 = 0; i4 < 4; ++i4) {
        const f32x4 xv = *(const f32x4*)(stg + r * 256 + (((nt * 8 + 2 * i4 + hh) ^ (r & 15)) << 4));
#pragma unroll
        for (int jj = 0; jj < 4; ++jj) a[mt][nt][4 * i4 + jj] += xv[jj];
      }
    asm volatile("s_waitcnt lgkmcnt(0)" ::: "memory");
    __builtin_amdgcn_wave_barrier();
  }
}
DI void wave_store64_f32(char* stg, const f32x16 (&a)[2][2], float* gdst, size_t row_stride, int lane, int r, int hh) {
#pragma unroll
  for (int mt = 0; mt < 2; ++mt) {
#pragma unroll
    for (int nt = 0; nt < 2; ++nt)
#pragma unroll
      for (int i4 = 0; i4 < 4; ++i4) {
        const f32x4 v = {a[mt][nt][4 * i4], a[mt][nt][4 * i4 + 1], a[mt][nt][4 * i4 + 2], a[mt][nt][4 * i4 + 3]};
        *(f32x4*)(stg + r * 256 + (((nt * 8 + 2 * i4 + hh) ^ (r & 15)) << 4)) = v;
      }
    asm volatile("s_waitcnt lgkmcnt(0)" ::: "memory");
    __builtin_amdgcn_wave_barrier();
#pragma unroll
    for (int s8 = 0; s8 < 8; ++s8) {
      const int row = s8 * 4 + (lane >> 4), c = lane & 15;
      const f32x4 q = *(const f32x4*)(stg + row * 256 + ((c ^ (row & 15)) << 4));
      *(f32x4*)(gdst + (size_t)(mt * 32 + row) * row_stride + c * 4) = q;
    }
    asm volatile("s_waitcnt lgkmcnt(0)" ::: "memory");
    __builtin_amdgcn_wave_barrier();
  }
}

DI size_t blk_off(int row, int col, int KB) { return (((size_t)(row >> 7) * KB + (col >> 6)) * 128 + (row & 127)) * 64 + (col & 63); }

DI void transpose_tile(const float* __restrict__ src, int ld, int K, int kt, int nt, int job, const float* g0, const float* g1, bf16_t* __restrict__ dst, char* lds) {
  bf16_t* tile = (bf16_t*)lds;
  const int t = tid(), nl = t & 63, kq = t >> 6;
  const int n = nt * 64 + nl;
  int c = n;
  if (job == 0) { c = n < 1024 ? n : (n < 1536 ? 1056 + (n - 1024) : (n < 1568 ? 1024 + (n - 1536) : -1)); }
  else if (job == 2) c = (n >> 6) * 128 + (n & 63);
  else if (job == 3) c = (n >> 6) * 128 + 64 + (n & 63);
#pragma unroll 4
  for (int pass = 0; pass < 16; ++pass) {
    const int kl = pass * 4 + kq, k = kt * 64 + kl;
    float v = 0.f;
    if (c >= 0) {
      v = src[(size_t)k * ld + c];
      if (g0) { const float g = (g1 && k >= 512) ? g1[k - 512] : g0[k]; v *= g; }
    }
    tile[nl * 66 + kl] = f2bf(v);
  }
  __syncthreads();
  const int kl = t & 63;
#pragma unroll 4
  for (int pass = 0; pass < 16; ++pass) { const int nl2 = pass * 4 + kq; dst[(size_t)(nt * 64 + nl2) * K + kt * 64 + kl] = tile[nl2 * 66 + kl]; }
  __syncthreads();
}

DI void phase0(const Params& p, char* lds) {
  const int t = tid(), nb = gridDim.x, bid = blockIdx.x, lane = t & 63, wid = t >> 6;
  for (int ti = bid; ti < 2992; ti += nb) {
    int job, base, nNt, ld, K; const float* src; const float* g0 = nullptr; const float* g1 = nullptr; bf16_t* dst;
    if (ti < 416) { job = 0; base = 0; nNt = 26; ld = 1568; K = 1024; src = p.in[7]; g0 = p.in[6]; dst = p.WinT; }
    else if (ti < 560) { job = 1; base = 416; nNt = 12; ld = 768; K = 768; src = p.in[9]; g0 = p.in[8]; dst = p.WqT; }
    else if (ti < 592) { job = 2; base = 560; nNt = 8; ld = 1024; K = 256; src = p.in[11]; dst = p.WkT; }
    else if (ti < 624) { job = 3; base = 592; nNt = 8; ld = 1024; K = 256; src = p.in[11]; dst = p.WvT; }
    else if (ti < 688) { job = 4; base = 624; nNt = 8; ld = 512; K = 512; src = p.in[20]; dst = p.WgT; }
    else if (ti < 944) { job = 5; base = 688; nNt = 16; ld = 1024; K = 1024; src = p.in[23]; g0 = p.in[21]; g1 = p.in[22]; dst = p.WoT; }
    else if (ti < 1968) { job = 6; base = 944; nNt = 64; ld = 4096; K = 1024; src = p.in[25]; g0 = p.in[24]; dst = p.WuT; }
    else { job = 7; base = 1968; nNt = 16; ld = 1024; K = 4096; src = p.in[26]; dst = p.WdT; }
    const int tile = ti - base;
    transpose_tile(src, ld, K, tile / nNt, tile % nNt, job, g0, g1, dst, lds);
  }
  for (int row = bid * 4 + wid; row < NT; row += nb * 4) {
    const float* x = xrow(p, row);
    f32x4 v[4]; float ss = 0.f;
#pragma unroll
    for (int j = 0; j < 4; ++j) { v[j] = __builtin_nontemporal_load((const f32x4*)(x + lane * 4 + 256 * j)); ss += v[j][0] * v[j][0] + v[j][1] * v[j][1] + v[j][2] * v[j][2] + v[j][3] * v[j][3]; }
    ss += __shfl_xor(ss, 32); ss = half_reduce(ss);
#pragma unroll
    for (int j = 0; j < 4; ++j) { u32x2 w; w.x = pk_bf16(v[j][0], v[j][1]); w.y = pk_bf16(v[j][2], v[j][3]); *(u32x2*)(p.xb + blk_off(row, lane * 4 + 256 * j, 16)) = w; }
    if (lane == 0) p.rstd_x[row] = rsqrtf(ss * (1.f / 1024.f) + EPS);
  }
  const int gt = bid * 256 + t, ngt = nb * 256;
  for (int v = gt; v < 32 * 4096 * 32; v += ngt) {
    const size_t e0 = (size_t)v * 8; const int b = (int)(e0 >> 20), rem = (int)(e0 & 1048575), tt = rem >> 8, c = rem & 255;
    const f32x4 a = __builtin_nontemporal_load((const f32x4*)(p.in[2] + e0)), bq = __builtin_nontemporal_load((const f32x4*)(p.in[2] + e0 + 4));
    u32x4 w; w.x = pk_bf16(a[0], a[1]); w.y = pk_bf16(a[2], a[3]); w.z = pk_bf16(bq[0], bq[1]); w.w = pk_bf16(bq[2], bq[3]);
    *(u32x4*)(p.latb + (size_t)(NTP + b * SKS + tt) * 256 + c) = w;
  }
  for (int v = gt; v < 32 * 4096 * 4; v += ngt) {
    const size_t e0 = (size_t)v * 8; const int b = (int)(e0 >> 17), rem = (int)(e0 & 131071), tt = rem >> 5, c = rem & 31;
    const f32x4 a = __builtin_nontemporal_load((const f32x4*)(p.in[3] + e0)), bq = __builtin_nontemporal_load((const f32x4*)(p.in[3] + e0 + 4));
    u32x4 w; w.x = pk_bf16(a[0], a[1]); w.y = pk_bf16(a[2], a[3]); w.z = pk_bf16(bq[0], bq[1]); w.w = pk_bf16(bq[2], bq[3]);
    *(u32x4*)(p.krb + (size_t)(NTP + b * SKS + tt) * 32 + c) = w;
  }
  if (gt < 2048) {
    const int g = gt >> 6, n = gt & 63;
    const double dt = (double)expf(p.in[14][g]);
    const double lr = p.in[12][gt], li = p.in[13][gt];
    const double mag = (double)expf((float)(lr * dt)); double s, c; sincos_d(li * dt, s, c);
    const double lbr = mag * c, lbi = mag * s;
    const double nr = lbr - 1.0, ni = lbi, den = lr * lr + li * li;
    const double cr = (nr * lr + ni * li) / den, ci = (ni * lr - nr * li) / den;
    p.lam[gt] = make_float2((float)lbr, (float)lbi);
    const double mag64 = (double)expf((float)(64.0 * lr * dt)); sincos_d(64.0 * li * dt, s, c);
    p.lam64[gt] = make_float2((float)(mag64 * c), (float)(mag64 * s));
    for (int q = 0; q < 16; ++q) {
      const double br = p.in[15][(size_t)gt * 16 + q], bi = p.in[16][(size_t)gt * 16 + q];
      p.BbT[(size_t)(g * 128 + n) * 16 + q] = f2bf((float)(cr * br - ci * bi));
      p.BbT[(size_t)(g * 128 + 64 + n) * 16 + q] = f2bf((float)(cr * bi + ci * br));
      p.CcT[(size_t)(g * 16 + q) * 128 + n] = f2bf(p.in[17][(size_t)(g * 16 + q) * 64 + n]);
      p.CcT[(size_t)(g * 16 + q) * 128 + 64 + n] = f2bf(-p.in[18][(size_t)(g * 16 + q) * 64 + n]);
    }
  }
  for (int e = gt; e < 8192 * 16; e += ngt) {
    const int pos = e >> 4, i = e & 15;
    const float inv = expf(-(float)i * (9.210340371976184f / 16.0f));
    const float ang = (float)pos * inv;
    double s, c; sincos_d((double)ang, s, c);
    p.rope[e] = make_float2((float)c, (float)s);
  }
}

DI void phase1(const Params& p, char* lds) {
  float* rs = (float*)(lds + 65536);
  const int ntiles = 528 * 13;
  {
    auto tile_fn = [&](int j, int& m0, int& n0) -> bool { const int li = (int)(blockIdx.x >> 3) + j * (int)(gridDim.x >> 3); const int ti_ = li / 13, tj_ = li - ti_ * 13; const int tbig = ti_ * 8 + (int)(blockIdx.x & 7); if (tbig >= 528) return false; m0 = tbig * 128; n0 = tj_ * 128; return true; };
    auto rs_fn = [&](int m0, int t) -> float2 { return make_float2(p.rstd_x[m0 + t], 0.f); };
    auto epi = [&](f32x16 (&acc)[2][2], int m0, int n0, const float* rs, int fstage) { (void)fstage;
    const int tn = n0 >> 7; (void)tn;
    { EPI_IDS
    u32x2 wq[2][2][4];
    if (tn < 8) {
#pragma unroll
      for (int mt = 0; mt < 2; ++mt) {
        const int rl = wm * 64 + mt * 32 + r, row = m0 + rl;
        const float sc = rs[rl];
        float ss = 0.f;
#pragma unroll
        for (int nt = 0; nt < 2; ++nt)
#pragma unroll
          for (int i4 = 0; i4 < 4; ++i4) {
            const float v0 = acc[mt][nt][4 * i4] * sc, v1 = acc[mt][nt][4 * i4 + 1] * sc, v2 = acc[mt][nt][4 * i4 + 2] * sc, v3 = acc[mt][nt][4 * i4 + 3] * sc;
            ss += v0 * v0 + v1 * v1 + v2 * v2 + v3 * v3;
            const int col = n0 + wn * 64 + nt * 32 + 8 * i4 + 4 * hh;
            if (tn < 6) { wq[mt][nt][i4].x = pk_bf16(v0, v1); wq[mt][nt][i4].y = pk_bf16(v2, v3); }
            else { acc[mt][nt][4 * i4] = v0; acc[mt][nt][4 * i4 + 1] = v1; acc[mt][nt][4 * i4 + 2] = v2; acc[mt][nt][4 * i4 + 3] = v3; }
          }
        ss += __shfl_xor(ss, 32);
        if (hh == 0) { if (tn < 6) p.cq_part[(size_t)row * 12 + tn * 2 + wn] = ss; else p.ckv_part[(size_t)row * 4 + (tn - 6) * 2 + wn] = ss; }
      }
      if (tn < 6) wave_store64(wave_stage(lds, fstage, wid), wq, p.cq + blk_off(m0 + wm * 64, n0 + wn * 64, 12), 64, lane, r, hh);
      else wave_store64_f32(wave_stage(lds, fstage, wid), acc, p.ckv_raw + (size_t)(m0 + wm * 64) * 256 + (n0 - 768) + wn * 64, 256, lane, r, hh);
    } else if (tn < 12) {
#pragma unroll
      for (int mt = 0; mt < 2; ++mt) {
        const int rl = wm * 64 + mt * 32 + r, row = m0 + rl;
        const float sc = rs[rl];
#pragma unroll
        for (int nt = 0; nt < 2; ++nt)
#pragma unroll
          for (int i4 = 0; i4 < 4; ++i4) {
            wq[mt][nt][i4].x = pk_bf16(acc[mt][nt][4 * i4] * sc, acc[mt][nt][4 * i4 + 1] * sc); wq[mt][nt][i4].y = pk_bf16(acc[mt][nt][4 * i4 + 2] * sc, acc[mt][nt][4 * i4 + 3] * sc);
          }
      }
      wave_store64(wave_stage(lds, fstage, wid), wq, p.ub + (size_t)(m0 + wm * 64) * 512 + (n0 - 1024) + wn * 64, 512, lane, r, hh);
    } else if (wn == 0) {
#pragma unroll
      for (int mt = 0; mt < 2; ++mt) {
        const int rl = wm * 64 + mt * 32 + r, row = m0 + rl;
        const float sc = rs[rl];
        float* dst = row < NTP ? p.out + OFF_KRP + (size_t)row * 32 : p.out + OFF_KRS + (size_t)(row - NTP) * 32;
        bf16_t* dkb = p.krb + (size_t)kr_of(row) * 32;
        const float* rp = (const float*)(p.rope + pos_of(row) * 16);
#pragma unroll
        for (int ih = 0; ih < 2; ++ih) {
          const int j0 = 8 * ih + 4 * hh;
          const f32x4 c01 = *(const f32x4*)(rp + 2 * j0), c23 = *(const f32x4*)(rp + 2 * j0 + 4);
          const float cc[4] = {c01[0], c01[2], c23[0], c23[2]}, sn[4] = {c01[1], c01[3], c23[1], c23[3]};
          f32x4 o1, o2;
#pragma unroll
          for (int jj = 0; jj < 4; ++jj) {
            const float x1 = acc[mt][0][4 * ih + jj] * sc, x2 = acc[mt][0][8 + 4 * ih + jj] * sc;
            o1[jj] = x1 * cc[jj] - x2 * sn[jj]; o2[jj] = x1 * sn[jj] + x2 * cc[jj];
          }
          *(f32x4*)(dst + j0) = o1; *(f32x4*)(dst + 16 + j0) = o2;
          u32x2 w1, w2; w1.x = pk_bf16(o1[0], o1[1]); w1.y = pk_bf16(o1[2], o1[3]); w2.x = pk_bf16(o2[0], o2[1]); w2.y = pk_bf16(o2[2], o2[3]);
          *(u32x2*)(dkb + j0) = w1; *(u32x2*)(dkb + 16 + j0) = w2;
        }
      }
    }
    }
    __syncthreads();
    };
    gemm_stream<true>(p.xb, 1024, p.WinT, 1024, 16, lds, 0, tile_fn, rs_fn, epi);
  }
}

DI void ssm_chunk(const Params& p, int row0, int g, float& hr, float& hi, bool write_y, char* lds_w) {
  const int lane = tid() & 63, r = lane & 31, hh = lane >> 5;
  const float2 lm = p.lam[g * 64 + lane];
  bf16x8 bfr[4];
#pragma unroll
  for (int nt = 0; nt < 4; ++nt) bfr[nt] = *(const bf16x8*)(p.BbT + (size_t)(g * 128 + nt * 32 + r) * 16 + hh * 8);
  const int fr = lane & 15, fq = lane >> 4;
  bf16x8 cfr[4];
#pragma unroll
  for (int ks = 0; ks < 4; ++ks) cfr[ks] = *(const bf16x8*)(p.CcT + (size_t)(g * 16 + fr) * 128 + ks * 32 + fq * 8);
  const float dsk = p.in[19][g * 16 + fr];
#pragma unroll 1
  for (int sub = 0; sub < 2; ++sub) {
    const int rb = row0 + sub * 32;
    const bf16x8 uf = *(const bf16x8*)(p.ub + (size_t)(rb + r) * 512 + g * 16 + hh * 8);
    f32x16 z; for (int i = 0; i < 16; ++i) z[i] = 0.f;
    const f32x16 x0 = MFMA32(uf, bfr[0], z), x1 = MFMA32(uf, bfr[1], z), x2 = MFMA32(uf, bfr[2], z), x3 = MFMA32(uf, bfr[3], z);
    float xr0[16], xr1[16], xi0[16], xi1[16];
#pragma unroll
    for (int i = 0; i < 16; ++i) {
      const auto re = __builtin_amdgcn_permlane32_swap(__float_as_uint(x0[i]), __float_as_uint(x1[i]), false, false);
      const auto im = __builtin_amdgcn_permlane32_swap(__float_as_uint(x2[i]), __float_as_uint(x3[i]), false, false);
      xr0[i] = __uint_as_float(re[0]); xr1[i] = __uint_as_float(re[1]);
      xi0[i] = __uint_as_float(im[0]); xi1[i] = __uint_as_float(im[1]);
    }
    bf16_t* Hs = (bf16_t*)lds_w;
#pragma unroll
    for (int m = 0; m < 4; ++m) {
#pragma unroll
      for (int half = 0; half < 2; ++half) {
#pragma unroll
        for (int jj = 0; jj < 4; ++jj) {
          const int i = 4 * m + jj, tt = 8 * m + 4 * half + jj;
          const float xr = half ? xr1[i] : xr0[i], xi = half ? xi1[i] : xi0[i];
          const float nr = lm.x * hr - lm.y * hi + xr;
          const float ni = lm.x * hi + lm.y * hr + xi;
          hr = nr; hi = ni;
          if (write_y) { Hs[tt * 136 + lane] = f2bf(hr); Hs[tt * 136 + 64 + lane] = f2bf(hi); }
        }
      }
    }
    if (write_y) {
      asm volatile("s_waitcnt lgkmcnt(0)" ::: "memory");
      __builtin_amdgcn_wave_barrier();
#pragma unroll
      for (int mt = 0; mt < 2; ++mt) {
        f32x4 y = {0.f, 0.f, 0.f, 0.f};
#pragma unroll
        for (int ks = 0; ks < 4; ++ks) {
          const bf16x8 hf = *(const bf16x8*)(Hs + (mt * 16 + fr) * 136 + ks * 32 + fq * 8);
          y = MFMA16(hf, cfr[ks], y);
        }
#pragma unroll
        for (int j = 0; j < 4; ++j) {
          const int row = rb + mt * 16 + fq * 4 + j;
          const float u = bf2f(p.ub[(size_t)row * 512 + g * 16 + fr]);
          const float v = y[j] + dsk * u;
          const float zz = 0.7978845608028654f * (v + 0.044715f * v * v * v);
          const float th = 1.f - 2.f / (__expf(2.f * zz) + 1.f);
          p.ssm_y[(size_t)row * 512 + g * 16 + fr] = f2bf(0.5f * v * (1.f + th));
        }
      }
      asm volatile("s_waitcnt lgkmcnt(0)" ::: "memory");
      __builtin_amdgcn_wave_barrier();
    }
  }
}

DI void phase2(const Params& p, char* lds) {
  const int lane = tid() & 63, wid = tid() >> 6;
  const int nb = gridDim.x, bid = blockIdx.x;
  for (int row = bid * 4 + wid; row < NT; row += nb * 4) {
    const f32x4 v = *(const f32x4*)(p.ckv_raw + (size_t)row * 256 + lane * 4);
    const f32x4 pp = *(const f32x4*)(p.ckv_part + (size_t)row * 4);
    const float rstd = rsqrtf((pp[0] + pp[1] + pp[2] + pp[3]) * (1.f / 256.f) + EPS);
    const f32x4 g = *(const f32x4*)(p.in[10] + lane * 4);
    f32x4 o; o[0] = v[0] * rstd * g[0]; o[1] = v[1] * rstd * g[1]; o[2] = v[2] * rstd * g[2]; o[3] = v[3] * rstd * g[3];
    float* dst = row < NTP ? p.out + OFF_LATP + (size_t)row * 256 : p.out + OFF_LATS + (size_t)(row - NTP) * 256;
    *(f32x4*)(dst + lane * 4) = o;
    u32x2 w; w.x = pk_bf16(o[0], o[1]); w.y = pk_bf16(o[2], o[3]);
    *(u32x2*)(p.latb + (size_t)kr_of(row) * 256 + lane * 4) = w;
  }
  for (int it = bid * 4 + wid; it < 8 * 128 * 32; it += nb * 4) {
    const int g = it & 31, c = (it >> 5) & 127, b = it >> 12;
    float hr = 0.f, hi = 0.f;
    ssm_chunk(p, b * 8192 + c * 64, g, hr, hi, false, lds + wid * 8704);
    p.E[(size_t)it * 64 + lane] = make_float2(hr, hi);
  }
  float* rs = (float*)(lds + 65536);
  {
    auto tile_fn = [&](int j, int& m0, int& n0) -> bool { const int li = (int)(blockIdx.x >> 3) + j * (int)(gridDim.x >> 3); const int ti_ = li / 6, tj_ = li - ti_ * 6; const int tbig = ti_ * 8 + (int)(blockIdx.x & 7); if (tbig >= 528) return false; m0 = tbig * 128; n0 = tj_ * 128; return true; };
    auto rs_fn = [&](int m0, int t) -> float2 { float sm = 0.f; for (int q = 0; q < 3; ++q) { const f32x4 v = *(const f32x4*)(p.cq_part + (size_t)(m0 + t) * 12 + 4 * q); sm += (v[0] + v[1]) + (v[2] + v[3]); } return make_float2(rsqrtf(sm * (1.f / 768.f) + EPS), 0.f); };
    auto epi = [&](f32x16 (&acc)[2][2], int m0, int n0, const float* rs, int fstage) { (void)fstage;
    const int tn = n0 >> 7; (void)tn;
    EPI_IDS
    const float qs = 0.10206207261596577f * 1.4426950408889634f;
    u32x2 wq[2][2][4];
#pragma unroll
    for (int mt = 0; mt < 2; ++mt) {
      const int rl = wm * 64 + mt * 32 + r, row = m0 + rl;
      const float sc = rs[rl] * qs;
      const float* rp = (const float*)(p.rope + pos_of(row) * 16);
#pragma unroll
      for (int nt = 0; nt < 2; ++nt) {
        const int cb = n0 + wn * 64 + nt * 32;
        if ((cb % 96) == 64) {
#pragma unroll
          for (int ih = 0; ih < 2; ++ih) {
            const int j0 = 8 * ih + 4 * hh;
            const f32x4 c01 = *(const f32x4*)(rp + 2 * j0), c23 = *(const f32x4*)(rp + 2 * j0 + 4);
            const float cc[4] = {c01[0], c01[2], c23[0], c23[2]}, sn[4] = {c01[1], c01[3], c23[1], c23[3]};
            float o1[4], o2[4];
#pragma unroll
            for (int jj = 0; jj < 4; ++jj) {
              const float x1 = acc[mt][nt][4 * ih + jj] * sc, x2 = acc[mt][nt][8 + 4 * ih + jj] * sc;
              o1[jj] = x1 * cc[jj] - x2 * sn[jj]; o2[jj] = x1 * sn[jj] + x2 * cc[jj];
            }
            wq[mt][nt][ih].x = pk_bf16(o1[0], o1[1]); wq[mt][nt][ih].y = pk_bf16(o1[2], o1[3]); wq[mt][nt][ih + 2].x = pk_bf16(o2[0], o2[1]); wq[mt][nt][ih + 2].y = pk_bf16(o2[2], o2[3]);
          }
        } else {
#pragma unroll
          for (int i4 = 0; i4 < 4; ++i4) {
            wq[mt][nt][i4].x = pk_bf16(acc[mt][nt][4 * i4] * sc, acc[mt][nt][4 * i4 + 1] * sc); wq[mt][nt][i4].y = pk_bf16(acc[mt][nt][4 * i4 + 2] * sc, acc[mt][nt][4 * i4 + 3] * sc);
          }
        }
      }
    }

    wave_store64(wave_stage(lds, fstage, wid), wq, p.Q + (size_t)(m0 + wm * 64) * 768 + n0 + wn * 64, 768, lane, r, hh);
    __syncthreads();
    };
    gemm_stream<true>(p.cq, 768, p.WqT, 768, 12, lds, 0, tile_fn, rs_fn, epi);
  }
}

DI void phase3(const Params& p, char* lds) {
  const int lane = tid() & 63, wid = tid() >> 6;
  const int nb = gridDim.x, bid = blockIdx.x;
  for (int it = bid * 4 + wid; it < 256; it += nb * 4) {
    const int b = it >> 5, g = it & 31;
    const float2 l64 = p.lam64[g * 64 + lane];
    float sr = 0.f, si = 0.f;
    const size_t base = ((size_t)(b * 128) * 32 + g) * 64 + lane;
    for (int c0 = 0; c0 < 128; c0 += 16) {
      float2 e[16];
#pragma unroll
      for (int j = 0; j < 16; ++j) e[j] = p.E[base + (size_t)(c0 + j) * 2048];
#pragma unroll
      for (int j = 0; j < 16; ++j) {
        p.S[base + (size_t)(c0 + j) * 2048] = make_float2(sr, si);
        const float nr = l64.x * sr - l64.y * si + e[j].x, ni = l64.x * si + l64.y * sr + e[j].y;
        sr = nr; si = ni;
      }
    }
  }
  {
    auto tile_fn = [&](int j, int& m0, int& n0) -> bool { const int li = (int)(blockIdx.x >> 3) + j * (int)(gridDim.x >> 3); const int ti_ = li / 4, tj_ = li - ti_ * 4; const int tbig = ti_ * 8 + (int)(blockIdx.x & 7); if (tbig >= 1552) return false; m0 = tbig * 128; n0 = tj_ * 128; return true; };
    auto rs_fn = [&](int m0, int t) -> float2 { return make_float2(0.f, 0.f); };
    auto epi = [&](f32x16 (&acc)[2][2], int m0, int n0, const float* rs, int fstage) { (void)fstage;
    const int tn = n0 >> 7; (void)tn;
    EPI_IDS
    u32x2 w[2][2][4];
#pragma unroll
    for (int mt = 0; mt < 2; ++mt)
#pragma unroll
      for (int nt = 0; nt < 2; ++nt)
#pragma unroll
        for (int i4 = 0; i4 < 4; ++i4) { w[mt][nt][i4].x = pk_bf16(acc[mt][nt][4 * i4], acc[mt][nt][4 * i4 + 1]); w[mt][nt][i4].y = pk_bf16(acc[mt][nt][4 * i4 + 2], acc[mt][nt][4 * i4 + 3]); }
    wave_store64(wave_stage(lds, fstage, wid), w, p.Kn + (size_t)(m0 + wm * 64) * 512 + n0 + wn * 64, 512, lane, r, hh);
    __syncthreads();
    };
    gemm_stream(p.latb, 256, p.WkT, 256, 4, lds, 0, tile_fn, rs_fn, epi);
  }
  {
    auto tile_fn = [&](int j, int& m0, int& n0) -> bool { const int li = (int)(blockIdx.x >> 3) + j * (int)(gridDim.x >> 3); const int ti_ = li / 4, tj_ = li - ti_ * 4; const int tbig = ti_ * 8 + (int)(blockIdx.x & 7); if (tbig >= 1552) return false; n0 = tbig * 128; m0 = tj_ * 128; return true; };
    auto rs_fn = [&](int m0, int t) -> float2 { return make_float2(0.f, 0.f); };
    auto epi = [&](f32x16 (&acc)[2][2], int m0, int n0, const float* rs, int fstage) { (void)fstage;
    const int tn = n0 >> 7; (void)tn;
    EPI_IDS
    u32x2 w[2][2][4];
#pragma unroll
    for (int mt = 0; mt < 2; ++mt)
#pragma unroll
      for (int nt = 0; nt < 2; ++nt)
#pragma unroll
        for (int i4 = 0; i4 < 4; ++i4) { w[mt][nt][i4].x = pk_bf16(acc[mt][nt][4 * i4], acc[mt][nt][4 * i4 + 1]); w[mt][nt][i4].y = pk_bf16(acc[mt][nt][4 * i4 + 2], acc[mt][nt][4 * i4 + 3]); }
    const int kr0 = n0 + wn * 64;
    size_t cbase; int S;
    if (kr0 < NTP) { cbase = (size_t)(kr0 >> 13) * 512 * 8192 + (kr0 & 8191); S = 8192; }
    else { const int k2 = kr0 - NTP, b = k2 / SKS, tt = k2 - b * SKS; cbase = VT_S_OFF + (size_t)b * 512 * SKS + tt; S = SKS; }
    wave_store64(wave_stage(lds, fstage, wid), w, p.Vt + cbase + (size_t)(m0 + wm * 64) * S, (size_t)S, lane, r, hh);
    __syncthreads();
    };
    gemm_stream(p.WvT, 256, p.latb, 256, 4, lds, 0, tile_fn, rs_fn, epi);
  }
}

template <int QT, bool HALF>
DI void attn_item(const Params& p, int kind, int b, int h, int qq, char* lds) {
  const int t = tid(), lane = t & 63, wid = t >> 6, r = lane & 31, hh = lane >> 5;
  int qrow0, nkb_w, nkb_max, S; size_t kr0; const bf16_t* vt_base;
  constexpr int RW = 32 * QT, WPC = 64 / RW, CPB = 4 / WPC;
  if (kind == 0) {
    const int c = qq * CPB + wid / WPC; qrow0 = b * 8192 + c * 64 + (wid % WPC) * RW; nkb_w = c + 1; nkb_max = qq * CPB + CPB; kr0 = (size_t)b * 8192; S = 8192;
    vt_base = p.Vt + (size_t)(b * 8 + h) * 64 * 8192;
  } else {
    qrow0 = NTP + b * 64 + (wid % WPC) * RW; nkb_w = (wid < WPC) ? 65 : 0; nkb_max = 65; kr0 = (size_t)NTP + (size_t)b * SKS; S = SKS;
    vt_base = p.Vt + VT_S_OFF + (size_t)(b * 8 + h) * 64 * SKS;
  }
  bf16x8 qf[QT][6];
#pragma unroll
  for (int qt = 0; qt < QT; ++qt)
#pragma unroll
    for (int ks = 0; ks < 6; ++ks) qf[qt][ks] = *(const bf16x8*)(p.Q + (size_t)(qrow0 + qt * 32 + r) * 768 + h * 96 + ks * 16 + hh * 8);
  f32x16 o[2][QT];
  float mrun[QT], lrun[QT];
#pragma unroll
  for (int qt = 0; qt < QT; ++qt) { mrun[qt] = -1e30f; lrun[qt] = 0.f;
#pragma unroll
    for (int dt = 0; dt < 2; ++dt)
#pragma unroll
      for (int i = 0; i < 16; ++i) o[dt][qt][i] = 0.f; }
  const int kkey = t >> 3, kc = t & 7;
  const int rkey = t >> 2, rc = t & 3;
  const int vd = t >> 3, vc = t & 7;
  const bf16_t* gk = p.Kn + (kr0 + kkey) * 512 + h * 64 + kc * 8;
  const bf16_t* gr = p.krb + (kr0 + rkey) * 32 + rc * 8;
  const bf16_t* gv = vt_base + (size_t)vd * S + vc * 8;
  const unsigned kw0 = kkey * 208 + kc * 16, kw1 = kw0 + 32 * 208, rw = rkey * 208 + 128 + rc * 16;
  const unsigned vlo = vd * 144 + (vc >> 1) * 32 + (vc & 1) * 8, vhi = vlo + 16;
  constexpr int KB = 13312, VB = 9216, BUF = KB + VB;
  u32x4 k0r, k1r, rr, v0r, v1r;
  k0r = *(const u32x4*)gk; k1r = *(const u32x4*)(gk + 32 * 512); rr = *(const u32x4*)gr;
  v0r = *(const u32x4*)gv; v1r = *(const u32x4*)(gv + (size_t)32 * S);
  __syncthreads();
  {
    char* kb_ = lds; char* vb_ = lds + KB;
    *(u32x4*)(kb_ + kw0) = k0r; *(u32x4*)(kb_ + kw1) = k1r; *(u32x4*)(kb_ + rw) = rr;
    *(u32x2*)(vb_ + vlo) = (u32x2){v0r.x, v0r.y}; *(u32x2*)(vb_ + vhi) = (u32x2){v0r.z, v0r.w};
    *(u32x2*)(vb_ + vlo + 32 * 144) = (u32x2){v1r.x, v1r.y}; *(u32x2*)(vb_ + vhi + 32 * 144) = (u32x2){v1r.z, v1r.w};
  }
  __syncthreads();
  for (int kb = 0; kb < nkb_max; ++kb) {
    const int cur = kb & 1;
    const bool more = kb + 1 < nkb_max;
    if (more) {
      const size_t ko = (size_t)(kb + 1) * 64;
      k0r = *(const u32x4*)(gk + ko * 512); k1r = *(const u32x4*)(gk + (ko + 32) * 512); rr = *(const u32x4*)(gr + ko * 32);
      v0r = *(const u32x4*)(gv + ko); v1r = *(const u32x4*)(gv + (size_t)32 * S + ko);
    }
    if (HALF && kb < nkb_w) {
      const char* kt_ = lds + cur * BUF; const char* vt_ = kt_ + KB;
#pragma unroll
      for (int kt = 0; kt < 2; ++kt) {
        __builtin_amdgcn_iglp_opt(0);
        f32x16 sh[QT];
#pragma unroll
        for (int qt = 0; qt < QT; ++qt)
#pragma unroll
          for (int i = 0; i < 16; ++i) sh[qt][i] = 0.f;
#pragma unroll
        for (int ks = 0; ks < 6; ++ks) {
          const bf16x8 kf = *(const bf16x8*)(kt_ + (kt * 32 + r) * 208 + ks * 32 + hh * 16);
#pragma unroll
          for (int qt = 0; qt < QT; ++qt) sh[qt] = MFMA32(kf, qf[qt][ks], sh[qt]);
        }
        bf16x8 ph[QT][2];
#pragma unroll
        for (int qt = 0; qt < QT; ++qt) {
          float mx = sh[qt][0];
#pragma unroll
          for (int i = 1; i < 16; ++i) mx = fmaxf(mx, sh[qt][i]);
          mx = fmaxf(mx, __shfl_xor(mx, 32));
          const bool need = mx > mrun[qt] + 8.f;
          if (__any(need)) {
            const float mnew = need ? mx : mrun[qt];
            const float alpha = __builtin_amdgcn_exp2f(mrun[qt] - mnew);
            mrun[qt] = mnew; lrun[qt] *= alpha;
#pragma unroll
            for (int dt = 0; dt < 2; ++dt)
#pragma unroll
              for (int i = 0; i < 16; ++i) o[dt][qt][i] *= alpha;
          }
          float ls = 0.f;
#pragma unroll
          for (int i = 0; i < 16; ++i) { const float pv = __builtin_amdgcn_exp2f(sh[qt][i] - mrun[qt]); ls += pv; sh[qt][i] = pv; }
          lrun[qt] += ls;
#pragma unroll
          for (int s2 = 0; s2 < 2; ++s2) {
            u32x4 w;
            w.x = pk_bf16(sh[qt][8 * s2 + 0], sh[qt][8 * s2 + 1]); w.y = pk_bf16(sh[qt][8 * s2 + 2], sh[qt][8 * s2 + 3]);
            w.z = pk_bf16(sh[qt][8 * s2 + 4], sh[qt][8 * s2 + 5]); w.w = pk_bf16(sh[qt][8 * s2 + 6], sh[qt][8 * s2 + 7]);
            ph[qt][s2] = __builtin_bit_cast(bf16x8, w);
          }
        }
#pragma unroll
        for (int dt = 0; dt < 2; ++dt)
#pragma unroll
          for (int s2 = 0; s2 < 2; ++s2) {
            const bf16x8 vf = *(const bf16x8*)(vt_ + (dt * 32 + r) * 144 + (kt * 2 + s2) * 32 + hh * 16);
#pragma unroll
            for (int qt = 0; qt < QT; ++qt) o[dt][qt] = MFMA32(vf, ph[qt][s2], o[dt][qt]);
          }
      }
    }
    if (!HALF && kb < nkb_w) {
      const char* kt_ = lds + cur * BUF; const char* vt_ = kt_ + KB;
      f32x16 st[2][QT];
#pragma unroll
      for (int kt = 0; kt < 2; ++kt)
#pragma unroll
        for (int qt = 0; qt < QT; ++qt)
#pragma unroll
          for (int i = 0; i < 16; ++i) st[kt][qt][i] = 0.f;
#pragma unroll
      for (int ks = 0; ks < 6; ++ks)
#pragma unroll
        for (int kt = 0; kt < 2; ++kt) {
          const bf16x8 kf = *(const bf16x8*)(kt_ + (kt * 32 + r) * 208 + ks * 32 + hh * 16);
#pragma unroll
          for (int qt = 0; qt < QT; ++qt) st[kt][qt] = MFMA32(kf, qf[qt][ks], st[kt][qt]);
        }
      bf16x8 pb[2][QT][2];
#pragma unroll
      for (int qt = 0; qt < QT; ++qt) {
        float mx = mrun[qt];
#pragma unroll
        for (int kt = 0; kt < 2; ++kt)
#pragma unroll
          for (int i = 0; i < 16; ++i) mx = fmaxf(mx, st[kt][qt][i]);
        mx = fmaxf(mx, __shfl_xor(mx, 32));
        const float alpha = __builtin_amdgcn_exp2f(mrun[qt] - mx);
        mrun[qt] = mx;
        float ls = 0.f;
#pragma unroll
        for (int kt = 0; kt < 2; ++kt) {
#pragma unroll
          for (int i = 0; i < 16; ++i) { const float pv = __builtin_amdgcn_exp2f(st[kt][qt][i] - mx); ls += pv; st[kt][qt][i] = pv; }
#pragma unroll
          for (int s2 = 0; s2 < 2; ++s2) {
            u32x4 w;
            w.x = pk_bf16(st[kt][qt][8 * s2 + 0], st[kt][qt][8 * s2 + 1]); w.y = pk_bf16(st[kt][qt][8 * s2 + 2], st[kt][qt][8 * s2 + 3]);
            w.z = pk_bf16(st[kt][qt][8 * s2 + 4], st[kt][qt][8 * s2 + 5]); w.w = pk_bf16(st[kt][qt][8 * s2 + 6], st[kt][qt][8 * s2 + 7]);
            pb[kt][qt][s2] = __builtin_bit_cast(bf16x8, w);
          }
        }
        lrun[qt] = lrun[qt] * alpha + ls;
#pragma unroll
        for (int dt = 0; dt < 2; ++dt)
#pragma unroll
          for (int i = 0; i < 16; ++i) o[dt][qt][i] *= alpha;
      }
#pragma unroll
      for (int dt = 0; dt < 2; ++dt)
#pragma unroll
        for (int kt = 0; kt < 2; ++kt)
#pragma unroll
          for (int s2 = 0; s2 < 2; ++s2) {
            const bf16x8 vf = *(const bf16x8*)(vt_ + (dt * 32 + r) * 144 + (kt * 2 + s2) * 32 + hh * 16);
#pragma unroll
            for (int qt = 0; qt < QT; ++qt) o[dt][qt] = MFMA32(vf, pb[kt][qt][s2], o[dt][qt]);
          }
    }
    if (more) {
      char* kb_ = lds + (cur ^ 1) * BUF; char* vb_ = kb_ + KB;
      *(u32x4*)(kb_ + kw0) = k0r; *(u32x4*)(kb_ + kw1) = k1r; *(u32x4*)(kb_ + rw) = rr;
      *(u32x2*)(vb_ + vlo) = (u32x2){v0r.x, v0r.y}; *(u32x2*)(vb_ + vhi) = (u32x2){v0r.z, v0r.w};
      *(u32x2*)(vb_ + vlo + 32 * 144) = (u32x2){v1r.x, v1r.y}; *(u32x2*)(vb_ + vhi + 32 * 144) = (u32x2){v1r.z, v1r.w};
    }
    __syncthreads();
  }
  if (nkb_w > 0) {
    u32x2 wo[2][2][4];
#pragma unroll
    for (int qt = 0; qt < QT; ++qt) {
      const float lt = lrun[qt] + __shfl_xor(lrun[qt], 32);
      const float inv = 1.f / lt;
      const int row = qrow0 + qt * 32 + r;
      float ss = 0.f;
#pragma unroll
      for (int dt = 0; dt < 2; ++dt)
#pragma unroll
        for (int i4 = 0; i4 < 4; ++i4) {
          const float a0 = o[dt][qt][4 * i4] * inv, a1 = o[dt][qt][4 * i4 + 1] * inv, a2 = o[dt][qt][4 * i4 + 2] * inv, a3 = o[dt][qt][4 * i4 + 3] * inv;
          ss += a0 * a0 + a1 * a1 + a2 * a2 + a3 * a3;
          u32x2 w; w.x = pk_bf16(a0, a1); w.y = pk_bf16(a2, a3);
          if (QT == 2) wo[qt][dt][i4] = w;
          else *(u32x2*)(p.mix + blk_off(row, h * 64 + dt * 32 + 8 * i4 + 4 * hh, 16)) = w;
        }
      ss += __shfl_xor(ss, 32);
      if (hh == 0) p.attn_part[(size_t)row * 8 + h] = ss;
    }
    if (QT == 2) wave_store64(lds + wid * 8192, wo, p.mix + blk_off(qrow0, h * 64, 16), 64, lane, r, hh);
  }
}

DI void phase4(const Params& p, char* lds, int qidx) {
  const int t = tid(), lane = t & 63, wid = t >> 6;
  const int nb = gridDim.x, bid = blockIdx.x;
  int* nxt = (int*)(lds + 65536);
  for (;;) {
    __syncthreads();
    if (t == 0) *nxt = atomicAdd(p.counters + qidx, 1);
    __syncthreads();
    const int it = *nxt;
    if (it >= 256 + 64 * 32) break;
    if (it < 256) attn_item<1, false>(p, 1, it >> 3, it & 7, 0, lds);
    else { const int j = it - 256; const int qq = 31 - (j >> 6), bh = j & 63; attn_item<2, true>(p, 0, bh >> 3, bh & 7, qq, lds); }
  }
  __syncthreads();
  for (int it = bid * 4 + wid; it < 8 * 128 * 32 + 1024; it += nb * 4) {
    if (it < 8 * 128 * 32) {
      const int g = it & 31, c = (it >> 5) & 127, b = it >> 12;
      const float2 s0 = p.S[(size_t)it * 64 + lane];
      float hr = s0.x, hi = s0.y;
      ssm_chunk(p, b * 8192 + c * 64, g, hr, hi, true, lds + wid * 8704);
      if (c == 127) { p.out[OFF_HRP + (size_t)(b * 32 + g) * 64 + lane] = hr; p.out[OFF_HIP + (size_t)(b * 32 + g) * 64 + lane] = hi; }
    } else {
      const int j = it - 8 * 128 * 32, g = j & 31, b = j >> 5;
      float hr = p.in[4][(size_t)(b * 32 + g) * 64 + lane], hi = p.in[5][(size_t)(b * 32 + g) * 64 + lane];
      ssm_chunk(p, NTP + b * 64, g, hr, hi, true, lds + wid * 8704);
      p.out[OFF_HRS + (size_t)(b * 32 + g) * 64 + lane] = hr; p.out[OFF_HIS + (size_t)(b * 32 + g) * 64 + lane] = hi;
    }
  }
}

DI void phase5(const Params& p, char* lds) {
  {
    auto tile_fn = [&](int j, int& m0, int& n0) -> bool { const int li = (int)(blockIdx.x >> 3) + j * (int)(gridDim.x >> 3); const int ti_ = li / 4, tj_ = li - ti_ * 4; const int tbig = ti_ * 8 + (int)(blockIdx.x & 7); if (tbig >= 528) return false; m0 = tbig * 128; n0 = tj_ * 128; return true; };
    auto rs_fn = [&](int m0, int t) -> float2 { return make_float2(0.f, 0.f); };
    auto epi = [&](f32x16 (&acc)[2][2], int m0, int n0, const float* rs, int fstage) { (void)fstage;
    const int tn = n0 >> 7; (void)tn;
    { EPI_IDS
    u32x2 wq[2][2][4], yw[2][2][4];
    wave_load64(wave_stage(lds, fstage, wid), yw, p.ssm_y + (size_t)(m0 + wm * 64) * 512 + n0 + wn * 64, 512, lane, r, hh);
#pragma unroll
    for (int mt = 0; mt < 2; ++mt) {
      const int row = m0 + wm * 64 + mt * 32 + r;
      float ss = 0.f;
#pragma unroll
      for (int nt = 0; nt < 2; ++nt)
#pragma unroll
        for (int i4 = 0; i4 < 4; ++i4) {
          const int col = n0 + wn * 64 + nt * 32 + 8 * i4 + 4 * hh;
          const u32x2 yv = yw[mt][nt][i4];
          const float y0 = __uint_as_float(yv.x << 16), y1 = __uint_as_float(yv.x & 0xffff0000u), y2 = __uint_as_float(yv.y << 16), y3 = __uint_as_float(yv.y & 0xffff0000u);
          const float o0 = y0 / (1.f + __expf(-acc[mt][nt][4 * i4])), o1 = y1 / (1.f + __expf(-acc[mt][nt][4 * i4 + 1]));
          const float o2 = y2 / (1.f + __expf(-acc[mt][nt][4 * i4 + 2])), o3 = y3 / (1.f + __expf(-acc[mt][nt][4 * i4 + 3]));
          ss += o0 * o0 + o1 * o1 + o2 * o2 + o3 * o3;
          wq[mt][nt][i4].x = pk_bf16(o0, o1); wq[mt][nt][i4].y = pk_bf16(o2, o3);
        }
      ss += __shfl_xor(ss, 32);
      if (hh == 0) p.ssm_part[(size_t)row * 8 + tn * 2 + wn] = ss;
    }
    wave_store64(wave_stage(lds, fstage, wid), wq, p.mix + blk_off(m0 + wm * 64, 512 + n0 + wn * 64, 16), 64, lane, r, hh);
    }
    __syncthreads();
    };
    gemm_stream(p.ssm_y, 512, p.WgT, 512, 8, lds, 0, tile_fn, rs_fn, epi);
  }
}

DI void phase6(const Params& p, char* lds) {
  const int xb_ = blockIdx.x & 7, xl_ = blockIdx.x >> 3, nbx_ = gridDim.x >> 3;
  {
    auto tile_fn = [&](int j, int& m0, int& n0) -> bool { const int li6 = xl_ + j * nbx_, tm = (li6 >> 3) * 8 + xb_; if (tm >= 528) return false; m0 = tm * 128; n0 = (li6 & 7) * 128; return true; };
    auto rs_fn = [&](int m0, int t) -> float2 {
      const f32x4 a0 = *(const f32x4*)(p.attn_part + (size_t)(m0 + t) * 8), a1 = *(const f32x4*)(p.attn_part + (size_t)(m0 + t) * 8 + 4);
      const float sa = (a0[0] + a0[1]) + (a0[2] + a0[3]) + (a1[0] + a1[1]) + (a1[2] + a1[3]);
      const f32x4 b0 = *(const f32x4*)(p.ssm_part + (size_t)(m0 + t) * 8), b1 = *(const f32x4*)(p.ssm_part + (size_t)(m0 + t) * 8 + 4);
      const float sb = (b0[0] + b0[1]) + (b0[2] + b0[3]) + (b1[0] + b1[1]) + (b1[2] + b1[3]);
      const float ra = rsqrtf(sa * (1.f / 512.f) + EPS), rb = rsqrtf(sb * (1.f / 512.f) + EPS);
      return make_float2(rb, ra / rb); };
    auto epi = [&](f32x16 (&acc)[2][2], int m0, int n0, const float* rs, int fstage) { (void)fstage;
    const int tn = n0 >> 7;
    { EPI_IDS
    char* stg = wave_stage(lds, fstage, wid);
#pragma unroll
    for (int mt = 0; mt < 2; ++mt) {
      const float sc = rs[wm * 64 + mt * 32 + r];
#pragma unroll
      for (int nt = 0; nt < 2; ++nt)
#pragma unroll
        for (int i = 0; i < 16; ++i) acc[mt][nt][i] *= sc;
    }
    wave_add64_f32(stg, acc, xrow(p, m0 + wm * 64) + n0 + wn * 64, 1024, lane, r, hh);
    u32x2 w[2][2][4];
#pragma unroll
    for (int mt = 0; mt < 2; ++mt) {
      const int row = m0 + wm * 64 + mt * 32 + r;
      float ss = 0.f;
#pragma unroll
      for (int nt = 0; nt < 2; ++nt)
#pragma unroll
        for (int i4 = 0; i4 < 4; ++i4) {
#pragma unroll
          for (int jj = 0; jj < 4; ++jj) ss += acc[mt][nt][4 * i4 + jj] * acc[mt][nt][4 * i4 + jj];
          w[mt][nt][i4].x = pk_bf16(acc[mt][nt][4 * i4], acc[mt][nt][4 * i4 + 1]); w[mt][nt][i4].y = pk_bf16(acc[mt][nt][4 * i4 + 2], acc[mt][nt][4 * i4 + 3]);
        }
      ss += __shfl_xor(ss, 32);
      if (hh == 0) p.h_part[(size_t)row * 16 + tn * 2 + wn] = ss;
    }
    wave_store64(stg, w, p.hb + blk_off(m0 + wm * 64, n0 + wn * 64, 16), 64, lane, r, hh);
    }
    __syncthreads();
    };
    gemm_stream<true>(p.mix, 1024, p.WoT, 1024, 16, lds, 8, tile_fn, rs_fn, epi);
  }
}

DI void phase7(const Params& p, char* lds) {
  float* rs = (float*)(lds + 65536);
  const int xb_ = blockIdx.x & 7, xl_ = blockIdx.x >> 3, nbx_ = gridDim.x >> 3;
  {
    auto tile_fn = [&](int j, int& m0, int& n0) -> bool { const int tm = j * (nbx_ >> 2) + (xl_ >> 2); if (tm >= 528) return false; m0 = tm * 128; n0 = (xb_ * 4 + (xl_ & 3)) * 128; return true; };
    auto rs_fn = [&](int m0, int t) -> float2 { float sm = 0.f; for (int q = 0; q < 4; ++q) { const f32x4 v = *(const f32x4*)(p.h_part + (size_t)(m0 + t) * 16 + 4 * q); sm += (v[0] + v[1]) + (v[2] + v[3]); } return make_float2(rsqrtf(sm * (1.f / 1024.f) + EPS), 0.f); };
    auto epi = [&](f32x16 (&acc)[2][2], int m0, int n0, const float* rs, int fstage) { (void)fstage;
    const int tn = n0 >> 7; (void)tn;
    { EPI_IDS
    char* stg = lds + (wid < 2 ? 0 : 32768) + fstage * 16384 + (wid & 1) * 8192;
#pragma unroll
    for (int mt = 0; mt < 2; ++mt) {
      const int rloc = mt * 32 + r;
      const float sc = rs[wm * 64 + rloc];
#pragma unroll
      for (int nt = 0; nt < 2; ++nt)
#pragma unroll
        for (int i4 = 0; i4 < 4; ++i4) {
          float v[4];
#pragma unroll
          for (int jj = 0; jj < 4; ++jj) { const float a_ = fmaxf(acc[mt][nt][4 * i4 + jj] * sc, 0.f); v[jj] = a_ * a_; }
          u32x2 w; w.x = pk_bf16(v[0], v[1]); w.y = pk_bf16(v[2], v[3]);
          *(u32x2*)(stg + rloc * 128 + (((nt * 4 + i4) ^ (rloc & 7)) << 4) + hh * 8) = w;
        }
    }
    asm volatile("s_waitcnt lgkmcnt(0)" ::: "memory");
    __builtin_amdgcn_wave_barrier();
    bf16_t* gdst = p.act + ((((size_t)(m0 >> 7) * 64 + (n0 >> 6) + wn) * 128 + wm * 64) * 64);
#pragma unroll
    for (int s8 = 0; s8 < 8; ++s8) {
      const int rloc = s8 * 8 + (lane >> 3), c = lane & 7;
      const u32x4 q = *(const u32x4*)(stg + rloc * 128 + ((c ^ (rloc & 7)) << 4));
      *(u32x4*)(gdst + rloc * 64 + c * 8) = q;
    }
    }
    __syncthreads();
    };
    gemm_stream<true>(p.hb, 1024, p.WuT, 1024, 16, lds, 0, tile_fn, rs_fn, epi);
  }
}

DI void phase8(const Params& p, char* lds) {
  const int xb_ = blockIdx.x & 7, xl_ = blockIdx.x >> 3, nbx_ = gridDim.x >> 3;
  {
    auto tile_fn = [&](int j, int& m0, int& n0) -> bool { const int li = (int)(blockIdx.x >> 3) + j * (int)(gridDim.x >> 3); const int ti_ = li / 8, tj_ = li - ti_ * 8; const int tbig = ti_ * 8 + (int)(blockIdx.x & 7); if (tbig >= 528) return false; m0 = tbig * 128; n0 = tj_ * 128; return true; };
    auto rs_fn = [&](int m0, int t) -> float2 { return make_float2(0.f, 0.f); };
    auto epi = [&](f32x16 (&acc)[2][2], int m0, int n0, const float* rs, int fstage) { (void)fstage;
    const int tn = n0 >> 7; (void)tn;
    { EPI_IDS
    char* stg = wave_stage(lds, fstage, wid);
    u32x2 hw[2][2][4];
    wave_load64(stg, hw, p.hb + blk_off(m0 + wm * 64, n0 + wn * 64, 16), 64, lane, r, hh);
#pragma unroll
    for (int mt = 0; mt < 2; ++mt) {
      const int row = m0 + wm * 64 + mt * 32 + r;
      float ss = 0.f;
#pragma unroll
      for (int nt = 0; nt < 2; ++nt)
#pragma unroll
        for (int i4 = 0; i4 < 4; ++i4) {
          const u32x2 hq = hw[mt][nt][i4];
          const float h0 = __uint_as_float(hq.x << 16), h1 = __uint_as_float(hq.x & 0xffff0000u), h2 = __uint_as_float(hq.y << 16), h3 = __uint_as_float(hq.y & 0xffff0000u);
          acc[mt][nt][4 * i4] += h0; acc[mt][nt][4 * i4 + 1] += h1; acc[mt][nt][4 * i4 + 2] += h2; acc[mt][nt][4 * i4 + 3] += h3;
#pragma unroll
          for (int jj = 0; jj < 4; ++jj) ss += acc[mt][nt][4 * i4 + jj] * acc[mt][nt][4 * i4 + jj];
        }
      ss += __shfl_xor(ss, 32);
      if (hh == 0) p.out_part[(size_t)row * 16 + tn * 2 + wn] = ss;
    }
    wave_store64_f32(stg, acc, p.out + OFF_Y + (size_t)(m0 + wm * 64) * 1024 + n0 + wn * 64, 1024, lane, r, hh);
    }
    __syncthreads();
    };
    gemm_stream<true>(p.act, 4096, p.WdT, 4096, 64, lds, 0, tile_fn, rs_fn, epi);
  }
}

DI void phase9(const Params& p) {
  const int t = tid(), lane = t & 63, wid = t >> 6;
  for (int row = blockIdx.x * 4 + wid; row < NT; row += gridDim.x * 4) {
    float s = 0.f;
    for (int j = 0; j < 16; ++j) s += p.out_part[(size_t)row * 16 + j];
    const float rstd = rsqrtf(s * (1.f / 1024.f) + EPS);
    float* y = p.out + OFF_Y + (size_t)row * 1024;
#pragma unroll
    for (int j = 0; j < 4; ++j) {
      f32x4 v = *(const f32x4*)(y + lane * 4 + 256 * j);
      const f32x4 g = *(const f32x4*)(p.in[27] + lane * 4 + 256 * j);
      v[0] *= rstd * g[0]; v[1] *= rstd * g[1]; v[2] *= rstd * g[2]; v[3] *= rstd * g[3];
      *(f32x4*)(y + lane * 4 + 256 * j) = v;
    }
  }
}

DI void grid_barrier(unsigned* cnt, unsigned target) {
  asm volatile("s_waitcnt vmcnt(0)" ::: "memory");
  __syncthreads();
  if (tid() == 0) {
    __builtin_amdgcn_fence(__ATOMIC_RELEASE, "agent");
    asm volatile("s_waitcnt vmcnt(0)" ::: "memory");
    __hip_atomic_fetch_add(cnt, 1u, __ATOMIC_RELAXED, __HIP_MEMORY_SCOPE_AGENT);
    while (__hip_atomic_load(cnt, __ATOMIC_RELAXED, __HIP_MEMORY_SCOPE_AGENT) < target) __builtin_amdgcn_s_sleep(2);
  }
  __syncthreads();
  __builtin_amdgcn_fence(__ATOMIC_ACQUIRE, "agent");
  asm volatile("s_waitcnt vmcnt(0)" ::: "memory");
}

#define XB_TMO      128
#define XB_XCNT(j)  (256  + 64 * (j))
#define XB_XSUB(j)  (1280 + 64 * (j))
#define XB_XGEN(j)  (2304 + 64 * (j))
#define XB_TOP      3328
#define XB_TOPGEN   3392
#define XCD_BAR_WORDS 3456
#define XB_SPIN_CAP (1u << 22)
#define LAS __attribute__((address_space(3)))
DI unsigned xb_ld(unsigned* p)              { return __hip_atomic_load(p, __ATOMIC_RELAXED, __HIP_MEMORY_SCOPE_AGENT); }
DI unsigned xb_add(unsigned* p, unsigned v) { return __hip_atomic_fetch_add(p, v, __ATOMIC_RELAXED, __HIP_MEMORY_SCOPE_AGENT); }
DI unsigned xb_xcc_id() { return (unsigned)__builtin_amdgcn_s_getreg((3 << 11) | 20) & 0xFu; }
#define XB_SPIN(cond, bar) do { unsigned _sp = 0; while (cond) { __builtin_amdgcn_s_sleep(1); \
    if ((++_sp & 255u) == 0u) { if (xb_ld(&(bar)[XB_TMO])) break; if (_sp > XB_SPIN_CAP) { atomicAdd(&(bar)[XB_TMO], 1u); break; } } } } while (0)
struct XcdBarrier { unsigned* bar; unsigned x; volatile LAS unsigned* st; };
DI XcdBarrier xcd_barrier_post(unsigned* bar, volatile LAS unsigned* st) {
  XcdBarrier b; b.bar = bar; b.x = xb_xcc_id(); b.st = st;
  if (tid() == 0) (void)xb_add(&bar[XB_XCNT(b.x)], 1u);
  return b;
}
DI void xcd_barrier_complete(unsigned* bar, unsigned x, unsigned& nloc, unsigned& nx) {
  const unsigned G = gridDim.x * gridDim.y * gridDim.z;
  unsigned sum, cnt, mine, sp = 0u;
  for (;;) {
    sum = 0u; cnt = 0u; mine = 0u;
#pragma unroll
    for (unsigned j = 0; j < 16; ++j) { const unsigned c = xb_ld(&bar[XB_XCNT(j)]); sum += c; cnt += (c > 0u) ? 1u : 0u; mine = (j == x) ? c : mine; }
    if (sum == G) break;
    __builtin_amdgcn_s_sleep(1);
    if ((++sp & 255u) == 0u) { if (xb_ld(&bar[XB_TMO])) break; if (sp > XB_SPIN_CAP) { atomicAdd(&bar[XB_TMO], 1u); break; } }
  }
  nloc = mine > 0u ? mine : 1u; nx = cnt > 0u ? cnt : 1u;
}
DI void xcd_barrier(const XcdBarrier& b) {
  asm volatile("s_waitcnt vmcnt(0)" ::: "memory");
  __syncthreads();
  if (tid() == 0) {
    unsigned* bar = b.bar;
    __builtin_amdgcn_s_waitcnt(0);
    unsigned nloc = b.st[0], nx = b.st[1];
    if (nloc == 0u) { xcd_barrier_complete(bar, b.x, nloc, nx); b.st[0] = nloc; b.st[1] = nx; }
    const unsigned old = xb_add(&bar[XB_XSUB(b.x)], 1u);
    const unsigned gen = old / nloc;
    if (old + 1u == (gen + 1u) * nloc) {
      __builtin_amdgcn_fence(__ATOMIC_RELEASE, "agent");
      asm volatile("s_waitcnt vmcnt(0)" ::: "memory");
      const unsigned og = xb_add(&bar[XB_TOP], 1u);
      const unsigned tg = og / nx;
      if (og + 1u == (tg + 1u) * nx) xb_add(&bar[XB_TOPGEN], 1u);
      else XB_SPIN(xb_ld(&bar[XB_TOPGEN]) == tg, bar);
      __builtin_amdgcn_fence(__ATOMIC_ACQUIRE, "agent");
      xb_add(&bar[XB_XGEN(b.x)], 1u);
      asm volatile("s_waitcnt vmcnt(0)" ::: "memory");
    } else {
      XB_SPIN(xb_ld(&bar[XB_XGEN(b.x)]) == gen, bar);
      __builtin_amdgcn_fence(__ATOMIC_ACQUIRE, "agent");
      asm volatile("s_waitcnt vmcnt(0)" ::: "memory");
    }
  }
  __syncthreads();
}

template <bool COOP>
__global__ void __launch_bounds__(256, 2) mega(Params p) {
  __shared__ __attribute__((aligned(16))) char lds[LDS_BYTES];
  XcdBarrier xb{};
  if (COOP) {
    volatile LAS unsigned* st = (volatile LAS unsigned*)(lds + 67584);
    if (tid() == 0) { st[0] = 0u; st[1] = 0u; }
    __syncthreads();
    xb = xcd_barrier_post((unsigned*)p.counters + 64, st);
  }
  for (int ph = p.ph_lo; ph < p.ph_hi; ++ph) {
#ifdef ONLY_PHASE
    if (ph != ONLY_PHASE) continue;
#endif
    switch (ph) {
      case 0: phase0(p, lds); break;
      case 1: phase1(p, lds); break;
      case 2: phase2(p, lds); break;
      case 3: phase3(p, lds); break;
      case 4: phase4(p, lds, 0); break;
      case 5: phase5(p, lds); break;
      case 6: phase6(p, lds); break;
      case 7: phase7(p, lds); break;
      case 8: phase8(p, lds); break;
      default: phase9(p); break;
    }
#ifdef DOUBLE_PHASE
    if (ph == DOUBLE_PHASE) {
      __syncthreads();
      switch (ph) { case 0: phase0(p, lds); break; case 1: phase1(p, lds); break; case 2: phase2(p, lds); break; case 3: phase3(p, lds); break; case 4: phase4(p, lds, 1); break;
                    case 5: phase5(p, lds); break; case 6: phase6(p, lds); break; case 7: phase7(p, lds); break; default: break; }
    }
#endif
    if (COOP) { if (ph + 1 < p.ph_hi) { if (p.ph_hi > NPHASE) cg::this_grid().sync();   xcd_barrier(xb); } }
  }
}

static size_t al256(size_t x) { return (x + 255) & ~(size_t)255; }

extern "C" void kernel_launch(void* const* d_in, const int* in_sizes, int n_in, void* d_out, int out_size, void* d_ws, size_t ws_size, hipStream_t stream) {
  Params p{};
  for (int i = 0; i < 28; ++i) p.in[i] = (const float*)d_in[i];
  p.out = (float*)d_out;
  char* base = (char*)d_ws; size_t off = 0;
  auto take = [&](size_t bytes) { char* q = base + off; off = al256(off + bytes); return q; };
  p.WinT = (bf16_t*)take((size_t)1664 * 1024 * 2);
  p.WqT = (bf16_t*)take((size_t)768 * 768 * 2);
  p.WkT = (bf16_t*)take((size_t)512 * 256 * 2);
  p.WvT = (bf16_t*)take((size_t)512 * 256 * 2);
  p.WgT = (bf16_t*)take((size_t)512 * 512 * 2);
  p.WoT = (bf16_t*)take((size_t)1024 * 1024 * 2);
  p.WuT = (bf16_t*)take((size_t)4096 * 1024 * 2);
  p.WdT = (bf16_t*)take((size_t)1024 * 4096 * 2);
  p.BbT = (bf16_t*)take((size_t)32 * 128 * 16 * 2);
  p.CcT = (bf16_t*)take((size_t)32 * 16 * 128 * 2);
  p.lam = (float2*)take(2048 * 8);
  p.lam64 = (float2*)take(2048 * 8);
  p.rope = (float2*)take((size_t)8192 * 16 * 8);
  p.rstd_x = (float*)take((size_t)NT * 4);
  p.cq_part = (float*)take((size_t)NT * 12 * 4);
  p.ckv_part = (float*)take((size_t)NT * 4 * 4);
  p.attn_part = (float*)take((size_t)NT * 8 * 4);
  p.ssm_part = (float*)take((size_t)NT * 8 * 4);
  p.h_part = (float*)take((size_t)NT * 16 * 4);
  p.out_part = (float*)take((size_t)NT * 16 * 4);
  p.counters = (int*)take(16384);
  p.E = (float2*)take((size_t)8 * 128 * 32 * 64 * 8);
  p.S = (float2*)take((size_t)8 * 128 * 32 * 64 * 8);
  const size_t a0 = off;
  p.Kn = (bf16_t*)take((size_t)NK * 512 * 2);
  const size_t aVt = off;
  p.Vt = (bf16_t*)take((size_t)NK * 512 * 2);
  p.Q = (bf16_t*)take((size_t)NT * 768 * 2);
  p.latb = (bf16_t*)take((size_t)NK * 256 * 2);
  p.krb = (bf16_t*)take((size_t)NK * 32 * 2);
  p.ub = (bf16_t*)take((size_t)NT * 512 * 2);
  const size_t aSsmY = off;
  p.ssm_y = (bf16_t*)take((size_t)NT * 512 * 2);
  p.mix = (bf16_t*)take((size_t)NT * 1024 * 2);
  const size_t total = off;
  p.xb = (bf16_t*)(base + a0);
  p.cq = (bf16_t*)(base + aVt);
  p.ckv_raw = (float*)(base + aVt + al256((size_t)NT * 768 * 2));
  p.act = (bf16_t*)(base + a0);
  const size_t aHb = a0 + al256((size_t)NT * 4096 * 2);
  p.hb = (bf16_t*)(base + aHb);
  if (aHb + (size_t)NT * 1024 * 2 > aSsmY || total > ws_size) { fprintf(stderr, "workspace layout error: total %zu ws %zu\n", total, ws_size); return; }

  const int MULTI = 0;
  hipMemsetAsync(p.counters, 0, 16384, stream);
  if (MULTI) {
    for (int ph = 0; ph < NPHASE; ++ph) {
      p.ph_lo = ph; p.ph_hi = ph + 1;
      hipLaunchKernelGGL(mega<false>, dim3(512), dim3(256), 0, stream, p);
    }
  } else {
    static int grid_blocks = 0;
    if (!grid_blocks) {
      int dev = 0, cus = 0, per_cu = 0;
      hipGetDevice(&dev);
      hipDeviceGetAttribute(&cus, hipDeviceAttributeMultiprocessorCount, dev);
      hipOccupancyMaxActiveBlocksPerMultiprocessor(&per_cu, mega<true>, 256, 0);
      grid_blocks = cus * per_cu;
    }
    p.ph_lo = 0; p.ph_hi = NPHASE;
    void* args[] = {&p};
    hipError_t e = hipLaunchCooperativeKernel((void*)mega<true>, dim3(grid_blocks), dim3(256), args, 0, stream);
    if (e != hipSuccess) fprintf(stderr, "cooperative launch failed: %s (grid %d)\n", hipGetErrorString(e), grid_blocks);
  }
}
```
